# Optimizing an MI355X kernel written in HIP

```python
import math
import jax, jax.numpy as jnp
from jax import lax
import numpy as np

D_MODEL = 1024
BATCH = 4
SEQ = 4096
DEPTH = 2

GRID_W = 64
CTX_LEN = 256
N_MOD = 9
D_FF = 2816
EPS = 1e-6
ROPE_BASE = 10000.0
RET_WIDTH = D_MODEL // 2
RET_HEADS = 4
RET_HEAD_DIM = RET_WIDTH // RET_HEADS
RET_CHUNK = 128
S5_WIDTH = D_MODEL - RET_WIDTH
S5_GROUP = 16
S5_GROUPS = S5_WIDTH // S5_GROUP
S5_STATE = 64
S5_DT_MIN = 0.001
S5_DT_MAX = 0.1
AB_IN_WIDTH = 4 * RET_WIDTH + S5_WIDTH
NA_HEADS = 16
NA_HEAD_DIM = D_MODEL // NA_HEADS
NA_KH_MAX = 8
NA_KW = 16
NA_QBLOCK_W = 16
NA_KSPAN_W = 2 * NA_KW
NEG_INF = -1e30

kernel_name = "hybrid_retention_s5_natten_macaron_dit"


def rms_norm(x, g):
    xf = x.astype(jnp.float32)
    y = xf * lax.rsqrt(jnp.mean(xf * xf, axis=-1, keepdims=True) + EPS)
    return (y * g.astype(jnp.float32)).astype(x.dtype)


def modulate(x, g, shift, scale):
    return rms_norm(x, g) * (1 + scale) + shift


def swiglu(h, w1, w2):
    a, b = jnp.split(h @ w1, 2, axis=-1)
    return (jax.nn.silu(a) * b) @ w2


def axial_rope(x, row, col):
    dh = x.shape[-1]
    half = dh // 2
    quarter = half // 2
    inv = ROPE_BASE ** (-jnp.arange(0, half, 2, dtype=jnp.float32) / half)

    def rot(xp, pos):
        ang = pos.astype(jnp.float32)[:, None] * inv[None, :]
        cos = jnp.cos(ang)[None, :, None, :].astype(x.dtype)
        sin = jnp.sin(ang)[None, :, None, :].astype(x.dtype)
        x1, x2 = xp[..., :quarter], xp[..., quarter:]
        return jnp.concatenate([x1 * cos - x2 * sin, x2 * cos + x1 * sin], axis=-1)

    return jnp.concatenate([rot(x[..., :half], row), rot(x[..., half:], col)], axis=-1)


def retention_scan(q, k, v, log_gamma, s0):
    B, H, L, dk = q.shape
    dv = v.shape[-1]
    C = RET_CHUNK
    N = L // C
    qc = q.reshape(B, H, N, C, dk)
    kc = k.reshape(B, H, N, C, dk)
    vc = v.reshape(B, H, N, C, dv)
    pos = jnp.arange(C, dtype=jnp.float32)
    lg = log_gamma[:, None]
    diff = pos[:, None] - pos[None, :]
    dmask = jnp.where(diff >= 0, jnp.exp(lg[:, :, None] * jnp.maximum(diff, 0.0)), 0.0)
    inner = jnp.einsum('bhnid,bhnjd->bhnij', qc, kc) * dmask[None, :, None]
    o_inner = jnp.einsum('bhnij,bhnje->bhnie', inner, vc)
    k_w = jnp.exp(lg * (C - 1 - pos))
    kv = jnp.einsum('bhnjd,bhnje->nbhde', kc * k_w[None, :, None, :, None], vc)
    chunk_decay = jnp.exp(log_gamma * C)[None, :, None, None]

    def step(s, kv_n):
        return chunk_decay * s + kv_n, s

    s_final, s_prev = lax.scan(step, s0, kv)
    q_w = jnp.exp(lg * (pos + 1.0))
    o_cross = jnp.einsum('bhnid,nbhde->bhnie', qc * q_w[None, :, None, :, None], s_prev)
    return (o_inner + o_cross).reshape(B, H, L, dv), s_final


def retention_mixer(q_l, k_l, v_l, g_l, q_c, k_c, v_c, g_c, decay_logit, row, col, need_ctx):
    def heads(t):
        return t.reshape(t.shape[0], t.shape[1], RET_HEADS, RET_HEAD_DIM)

    def tr(t):
        return jnp.swapaxes(t, 1, 2).astype(jnp.float32)

    kscale = RET_HEAD_DIM ** -0.5
    ql = tr(axial_rope(heads(q_l), row, col))
    kl = tr(axial_rope(heads(k_l), row, col) * kscale)
    vl = tr(heads(v_l))
    qc = tr(heads(q_c))
    kc = tr(heads(k_c) * kscale)
    vc = tr(heads(v_c))
    log_gamma = jax.nn.log_sigmoid(decay_logit.astype(jnp.float32))
    s0 = jnp.zeros((q_l.shape[0], RET_HEADS, RET_HEAD_DIM, RET_HEAD_DIM), jnp.float32)

    def flip(t):
        return jnp.flip(t, axis=2)

    oc_f, sc_f = retention_scan(qc, kc, vc, log_gamma[0], s0)
    oc_b, sc_b = retention_scan(flip(qc), flip(kc), flip(vc), log_gamma[1], s0)
    ol_f, _ = retention_scan(ql, kl, vl, log_gamma[0], sc_f)
    ol_b, _ = retention_scan(flip(ql), flip(kl), flip(vl), log_gamma[1], sc_b)

    def finish(o, g):
        o = o * lax.rsqrt(jnp.mean(o * o, axis=-1, keepdims=True) + EPS)
        Bo, Ho, Lo, do = o.shape
        o = jnp.swapaxes(o, 1, 2).reshape(Bo, Lo, Ho * do)
        return (o * jax.nn.silu(g.astype(jnp.float32))).astype(g.dtype)

    y_l = finish(ol_f + flip(ol_b), g_l)
    y_c = finish(oc_f + flip(oc_b), g_c) if need_ctx else None
    return y_l, y_c


def _ssm_combine(e1, e2):
    a1, b1 = e1
    a2, b2 = e2
    return a1 * a2, a2 * b1 + b2


def ssm_scan(lam_bar, bu):
    a = jnp.broadcast_to(lam_bar, bu.shape)
    _, xs = lax.associative_scan(_ssm_combine, (a, bu), axis=1)
    return xs


def s5_mixer(u_lat, u_ctx, lam_re, lam_im, log_dt, b_re, b_im, c_re, c_im, d_skip, glu_w, glu_b, need_ctx):
    B, L, _ = u_lat.shape
    Lc = u_ctx.shape[1]
    ul = u_lat.astype(jnp.float32).reshape(B, L, S5_GROUPS, S5_GROUP)
    uc = u_ctx.astype(jnp.float32).reshape(B, Lc, S5_GROUPS, S5_GROUP)
    dsk = d_skip.astype(jnp.float32).reshape(S5_GROUPS, S5_GROUP)
    ys_l = dsk * ul
    ys_c = dsk * uc
    for direction in range(2):
        lam = lax.complex(jnp.minimum(lam_re[direction].astype(jnp.float32), -1e-4),
                          lam_im[direction].astype(jnp.float32))
        dt = jnp.exp(log_dt[direction].astype(jnp.float32))[:, None]
        lam_bar = jnp.exp(lam * dt)
        b_bar = ((lam_bar - 1.0) / lam)[..., None] * lax.complex(
            b_re[direction].astype(jnp.float32), b_im[direction].astype(jnp.float32))
        c_mat = lax.complex(c_re[direction].astype(jnp.float32), c_im[direction].astype(jnp.float32))
        if direction == 0:
            order = lambda t: t
        else:
            order = lambda t: jnp.flip(t, axis=1)
        bu_c = jnp.einsum('gpk,blgk->blgp', b_bar, order(uc).astype(jnp.complex64))
        x_c = ssm_scan(lam_bar, bu_c)
        bu_l = jnp.einsum('gpk,blgk->blgp', b_bar, order(ul).astype(jnp.complex64))
        bu_l = bu_l.at[:, 0].add(lam_bar * x_c[:, -1])
        x_l = ssm_scan(lam_bar, bu_l)
        ys_l = ys_l + order(jnp.einsum('gkp,blgp->blgk', c_mat, x_l).real)
        if need_ctx:
            ys_c = ys_c + order(jnp.einsum('gkp,blgp->blgk', c_mat, x_c).real)

    def glu(y, Ly):
        y = jax.nn.gelu(y.reshape(B, Ly, S5_WIDTH))
        y = y * jax.nn.sigmoid(y @ glu_w.astype(jnp.float32) + glu_b.astype(jnp.float32))
        return y.astype(u_lat.dtype)

    y_l = glu(ys_l, L)
    y_c = glu(ys_c, Lc) if need_ctx else None
    return y_l, y_c


def ab_mixer(h_lat, h_ctx, w_in, w_out, decay_logit, lam_re, lam_im, log_dt, b_re, b_im,
             c_re, c_im, d_skip, glu_w, glu_b, row, col, need_ctx):
    cuts = [RET_WIDTH, 2 * RET_WIDTH, 3 * RET_WIDTH, 4 * RET_WIDTH]
    ql, kl, vl, gl, ul = jnp.split(h_lat @ w_in, cuts, axis=-1)
    qc, kc, vc, gc, uc = jnp.split(h_ctx @ w_in, cuts, axis=-1)
    r_l, r_c = retention_mixer(ql, kl, vl, gl, qc, kc, vc, gc, decay_logit, row, col, need_ctx)
    s_l, s_c = s5_mixer(ul, uc, lam_re, lam_im, log_dt, b_re, b_im, c_re, c_im, d_skip, glu_w, glu_b, need_ctx)
    y_l = jnp.concatenate([r_l, s_l], axis=-1) @ w_out
    y_c = (jnp.concatenate([r_c, s_c], axis=-1) @ w_out) if need_ctx else None
    return y_l, y_c


def na_mixer(h_lat, h_ctx, w_qkv, w_o, rpb, need_ctx):
    B, S, _ = h_lat.shape
    rows = S // GRID_W
    kh = min(NA_KH_MAX, rows)
    H, dh = NA_HEADS, NA_HEAD_DIM
    scale = dh ** -0.5
    q, k, v = jnp.split(h_lat @ w_qkv, 3, axis=-1)
    qc, kc, vc = jnp.split(h_ctx @ w_qkv, 3, axis=-1)
    q_g = q.reshape(B, rows, GRID_W, H, dh) * scale
    k_g = k.reshape(B, rows, GRID_W, H, dh)
    v_g = v.reshape(B, rows, GRID_W, H, dh)
    k_c = kc.reshape(B, -1, H, dh)
    v_c = vc.reshape(B, -1, H, dh)
    n_cb = GRID_W // NA_QBLOCK_W
    row_start = jnp.clip(jnp.arange(rows) - kh // 2, 0, rows - kh)
    qcol = np.arange(GRID_W).reshape(n_cb, NA_QBLOCK_W)
    kcol0 = np.clip(np.arange(n_cb) * NA_QBLOCK_W - NA_KW // 2, 0, GRID_W - NA_KSPAN_W)
    kcol = kcol0[:, None] + np.arange(NA_KSPAN_W)
    wstart = np.clip(qcol - NA_KW // 2, 0, GRID_W - NA_KW)
    kc3 = kcol[:, None, :]
    col_valid = jnp.asarray((kc3 >= wstart[..., None]) & (kc3 < wstart[..., None] + NA_KW))
    col_rel = np.clip(kc3 - qcol[..., None], -(NA_KW - 1), NA_KW - 1) + NA_KW - 1
    bias_cols = rpb.astype(jnp.float32)[:, :, col_rel]
    n_loc = kh * NA_KSPAN_W

    def row_block(args):
        r, r0, q_r = args
        k_rows = lax.dynamic_slice_in_dim(k_g, r0, kh, axis=1)
        v_rows = lax.dynamic_slice_in_dim(v_g, r0, kh, axis=1)
        k_blk = k_rows[:, :, kcol]
        v_blk = v_rows[:, :, kcol]
        qb = q_r.reshape(B, n_cb, NA_QBLOCK_W, H, dh)
        s_loc = jnp.einsum('bjqhd,bijlhd->bhjqil', qb, k_blk).astype(jnp.float32)
        rel_r = r0 + jnp.arange(kh) - r + NA_KH_MAX - 1
        bias = jnp.moveaxis(bias_cols[:, rel_r], 1, 3)
        s_loc = jnp.where(col_valid[:, :, None, :], s_loc + bias, NEG_INF)
        s_ctx = jnp.einsum('bjqhd,bkhd->bhjqk', qb, k_c).astype(jnp.float32)
        s = jnp.concatenate([s_loc.reshape(B, H, n_cb, NA_QBLOCK_W, n_loc), s_ctx], axis=-1)
        p = jax.nn.softmax(s, axis=-1).astype(v_g.dtype)
        p_loc = p[..., :n_loc].reshape(B, H, n_cb, NA_QBLOCK_W, kh, NA_KSPAN_W)
        p_ctx = p[..., n_loc:]
        o = (jnp.einsum('bhjqil,bijlhd->bjqhd', p_loc, v_blk)
             + jnp.einsum('bhjqk,bkhd->bjqhd', p_ctx, v_c))
        return o.reshape(B, GRID_W, H * dh)

    o = lax.map(row_block, (jnp.arange(rows), row_start, jnp.moveaxis(q_g, 1, 0)))
    y_l = jnp.moveaxis(o, 0, 1).reshape(B, S, H * dh) @ w_o
    y_c = None
    if need_ctx:
        q_cc = qc.reshape(B, -1, H, dh) * scale
        s = jnp.einsum('bqhd,bkhd->bhqk', q_cc, k_c).astype(jnp.float32)
        p = jax.nn.softmax(s, axis=-1).astype(v_c.dtype)
        oc = jnp.einsum('bhqk,bkhd->bqhd', p, v_c)
        y_c = oc.reshape(B, -1, H * dh) @ w_o
    return y_l, y_c


def setup_inputs(seed: int = 0) -> dict:
    key = jax.random.key(seed)
    ks = jax.random.split(key, 32)
    n_even = (DEPTH + 1) // 2
    n_odd = DEPTH // 2
    nrm = jax.random.normal
    D, F = D_MODEL, D_FF
    x = nrm(ks[0], (BATCH, SEQ, D), jnp.float32)
    c = nrm(ks[1], (BATCH, D), jnp.float32)
    ctx = nrm(ks[2], (BATCH, CTX_LEN, D), jnp.float32)
    c_ctx = nrm(ks[3], (D,), jnp.float32)
    w_mod = nrm(ks[4], (DEPTH, D, N_MOD * D), jnp.float32) * (0.5 * D ** -0.5)
    b_mod = nrm(ks[5], (DEPTH, N_MOD * D), jnp.float32) * 0.02
    norm_g = 1.0 + 0.02 * nrm(ks[6], (DEPTH, 3, D), jnp.float32)
    ffn_w1 = nrm(ks[7], (DEPTH, 2, D, 2 * F), jnp.float32) * D ** -0.5
    ffn_w2 = nrm(ks[8], (DEPTH, 2, F, D), jnp.float32) * F ** -0.5
    w_in_ab = nrm(ks[9], (n_even, D, AB_IN_WIDTH), jnp.float32) * D ** -0.5
    w_out_ab = nrm(ks[10], (n_even, D, D), jnp.float32) * D ** -0.5
    base_logit = jnp.log(2.0 ** (5.0 + jnp.arange(RET_HEADS, dtype=jnp.float32)) - 1.0)
    ret_decay_logit = base_logit + 0.01 * nrm(ks[11], (n_even, 2, RET_HEADS), jnp.float32)
    gp = (n_even, 2, S5_GROUPS, S5_STATE)
    s5_lam_re = -0.5 + 0.01 * nrm(ks[12], gp, jnp.float32)
    s5_lam_im = math.pi * jnp.arange(S5_STATE, dtype=jnp.float32) + 0.01 * nrm(ks[13], gp, jnp.float32)
    s5_log_dt = jax.random.uniform(ks[14], (n_even, 2, S5_GROUPS), jnp.float32,
                                   math.log(S5_DT_MIN), math.log(S5_DT_MAX))
    bsh = (n_even, 2, S5_GROUPS, S5_STATE, S5_GROUP)
    s5_b_re = nrm(ks[15], bsh, jnp.float32) * (2 * S5_GROUP) ** -0.5
    s5_b_im = nrm(ks[16], bsh, jnp.float32) * (2 * S5_GROUP) ** -0.5
    csh = (n_even, 2, S5_GROUPS, S5_GROUP, S5_STATE)
    s5_c_re = nrm(ks[17], csh, jnp.float32) * (2 * S5_STATE) ** -0.5
    s5_c_im = nrm(ks[18], csh, jnp.float32) * (2 * S5_STATE) ** -0.5
    s5_d = nrm(ks[19], (n_even, S5_WIDTH), jnp.float32)
    s5_glu_w = nrm(ks[20], (n_even, S5_WIDTH, S5_WIDTH), jnp.float32) * S5_WIDTH ** -0.5
    s5_glu_b = 0.02 * nrm(ks[21], (n_even, S5_WIDTH), jnp.float32)
    na_w_qkv = nrm(ks[22], (n_odd, D, 3 * D), jnp.float32) * D ** -0.5
    na_w_o = nrm(ks[23], (n_odd, D, D), jnp.float32) * D ** -0.5
    na_rpb = 0.02 * nrm(ks[24], (n_odd, NA_HEADS, 2 * NA_KH_MAX - 1, 2 * NA_KW - 1), jnp.float32)
    final_g = 1.0 + 0.02 * nrm(ks[25], (D,), jnp.float32)
    return {"x": x, "c": c, "ctx": ctx, "c_ctx": c_ctx, "w_mod": w_mod, "b_mod": b_mod,
            "norm_g": norm_g, "ffn_w1": ffn_w1, "ffn_w2": ffn_w2, "w_in_ab": w_in_ab,
            "w_out_ab": w_out_ab, "ret_decay_logit": ret_decay_logit, "s5_lam_re": s5_lam_re,
            "s5_lam_im": s5_lam_im, "s5_log_dt": s5_log_dt, "s5_b_re": s5_b_re, "s5_b_im": s5_b_im,
            "s5_c_re": s5_c_re, "s5_c_im": s5_c_im, "s5_d": s5_d, "s5_glu_w": s5_glu_w,
            "s5_glu_b": s5_glu_b, "na_w_qkv": na_w_qkv, "na_w_o": na_w_o, "na_rpb": na_rpb,
            "final_g": final_g}


def reference(x, c, ctx, c_ctx, w_mod, b_mod, norm_g, ffn_w1, ffn_w2, w_in_ab, w_out_ab,
              ret_decay_logit, s5_lam_re, s5_lam_im, s5_log_dt, s5_b_re, s5_b_im, s5_c_re, s5_c_im,
              s5_d, s5_glu_w, s5_glu_b, na_w_qkv, na_w_o, na_rpb, final_g):
    S = x.shape[1]
    t = jnp.arange(S)
    row = t // GRID_W
    col = t % GRID_W
    h = x
    hc = ctx
    sc = jax.nn.silu(c)
    scc = jax.nn.silu(c_ctx)
    for layer in range(DEPTH):
        last = layer == DEPTH - 1
        i = layer // 2
        ml = jnp.split((sc @ w_mod[layer] + b_mod[layer])[:, None, :], N_MOD, axis=-1)
        mc = jnp.split((scc @ w_mod[layer] + b_mod[layer])[None, None, :], N_MOD, axis=-1)
        h = h + 0.5 * ml[2] * swiglu(modulate(h, norm_g[layer, 0], ml[0], ml[1]), ffn_w1[layer, 0], ffn_w2[layer, 0])
        hc = hc + 0.5 * mc[2] * swiglu(modulate(hc, norm_g[layer, 0], mc[0], mc[1]), ffn_w1[layer, 0], ffn_w2[layer, 0])
        a_l = modulate(h, norm_g[layer, 1], ml[3], ml[4])
        a_c = modulate(hc, norm_g[layer, 1], mc[3], mc[4])
        if layer % 2 == 0:
            y_l, y_c = ab_mixer(a_l, a_c, w_in_ab[i], w_out_ab[i], ret_decay_logit[i], s5_lam_re[i],
                                s5_lam_im[i], s5_log_dt[i], s5_b_re[i], s5_b_im[i], s5_c_re[i], s5_c_im[i],
                                s5_d[i], s5_glu_w[i], s5_glu_b[i], row, col, not last)
        else:
            y_l, y_c = na_mixer(a_l, a_c, na_w_qkv[i], na_w_o[i], na_rpb[i], not last)
        h = h + ml[5] * y_l
        h = h + 0.5 * ml[8] * swiglu(modulate(h, norm_g[layer, 2], ml[6], ml[7]), ffn_w1[layer, 1], ffn_w2[layer, 1])
        if not last:
            hc = hc + mc[5] * y_c
            hc = hc + 0.5 * mc[8] * swiglu(modulate(hc, norm_g[layer, 2], mc[6], mc[7]), ffn_w1[layer, 1], ffn_w2[layer, 1])
    return rms_norm(h, final_g)
```

```cpp
#include <hip/hip_runtime.h>
#include <hip/hip_cooperative_groups.h>
#include <cstdio>
#include <cstdint>
namespace cg = cooperative_groups;

constexpr int DM = 1024, NB = 4, SEQ = 4096, CTXL = 256, FF = 2816, NMOD = 9;
constexpr int ML = NB * SEQ, MC = NB * CTXL, MT = ML + MC;
constexpr int MODW = NMOD * DM;
constexpr float EPS = 1e-6f;

namespace pg8 {
#define PG8_LAS __attribute__((address_space(3)))
typedef unsigned short bf16_t;
typedef short bf16x8 __attribute__((ext_vector_type(8)));
typedef float f32x4 __attribute__((ext_vector_type(4)));
typedef unsigned u32x4 __attribute__((ext_vector_type(4)));
constexpr int BM = 256, BK = 64, HALF = 128, HTB = HALF * BK * 2  , STAGE_BYTES = 8 * HTB, NXCD = 8, WGM = 8;

__host__ __device__ __forceinline__ int lds_byte(int r, int c) { const int st = (r >> 4) * 2 + (c >> 5), rr = r & 15, cc = c & 31, ob = rr * 64 + cc * 2; return st * 1024 + (ob ^ (((ob >> 9) & 1) << 5)); }
__host__ __device__ __forceinline__ void stage_rc(int b, int& R, int& C) { const int st = b / 1024, sb = b % 1024, swz = sb ^ (((sb >> 9) & 1) << 5); R = (st >> 1) * 16 + swz / 64; C = (st & 1) * 32 + (swz % 64) / 2; }
__host__ __device__ __forceinline__ int perm32(int rho) { const int n = rho >> 4, i = rho & 15; return 8 * (i >> 2) + 4 * n + (i & 3); }

struct Unit { int pm, pn; };
struct Gemm { const bf16_t* A; const bf16_t* Bt; int M, N, K; };

struct StaticOrder {
    int nM, nN, nwg, G, c;
    __host__ __device__ void init(int M, int N, int G_, int c_) { nM = M / BM; nN = N / BM; nwg = nM * nN; G = G_; c = c_; }
    __host__ __device__ bool next(int i, Unit& u) const {
        const long L = (long)i * G + c; if (L >= nwg) return false;
        int wgid = (int)L; { const int q = nwg / NXCD, r = nwg % NXCD, xcd = wgid % NXCD, off = wgid / NXCD; wgid = (xcd < r ? xcd * (q + 1) : r * (q + 1) + (xcd - r) * q) + off; }
        const int nig = WGM * nN, gid = wgid / nig, fm = gid * WGM, gsz = (nM - fm) < WGM ? (nM - fm) : WGM;
        u.pm = fm + ((wgid % nig) % gsz); u.pn = (wgid % nig) / gsz; return true;
    }
    __device__ __forceinline__ void a_ready(const Unit&) const {}
    __device__ __forceinline__ void done(const Unit&) const {}
};


__device__ __forceinline__ unsigned cvt_pk_bf16(float lo, float hi) { unsigned r; asm volatile("v_cvt_pk_bf16_f32 %0, %1, %2" : "=v"(r) : "v"(lo), "v"(hi)); return r; }
__device__ __forceinline__ float bf_lo(unsigned w) { return __uint_as_float(w << 16); }
__device__ __forceinline__ float bf_hi(unsigned w) { return __uint_as_float(w & 0xffff0000u); }
__device__ __forceinline__ float fsilu(float a) { return a * __builtin_amdgcn_rcpf(1.0f + __expf(-a)); }
__device__ __forceinline__ float fsigmoid(float a) { return __builtin_amdgcn_rcpf(1.0f + __expf(-a)); }

struct EpiSwiglu {
    static constexpr bool PERM = true, AFTER_DRAIN = false;
    bf16_t* O; int ldo;
    __device__ __forceinline__ void operator()(const f32x4 (&acc)[2][2][4][2], const Unit& u, int wr, int wc, int fr, int fq) const {
        const int row0 = u.pm * BM + wr * 64 + fr, col0 = u.pn * HALF + wc * 32 + 8 * fq;
#pragma unroll
        for (int ai = 0; ai < 2; ++ai)
#pragma unroll
            for (int m = 0; m < 4; ++m) {
                bf16_t* rowp = O + (size_t)(row0 + ai * HALF + m * 16) * ldo + col0;
                float h[8];
#pragma unroll
                for (int n = 0; n < 2; ++n)
#pragma unroll
                    for (int i = 0; i < 4; ++i) { const float a = acc[ai][0][m][n][i], b = acc[ai][1][m][n][i]; h[4 * n + i] = fsilu(a) * b; }
                u32x4 w; w.x = cvt_pk_bf16(h[0], h[1]); w.y = cvt_pk_bf16(h[2], h[3]); w.z = cvt_pk_bf16(h[4], h[5]); w.w = cvt_pk_bf16(h[6], h[7]);
                *(u32x4*)rowp = w;
            }
    }
};

struct EpiResid {
    static constexpr bool PERM = false, AFTER_DRAIN = false;
    const float* rin_lat; const float* rin_ctx; float* rout_lat; float* rout_ctx; const float* gate; float gs;
    __device__ __forceinline__ void operator()(const f32x4 (&acc)[2][2][4][2], const Unit& u, int wr, int wc, int fr, int fq) const {
        const bool lat = u.pm < (ML / BM);
        const int bidx = lat ? (u.pm >> 4) : 4;
        const float* gp = gate + (size_t)bidx * MODW;
        const float* ri = lat ? rin_lat + (size_t)u.pm * BM * DM : rin_ctx + (size_t)(u.pm - ML / BM) * BM * DM;
        float* ro = lat ? rout_lat + (size_t)u.pm * BM * DM : rout_ctx + (size_t)(u.pm - ML / BM) * BM * DM;
        const int col0 = u.pn * BM + wc * 32 + 4 * fq;
        f32x4 gv[2][2];
#pragma unroll
        for (int bj = 0; bj < 2; ++bj)
#pragma unroll
            for (int n = 0; n < 2; ++n) gv[bj][n] = *(const f32x4*)(gp + col0 + bj * HALF + n * 16) * gs;
#pragma unroll
        for (int ai = 0; ai < 2; ++ai)
#pragma unroll
            for (int m = 0; m < 4; ++m) {
                const size_t off = (size_t)(ai * HALF + wr * 64 + m * 16 + fr) * DM + col0;
#pragma unroll
                for (int bj = 0; bj < 2; ++bj)
#pragma unroll
                    for (int n = 0; n < 2; ++n) { const f32x4 r = *(const f32x4*)(ri + off + bj * HALF + n * 16); *(f32x4*)(ro + off + bj * HALF + n * 16) = r + gv[bj][n] * acc[ai][bj][m][n]; }
            }
    }
};

struct EpiWin {
    static constexpr bool PERM = true, AFTER_DRAIN = false;
    bf16_t* QKVG; bf16_t* U; const float* rope;
    __device__ __forceinline__ void operator()(const f32x4 (&acc)[2][2][4][2], const Unit& u, int wr, int wc, int fr, int fq) const {
        const int row0 = u.pm * BM + wr * 64 + fr;
        if (u.pn >= 4) {
            bf16_t* base = u.pn < 8 ? QKVG + u.pn * BM : U + (u.pn - 8) * BM; const int ld = u.pn < 8 ? 2048 : 512;
            const int col0 = wc * 32 + 8 * fq;
#pragma unroll
            for (int ai = 0; ai < 2; ++ai)
#pragma unroll
                for (int m = 0; m < 4; ++m) { bf16_t* rowp = base + (size_t)(row0 + ai * HALF + m * 16) * ld + col0;
#pragma unroll
                    for (int bj = 0; bj < 2; ++bj) { const f32x4 v0 = acc[ai][bj][m][0], v1 = acc[ai][bj][m][1];
                        u32x4 w; w.x = cvt_pk_bf16(v0[0], v0[1]); w.y = cvt_pk_bf16(v0[2], v0[3]); w.z = cvt_pk_bf16(v1[0], v1[1]); w.w = cvt_pk_bf16(v1[2], v1[3]);
                        *(u32x4*)(rowp + bj * HALF) = w; } }
        } else {
            const bool lat = u.pm < (ML / BM);
            const float sc = u.pn >= 2 ? 0.08838834764831845f : 1.0f;
            const int hh = wc >> 1, rot = wc & 1, f0 = 8 * fq;
            const int dcol = u.pn * BM + 128 * hh + 64 * rot + f0;
#pragma unroll
            for (int ai = 0; ai < 2; ++ai)
#pragma unroll
                for (int m = 0; m < 4; ++m) {
                    const int row = row0 + ai * HALF + m * 16;
                    float y1[8], y2[8];
                    const int t = row & (SEQ - 1), pos = rot ? (t & 63) : (t >> 6);
                    const float* rp = rope + (size_t)(pos * 32 + f0) * 2;
#pragma unroll
                    for (int n = 0; n < 2; ++n) {
                        f32x4 cs0 = (f32x4){1.f, 0.f, 1.f, 0.f}, cs1 = cs0;
                        if (lat) { cs0 = *(const f32x4*)(rp + 8 * n); cs1 = *(const f32x4*)(rp + 8 * n + 4); }
                        const f32x4 x1 = acc[ai][0][m][n], x2 = acc[ai][1][m][n];
                        y1[4 * n + 0] = (x1[0] * cs0[0] - x2[0] * cs0[1]) * sc; y2[4 * n + 0] = (x2[0] * cs0[0] + x1[0] * cs0[1]) * sc;
                        y1[4 * n + 1] = (x1[1] * cs0[2] - x2[1] * cs0[3]) * sc; y2[4 * n + 1] = (x2[1] * cs0[2] + x1[1] * cs0[3]) * sc;
                        y1[4 * n + 2] = (x1[2] * cs1[0] - x2[2] * cs1[1]) * sc; y2[4 * n + 2] = (x2[2] * cs1[0] + x1[2] * cs1[1]) * sc;
                        y1[4 * n + 3] = (x1[3] * cs1[2] - x2[3] * cs1[3]) * sc; y2[4 * n + 3] = (x2[3] * cs1[2] + x1[3] * cs1[3]) * sc;
                    }
                    bf16_t* rowp = QKVG + (size_t)row * 2048 + dcol;
                    u32x4 w; w.x = cvt_pk_bf16(y1[0], y1[1]); w.y = cvt_pk_bf16(y1[2], y1[3]); w.z = cvt_pk_bf16(y1[4], y1[5]); w.w = cvt_pk_bf16(y1[6], y1[7]);
                    *(u32x4*)rowp = w;
                    w.x = cvt_pk_bf16(y2[0], y2[1]); w.y = cvt_pk_bf16(y2[2], y2[3]); w.z = cvt_pk_bf16(y2[4], y2[5]); w.w = cvt_pk_bf16(y2[6], y2[7]);
                    *(u32x4*)(rowp + 32) = w;
                }
        }
    }
};

struct EpiGlu {
    static constexpr bool PERM = true, AFTER_DRAIN = false;
    const bf16_t* YS; bf16_t* YM; const float* bias;
    __device__ __forceinline__ void operator()(const f32x4 (&acc)[2][2][4][2], const Unit& u, int wr, int wc, int fr, int fq) const {
        const int row0 = u.pm * BM + wr * 64 + fr, col0 = u.pn * BM + wc * 32 + 8 * fq;
        f32x4 bv[2][2];
#pragma unroll
        for (int bj = 0; bj < 2; ++bj)
#pragma unroll
            for (int n = 0; n < 2; ++n) bv[bj][n] = *(const f32x4*)(bias + col0 + bj * HALF + 4 * n);
#pragma unroll
        for (int ai = 0; ai < 2; ++ai)
#pragma unroll
            for (int m = 0; m < 4; ++m) { const int row = row0 + ai * HALF + m * 16;
#pragma unroll
                for (int bj = 0; bj < 2; ++bj) {
                    const u32x4 yv = *(const u32x4*)(YS + (size_t)row * 512 + col0 + bj * HALF);
                    const f32x4 z0 = acc[ai][bj][m][0] + bv[bj][0], z1 = acc[ai][bj][m][1] + bv[bj][1];
                    u32x4 w;
                    w.x = cvt_pk_bf16(bf_lo(yv.x) * fsigmoid(z0[0]), bf_hi(yv.x) * fsigmoid(z0[1]));
                    w.y = cvt_pk_bf16(bf_lo(yv.y) * fsigmoid(z0[2]), bf_hi(yv.y) * fsigmoid(z0[3]));
                    w.z = cvt_pk_bf16(bf_lo(yv.z) * fsigmoid(z1[0]), bf_hi(yv.z) * fsigmoid(z1[1]));
                    w.w = cvt_pk_bf16(bf_lo(yv.w) * fsigmoid(z1[2]), bf_hi(yv.w) * fsigmoid(z1[3]));
                    *(u32x4*)(YM + (size_t)row * DM + 512 + col0 + bj * HALF) = w; } }
    }
};

struct EpiBf16S {
    static constexpr bool PERM = true, AFTER_DRAIN = false;
    bf16_t* O; int ldo; int nscale; float scale0;
    __device__ __forceinline__ void operator()(const f32x4 (&acc)[2][2][4][2], const Unit& u, int wr, int wc, int fr, int fq) const {
        const int row0 = u.pm * BM + wr * 64 + fr, col0 = u.pn * BM + wc * 32 + 8 * fq;
        const float sc = u.pn < nscale ? scale0 : 1.0f;
#pragma unroll
        for (int ai = 0; ai < 2; ++ai)
#pragma unroll
            for (int m = 0; m < 4; ++m) { bf16_t* rowp = O + (size_t)(row0 + ai * HALF + m * 16) * ldo + col0;
#pragma unroll
                for (int bj = 0; bj < 2; ++bj) { const f32x4 v0 = acc[ai][bj][m][0] * sc, v1 = acc[ai][bj][m][1] * sc;
                    u32x4 w; w.x = cvt_pk_bf16(v0[0], v0[1]); w.y = cvt_pk_bf16(v0[2], v0[3]); w.z = cvt_pk_bf16(v1[0], v1[1]); w.w = cvt_pk_bf16(v1[2], v1[3]);
                    *(u32x4*)(rowp + bj * HALF) = w; } }
    }
};
template <class Epi, class Sched, bool ALIGN_EPI = false, bool SP2 = false>
__device__ __forceinline__ void gemm_phase(PG8_LAS unsigned char* lds, const Gemm g, const Sched& S, const Epi& E) {
    int tid_ = threadIdx.x; asm volatile("" : "+v"(tid_));
    const int tid = tid_, wid = __builtin_amdgcn_readfirstlane(tid >> 6), lane = tid & 63, wr = wid >> 2, wc = wid & 3, fr = lane & 15, fq = lane >> 4;
    const int K = g.K, nt = K / BK;
    unsigned voffA[2], voffB[2];
#pragma unroll
    for (int i = 0; i < 2; ++i) { int R, C; stage_rc(tid * 16 + i * 8192, R, C); const int Rb = Epi::PERM ? ((R & ~31) + perm32(R & 31)) : R;
        voffA[i] = (unsigned)(R * K + C) * 2u; voffB[i] = (unsigned)(Rb * K + C) * 2u; }
    const size_t kstep = (size_t)(BK * 2);
    const size_t hstep = (size_t)HALF * K * 2;
    const size_t tstep = 2 * hstep;
    const unsigned ldsw = (unsigned)wid * 1024u;
    const int aoff = lds_byte(wr * 64 + fr, fq * 8), boff = lds_byte(wc * 32 + fr, fq * 8);
#define PG8_SA(b, h) (((b) * 2 + (h)) * HTB)
#define PG8_SB(b, h) ((4 + (b) * 2 + (h)) * HTB)
#define PG8_STAGE(bufoff, gbase, voff) do { _Pragma("unroll") for (int _i = 0; _i < 2; ++_i) \
        __builtin_amdgcn_global_load_lds((const unsigned*)((const char*)(gbase) + (voff)[_i]), (PG8_LAS unsigned*)(lds + (bufoff) + ldsw + _i * 8192), 16, 0, 0); } while (0)
#define PG8_LDA(dst, b, h) do { _Pragma("unroll") for (int m = 0; m < 4; ++m) _Pragma("unroll") for (int k = 0; k < 2; ++k) dst[m][k] = *(const PG8_LAS bf16x8*)(lds + PG8_SA(b, h) + aoff + m * 2048 + k * 1024); } while (0)
#define PG8_LDB(dst, b, h) do { _Pragma("unroll") for (int n = 0; n < 2; ++n) _Pragma("unroll") for (int k = 0; k < 2; ++k) dst[n][k] = *(const PG8_LAS bf16x8*)(lds + PG8_SB(b, h) + boff + n * 2048 + k * 1024); } while (0)
#define PG8_MMA(ai, bj, At, Bt) do { __builtin_amdgcn_s_setprio(1); _Pragma("unroll") for (int m = 0; m < 4; ++m) _Pragma("unroll") for (int n = 0; n < 2; ++n) _Pragma("unroll") for (int k = 0; k < 2; ++k) \
        acc[ai][bj][m][n] = __builtin_amdgcn_mfma_f32_16x16x32_bf16(Bt[n][k], At[m][k], acc[ai][bj][m][n], 0, 0, 0); __builtin_amdgcn_s_setprio(0); } while (0)
#define PG8_WAIT_V(n) asm volatile("s_waitcnt vmcnt(" #n ")" ::: "memory")
#define PG8_WAIT_L(n) asm volatile("s_waitcnt lgkmcnt(" #n ")" ::: "memory")
#define PG8_BAR __builtin_amdgcn_s_barrier()
#define PG8_SCHED __builtin_amdgcn_sched_barrier(0)
    Unit cur, nxt; int ui = 0;
    if (!S.next(0, cur)) return;
    f32x4 acc[2][2][4][2];
#pragma unroll
    for (int a = 0; a < 2; ++a)
#pragma unroll
        for (int b = 0; b < 2; ++b)
#pragma unroll
            for (int m = 0; m < 4; ++m)
#pragma unroll
                for (int n = 0; n < 2; ++n) acc[a][b][m][n] = (f32x4){0.f, 0.f, 0.f, 0.f};
    bf16x8 At[4][2], B0[2][2], B1[2][2];
    const char* cA = (const char*)g.A + (size_t)cur.pm * tstep; const char* cB = (const char*)g.Bt + (size_t)cur.pn * tstep;
    S.a_ready(cur);
    if constexpr (SP2) {
        PG8_STAGE(PG8_SB(0, 0), cB, voffB); PG8_STAGE(PG8_SB(0, 1), cB + hstep, voffB); PG8_STAGE(PG8_SA(0, 0), cA, voffA); PG8_STAGE(PG8_SA(0, 1), cA + hstep, voffA);
        if (wr == 1) PG8_BAR;
        PG8_WAIT_V(2); PG8_BAR;
        PG8_STAGE(PG8_SB(1, 0), cB + kstep, voffB); PG8_STAGE(PG8_SA(1, 0), cA + kstep, voffA); PG8_STAGE(PG8_SB(1, 1), cB + hstep + kstep, voffB);
        PG8_WAIT_V(6); PG8_BAR;
    } else {
        PG8_STAGE(PG8_SB(0, 0), cB, voffB); PG8_STAGE(PG8_SA(0, 0), cA, voffA); PG8_STAGE(PG8_SB(0, 1), cB + hstep, voffB); PG8_STAGE(PG8_SA(0, 1), cA + hstep, voffA);
        if (wr == 1) PG8_BAR;
        PG8_WAIT_V(4); PG8_BAR;
        PG8_STAGE(PG8_SB(1, 0), cB + kstep, voffB); PG8_STAGE(PG8_SA(1, 0), cA + kstep, voffA); PG8_STAGE(PG8_SB(1, 1), cB + hstep + kstep, voffB);
        PG8_WAIT_V(6); PG8_BAR;
    }
    for (;;) {
        const bool has_next = S.next(ui + 1, nxt);
        const char* nA = has_next ? (const char*)g.A + (size_t)nxt.pm * tstep : cA; const char* nB = has_next ? (const char*)g.Bt + (size_t)nxt.pn * tstep : cB;
        for (int t = 0; t < nt; t += 2) {
            const bool last = (t == nt - 2);
            const char* a1 = cA + (size_t)(t + 1) * kstep;
            const char* a2 = last ? nA : cA + (size_t)(t + 2) * kstep; const char* b2 = last ? nB : cB + (size_t)(t + 2) * kstep;
            const char* a3 = a2 + kstep; const char* b3 = b2 + kstep;
            if (last && has_next) S.a_ready(nxt);
            if constexpr (SP2) {
            PG8_LDB(B0, 0, 0); PG8_LDB(B1, 0, 1); PG8_SCHED; PG8_LDA(At, 0, 0); PG8_STAGE(PG8_SA(1, 1), a1 + hstep, voffA);
            PG8_WAIT_V(8); PG8_WAIT_L(0); PG8_BAR; PG8_MMA(0, 0, At, B0); PG8_MMA(0, 1, At, B1); PG8_BAR; PG8_SCHED;
            PG8_LDA(At, 0, 1); PG8_STAGE(PG8_SB(0, 0), b2, voffB); PG8_STAGE(PG8_SB(0, 1), b2 + hstep, voffB); PG8_STAGE(PG8_SA(0, 0), a2, voffA);
            PG8_WAIT_V(8); PG8_WAIT_L(0); PG8_BAR; PG8_MMA(1, 0, At, B0); PG8_MMA(1, 1, At, B1); PG8_BAR; PG8_SCHED;
            PG8_LDB(B0, 1, 0); PG8_LDB(B1, 1, 1); PG8_SCHED; PG8_LDA(At, 1, 0); PG8_STAGE(PG8_SA(0, 1), a2 + hstep, voffA);
            PG8_WAIT_V(8); PG8_WAIT_L(0); PG8_BAR; PG8_MMA(0, 0, At, B0); PG8_MMA(0, 1, At, B1); PG8_BAR; PG8_SCHED;
            PG8_LDA(At, 1, 1); PG8_STAGE(PG8_SB(1, 0), b3, voffB); PG8_STAGE(PG8_SB(1, 1), b3 + hstep, voffB); PG8_STAGE(PG8_SA(1, 0), a3, voffA);
            PG8_WAIT_V(8); PG8_WAIT_L(0); PG8_BAR; PG8_MMA(1, 0, At, B0); PG8_MMA(1, 1, At, B1); PG8_BAR; PG8_SCHED;
            } else {
            PG8_LDB(B0, 0, 0); PG8_SCHED; PG8_LDA(At, 0, 0); PG8_STAGE(PG8_SA(1, 1), a1 + hstep, voffA);
            PG8_WAIT_L(8); PG8_BAR; PG8_WAIT_L(0); PG8_MMA(0, 0, At, B0); PG8_BAR; PG8_SCHED;
            PG8_LDB(B1, 0, 1); PG8_STAGE(PG8_SB(0, 0), b2, voffB);
            PG8_BAR; PG8_WAIT_L(0); PG8_MMA(0, 1, At, B1); PG8_BAR;
            PG8_LDA(At, 0, 1); PG8_STAGE(PG8_SA(0, 0), a2, voffA);
            PG8_BAR; PG8_WAIT_L(0); PG8_MMA(1, 0, At, B0); PG8_BAR; PG8_SCHED;
            PG8_STAGE(PG8_SB(0, 1), b2 + hstep, voffB);
            PG8_WAIT_V(6); PG8_BAR; PG8_MMA(1, 1, At, B1); PG8_BAR;
            PG8_LDB(B0, 1, 0); PG8_SCHED; PG8_LDA(At, 1, 0); PG8_STAGE(PG8_SA(0, 1), a2 + hstep, voffA);
            PG8_WAIT_L(8); PG8_BAR; PG8_WAIT_L(0); PG8_MMA(0, 0, At, B0); PG8_BAR; PG8_SCHED;
            PG8_LDB(B1, 1, 1); PG8_STAGE(PG8_SB(1, 0), b3, voffB);
            PG8_BAR; PG8_WAIT_L(0); PG8_MMA(0, 1, At, B1); PG8_BAR;
            PG8_LDA(At, 1, 1); PG8_STAGE(PG8_SA(1, 0), a3, voffA);
            PG8_BAR; PG8_WAIT_L(0); PG8_MMA(1, 0, At, B0); PG8_BAR; PG8_SCHED;
            PG8_STAGE(PG8_SB(1, 1), b3 + hstep, voffB);
            PG8_WAIT_V(6); PG8_BAR; PG8_MMA(1, 1, At, B1); PG8_BAR;
            }
        }
        if constexpr (ALIGN_EPI) { if (wr == 0) PG8_BAR; }
        if constexpr (!Epi::AFTER_DRAIN) { E(acc, cur, wr, wc, fr, fq); S.done(cur); }
        if (!has_next) break;
#pragma unroll
        for (int a = 0; a < 2; ++a)
#pragma unroll
            for (int b = 0; b < 2; ++b)
#pragma unroll
                for (int m = 0; m < 4; ++m)
#pragma unroll
                    for (int n = 0; n < 2; ++n) acc[a][b][m][n] = (f32x4){0.f, 0.f, 0.f, 0.f};
        cur = nxt; cA = nA; cB = nB; ++ui;
        if constexpr (ALIGN_EPI) { if (wr == 1) PG8_BAR; }
    }
    PG8_WAIT_V(0);
    if constexpr (!ALIGN_EPI) { if (wr == 0) PG8_BAR; }
    PG8_BAR;
    if constexpr (Epi::AFTER_DRAIN) { E.fused(acc, cur, wr, wc, fr, fq, lds, wid, lane); S.done(cur); }
#undef PG8_SA
#undef PG8_SB
#undef PG8_STAGE
#undef PG8_LDA
#undef PG8_LDB
#undef PG8_MMA
#undef PG8_WAIT_V
#undef PG8_WAIT_L
#undef PG8_BAR
#undef PG8_SCHED
}
}

#define LAS __attribute__((address_space(3)))
typedef unsigned short bf16;
typedef unsigned v4u __attribute__((ext_vector_type(4)));
typedef unsigned v2u __attribute__((ext_vector_type(2)));
typedef float f32x4 __attribute__((ext_vector_type(4)));
typedef float f32x2 __attribute__((ext_vector_type(2)));
typedef short bf16x8 __attribute__((ext_vector_type(8)));
typedef short s16x4 __attribute__((ext_vector_type(4)));

constexpr size_t MiB = 1u << 20;
constexpr size_t WS_MOD   = 1 * MiB;
constexpr size_t WS_ROPE  = WS_MOD + 512 * 1024;
constexpr size_t WS_LB    = WS_ROPE + 64 * 1024;
constexpr size_t WS_LBT   = WS_LB + 64 * 1024;
constexpr size_t WS_BBR   = WS_LBT + 64 * 1024;
constexpr size_t WS_BBI   = WS_BBR + 256 * 1024;
constexpr size_t WS_CM    = WS_BBI + 256 * 1024;
static_assert(WS_CM + 256 * 1024 <= 4 * MiB, "param block");
constexpr size_t WS_W1    = 4 * MiB;
constexpr size_t WS_W2    = 48 * MiB;
constexpr size_t WS_WIN   = 70 * MiB;
constexpr size_t WS_WOUT  = 75 * MiB;
constexpr size_t WS_GLU   = 77 * MiB;
constexpr size_t WS_WQKV  = 78 * MiB;
constexpr size_t WS_WO    = 84 * MiB;
constexpr size_t WS_HCTX  = 86 * MiB;
constexpr size_t WS_XN    = 90 * MiB;
constexpr size_t WS_R     = 124 * MiB;
constexpr size_t WS_HID   = WS_R;
constexpr size_t WS_QKVG  = WS_R;
constexpr size_t WS_U     = WS_R + 68 * MiB;
constexpr size_t WS_KVS   = WS_R + 85 * MiB;
constexpr size_t WS_SF    = WS_R + 119 * MiB;
constexpr size_t WS_YS    = WS_R + 128 * MiB;
constexpr size_t WS_QK    = WS_R;
constexpr size_t WS_VT    = WS_R + 68 * MiB;
constexpr size_t WS_END   = WS_R + 145 * MiB;

constexpr int NWAVES = 8, NTHREADS = 512;
constexpr int LDS_BYTES = 147456;

struct Args {
    const float* in[26]; float* out; unsigned char* ws; int probe; int pad;
};
enum { I_X = 0, I_C, I_CTX, I_CCTX, I_WMOD, I_BMOD, I_NORMG, I_W1, I_W2, I_WIN, I_WOUT, I_DECAY, I_LAMRE, I_LAMIM, I_LOGDT, I_BRE, I_BIM, I_CRE, I_CIM,
       I_S5D, I_GLUW, I_GLUB, I_WQKV, I_WO, I_RPB, I_FINALG };

__device__ __forceinline__ unsigned f2bf(float f) { unsigned u = __builtin_bit_cast(unsigned, f); return (u + 0x7fffu + ((u >> 16) & 1u)) >> 16; }
__device__ __forceinline__ unsigned pk2(float lo, float hi) { return f2bf(lo) | (f2bf(hi) << 16); }
__device__ __forceinline__ float bf2f(unsigned short h) { return __uint_as_float((unsigned)h << 16); }
__device__ __forceinline__ float blo(unsigned w) { return __uint_as_float(w << 16); }
__device__ __forceinline__ float bhi(unsigned w) { return __uint_as_float(w & 0xffff0000u); }
__device__ __forceinline__ int opaque_tid() { int t = threadIdx.x; asm volatile("" : "+v"(t)); return t; }
__device__ __forceinline__ float wave_sum(float v) {
#pragma unroll
    for (int o = 1; o < 64; o <<= 1) v += __shfl_xor(v, o);
    return v;
}
__device__ __forceinline__ void sincos_acc(float x, float& s, float& c) {
    const float k = rintf(x * 0.6366197723675814f);
    float r = fmaf(k, -1.5703125f, x); r = fmaf(k, -4.837512969970703125e-4f, r); r = fmaf(k, -7.54978995489188216e-8f, r);
    const float r2 = r * r;
    float sp = 2.7557319e-6f; sp = fmaf(sp, r2, -1.9841270e-4f); sp = fmaf(sp, r2, 8.3333333e-3f); sp = fmaf(sp, r2, -1.6666667e-1f); sp = fmaf(sp * r2, r, r);
    float cp = -2.7557319e-7f; cp = fmaf(cp, r2, 2.4801587e-5f); cp = fmaf(cp, r2, -1.3888889e-3f); cp = fmaf(cp, r2, 4.1666667e-2f); cp = fmaf(cp, r2, -0.5f); cp = fmaf(cp, r2, 1.0f);
    const int q = ((int)k) & 3;
    s = (q == 0) ? sp : (q == 1) ? cp : (q == 2) ? -sp : -cp;
    c = (q == 0) ? cp : (q == 1) ? -sp : (q == 2) ? -cp : sp;
}
__device__ __forceinline__ float gelu_tanh(float v) {
    const float t = 0.7978845608028654f * (v + 0.044715f * v * v * v);
    const float e = __expf(2.0f * t);
    const float th = 1.0f - 2.0f * __builtin_amdgcn_rcpf(e + 1.0f);
    return 0.5f * v * (1.0f + th);
}

__device__ __forceinline__ int map_row(int kind, int n) {
    if (kind == 1) { const int j = n < FF ? n : n - FF; return 256 * (j >> 7) + (n < FF ? 0 : 128) + (j & 127); }
    if (kind == 2 && n < 1024) { const int tile = n >> 8, hh = (n >> 7) & 1, d = n & 127; return 256 * tile + 128 * ((d >> 5) & 1) + 64 * hh + 32 * (d >> 6) + (d & 31); }
    return n;
}
__device__ __forceinline__ void p0_transpose_item(const float* W, int K, int N, int kind, bf16* WT, LAS float* scr, int item, int lane) {
    const int nblk = N / 32, kb = item / nblk, nb = item % nblk, k0 = 64 * kb, n0 = 32 * nb;
    const int drow = map_row(kind, n0);
#pragma unroll 8
    for (int i = 0; i < 32; ++i) { const int kk = 2 * i + (lane >> 5); scr[kk * 33 + (lane & 31)] = W[(size_t)(k0 + kk) * N + n0 + (lane & 31)]; }
    asm volatile("s_waitcnt lgkmcnt(0)" ::: "memory");
    const int c = lane & 7;
#pragma unroll
    for (int j = 0; j < 4; ++j) { const int n = (lane >> 3) + 8 * j; const LAS float* s = scr + (8 * c) * 33 + n;
        v4u o; o.x = pk2(s[0 * 33], s[1 * 33]); o.y = pk2(s[2 * 33], s[3 * 33]); o.z = pk2(s[4 * 33], s[5 * 33]); o.w = pk2(s[6 * 33], s[7 * 33]);
        *(v4u*)(WT + (size_t)(drow + n) * K + k0 + 8 * c) = o; }
    asm volatile("s_waitcnt lgkmcnt(0)" ::: "memory");
}

struct WDesc { const float* W; bf16* dst; int K, N, kind, items; };
__device__ __forceinline__ WDesc wdesc(const Args& a, int mi) {
    WDesc d;
    if (mi < 4)       { d.W = a.in[I_W1] + (size_t)mi * DM * 2 * FF; d.dst = (bf16*)(a.ws + WS_W1) + (size_t)mi * 2 * FF * DM; d.K = DM; d.N = 2 * FF; d.kind = 1; }
    else if (mi < 8)  { d.W = a.in[I_W2] + (size_t)(mi - 4) * FF * DM; d.dst = (bf16*)(a.ws + WS_W2) + (size_t)(mi - 4) * DM * FF; d.K = FF; d.N = DM; d.kind = 0; }
    else if (mi == 8) { d.W = a.in[I_WIN]; d.dst = (bf16*)(a.ws + WS_WIN); d.K = DM; d.N = 2560; d.kind = 2; }
    else if (mi == 9) { d.W = a.in[I_WOUT]; d.dst = (bf16*)(a.ws + WS_WOUT); d.K = DM; d.N = DM; d.kind = 0; }
    else if (mi == 10){ d.W = a.in[I_GLUW]; d.dst = (bf16*)(a.ws + WS_GLU); d.K = 512; d.N = 512; d.kind = 0; }
    else if (mi == 11){ d.W = a.in[I_WQKV]; d.dst = (bf16*)(a.ws + WS_WQKV); d.K = DM; d.N = 3072; d.kind = 0; }
    else              { d.W = a.in[I_WO]; d.dst = (bf16*)(a.ws + WS_WO); d.K = DM; d.N = DM; d.kind = 0; }
    d.items = (d.K / 64) * (d.N / 32);
    return d;
}
constexpr int NWMAT = 13;

__device__ __forceinline__ void p0_prologue(const Args& a, LAS unsigned char* lds, int G) {
    const int tid = opaque_tid(), lane = tid & 63, wave = __builtin_amdgcn_readfirstlane(tid >> 6);
    {
        LAS float* sv = (LAS float*)lds;
        LAS float* red = (LAS float*)(lds + 32768);
        bool have = false;
        for (int it = blockIdx.x; it < 2 * (MODW / 64); it += G) {
            if (!have) {
                for (int i = tid; i < 5 * DM; i += NTHREADS) { const int b = i >> 10, k = i & 1023; const float v = b < 4 ? a.in[I_C][b * DM + k] : a.in[I_CCTX][k]; sv[k * 8 + b] = v / (1.0f + expf(-v)); }
                __syncthreads(); have = true;
            }
            const int layer = it / (MODW / 64), n = (it % (MODW / 64)) * 64 + lane;
            const float* wp = a.in[I_WMOD] + (size_t)layer * DM * MODW + n;
            float acc[5] = {0.f, 0.f, 0.f, 0.f, 0.f};
#pragma unroll 8
            for (int kk = 0; kk < 128; ++kk) { const int k = wave * 128 + kk; const float w = wp[(size_t)k * MODW];
                const f32x4 s0 = *(const LAS f32x4*)(sv + k * 8); const float s4 = sv[k * 8 + 4];
                acc[0] = fmaf(s0[0], w, acc[0]); acc[1] = fmaf(s0[1], w, acc[1]); acc[2] = fmaf(s0[2], w, acc[2]); acc[3] = fmaf(s0[3], w, acc[3]); acc[4] = fmaf(s4, w, acc[4]); }
#pragma unroll
            for (int b = 0; b < 5; ++b) red[(wave * 5 + b) * 64 + lane] = acc[b];
            __syncthreads();
            if (tid < 320) { const int b = tid >> 6, l = tid & 63, nn = (it % (MODW / 64)) * 64 + l; float s = a.in[I_BMOD][layer * MODW + nn];
#pragma unroll
                for (int w = 0; w < 8; ++w) s += red[(w * 5 + b) * 64 + l];
                ((float*)(a.ws + WS_MOD))[((size_t)layer * 5 + b) * MODW + nn] = s; }
            __syncthreads();
        }
        __syncthreads();
    }
    const int gtid = blockIdx.x * NTHREADS + tid, GT = G * NTHREADS;
    for (int i = gtid; i < 64 * 32; i += GT) { const int pos = i >> 5, f = i & 31; const float inv = exp2f(-(float)f * (13.287712379549449f / 32.0f));
        float s, c; sincos_acc((float)pos * inv, s, c); ((f32x2*)(a.ws + WS_ROPE))[i] = (f32x2){c, s}; }
    for (int i = gtid; i < 2 * 32 * 64; i += GT) {
        const int p = i & 63, dg = i >> 6;
        const float lr = fminf(a.in[I_LAMRE][i], -1e-4f), li = a.in[I_LAMIM][i], dt = expf(a.in[I_LOGDT][dg]);
        float s, c; sincos_acc(li * dt, s, c); const float mg = expf(lr * dt); const float br = mg * c, bi = mg * s;
        ((f32x2*)(a.ws + WS_LB))[i] = (f32x2){br, bi};
        float s64, c64; sincos_acc(li * dt * 64.0f, s64, c64); const float m64 = expf(lr * dt * 64.0f);
        ((f32x2*)(a.ws + WS_LBT))[i] = (f32x2){m64 * c64, m64 * s64};
        const float nr = br - 1.0f, ni = bi, den = 1.0f / (lr * lr + li * li);
        const float cr = (nr * lr + ni * li) * den, ci = (ni * lr - nr * li) * den;
        for (int k = 0; k < 16; ++k) {
            const float bre = a.in[I_BRE][(size_t)i * 16 + k], bim = a.in[I_BIM][(size_t)i * 16 + k];
            ((float*)(a.ws + WS_BBR))[((size_t)dg * 16 + k) * 64 + p] = cr * bre - ci * bim;
            ((float*)(a.ws + WS_BBI))[((size_t)dg * 16 + k) * 64 + p] = cr * bim + ci * bre;
            const float cre = a.in[I_CRE][((size_t)dg * 16 + k) * 64 + p], cim = a.in[I_CIM][((size_t)dg * 16 + k) * 64 + p];
            ((unsigned*)(a.ws + WS_CM))[((size_t)dg * 16 + k) * 64 + p] = pk2(cre, -cim);
        }
    }
    {
        LAS float* scr = (LAS float*)(lds + wave * 16384);
        const int gw = blockIdx.x * NWAVES + wave, NGW = G * NWAVES;
        int total = 0;
        for (int mi = 0; mi < NWMAT; ++mi) total += wdesc(a, mi).items;
        for (int it = gw; it < total; it += NGW) {
            int r = it;
            for (int mi = 0; mi < NWMAT; ++mi) { const WDesc d = wdesc(a, mi); if (r < d.items) { p0_transpose_item(d.W, d.K, d.N, d.kind, d.dst, scr, r, lane); break; } r -= d.items; }
        }
    }
}

__device__ __forceinline__ void norm_phase(const float* src_lat, const float* src_ctx, bf16* XN, const float* g, const float* mod  , int ishift, int nrows, int G) {
    const int tid = opaque_tid(), lane = tid & 63, wave = __builtin_amdgcn_readfirstlane(tid >> 6);
    const int gw = blockIdx.x * NWAVES + wave, NGW = G * NWAVES;
    f32x4 gv[4];
#pragma unroll
    for (int j = 0; j < 4; ++j) gv[j] = *((const f32x4*)g + lane + 64 * j);
    for (int row = gw; row < nrows; row += NGW) {
        const float* xr = row < ML ? src_lat + (size_t)row * DM : src_ctx + (size_t)(row - ML) * DM;
        const int bidx = row < ML ? (row >> 12) : 4;
        const float* sh = mod + (size_t)bidx * MODW + ishift * DM; const float* sc = sh + DM;
        f32x4 v[4]; float s = 0.f;
#pragma unroll
        for (int j = 0; j < 4; ++j) { v[j] = *((const f32x4*)xr + lane + 64 * j); s += (v[j][0] * v[j][0] + v[j][1] * v[j][1]) + (v[j][2] * v[j][2] + v[j][3] * v[j][3]); }
        const float rstd = rsqrtf(wave_sum(s) * (1.0f / DM) + EPS);
#pragma unroll
        for (int j = 0; j < 4; ++j) {
            const f32x4 shv = *((const f32x4*)sh + lane + 64 * j), scv = *((const f32x4*)sc + lane + 64 * j);
            const f32x4 y = v[j] * rstd * gv[j] * (scv + 1.0f) + shv;
            *((v2u*)(XN + (size_t)row * DM) + lane + 64 * j) = (v2u){pk2(y[0], y[1]), pk2(y[2], y[3])};
        }
    }
}
__device__ __forceinline__ void final_norm_phase(float* io, const float* g, int G) {
    const int tid = opaque_tid(), lane = tid & 63, wave = __builtin_amdgcn_readfirstlane(tid >> 6);
    const int gw = blockIdx.x * NWAVES + wave, NGW = G * NWAVES;
    f32x4 gv[4];
#pragma unroll
    for (int j = 0; j < 4; ++j) gv[j] = *((const f32x4*)g + lane + 64 * j);
    for (int row = gw; row < ML; row += NGW) {
        float* xr = io + (size_t)row * DM;
        f32x4 v[4]; float s = 0.f;
#pragma unroll
        for (int j = 0; j < 4; ++j) { v[j] = *((const f32x4*)xr + lane + 64 * j); s += (v[j][0] * v[j][0] + v[j][1] * v[j][1]) + (v[j][2] * v[j][2] + v[j][3] * v[j][3]); }
        const float rstd = rsqrtf(wave_sum(s) * (1.0f / DM) + EPS);
#pragma unroll
        for (int j = 0; j < 4; ++j) *((f32x4*)xr + lane + 64 * j) = v[j] * rstd * gv[j];
    }
}

typedef float f32x4m __attribute__((ext_vector_type(4)));
#define MFMA16(a, b, c) __builtin_amdgcn_mfma_f32_16x16x32_bf16((a), (b), (c), 0, 0, 0)
__device__ __forceinline__ unsigned off_b(unsigned row, unsigned ch) { return 256u * row + 16u * (ch ^ (((row & 3u) << 2) | ((row >> 2) & 3u))); }
__device__ __forceinline__ bf16x8 tr_frag(LAS unsigned char* tile, int lane, int c, int ks) {
    const unsigned g = lane >> 4, q = (lane & 15) >> 2, p = lane & 3;
    const s16x4 lo = __builtin_amdgcn_ds_read_tr16_b64_v4i16((LAS s16x4*)(tile + off_b(32 * ks + 8 * g + q, 2 * c + (p >> 1)) + 8 * (p & 1)));
    const s16x4 hi = __builtin_amdgcn_ds_read_tr16_b64_v4i16((LAS s16x4*)(tile + off_b(32 * ks + 8 * g + 4 + q, 2 * c + (p >> 1)) + 8 * (p & 1)));
    return (bf16x8){lo[0], lo[1], lo[2], lo[3], hi[0], hi[1], hi[2], hi[3]};
}
__device__ __forceinline__ bf16x8 pack8(const f32x4 a, const f32x4 b) {
    v4u w; w.x = pk2(a[0], a[1]); w.y = pk2(a[2], a[3]); w.z = pk2(b[0], b[1]); w.w = pk2(b[2], b[3]);
    return __builtin_bit_cast(bf16x8, w);
}
__device__ __forceinline__ float log_sigmoid(float x) { return -log1pf(expf(-x)); }

__device__ __forceinline__ int ret_row0(int b, int s) { return s < 2 ? ML + b * CTXL + s * 128 : b * SEQ + (s - 2) * 128; }

__device__ __forceinline__ void r1_unit(const Args& a, LAS unsigned char* lds, int unit) {
    const int tid = opaque_tid(), lane = tid & 63, wave = __builtin_amdgcn_readfirstlane(tid >> 6);
    const int s = unit % 34, bh = unit / 34, h = bh & 3, b = bh >> 2, row0 = ret_row0(b, s);
    const bf16* QKVG = (const bf16*)(a.ws + WS_QKVG);
    const float lgf = log_sigmoid(a.in[I_DECAY][h]), lgb = log_sigmoid(a.in[I_DECAY][4 + h]);
#pragma unroll
    for (int it = 0; it < 4; ++it) {
        const int n = tid + NTHREADS * it, row = n >> 4, ch = n & 15;
        const bf16* kp = QKVG + (size_t)(row0 + row) * 2048 + 512 + 128 * h + 8 * ch;
        const v4u kv = *(const v4u*)kp, vv = *(const v4u*)(kp + 512);
        const float wf = expf(lgf * (float)(127 - row)), wb = expf(lgb * (float)row);
        v4u kf, kb;
        kf.x = pk2(blo(kv.x) * wf, bhi(kv.x) * wf); kf.y = pk2(blo(kv.y) * wf, bhi(kv.y) * wf); kf.z = pk2(blo(kv.z) * wf, bhi(kv.z) * wf); kf.w = pk2(blo(kv.w) * wf, bhi(kv.w) * wf);
        kb.x = pk2(blo(kv.x) * wb, bhi(kv.x) * wb); kb.y = pk2(blo(kv.y) * wb, bhi(kv.y) * wb); kb.z = pk2(blo(kv.z) * wb, bhi(kv.z) * wb); kb.w = pk2(blo(kv.w) * wb, bhi(kv.w) * wb);
        const unsigned o = off_b(row, ch);
        *(LAS v4u*)(lds + o) = kf; *(LAS v4u*)(lds + 32768 + o) = kb; *(LAS v4u*)(lds + 65536 + o) = vv;
    }
    __syncthreads();
    f32x4 accf[8], accb[8];
#pragma unroll
    for (int c = 0; c < 8; ++c) { accf[c] = (f32x4){0.f, 0.f, 0.f, 0.f}; accb[c] = (f32x4){0.f, 0.f, 0.f, 0.f}; }
#pragma unroll
    for (int ks = 0; ks < 4; ++ks) {
        const bf16x8 kf = tr_frag(lds, lane, wave, ks), kb = tr_frag(lds + 32768, lane, wave, ks);
#pragma unroll
        for (int c = 0; c < 8; ++c) { const bf16x8 vf = tr_frag(lds + 65536, lane, c, ks); accf[c] = MFMA16(kf, vf, accf[c]); accb[c] = MFMA16(kb, vf, accb[c]); }
    }
    bf16* Sf = (bf16*)(a.ws + WS_KVS) + ((size_t)(bh * 2 + 0) * 34 + s) * 16384;
    bf16* Sb = (bf16*)(a.ws + WS_KVS) + ((size_t)(bh * 2 + 1) * 34 + s) * 16384;
    const int d0 = 16 * wave + 4 * (lane >> 4);
#pragma unroll
    for (int c = 0; c < 8; ++c) { const int e = 16 * c + (lane & 15);
        *(v2u*)(Sf + e * 128 + d0) = (v2u){pk2(accf[c][0], accf[c][1]), pk2(accf[c][2], accf[c][3])};
        *(v2u*)(Sb + e * 128 + d0) = (v2u){pk2(accb[c][0], accb[c][1]), pk2(accb[c][2], accb[c][3])}; }
    __syncthreads();
}

__device__ __forceinline__ void r2_items(const Args& a, int G) {
    const int gtid = blockIdx.x * NTHREADS + opaque_tid(), GT = G * NTHREADS;
    for (int idx = gtid; idx < 32 * 4096; idx += GT) {
        const int bhd = idx >> 12, o4 = idx & 4095, dir = bhd & 1, h = (bhd >> 1) & 3;
        const float decay = expf(log_sigmoid(a.in[I_DECAY][dir * 4 + h]) * 128.0f);
        bf16* base = (bf16*)(a.ws + WS_KVS) + (size_t)bhd * 34 * 16384 + o4 * 4;
        const long step = dir == 0 ? 16384 : -16384;
        bf16* p0 = base + (dir == 0 ? 0 : 16384); bf16* p2 = base + (dir == 0 ? 2 * 16384 : 33 * 16384);
        v2u v[34];
        { bf16* p = p0;
#pragma unroll
          for (int i = 0; i < 34; ++i) { if (i == 2) p = p2; v[i] = *(const v2u*)p; p += step; asm volatile("" : "+v"(p)); } }
        float st0 = 0.f, st1 = 0.f, st2 = 0.f, st3 = 0.f;
        { bf16* p = p0;
#pragma unroll
          for (int i = 0; i < 34; ++i) { if (i == 2) p = p2;
            *(v2u*)p = (v2u){pk2(st0, st1), pk2(st2, st3)}; p += step; asm volatile("" : "+v"(p));
            st0 = fmaf(decay, st0, blo(v[i].x)); st1 = fmaf(decay, st1, bhi(v[i].x)); st2 = fmaf(decay, st2, blo(v[i].y)); st3 = fmaf(decay, st3, bhi(v[i].y)); } }
    }
}

__device__ __forceinline__ void r3_unit(const Args& a, LAS unsigned char* lds, int unit) {
    const int tid = opaque_tid(), lane = tid & 63, wave = __builtin_amdgcn_readfirstlane(tid >> 6);
    const int s = unit % 34, bh = unit / 34, h = bh & 3, b = bh >> 2, row0 = ret_row0(b, s);
    const bf16* QKVG = (const bf16*)(a.ws + WS_QKVG);
    const float l2f = log_sigmoid(a.in[I_DECAY][h]) * 1.4426950408889634f, l2b = log_sigmoid(a.in[I_DECAY][4 + h]) * 1.4426950408889634f;
#pragma unroll
    for (int it = 0; it < 4; ++it) {
        const int n = tid + NTHREADS * it, row = n >> 4, ch = n & 15;
        *(LAS v4u*)(lds + off_b(row, ch)) = *(const v4u*)(QKVG + (size_t)(row0 + row) * 2048 + 1024 + 128 * h + 8 * ch);
    }
    __syncthreads();
    const int fr = lane & 15, g = lane >> 4;
    bf16x8 qf[4];
#pragma unroll
    for (int ks = 0; ks < 4; ++ks) qf[ks] = *(const bf16x8*)(QKVG + (size_t)(row0 + 16 * wave + fr) * 2048 + 128 * h + 32 * ks + 8 * g);
    f32x4 acco[8];
#pragma unroll
    for (int c = 0; c < 8; ++c) acco[c] = (f32x4){0.f, 0.f, 0.f, 0.f};
    const int iq = 16 * wave + fr;
#pragma unroll
    for (int jt = 0; jt < 4; ++jt) {
        f32x4 sa = (f32x4){0.f, 0.f, 0.f, 0.f}, sb = sa;
        const int ja = 32 * jt + 8 * (fr >> 2) + (fr & 3);
        const bf16* kpa = QKVG + (size_t)(row0 + ja) * 2048 + 512 + 128 * h + 8 * g;
#pragma unroll
        for (int ks = 0; ks < 4; ++ks) {
            const bf16x8 ka = *(const bf16x8*)(kpa + 32 * ks), kb = *(const bf16x8*)(kpa + 4 * 2048 + 32 * ks);
            sa = MFMA16(ka, qf[ks], sa); sb = MFMA16(kb, qf[ks], sb);
        }
        f32x4 pa, pb;
#pragma unroll
        for (int r = 0; r < 4; ++r) {
            const int j0 = 32 * jt + 8 * g + r, d0 = iq - j0, d1 = d0 - 4;
            const float w0 = (d0 >= 0 ? __builtin_amdgcn_exp2f(l2f * (float)d0) : 0.f) + (d0 <= 0 ? __builtin_amdgcn_exp2f(-l2b * (float)d0) : 0.f);
            const float w1 = (d1 >= 0 ? __builtin_amdgcn_exp2f(l2f * (float)d1) : 0.f) + (d1 <= 0 ? __builtin_amdgcn_exp2f(-l2b * (float)d1) : 0.f);
            pa[r] = sa[r] * w0; pb[r] = sb[r] * w1;
        }
        const bf16x8 pf = pack8(pa, pb);
#pragma unroll
        for (int c = 0; c < 8; ++c) { const bf16x8 vf = tr_frag(lds, lane, c, jt); acco[c] = MFMA16(pf, vf, acco[c]); }
    }
    const bf16* Sf = (const bf16*)(a.ws + WS_KVS) + ((size_t)(bh * 2 + 0) * 34 + s) * 16384;
    const bf16* Sb = (const bf16*)(a.ws + WS_KVS) + ((size_t)(bh * 2 + 1) * 34 + s) * 16384;
    float ff[4], fb[4];
#pragma unroll
    for (int r = 0; r < 4; ++r) { const int i = 16 * wave + 4 * g + r; ff[r] = __builtin_amdgcn_exp2f(l2f * (float)(i + 1)); fb[r] = __builtin_amdgcn_exp2f(l2b * (float)(128 - i)); }
    float ss[4] = {0.f, 0.f, 0.f, 0.f};
#pragma unroll
    for (int c = 0; c < 8; ++c) {
        f32x4 t1 = (f32x4){0.f, 0.f, 0.f, 0.f}, t2 = t1;
        const int e = 16 * c + fr;
#pragma unroll
        for (int ks = 0; ks < 4; ++ks) {
            const bf16x8 s1 = *(const bf16x8*)(Sf + e * 128 + 32 * ks + 8 * g), s2 = *(const bf16x8*)(Sb + e * 128 + 32 * ks + 8 * g);
            t1 = MFMA16(qf[ks], s1, t1); t2 = MFMA16(qf[ks], s2, t2);
        }
#pragma unroll
        for (int r = 0; r < 4; ++r) { const float o = acco[c][r] + ff[r] * t1[r] + fb[r] * t2[r]; acco[c][r] = o; ss[r] = fmaf(o, o, ss[r]); }
    }
#pragma unroll
    for (int r = 0; r < 4; ++r) { float v = ss[r]; v += __shfl_xor(v, 1); v += __shfl_xor(v, 2); v += __shfl_xor(v, 4); v += __shfl_xor(v, 8); ss[r] = rsqrtf(v * (1.0f / 128.0f) + EPS); }
    bf16* YM = (bf16*)(a.ws + WS_XN);
#pragma unroll
    for (int r = 0; r < 4; ++r) { const size_t row = (size_t)(row0 + 16 * wave + 4 * g + r);
#pragma unroll
        for (int c = 0; c < 8; ++c) { const int e = 16 * c + fr; const float gt = bf2f(QKVG[row * 2048 + 1536 + 128 * h + e]);
            YM[row * DM + 128 * h + e] = (bf16)f2bf(acco[c][r] * ss[r] * (gt * __builtin_amdgcn_rcpf(1.0f + __expf(-gt)))); } }
    __syncthreads();
}

__device__ __forceinline__ int s5_row0(int b, int c) { return c < 4 ? ML + b * CTXL + 64 * c : b * SEQ + 64 * (c - 4); }
constexpr int S5_WLDS = 12288;

__device__ __forceinline__ void s5_stage_u(const Args& a, LAS float* us, int rowbase, int g, int lane) {
    const bf16* up = (const bf16*)(a.ws + WS_U) + (size_t)(rowbase + lane) * 512 + 16 * g;
    const v4u u0 = *(const v4u*)up, u1 = *(const v4u*)(up + 8);
    LAS f32x4* d = (LAS f32x4*)(us + lane * 16);
    d[0] = (f32x4){blo(u0.x), bhi(u0.x), blo(u0.y), bhi(u0.y)}; d[1] = (f32x4){blo(u0.z), bhi(u0.z), blo(u0.w), bhi(u0.w)};
    d[2] = (f32x4){blo(u1.x), bhi(u1.x), blo(u1.y), bhi(u1.y)}; d[3] = (f32x4){blo(u1.z), bhi(u1.z), blo(u1.w), bhi(u1.w)};
    asm volatile("s_waitcnt lgkmcnt(0)" ::: "memory");
}
#define S5_STEP(t_)  { const LAS f32x4* up_ = (const LAS f32x4*)(us + (t_) * 16); const f32x4 ua = up_[0], ub = up_[1], uc = up_[2], ud = up_[3]; \
        float br_ = bbr[0] * ua[0], bi_ = bbi[0] * ua[0]; \
        br_ = fmaf(bbr[1], ua[1], br_); bi_ = fmaf(bbi[1], ua[1], bi_); br_ = fmaf(bbr[2], ua[2], br_); bi_ = fmaf(bbi[2], ua[2], bi_); br_ = fmaf(bbr[3], ua[3], br_); bi_ = fmaf(bbi[3], ua[3], bi_); \
        br_ = fmaf(bbr[4], ub[0], br_); bi_ = fmaf(bbi[4], ub[0], bi_); br_ = fmaf(bbr[5], ub[1], br_); bi_ = fmaf(bbi[5], ub[1], bi_); br_ = fmaf(bbr[6], ub[2], br_); bi_ = fmaf(bbi[6], ub[2], bi_); br_ = fmaf(bbr[7], ub[3], br_); bi_ = fmaf(bbi[7], ub[3], bi_); \
        br_ = fmaf(bbr[8], uc[0], br_); bi_ = fmaf(bbi[8], uc[0], bi_); br_ = fmaf(bbr[9], uc[1], br_); bi_ = fmaf(bbi[9], uc[1], bi_); br_ = fmaf(bbr[10], uc[2], br_); bi_ = fmaf(bbi[10], uc[2], bi_); br_ = fmaf(bbr[11], uc[3], br_); bi_ = fmaf(bbi[11], uc[3], bi_); \
        br_ = fmaf(bbr[12], ud[0], br_); bi_ = fmaf(bbi[12], ud[0], bi_); br_ = fmaf(bbr[13], ud[1], br_); bi_ = fmaf(bbi[13], ud[1], bi_); br_ = fmaf(bbr[14], ud[2], br_); bi_ = fmaf(bbi[14], ud[2], bi_); br_ = fmaf(bbr[15], ud[3], br_); bi_ = fmaf(bbi[15], ud[3], bi_); \
        const float nr_ = fmaf(lr, xr, fmaf(-li, xi, br_)), ni_ = fmaf(lr, xi, fmaf(li, xr, bi_)); xr = nr_; xi = ni_; }

__device__ __forceinline__ void s1_unit(const Args& a, LAS unsigned char* wl, int wu, int lane) {
    const int c = wu % 68, bgd = wu / 68, dir = bgd & 1, g = (bgd >> 1) & 31, b = bgd >> 6, dg = dir * 32 + g, p = lane;
    LAS float* us = (LAS float*)wl;
    s5_stage_u(a, us, s5_row0(b, c), g, lane);
    const f32x2 lb = ((const f32x2*)(a.ws + WS_LB))[dg * 64 + p]; const float lr = lb.x, li = lb.y;
    float bbr[16], bbi[16];
#pragma unroll
    for (int k = 0; k < 16; ++k) { bbr[k] = ((const float*)(a.ws + WS_BBR))[(dg * 16 + k) * 64 + p]; bbi[k] = ((const float*)(a.ws + WS_BBI))[(dg * 16 + k) * 64 + p]; }
    float xr = 0.f, xi = 0.f;
    if (dir == 0) { for (int t = 0; t < 64; ++t) S5_STEP(t) }
    else { for (int t = 63; t >= 0; --t) S5_STEP(t) }
    ((f32x2*)(a.ws + WS_SF))[(size_t)wu * 64 + p] = (f32x2){xr, xi};
    asm volatile("s_waitcnt lgkmcnt(0)" ::: "memory");
}
__device__ __forceinline__ void s2_items(const Args& a, int G) {
    const int gtid = blockIdx.x * NTHREADS + opaque_tid(), GT = G * NTHREADS;
    for (int idx = gtid; idx < 4 * 32 * 2 * 64; idx += GT) {
        const int p = idx & 63, bgd = idx >> 6, dir = bgd & 1, g = (bgd >> 1) & 31, dg = dir * 32 + g;
        const f32x2 lt = ((const f32x2*)(a.ws + WS_LBT))[dg * 64 + p];
        f32x2* base = (f32x2*)(a.ws + WS_SF) + (size_t)bgd * 68 * 64 + p;
        const long step = dir == 0 ? 64 : -64;
        f32x2* q0 = base + (dir == 0 ? 0 : 3 * 64); f32x2* q4 = base + (dir == 0 ? 4 * 64 : 67 * 64);
        float cr = 0.f, ci = 0.f;
        f32x2* pl = q0; f32x2* ps = q0;
#pragma unroll
        for (int hb = 0; hb < 2; ++hb) {
            f32x2 v[34];
#pragma unroll
            for (int j = 0; j < 34; ++j) { if (34 * hb + j == 4) pl = q4; v[j] = *pl; pl += step; asm volatile("" : "+v"(pl)); }
#pragma unroll
            for (int j = 0; j < 34; ++j) { if (34 * hb + j == 4) ps = q4; *ps = (f32x2){cr, ci}; ps += step; asm volatile("" : "+v"(ps));
                const float nr = fmaf(lt.x, cr, fmaf(-lt.y, ci, v[j].x)), ni = fmaf(lt.x, ci, fmaf(lt.y, cr, v[j].y)); cr = nr; ci = ni; }
        }
    }
}
__device__ __forceinline__ void s3_unit(const Args& a, LAS unsigned char* wl, int wu, int lane) {
    const int c = wu % 68, bg = wu / 68, g = bg & 31, b = bg >> 5, p = lane, fr = lane & 15, gq = lane >> 4;
    LAS float* us = (LAS float*)wl; LAS unsigned char* xs = wl + 4096;
    const int rowbase = s5_row0(b, c);
    s5_stage_u(a, us, rowbase, g, lane);
    f32x4 acc[4];
#pragma unroll
    for (int i = 0; i < 4; ++i) acc[i] = (f32x4){0.f, 0.f, 0.f, 0.f};
#pragma unroll
    for (int dir = 0; dir < 2; ++dir) {
        const int dg = dir * 32 + g;
        const f32x2 lb = ((const f32x2*)(a.ws + WS_LB))[dg * 64 + p]; const float lr = lb.x, li = lb.y;
        float bbr[16], bbi[16];
#pragma unroll
        for (int k = 0; k < 16; ++k) { bbr[k] = ((const float*)(a.ws + WS_BBR))[(dg * 16 + k) * 64 + p]; bbi[k] = ((const float*)(a.ws + WS_BBI))[(dg * 16 + k) * 64 + p]; }
        bf16x8 cm[4];
#pragma unroll
        for (int ks = 0; ks < 4; ++ks) cm[ks] = *(const bf16x8*)((const bf16*)(a.ws + WS_CM) + (size_t)(dg * 16 + fr) * 128 + 32 * ks + 8 * gq);
        const f32x2 x0 = ((const f32x2*)(a.ws + WS_SF))[((size_t)((b * 32 + g) * 2 + dir) * 68 + c) * 64 + p];
        float xr = x0.x, xi = x0.y;
#pragma unroll
        for (int half = 0; half < 2; ++half) {
            const int hs = dir ? 1 - half : half;
            for (int tt = 0; tt < 32; ++tt) {
                const int tl = dir ? 31 - tt : tt, t = 32 * hs + tl;
                S5_STEP(t)
                *(LAS unsigned*)(xs + tl * 256 + (((p >> 2) ^ (tl & 15)) * 16) + (p & 3) * 4) = pk2(xr, xi);
            }
            asm volatile("s_waitcnt lgkmcnt(0)" ::: "memory");
#pragma unroll
            for (int th = 0; th < 2; ++th) {
                const int row = 16 * th + fr;
                f32x4 d = acc[2 * hs + th];
#pragma unroll
                for (int ks = 0; ks < 4; ++ks) { const bf16x8 xf = *(const LAS bf16x8*)(xs + row * 256 + (((4 * ks + gq) ^ (row & 15)) * 16)); d = MFMA16(cm[ks], xf, d); }
                acc[2 * hs + th] = d;
            }
            asm volatile("s_waitcnt lgkmcnt(0)" ::: "memory");
        }
    }
    const f32x4 dsk = *(const f32x4*)(a.in[I_S5D] + 16 * g + 4 * gq);
    bf16* YS = (bf16*)(a.ws + WS_YS);
#pragma unroll
    for (int T4 = 0; T4 < 4; ++T4) {
        const int t = 16 * T4 + fr; const f32x4 u4 = *(const LAS f32x4*)(us + t * 16 + 4 * gq);
        const f32x4 y = acc[T4] + dsk * u4;
        *(v2u*)(YS + (size_t)(rowbase + t) * 512 + 16 * g + 4 * gq) = (v2u){pk2(gelu_tanh(y[0]), gelu_tanh(y[1])), pk2(gelu_tanh(y[2]), gelu_tanh(y[3]))};
    }
    asm volatile("s_waitcnt lgkmcnt(0)" ::: "memory");
}

__device__ __forceinline__ void na_unit(const Args& a, int wu, int lane) {
    const int r = wu & 63, cb = (wu >> 6) & 3, h = (wu >> 8) & 15, b = wu >> 12, fr = lane & 15, g = lane >> 4;
    const bf16* QK = (const bf16*)(a.ws + WS_QK); const bf16* VT = (const bf16*)(a.ws + WS_VT); bf16* AO = (bf16*)(a.ws + WS_XN);
    const int r0 = min(max(r - 4, 0), 56), kcol0 = min(max(16 * cb - 8, 0), 32);
    const int tq0 = b * SEQ + r * 64 + 16 * cb;
    const unsigned qoff = (unsigned)(fr * 2048 + 8 * g);
    const bf16* qb = QK + (size_t)tq0 * 2048 + 64 * h;
    bf16x8 qf[2]; qf[0] = *(const bf16x8*)(qb + qoff); qf[1] = *(const bf16x8*)(qb + qoff + 32);
    const unsigned koffl = (unsigned)((8 * (fr >> 2) + (fr & 3)) * 2048 + 8 * g);
    const unsigned voffl = (unsigned)(fr * MT + 8 * g);
    const int cq = 16 * cb + fr, ws = min(max(cq - 8, 0), 48);
    int bidx[8]; bool bval[8];
#pragma unroll
    for (int j = 0; j < 8; ++j) { const int kc = kcol0 + 8 * g + (j & 3) + 4 * (j >> 2); bval[j] = kc >= ws && kc < ws + 16; bidx[j] = min(max(kc - cq + 15, 0), 30); }
    const float* rpb = a.in[I_RPB] + (size_t)h * 15 * 31;
    f32x4 o[4];
#pragma unroll
    for (int dt = 0; dt < 4; ++dt) o[dt] = (f32x4){0.f, 0.f, 0.f, 0.f};
    float mrun = -1e30f, lsum = 0.f;
#pragma unroll
    for (int half = 0; half < 2; ++half) {
        f32x4 sc[8][2];
#pragma unroll
        for (int i = 0; i < 8; ++i) {
            const int tok0 = half == 0 ? b * SEQ + (r0 + i) * 64 + kcol0 : ML + b * CTXL + 32 * i;
            const bf16* kb = QK + (size_t)tok0 * 2048 + 1024 + 64 * h;
            f32x4 sa = (f32x4){0.f, 0.f, 0.f, 0.f}, sb = sa;
            sa = MFMA16(*(const bf16x8*)(kb + koffl), qf[0], sa); sa = MFMA16(*(const bf16x8*)(kb + koffl + 32), qf[1], sa);
            sb = MFMA16(*(const bf16x8*)(kb + koffl + 4 * 2048), qf[0], sb); sb = MFMA16(*(const bf16x8*)(kb + koffl + 4 * 2048 + 32), qf[1], sb);
            if (half == 0) {
                const float* bp = rpb + (r0 + i - r + 7) * 31;
#pragma unroll
                for (int rr = 0; rr < 4; ++rr) { sa[rr] = bval[rr] ? sa[rr] + bp[bidx[rr]] : -1e30f; sb[rr] = bval[4 + rr] ? sb[rr] + bp[bidx[4 + rr]] : -1e30f; }
            }
            sc[i][0] = sa; sc[i][1] = sb;
        }
        float mx = -1e30f;
#pragma unroll
        for (int i = 0; i < 8; ++i)
#pragma unroll
            for (int t = 0; t < 2; ++t) mx = fmaxf(mx, fmaxf(fmaxf(sc[i][t][0], sc[i][t][1]), fmaxf(sc[i][t][2], sc[i][t][3])));
        mx = fmaxf(mx, __shfl_xor(mx, 16)); mx = fmaxf(mx, __shfl_xor(mx, 32));
        const float mnew = fmaxf(mrun, mx);
        const float resc = __builtin_amdgcn_exp2f((mrun - mnew) * 1.4426950408889634f);
        mrun = mnew; lsum *= resc;
#pragma unroll
        for (int dt = 0; dt < 4; ++dt) o[dt] = o[dt] * resc;
        const float mneg = -mnew * 1.4426950408889634f;
        float ls = 0.f;
#pragma unroll
        for (int i = 0; i < 8; ++i)
#pragma unroll
            for (int t = 0; t < 2; ++t)
#pragma unroll
                for (int rr = 0; rr < 4; ++rr) { const float pv = __builtin_amdgcn_exp2f(fmaf(sc[i][t][rr], 1.4426950408889634f, mneg)); sc[i][t][rr] = pv; ls += pv; }
        lsum += ls;
#pragma unroll
        for (int i = 0; i < 8; ++i) {
            const bf16x8 pf = pack8(sc[i][0], sc[i][1]);
            const int tok0 = half == 0 ? b * SEQ + (r0 + i) * 64 + kcol0 : ML + b * CTXL + 32 * i;
            const bf16* vb = VT + (size_t)(64 * h) * MT + tok0;
#pragma unroll
            for (int dt = 0; dt < 4; ++dt) o[dt] = MFMA16(*(const bf16x8*)(vb + voffl + (unsigned)(16 * dt * MT)), pf, o[dt]);
        }
    }
    lsum += __shfl_xor(lsum, 16); lsum += __shfl_xor(lsum, 32);
    const float rl = 1.0f / lsum;
    bf16* ob = AO + (size_t)tq0 * DM + 64 * h;
#pragma unroll
    for (int dt = 0; dt < 4; ++dt)
        *(v2u*)(ob + (unsigned)(fr * DM + 16 * dt + 4 * g)) = (v2u){pk2(o[dt][0] * rl, o[dt][1] * rl), pk2(o[dt][2] * rl, o[dt][3] * rl)};
}

#ifndef STAGE
#define STAGE 6
#endif
#define GSYNC() grid.sync()

template <class Epi>
__device__ __forceinline__ void run_gemm(LAS unsigned char* lds, const bf16* A, const bf16* Bt, int M, int N, int K, int G, const Epi& E) {
    pg8::Gemm g{A, Bt, M, N, K}; pg8::StaticOrder S; S.init(M, N, G, (int)blockIdx.x);
    pg8::gemm_phase<Epi, pg8::StaticOrder, true, true>(lds, g, S, E);
}

__device__ __forceinline__ void ffn_block(const Args& a, LAS unsigned char* lds, cg::grid_group& grid, int G, int layer, int f, const float* rin_lat, const float* rin_ctx, int nrows) {
    const float* MODL = (const float*)(a.ws + WS_MOD) + (size_t)layer * 5 * MODW;
    float* hl = a.out; float* hc = (float*)(a.ws + WS_HCTX);
    bf16* XN = (bf16*)(a.ws + WS_XN); bf16* HID = (bf16*)(a.ws + WS_HID);
    const bf16* W1b = (const bf16*)(a.ws + WS_W1) + (size_t)(layer * 2 + f) * 2 * FF * DM;
    const bf16* W2b = (const bf16*)(a.ws + WS_W2) + (size_t)(layer * 2 + f) * DM * FF;
    norm_phase(rin_lat, rin_ctx, XN, a.in[I_NORMG] + (size_t)(layer * 3 + (f ? 2 : 0)) * DM, MODL, f ? 6 : 0, nrows, G);
    GSYNC();
    { pg8::EpiSwiglu E{HID, FF}; run_gemm(lds, XN, W1b, nrows, 2 * FF, DM, G, E); }
    GSYNC();
    { pg8::EpiResid E{rin_lat, rin_ctx, hl, hc, MODL + (f ? 8 : 2) * DM, 0.5f}; run_gemm(lds, HID, W2b, nrows, DM, FF, G, E); }
    GSYNC();
}

__global__ void __launch_bounds__(NTHREADS, 2) fwd_megakernel(Args a) {
    extern __shared__ __attribute__((aligned(16))) unsigned char lds_raw[];
    LAS unsigned char* lds = (LAS unsigned char*)lds_raw;
    cg::grid_group grid = cg::this_grid();
    const int G = gridDim.x;
#define LANEWAVE() const int tid = opaque_tid(), lane = tid & 63, wave = __builtin_amdgcn_readfirstlane(tid >> 6)
    float* hl = a.out; float* hc = (float*)(a.ws + WS_HCTX);
    bf16* XN = (bf16*)(a.ws + WS_XN);
    const float* MOD0 = (const float*)(a.ws + WS_MOD); const float* MOD1 = MOD0 + 5 * MODW;

    p0_prologue(a, lds, G);
    GSYNC();

    if (STAGE == 0) {
        const int gtid = blockIdx.x * NTHREADS + opaque_tid(), GT = G * NTHREADS;
        for (int i = gtid; i < ML * DM / 4; i += GT) ((f32x4*)hl)[i] = ((const f32x4*)a.in[I_X])[i];
        GSYNC();
    }
    if (STAGE >= 1) ffn_block(a, lds, grid, G, 0, 0, a.in[I_X], a.in[I_CTX], MT);
    if (STAGE >= 2) {
        norm_phase(hl, hc, XN, a.in[I_NORMG] + 1 * DM, MOD0, 3, MT, G);
        GSYNC();
        { pg8::EpiWin E{(bf16*)(a.ws + WS_QKVG), (bf16*)(a.ws + WS_U), (const float*)(a.ws + WS_ROPE)}; run_gemm(lds, XN, (const bf16*)(a.ws + WS_WIN), MT, 2560, DM, G, E); }
        GSYNC();
        { LANEWAVE(); for (int u = blockIdx.x; u < 544 + 2176; u += G) { if (u < 544) r1_unit(a, lds, u); else s1_unit(a, lds + wave * S5_WLDS, (u - 544) * 8 + wave, lane); } }
        GSYNC();
        r2_items(a, G); s2_items(a, G);
        GSYNC();
        { LANEWAVE(); for (int u = blockIdx.x; u < 544 + 1088; u += G) { if (u < 544) r3_unit(a, lds, u); else s3_unit(a, lds + wave * S5_WLDS, (u - 544) * 8 + wave, lane); } }
        GSYNC();
        { pg8::EpiGlu E{(const bf16*)(a.ws + WS_YS), XN, a.in[I_GLUB]}; run_gemm(lds, (const bf16*)(a.ws + WS_YS), (const bf16*)(a.ws + WS_GLU), MT, 512, 512, G, E); }
        GSYNC();
        { pg8::EpiResid E{hl, hc, hl, hc, MOD0 + 5 * DM, 1.0f}; run_gemm(lds, XN, (const bf16*)(a.ws + WS_WOUT), MT, DM, DM, G, E); }
        GSYNC();
    }
    if (STAGE >= 3) ffn_block(a, lds, grid, G, 0, 1, hl, hc, MT);
    if (STAGE >= 4) ffn_block(a, lds, grid, G, 1, 0, hl, hc, MT);
    if (STAGE >= 5) {
        norm_phase(hl, hc, XN, a.in[I_NORMG] + 4 * DM, MOD1, 3, MT, G);
        GSYNC();
        { pg8::EpiBf16S E{(bf16*)(a.ws + WS_QK), 2048, 4, 0.125f}; run_gemm(lds, XN, (const bf16*)(a.ws + WS_WQKV), MT, 2048, DM, G, E); }
        { pg8::EpiBf16S E{(bf16*)(a.ws + WS_VT), MT, 0, 1.0f}; run_gemm(lds, (const bf16*)(a.ws + WS_WQKV) + (size_t)2048 * DM, XN, DM, MT, DM, G, E); }
        GSYNC();
        { LANEWAVE(); for (int u = blockIdx.x; u < 2048; u += G) na_unit(a, u * 8 + wave, lane); }
        GSYNC();
        { pg8::EpiResid E{hl, hc, hl, hc, MOD1 + 5 * DM, 1.0f}; run_gemm(lds, XN, (const bf16*)(a.ws + WS_WO), ML, DM, DM, G, E); }
        GSYNC();
    }
    if (STAGE >= 6) ffn_block(a, lds, grid, G, 1, 1, hl, hc, ML);
    final_norm_phase(hl, a.in[I_FINALG], G);
}

extern "C" void kernel_launch(void* const* d_in, const int* in_sizes, int n_in, void* d_out, int out_size, void* d_ws, size_t ws_size, hipStream_t stream) {
    static int grid = 0;
    if (grid == 0) {
        if (n_in != 26 || out_size != ML * DM || ws_size < WS_END) { fprintf(stderr, "kernel_launch: unexpected problem (n_in %d, out %d, ws %zu)\n", n_in, out_size, ws_size); grid = -1; return; }
        int dev = 0, cus = 0, per_cu = 0;
        if (hipGetDevice(&dev) != hipSuccess || hipDeviceGetAttribute(&cus, hipDeviceAttributeMultiprocessorCount, dev) != hipSuccess) { grid = -1; return; }
        if (hipFuncSetAttribute((const void*)fwd_megakernel, hipFuncAttributeMaxDynamicSharedMemorySize, LDS_BYTES) != hipSuccess) { fprintf(stderr, "kernel_launch: hipFuncSetAttribute failed\n"); grid = -1; return; }
        if (hipOccupancyMaxActiveBlocksPerMultiprocessor(&per_cu, (const void*)fwd_megakernel, NTHREADS, LDS_BYTES) != hipSuccess || per_cu < 1) { fprintf(stderr, "kernel_launch: occupancy query failed (%d)\n", per_cu); (void)hipGetLastError(); grid = -1; return; }
        grid = cus * per_cu;
    }
    if (grid < 0) return;
    Args a{};
    for (int i = 0; i < 26; ++i) a.in[i] = (const float*)d_in[i];
    a.out = (float*)d_out; a.ws = (unsigned char*)d_ws; a.probe = 0; a.pad = 0;
    void* args[] = {&a};
    hipError_t e = hipLaunchCooperativeKernel((const void*)fwd_megakernel, dim3(grid), dim3(NTHREADS), args, LDS_BYTES, stream);
    if (e != hipSuccess) fprintf(stderr, "kernel_launch: cooperative launch failed: %s (grid %d)\n", hipGetErrorString(e), grid);
}
```

```cpp
#include <hip/hip_runtime.h>
#include <hip/hip_cooperative_groups.h>
#include <cstdio>
#include <cstdint>
namespace cg = cooperative_groups;

constexpr int DM = 1024, NB = 4, SEQ = 4096, CTXL = 256, FF = 2816, NMOD = 9;
constexpr int ML = NB * SEQ, MC = NB * CTXL, MT = ML + MC;
constexpr int MODW = NMOD * DM;
constexpr float EPS = 1e-6f;

namespace pg8 {
#define PG8_LAS __attribute__((address_space(3)))
typedef unsigned short bf16_t;
typedef short bf16x8 __attribute__((ext_vector_type(8)));
typedef float f32x4 __attribute__((ext_vector_type(4)));
typedef unsigned u32x4 __attribute__((ext_vector_type(4)));
constexpr int BM = 256, BK = 64, HALF = 128, HTB = HALF * BK * 2  , STAGE_BYTES = 8 * HTB, NXCD = 8, WGM = 8;

__host__ __device__ __forceinline__ int lds_byte(int r, int c) { const int st = (r >> 4) * 2 + (c >> 5), rr = r & 15, cc = c & 31, ob = rr * 64 + cc * 2; return st * 1024 + (ob ^ (((ob >> 9) & 1) << 5)); }
__host__ __device__ __forceinline__ void stage_rc(int b, int& R, int& C) { const int st = b / 1024, sb = b % 1024, swz = sb ^ (((sb >> 9) & 1) << 5); R = (st >> 1) * 16 + swz / 64; C = (st & 1) * 32 + (swz % 64) / 2; }
__host__ __device__ __forceinline__ int perm32(int rho) { const int n = rho >> 4, i = rho & 15; return 8 * (i >> 2) + 4 * n + (i & 3); }

struct Unit { int pm, pn; };
struct Gemm { const bf16_t* A; const bf16_t* Bt; int M, N, K; };

struct StaticOrder {
    int nM, nN, nwg, G, c;
    __host__ __device__ void init(int M, int N, int G_, int c_) { nM = M / BM; nN = N / BM; nwg = nM * nN; G = G_; c = c_; }
    __host__ __device__ bool next(int i, Unit& u) const {
        const long L = (long)i * G + c; if (L >= nwg) return false;
        int wgid = (int)L; { const int q = nwg / NXCD, r = nwg % NXCD, xcd = wgid % NXCD, off = wgid / NXCD; wgid = (xcd < r ? xcd * (q + 1) : r * (q + 1) + (xcd - r) * q) + off; }
        const int nig = WGM * nN, gid = wgid / nig, fm = gid * WGM, gsz = (nM - fm) < WGM ? (nM - fm) : WGM;
        u.pm = fm + ((wgid % nig) % gsz); u.pn = (wgid % nig) / gsz; return true;
    }
    __device__ __forceinline__ void a_ready(const Unit&) const {}
    __device__ __forceinline__ void done(const Unit&) const {}
};


__device__ __forceinline__ unsigned cvt_pk_bf16(float lo, float hi) { unsigned r; asm volatile("v_cvt_pk_bf16_f32 %0, %1, %2" : "=v"(r) : "v"(lo), "v"(hi)); return r; }
__device__ __forceinline__ float bf_lo(unsigned w) { return __uint_as_float(w << 16); }
__device__ __forceinline__ float bf_hi(unsigned w) { return __uint_as_float(w & 0xffff0000u); }
__device__ __forceinline__ float fsilu(float a) { return a * __builtin_amdgcn_rcpf(1.0f + __expf(-a)); }
__device__ __forceinline__ float fsigmoid(float a) { return __builtin_amdgcn_rcpf(1.0f + __expf(-a)); }

struct EpiSwiglu {
    static constexpr bool PERM = true, AFTER_DRAIN = false;
    bf16_t* O; int ldo;
    __device__ __forceinline__ void operator()(const f32x4 (&acc)[2][2][4][2], const Unit& u, int wr, int wc, int fr, int fq) const {
        const int row0 = u.pm * BM + wr * 64 + fr, col0 = u.pn * HALF + wc * 32 + 8 * fq;
#pragma unroll
        for (int ai = 0; ai < 2; ++ai)
#pragma unroll
            for (int m = 0; m < 4; ++m) {
                bf16_t* rowp = O + (size_t)(row0 + ai * HALF + m * 16) * ldo + col0;
                float h[8];
#pragma unroll
                for (int n = 0; n < 2; ++n)
#pragma unroll
                    for (int i = 0; i < 4; ++i) { const float a = acc[ai][0][m][n][i], b = acc[ai][1][m][n][i]; h[4 * n + i] = fsilu(a) * b; }
                u32x4 w; w.x = cvt_pk_bf16(h[0], h[1]); w.y = cvt_pk_bf16(h[2], h[3]); w.z = cvt_pk_bf16(h[4], h[5]); w.w = cvt_pk_bf16(h[6], h[7]);
                *(u32x4*)rowp = w;
            }
    }
};

struct EpiResid {
    static constexpr bool PERM = false, AFTER_DRAIN = false;
    const float* rin_lat; const float* rin_ctx; float* rout_lat; float* rout_ctx; const float* gate; float gs;
    __device__ __forceinline__ void operator()(const f32x4 (&acc)[2][2][4][2], const Unit& u, int wr, int wc, int fr, int fq) const {
        const bool lat = u.pm < (ML / BM);
        const int bidx = lat ? (u.pm >> 4) : 4;
        const float* gp = gate + (size_t)bidx * MODW;
        const float* ri = lat ? rin_lat + (size_t)u.pm * BM * DM : rin_ctx + (size_t)(u.pm - ML / BM) * BM * DM;
        float* ro = lat ? rout_lat + (size_t)u.pm * BM * DM : rout_ctx + (size_t)(u.pm - ML / BM) * BM * DM;
        const int col0 = u.pn * BM + wc * 32 + 4 * fq;
        f32x4 gv[2][2];
#pragma unroll
        for (int bj = 0; bj < 2; ++bj)
#pragma unroll
            for (int n = 0; n < 2; ++n) gv[bj][n] = *(const f32x4*)(gp + col0 + bj * HALF + n * 16) * gs;
#pragma unroll
        for (int ai = 0; ai < 2; ++ai)
#pragma unroll
            for (int m = 0; m < 4; ++m) {
                const size_t off = (size_t)(ai * HALF + wr * 64 + m * 16 + fr) * DM + col0;
#pragma unroll
                for (int bj = 0; bj < 2; ++bj)
#pragma unroll
                    for (int n = 0; n < 2; ++n) { const f32x4 r = *(const f32x4*)(ri + off + bj * HALF + n * 16); *(f32x4*)(ro + off + bj * HALF + n * 16) = r + gv[bj][n] * acc[ai][bj][m][n]; }
            }
    }
};

struct EpiWin {
    static constexpr bool PERM = true, AFTER_DRAIN = false;
    bf16_t* QKVG; bf16_t* U; const float* rope;
    __device__ __forceinline__ void operator()(const f32x4 (&acc)[2][2][4][2], const Unit& u, int wr, int wc, int fr, int fq) const {
        const int row0 = u.pm * BM + wr * 64 + fr;
        if (u.pn >= 4) {
            bf16_t* base = u.pn < 8 ? QKVG + u.pn * BM : U + (u.pn - 8) * BM; const int ld = u.pn < 8 ? 2048 : 512;
            const int col0 = wc * 32 + 8 * fq;
#pragma unroll
            for (int ai = 0; ai < 2; ++ai)
#pragma unroll
                for (int m = 0; m < 4; ++m) { bf16_t* rowp = base + (size_t)(row0 + ai * HALF + m * 16) * ld + col0;
#pragma unroll
                    for (int bj = 0; bj < 2; ++bj) { const f32x4 v0 = acc[ai][bj][m][0], v1 = acc[ai][bj][m][1];
                        u32x4 w; w.x = cvt_pk_bf16(v0[0], v0[1]); w.y = cvt_pk_bf16(v0[2], v0[3]); w.z = cvt_pk_bf16(v1[0], v1[1]); w.w = cvt_pk_bf16(v1[2], v1[3]);
                        *(u32x4*)(rowp + bj * HALF) = w; } }
        } else {
            const bool lat = u.pm < (ML / BM);
            const float sc = u.pn >= 2 ? 0.08838834764831845f : 1.0f;
            const int hh = wc >> 1, rot = wc & 1, f0 = 8 * fq;
            const int dcol = u.pn * BM + 128 * hh + 64 * rot + f0;
#pragma unroll
            for (int ai = 0; ai < 2; ++ai)
#pragma unroll
                for (int m = 0; m < 4; ++m) {
                    const int row = row0 + ai * HALF + m * 16;
                    float y1[8], y2[8];
                    const int t = row & (SEQ - 1), pos = rot ? (t & 63) : (t >> 6);
                    const float* rp = rope + (size_t)(pos * 32 + f0) * 2;
#pragma unroll
                    for (int n = 0; n < 2; ++n) {
                        f32x4 cs0 = (f32x4){1.f, 0.f, 1.f, 0.f}, cs1 = cs0;
                        if (lat) { cs0 = *(const f32x4*)(rp + 8 * n); cs1 = *(const f32x4*)(rp + 8 * n + 4); }
                        const f32x4 x1 = acc[ai][0][m][n], x2 = acc[ai][1][m][n];
                        y1[4 * n + 0] = (x1[0] * cs0[0] - x2[0] * cs0[1]) * sc; y2[4 * n + 0] = (x2[0] * cs0[0] + x1[0] * cs0[1]) * sc;
                        y1[4 * n + 1] = (x1[1] * cs0[2] - x2[1] * cs0[3]) * sc; y2[4 * n + 1] = (x2[1] * cs0[2] + x1[1] * cs0[3]) * sc;
                        y1[4 * n + 2] = (x1[2] * cs1[0] - x2[2] * cs1[1]) * sc; y2[4 * n + 2] = (x2[2] * cs1[0] + x1[2] * cs1[1]) * sc;
                        y1[4 * n + 3] = (x1[3] * cs1[2] - x2[3] * cs1[3]) * sc; y2[4 * n + 3] = (x2[3] * cs1[2] + x1[3] * cs1[3]) * sc;
                    }
                    bf16_t* rowp = QKVG + (size_t)row * 2048 + dcol;
                    u32x4 w; w.x = cvt_pk_bf16(y1[0], y1[1]); w.y = cvt_pk_bf16(y1[2], y1[3]); w.z = cvt_pk_bf16(y1[4], y1[5]); w.w = cvt_pk_bf16(y1[6], y1[7]);
                    *(u32x4*)rowp = w;
                    w.x = cvt_pk_bf16(y2[0], y2[1]); w.y = cvt_pk_bf16(y2[2], y2[3]); w.z = cvt_pk_bf16(y2[4], y2[5]); w.w = cvt_pk_bf16(y2[6], y2[7]);
                    *(u32x4*)(rowp + 32) = w;
                }
        }
    }
};

struct EpiGlu {
    static constexpr bool PERM = true, AFTER_DRAIN = false;
    const bf16_t* YS; bf16_t* YM; const float* bias;
    __device__ __forceinline__ void operator()(const f32x4 (&acc)[2][2][4][2], const Unit& u, int wr, int wc, int fr, int fq) const {
        const int row0 = u.pm * BM + wr * 64 + fr, col0 = u.pn * BM + wc * 32 + 8 * fq;
        f32x4 bv[2][2];
#pragma unroll
        for (int bj = 0; bj < 2; ++bj)
#pragma unroll
            for (int n = 0; n < 2; ++n) bv[bj][n] = *(const f32x4*)(bias + col0 + bj * HALF + 4 * n);
#pragma unroll
        for (int ai = 0; ai < 2; ++ai)
#pragma unroll
            for (int m = 0; m < 4; ++m) { const int row = row0 + ai * HALF + m * 16;
#pragma unroll
                for (int bj = 0; bj < 2; ++bj) {
                    const u32x4 yv = *(const u32x4*)(YS + (size_t)row * 512 + col0 + bj * HALF);
                    const f32x4 z0 = acc[ai][bj][m][0] + bv[bj][0], z1 = acc[ai][bj][m][1] + bv[bj][1];
                    u32x4 w;
                    w.x = cvt_pk_bf16(bf_lo(yv.x) * fsigmoid(z0[0]), bf_hi(yv.x) * fsigmoid(z0[1]));
                    w.y = cvt_pk_bf16(bf_lo(yv.y) * fsigmoid(z0[2]), bf_hi(yv.y) * fsigmoid(z0[3]));
                    w.z = cvt_pk_bf16(bf_lo(yv.z) * fsigmoid(z1[0]), bf_hi(yv.z) * fsigmoid(z1[1]));
                    w.w = cvt_pk_bf16(bf_lo(yv.w) * fsigmoid(z1[2]), bf_hi(yv.w) * fsigmoid(z1[3]));
                    *(u32x4*)(YM + (size_t)row * DM + 512 + col0 + bj * HALF) = w; } }
    }
};

struct EpiBf16S {
    static constexpr bool PERM = true, AFTER_DRAIN = false;
    bf16_t* O; int ldo; int nscale; float scale0;
    __device__ __forceinline__ void operator()(const f32x4 (&acc)[2][2][4][2], const Unit& u, int wr, int wc, int fr, int fq) const {
        const int row0 = u.pm * BM + wr * 64 + fr, col0 = u.pn * BM + wc * 32 + 8 * fq;
        const float sc = u.pn < nscale ? scale0 : 1.0f;
#pragma unroll
        for (int ai = 0; ai < 2; ++ai)
#pragma unroll
            for (int m = 0; m < 4; ++m) { bf16_t* rowp = O + (size_t)(row0 + ai * HALF + m * 16) * ldo + col0;
#pragma unroll
                for (int bj = 0; bj < 2; ++bj) { const f32x4 v0 = acc[ai][bj][m][0] * sc, v1 = acc[ai][bj][m][1] * sc;
                    u32x4 w; w.x = cvt_pk_bf16(v0[0], v0[1]); w.y = cvt_pk_bf16(v0[2], v0[3]); w.z = cvt_pk_bf16(v1[0], v1[1]); w.w = cvt_pk_bf16(v1[2], v1[3]);
                    *(u32x4*)(rowp + bj * HALF) = w; } }
    }
};
template <class Epi, class Sched, bool ALIGN_EPI = false, bool SP2 = false>
__device__ __forceinline__ void gemm_phase(PG8_LAS unsigned char* lds, const Gemm g, const Sched& S, const Epi& E) {
    int tid_ = threadIdx.x; asm volatile("" : "+v"(tid_));
    const int tid = tid_, wid = __builtin_amdgcn_readfirstlane(tid >> 6), lane = tid & 63, wr = wid >> 2, wc = wid & 3, fr = lane & 15, fq = lane >> 4;
    const int K = g.K, nt = K / BK;
    unsigned voffA[2], voffB[2];
#pragma unroll
    for (int i = 0; i < 2; ++i) { int R, C; stage_rc(tid * 16 + i * 8192, R, C); const int Rb = Epi::PERM ? ((R & ~31) + perm32(R & 31)) : R;
        voffA[i] = (unsigned)(R * K + C) * 2u; voffB[i] = (unsigned)(Rb * K + C) * 2u; }
    const size_t kstep = (size_t)(BK * 2);
    const size_t hstep = (size_t)HALF * K * 2;
    const size_t tstep = 2 * hstep;
    const unsigned ldsw = (unsigned)wid * 1024u;
    const int aoff = lds_byte(wr * 64 + fr, fq * 8), boff = lds_byte(wc * 32 + fr, fq * 8);
#define PG8_SA(b, h) (((b) * 2 + (h)) * HTB)
#define PG8_SB(b, h) ((4 + (b) * 2 + (h)) * HTB)
#define PG8_STAGE(bufoff, gbase, voff) do { _Pragma("unroll") for (int _i = 0; _i < 2; ++_i) \
        __builtin_amdgcn_global_load_lds((const unsigned*)((const char*)(gbase) + (voff)[_i]), (PG8_LAS unsigned*)(lds + (bufoff) + ldsw + _i * 8192), 16, 0, 0); } while (0)
#define PG8_LDA(dst, b, h) do { _Pragma("unroll") for (int m = 0; m < 4; ++m) _Pragma("unroll") for (int k = 0; k < 2; ++k) dst[m][k] = *(const PG8_LAS bf16x8*)(lds + PG8_SA(b, h) + aoff + m * 2048 + k * 1024); } while (0)
#define PG8_LDB(dst, b, h) do { _Pragma("unroll") for (int n = 0; n < 2; ++n) _Pragma("unroll") for (int k = 0; k < 2; ++k) dst[n][k] = *(const PG8_LAS bf16x8*)(lds + PG8_SB(b, h) + boff + n * 2048 + k * 1024); } while (0)
#define PG8_MMA(ai, bj, At, Bt) do { __builtin_amdgcn_s_setprio(1); _Pragma("unroll") for (int m = 0; m < 4; ++m) _Pragma("unroll") for (int n = 0; n < 2; ++n) _Pragma("unroll") for (int k = 0; k < 2; ++k) \
        acc[ai][bj][m][n] = __builtin_amdgcn_mfma_f32_16x16x32_bf16(Bt[n][k], At[m][k], acc[ai][bj][m][n], 0, 0, 0); __builtin_amdgcn_s_setprio(0); } while (0)
#define PG8_WAIT_V(n) asm volatile("s_waitcnt vmcnt(" #n ")" ::: "memory")
#define PG8_WAIT_L(n) asm volatile("s_waitcnt lgkmcnt(" #n ")" ::: "memory")
#define PG8_BAR __builtin_amdgcn_s_barrier()
#define PG8_SCHED __builtin_amdgcn_sched_barrier(0)
    Unit cur, nxt; int ui = 0;
    if (!S.next(0, cur)) return;
    f32x4 acc[2][2][4][2];
#pragma unroll
    for (int a = 0; a < 2; ++a)
#pragma unroll
        for (int b = 0; b < 2; ++b)
#pragma unroll
            for (int m = 0; m < 4; ++m)
#pragma unroll
                for (int n = 0; n < 2; ++n) acc[a][b][m][n] = (f32x4){0.f, 0.f, 0.f, 0.f};
    bf16x8 At[4][2], B0[2][2], B1[2][2];
    const char* cA = (const char*)g.A + (size_t)cur.pm * tstep; const char* cB = (const char*)g.Bt + (size_t)cur.pn * tstep;
    S.a_ready(cur);
    if constexpr (SP2) {
        PG8_STAGE(PG8_SB(0, 0), cB, voffB); PG8_STAGE(PG8_SB(0, 1), cB + hstep, voffB); PG8_STAGE(PG8_SA(0, 0), cA, voffA); PG8_STAGE(PG8_SA(0, 1), cA + hstep, voffA);
        if (wr == 1) PG8_BAR;
        PG8_WAIT_V(2); PG8_BAR;
        PG8_STAGE(PG8_SB(1, 0), cB + kstep, voffB); PG8_STAGE(PG8_SA(1, 0), cA + kstep, voffA); PG8_STAGE(PG8_SB(1, 1), cB + hstep + kstep, voffB);
        PG8_WAIT_V(6); PG8_BAR;
    } else {
        PG8_STAGE(PG8_SB(0, 0), cB, voffB); PG8_STAGE(PG8_SA(0, 0), cA, voffA); PG8_STAGE(PG8_SB(0, 1), cB + hstep, voffB); PG8_STAGE(PG8_SA(0, 1), cA + hstep, voffA);
        if (wr == 1) PG8_BAR;
        PG8_WAIT_V(4); PG8_BAR;
        PG8_STAGE(PG8_SB(1, 0), cB + kstep, voffB); PG8_STAGE(PG8_SA(1, 0), cA + kstep, voffA); PG8_STAGE(PG8_SB(1, 1), cB + hstep + kstep, voffB);
        PG8_WAIT_V(6); PG8_BAR;
    }
    for (;;) {
        const bool has_next = S.next(ui + 1, nxt);
        const char* nA = has_next ? (const char*)g.A + (size_t)nxt.pm * tstep : cA; const char* nB = has_next ? (const char*)g.Bt + (size_t)nxt.pn * tstep : cB;
        for (int t = 0; t < nt; t += 2) {
            const bool last = (t == nt - 2);
            const char* a1 = cA + (size_t)(t + 1) * kstep;
            const char* a2 = last ? nA : cA + (size_t)(t + 2) * kstep; const char* b2 = last ? nB : cB + (size_t)(t + 2) * kstep;
            const char* a3 = a2 + kstep; const char* b3 = b2 + kstep;
            if (last && has_next) S.a_ready(nxt);
            if constexpr (SP2) {
            PG8_LDB(B0, 0, 0); PG8_LDB(B1, 0, 1); PG8_SCHED; PG8_LDA(At, 0, 0); PG8_STAGE(PG8_SA(1, 1), a1 + hstep, voffA);
            PG8_WAIT_V(8); PG8_WAIT_L(0); PG8_BAR; PG8_MMA(0, 0, At, B0); PG8_MMA(0, 1, At, B1); PG8_BAR; PG8_SCHED;
            PG8_LDA(At, 0, 1); PG8_STAGE(PG8_SB(0, 0), b2, voffB); PG8_STAGE(PG8_SB(0, 1), b2 + hstep, voffB); PG8_STAGE(PG8_SA(0, 0), a2, voffA);
            PG8_WAIT_V(8); PG8_WAIT_L(0); PG8_BAR; PG8_MMA(1, 0, At, B0); PG8_MMA(1, 1, At, B1); PG8_BAR; PG8_SCHED;
            PG8_LDB(B0, 1, 0); PG8_LDB(B1, 1, 1); PG8_SCHED; PG8_LDA(At, 1, 0); PG8_STAGE(PG8_SA(0, 1), a2 + hstep, voffA);
            PG8_WAIT_V(8); PG8_WAIT_L(0); PG8_BAR; PG8_MMA(0, 0, At, B0); PG8_MMA(0, 1, At, B1); PG8_BAR; PG8_SCHED;
            PG8_LDA(At, 1, 1); PG8_STAGE(PG8_SB(1, 0), b3, voffB); PG8_STAGE(PG8_SB(1, 1), b3 + hstep, voffB); PG8_STAGE(PG8_SA(1, 0), a3, voffA);
            PG8_WAIT_V(8); PG8_WAIT_L(0); PG8_BAR; PG8_MMA(1, 0, At, B0); PG8_MMA(1, 1, At, B1); PG8_BAR; PG8_SCHED;
            } else {
            PG8_LDB(B0, 0, 0); PG8_SCHED; PG8_LDA(At, 0, 0); PG8_STAGE(PG8_SA(1, 1), a1 + hstep, voffA);
            PG8_WAIT_L(8); PG8_BAR; PG8_WAIT_L(0); PG8_MMA(0, 0, At, B0); PG8_BAR; PG8_SCHED;
            PG8_LDB(B1, 0, 1); PG8_STAGE(PG8_SB(0, 0), b2, voffB);
            PG8_BAR; PG8_WAIT_L(0); PG8_MMA(0, 1, At, B1); PG8_BAR;
            PG8_LDA(At, 0, 1); PG8_STAGE(PG8_SA(0, 0), a2, voffA);
            PG8_BAR; PG8_WAIT_L(0); PG8_MMA(1, 0, At, B0); PG8_BAR; PG8_SCHED;
            PG8_STAGE(PG8_SB(0, 1), b2 + hstep, voffB);
            PG8_WAIT_V(6); PG8_BAR; PG8_MMA(1, 1, At, B1); PG8_BAR;
            PG8_LDB(B0, 1, 0); PG8_SCHED; PG8_LDA(At, 1, 0); PG8_STAGE(PG8_SA(0, 1), a2 + hstep, voffA);
            PG8_WAIT_L(8); PG8_BAR; PG8_WAIT_L(0); PG8_MMA(0, 0, At, B0); PG8_BAR; PG8_SCHED;
            PG8_LDB(B1, 1, 1); PG8_STAGE(PG8_SB(1, 0), b3, voffB);
            PG8_BAR; PG8_WAIT_L(0); PG8_MMA(0, 1, At, B1); PG8_BAR;
            PG8_LDA(At, 1, 1); PG8_STAGE(PG8_SA(1, 0), a3, voffA);
            PG8_BAR; PG8_WAIT_L(0); PG8_MMA(1, 0, At, B0); PG8_BAR; PG8_SCHED;
            PG8_STAGE(PG8_SB(1, 1), b3 + hstep, voffB);
            PG8_WAIT_V(6); PG8_BAR; PG8_MMA(1, 1, At, B1); PG8_BAR;
            }
        }
        if constexpr (ALIGN_EPI) { if (wr == 0) PG8_BAR; }
        if constexpr (!Epi::AFTER_DRAIN) { E(acc, cur, wr, wc, fr, fq); S.done(cur); }
        if (!has_next) break;
#pragma unroll
        for (int a = 0; a < 2; ++a)
#pragma unroll
            for (int b = 0; b < 2; ++b)
#pragma unroll
                for (int m = 0; m < 4; ++m)
#pragma unroll
                    for (int n = 0; n < 2; ++n) acc[a][b][m][n] = (f32x4){0.f, 0.f, 0.f, 0.f};
        cur = nxt; cA = nA; cB = nB; ++ui;
        if constexpr (ALIGN_EPI) { if (wr == 1) PG8_BAR; }
    }
    PG8_WAIT_V(0);
    if constexpr (!ALIGN_EPI) { if (wr == 0) PG8_BAR; }
    PG8_BAR;
    if constexpr (Epi::AFTER_DRAIN) { E.fused(acc, cur, wr, wc, fr, fq, lds, wid, lane); S.done(cur); }
#undef PG8_SA
#undef PG8_SB
#undef PG8_STAGE
#undef PG8_LDA
#undef PG8_LDB
#undef PG8_MMA
#undef PG8_WAIT_V
#undef PG8_WAIT_L
#undef PG8_BAR
#undef PG8_SCHED
}
}

#define LAS __attribute__((address_space(3)))
typedef unsigned short bf16;
typedef unsigned v4u __attribute__((ext_vector_type(4)));
typedef unsigned v2u __attribute__((ext_vector_type(2)));
typedef float f32x4 __attribute__((ext_vector_type(4)));
typedef float f32x2 __attribute__((ext_vector_type(2)));
typedef short bf16x8 __attribute__((ext_vector_type(8)));
typedef short s16x4 __attribute__((ext_vector_type(4)));

constexpr size_t MiB = 1u << 20;
constexpr size_t WS_MOD   = 1 * MiB;
constexpr size_t WS_ROPE  = WS_MOD + 512 * 1024;
constexpr size_t WS_LB    = WS_ROPE + 64 * 1024;
constexpr size_t WS_LBT   = WS_LB + 64 * 1024;
constexpr size_t WS_BBR   = WS_LBT + 64 * 1024;
constexpr size_t WS_BBI   = WS_BBR + 256 * 1024;
constexpr size_t WS_CM    = WS_BBI + 256 * 1024;
static_assert(WS_CM + 256 * 1024 <= 4 * MiB, "param block");
constexpr size_t WS_W1    = 4 * MiB;
constexpr size_t WS_W2    = 48 * MiB;
constexpr size_t WS_WIN   = 70 * MiB;
constexpr size_t WS_WOUT  = 75 * MiB;
constexpr size_t WS_GLU   = 77 * MiB;
constexpr size_t WS_WQKV  = 78 * MiB;
constexpr size_t WS_WO    = 84 * MiB;
constexpr size_t WS_HCTX  = 86 * MiB;
constexpr size_t WS_XN    = 90 * MiB;
constexpr size_t WS_R     = 124 * MiB;
constexpr size_t WS_HID   = WS_R;
constexpr size_t WS_QKVG  = WS_R;
constexpr size_t WS_U     = WS_R + 68 * MiB;
constexpr size_t WS_KVS   = WS_R + 85 * MiB;
constexpr size_t WS_SF    = WS_R + 119 * MiB;
constexpr size_t WS_YS    = WS_R + 128 * MiB;
constexpr size_t WS_QK    = WS_R;
constexpr size_t WS_VT    = WS_R + 68 * MiB;
constexpr size_t WS_END   = WS_R + 145 * MiB;

constexpr size_t WS_BAR = 0;
constexpr int BARLDS_OFF = 131072 + 320;
constexpr int NWAVES = 8, NTHREADS = 512;
constexpr int LDS_BYTES = 147456;

struct Args {
    const float* in[26]; float* out; unsigned char* ws; int probe; int pad;
};
enum { I_X = 0, I_C, I_CTX, I_CCTX, I_WMOD, I_BMOD, I_NORMG, I_W1, I_W2, I_WIN, I_WOUT, I_DECAY, I_LAMRE, I_LAMIM, I_LOGDT, I_BRE, I_BIM, I_CRE, I_CIM,
       I_S5D, I_GLUW, I_GLUB, I_WQKV, I_WO, I_RPB, I_FINALG };

__device__ __forceinline__ unsigned f2bf(float f) { unsigned u = __builtin_bit_cast(unsigned, f); return (u + 0x7fffu + ((u >> 16) & 1u)) >> 16; }
__device__ __forceinline__ unsigned pk2(float lo, float hi) { return f2bf(lo) | (f2bf(hi) << 16); }
__device__ __forceinline__ float bf2f(unsigned short h) { return __uint_as_float((unsigned)h << 16); }
__device__ __forceinline__ float blo(unsigned w) { return __uint_as_float(w << 16); }
__device__ __forceinline__ float bhi(unsigned w) { return __uint_as_float(w & 0xffff0000u); }
__device__ __forceinline__ int opaque_tid() { int t = threadIdx.x; asm volatile("" : "+v"(t)); return t; }
__device__ __forceinline__ float wave_sum(float v) {
#pragma unroll
    for (int o = 1; o < 64; o <<= 1) v += __shfl_xor(v, o);
    return v;
}
__device__ __forceinline__ void sincos_acc(float x, float& s, float& c) {
    const float k = rintf(x * 0.6366197723675814f);
    float r = fmaf(k, -1.5703125f, x); r = fmaf(k, -4.837512969970703125e-4f, r); r = fmaf(k, -7.54978995489188216e-8f, r);
    const float r2 = r * r;
    float sp = 2.7557319e-6f; sp = fmaf(sp, r2, -1.9841270e-4f); sp = fmaf(sp, r2, 8.3333333e-3f); sp = fmaf(sp, r2, -1.6666667e-1f); sp = fmaf(sp * r2, r, r);
    float cp = -2.7557319e-7f; cp = fmaf(cp, r2, 2.4801587e-5f); cp = fmaf(cp, r2, -1.3888889e-3f); cp = fmaf(cp, r2, 4.1666667e-2f); cp = fmaf(cp, r2, -0.5f); cp = fmaf(cp, r2, 1.0f);
    const int q = ((int)k) & 3;
    s = (q == 0) ? sp : (q == 1) ? cp : (q == 2) ? -sp : -cp;
    c = (q == 0) ? cp : (q == 1) ? -sp : (q == 2) ? -cp : sp;
}
__device__ __forceinline__ float gelu_tanh(float v) {
    const float t = 0.7978845608028654f * (v + 0.044715f * v * v * v);
    const float e = __expf(2.0f * t);
    const float th = 1.0f - 2.0f * __builtin_amdgcn_rcpf(e + 1.0f);
    return 0.5f * v * (1.0f + th);
}

__device__ __forceinline__ int map_row(int kind, int n) {
    if (kind == 1) { const int j = n < FF ? n : n - FF; return 256 * (j >> 7) + (n < FF ? 0 : 128) + (j & 127); }
    if (kind == 2 && n < 1024) { const int tile = n >> 8, hh = (n >> 7) & 1, d = n & 127; return 256 * tile + 128 * ((d >> 5) & 1) + 64 * hh + 32 * (d >> 6) + (d & 31); }
    return n;
}
__device__ __forceinline__ void p0_transpose_item(const float* W, int K, int N, int kind, bf16* WT, LAS float* scr, int item, int lane) {
    const int nblk = N / 32, kb = item / nblk, nb = item % nblk, k0 = 64 * kb, n0 = 32 * nb;
    const int drow = map_row(kind, n0);
#pragma unroll 8
    for (int i = 0; i < 32; ++i) { const int kk = 2 * i + (lane >> 5); scr[kk * 33 + (lane & 31)] = W[(size_t)(k0 + kk) * N + n0 + (lane & 31)]; }
    asm volatile("s_waitcnt lgkmcnt(0)" ::: "memory");
    const int c = lane & 7;
#pragma unroll
    for (int j = 0; j < 4; ++j) { const int n = (lane >> 3) + 8 * j; const LAS float* s = scr + (8 * c) * 33 + n;
        v4u o; o.x = pk2(s[0 * 33], s[1 * 33]); o.y = pk2(s[2 * 33], s[3 * 33]); o.z = pk2(s[4 * 33], s[5 * 33]); o.w = pk2(s[6 * 33], s[7 * 33]);
        *(v4u*)(WT + (size_t)(drow + n) * K + k0 + 8 * c) = o; }
    asm volatile("s_waitcnt lgkmcnt(0)" ::: "memory");
}

struct WDesc { const float* W; bf16* dst; int K, N, kind, items; };
__device__ __forceinline__ WDesc wdesc(const Args& a, int mi) {
    WDesc d;
    if (mi < 4)       { d.W = a.in[I_W1] + (size_t)mi * DM * 2 * FF; d.dst = (bf16*)(a.ws + WS_W1) + (size_t)mi * 2 * FF * DM; d.K = DM; d.N = 2 * FF; d.kind = 1; }
    else if (mi < 8)  { d.W = a.in[I_W2] + (size_t)(mi - 4) * FF * DM; d.dst = (bf16*)(a.ws + WS_W2) + (size_t)(mi - 4) * DM * FF; d.K = FF; d.N = DM; d.kind = 0; }
    else if (mi == 8) { d.W = a.in[I_WIN]; d.dst = (bf16*)(a.ws + WS_WIN); d.K = DM; d.N = 2560; d.kind = 2; }
    else if (mi == 9) { d.W = a.in[I_WOUT]; d.dst = (bf16*)(a.ws + WS_WOUT); d.K = DM; d.N = DM; d.kind = 0; }
    else if (mi == 10){ d.W = a.in[I_GLUW]; d.dst = (bf16*)(a.ws + WS_GLU); d.K = 512; d.N = 512; d.kind = 0; }
    else if (mi == 11){ d.W = a.in[I_WQKV]; d.dst = (bf16*)(a.ws + WS_WQKV); d.K = DM; d.N = 3072; d.kind = 0; }
    else              { d.W = a.in[I_WO]; d.dst = (bf16*)(a.ws + WS_WO); d.K = DM; d.N = DM; d.kind = 0; }
    d.items = (d.K / 64) * (d.N / 32);
    return d;
}
constexpr int NWMAT = 13;

__device__ __forceinline__ void p0_prologue(const Args& a, LAS unsigned char* lds, int G) {
    const int tid = opaque_tid(), lane = tid & 63, wave = __builtin_amdgcn_readfirstlane(tid >> 6);
    {
        LAS float* sv = (LAS float*)lds;
        LAS float* red = (LAS float*)(lds + 32768);
        bool have = false;
        for (int it = blockIdx.x; it < 2 * (MODW / 64); it += G) {
            if (!have) {
                for (int i = tid; i < 5 * DM; i += NTHREADS) { const int b = i >> 10, k = i & 1023; const float v = b < 4 ? a.in[I_C][b * DM + k] : a.in[I_CCTX][k]; sv[k * 8 + b] = v / (1.0f + expf(-v)); }
                __syncthreads(); have = true;
            }
            const int layer = it / (MODW / 64), n = (it % (MODW / 64)) * 64 + lane;
            const float* wp = a.in[I_WMOD] + (size_t)layer * DM * MODW + n;
            float acc[5] = {0.f, 0.f, 0.f, 0.f, 0.f};
#pragma unroll 8
            for (int kk = 0; kk < 128; ++kk) { const int k = wave * 128 + kk; const float w = wp[(size_t)k * MODW];
                const f32x4 s0 = *(const LAS f32x4*)(sv + k * 8); const float s4 = sv[k * 8 + 4];
                acc[0] = fmaf(s0[0], w, acc[0]); acc[1] = fmaf(s0[1], w, acc[1]); acc[2] = fmaf(s0[2], w, acc[2]); acc[3] = fmaf(s0[3], w, acc[3]); acc[4] = fmaf(s4, w, acc[4]); }
#pragma unroll
            for (int b = 0; b < 5; ++b) red[(wave * 5 + b) * 64 + lane] = acc[b];
            __syncthreads();
            if (tid < 320) { const int b = tid >> 6, l = tid & 63, nn = (it % (MODW / 64)) * 64 + l; float s = a.in[I_BMOD][layer * MODW + nn];
#pragma unroll
                for (int w = 0; w < 8; ++w) s += red[(w * 5 + b) * 64 + l];
                ((float*)(a.ws + WS_MOD))[((size_t)layer * 5 + b) * MODW + nn] = s; }
            __syncthreads();
        }
        __syncthreads();
    }
    const int gtid = blockIdx.x * NTHREADS + tid, GT = G * NTHREADS;
    for (int i = gtid; i < 64 * 32; i += GT) { const int pos = i >> 5, f = i & 31; const float inv = exp2f(-(float)f * (13.287712379549449f / 32.0f));
        float s, c; sincos_acc((float)pos * inv, s, c); ((f32x2*)(a.ws + WS_ROPE))[i] = (f32x2){c, s}; }
    for (int i = gtid; i < 2 * 32 * 64; i += GT) {
        const int p = i & 63, dg = i >> 6;
        const float lr = fminf(a.in[I_LAMRE][i], -1e-4f), li = a.in[I_LAMIM][i], dt = expf(a.in[I_LOGDT][dg]);
        float s, c; sincos_acc(li * dt, s, c); const float mg = expf(lr * dt); const float br = mg * c, bi = mg * s;
        ((f32x2*)(a.ws + WS_LB))[i] = (f32x2){br, bi};
        float s64, c64; sincos_acc(li * dt * 64.0f, s64, c64); const float m64 = expf(lr * dt * 64.0f);
        ((f32x2*)(a.ws + WS_LBT))[i] = (f32x2){m64 * c64, m64 * s64};
        const float nr = br - 1.0f, ni = bi, den = 1.0f / (lr * lr + li * li);
        const float cr = (nr * lr + ni * li) * den, ci = (ni * lr - nr * li) * den;
        for (int k = 0; k < 16; ++k) {
            const float bre = a.in[I_BRE][(size_t)i * 16 + k], bim = a.in[I_BIM][(size_t)i * 16 + k];
            ((float*)(a.ws + WS_BBR))[((size_t)dg * 16 + k) * 64 + p] = cr * bre - ci * bim;
            ((float*)(a.ws + WS_BBI))[((size_t)dg * 16 + k) * 64 + p] = cr * bim + ci * bre;
            const float cre = a.in[I_CRE][((size_t)dg * 16 + k) * 64 + p], cim = a.in[I_CIM][((size_t)dg * 16 + k) * 64 + p];
            ((unsigned*)(a.ws + WS_CM))[((size_t)dg * 16 + k) * 64 + p] = pk2(cre, -cim);
        }
    }
    {
        LAS float* scr = (LAS float*)(lds + wave * 16384);
        const int gw = blockIdx.x * NWAVES + wave, NGW = G * NWAVES;
        int total = 0;
        for (int mi = 0; mi < NWMAT; ++mi) total += wdesc(a, mi).items;
        for (int it = gw; it < total; it += NGW) {
            int r = it;
            for (int mi = 0; mi < NWMAT; ++mi) { const WDesc d = wdesc(a, mi); if (r < d.items) { p0_transpose_item(d.W, d.K, d.N, d.kind, d.dst, scr, r, lane); break; } r -= d.items; }
        }
    }
}

__device__ __forceinline__ void norm_phase(const float* src_lat, const float* src_ctx, bf16* XN, const float* g, const float* mod  , int ishift, int nrows, int G) {
    const int tid = opaque_tid(), lane = tid & 63, wave = __builtin_amdgcn_readfirstlane(tid >> 6);
    const int gw = blockIdx.x * NWAVES + wave, NGW = G * NWAVES;
    f32x4 gv[4];
#pragma unroll
    for (int j = 0; j < 4; ++j) gv[j] = *((const f32x4*)g + lane + 64 * j);
    for (int row = gw; row < nrows; row += NGW) {
        const float* xr = row < ML ? src_lat + (size_t)row * DM : src_ctx + (size_t)(row - ML) * DM;
        const int bidx = row < ML ? (row >> 12) : 4;
        const float* sh = mod + (size_t)bidx * MODW + ishift * DM; const float* sc = sh + DM;
        f32x4 v[4]; float s = 0.f;
#pragma unroll
        for (int j = 0; j < 4; ++j) { v[j] = *((const f32x4*)xr + lane + 64 * j); s += (v[j][0] * v[j][0] + v[j][1] * v[j][1]) + (v[j][2] * v[j][2] + v[j][3] * v[j][3]); }
        const float rstd = rsqrtf(wave_sum(s) * (1.0f / DM) + EPS);
#pragma unroll
        for (int j = 0; j < 4; ++j) {
            const f32x4 shv = *((const f32x4*)sh + lane + 64 * j), scv = *((const f32x4*)sc + lane + 64 * j);
            const f32x4 y = v[j] * rstd * gv[j] * (scv + 1.0f) + shv;
            *((v2u*)(XN + (size_t)row * DM) + lane + 64 * j) = (v2u){pk2(y[0], y[1]), pk2(y[2], y[3])};
        }
    }
}
__device__ __forceinline__ void final_norm_phase(float* io, const float* g, int G) {
    const int tid = opaque_tid(), lane = tid & 63, wave = __builtin_amdgcn_readfirstlane(tid >> 6);
    const int gw = blockIdx.x * NWAVES + wave, NGW = G * NWAVES;
    f32x4 gv[4];
#pragma unroll
    for (int j = 0; j < 4; ++j) gv[j] = *((const f32x4*)g + lane + 64 * j);
    for (int row = gw; row < ML; row += NGW) {
        float* xr = io + (size_t)row * DM;
        f32x4 v[4]; float s = 0.f;
#pragma unroll
        for (int j = 0; j < 4; ++j) { v[j] = *((const f32x4*)xr + lane + 64 * j); s += (v[j][0] * v[j][0] + v[j][1] * v[j][1]) + (v[j][2] * v[j][2] + v[j][3] * v[j][3]); }
        const float rstd = rsqrtf(wave_sum(s) * (1.0f / DM) + EPS);
#pragma unroll
        for (int j = 0; j < 4; ++j) *((f32x4*)xr + lane + 64 * j) = v[j] * rstd * gv[j];
    }
}

#define XB_TMO      128
#define XB_XCNT(j)  (256  + 64 * (j))
#define XB_XSUB(j)  (1280 + 64 * (j))
#define XB_XGEN(j)  (2304 + 64 * (j))
#define XB_TOP      3328
#define XB_TOPGEN   3392
#define XCD_BAR_WORDS 3456
#define XB_SPIN_CAP (1u << 18)

__device__ __forceinline__ unsigned xb_ld(unsigned* p)              { return __hip_atomic_load(p, __ATOMIC_RELAXED, __HIP_MEMORY_SCOPE_AGENT); }
__device__ __forceinline__ unsigned xb_add(unsigned* p, unsigned v) { return __hip_atomic_fetch_add(p, v, __ATOMIC_RELAXED, __HIP_MEMORY_SCOPE_AGENT); }
__device__ __forceinline__ unsigned xb_xcc_id() { return (unsigned)__builtin_amdgcn_s_getreg((3 << 11) | 20) & 0xFu; }
#define XB_SPIN(cond, bar) do { unsigned _sp = 0; while (cond) { __builtin_amdgcn_s_sleep(1); \
    if ((++_sp & 255u) == 0u) { if (xb_ld(&(bar)[XB_TMO])) break; if (_sp > XB_SPIN_CAP) { atomicAdd(&(bar)[XB_TMO], 1u); break; } } } } while (0)

struct XcdBarrier {
    unsigned* bar; unsigned x;
    volatile LAS unsigned* st;
};

__device__ __forceinline__ XcdBarrier xcd_barrier_post(unsigned* bar, volatile LAS unsigned* st) {
    XcdBarrier b; b.bar = bar; b.x = xb_xcc_id(); b.st = st;
    if (threadIdx.x == 0) (void)xb_add(&bar[XB_XCNT(b.x)], 1u);
    return b;
}
__device__ __forceinline__ void xcd_barrier_complete(unsigned* bar, unsigned x, unsigned& nloc, unsigned& nx) {
    const unsigned G = gridDim.x * gridDim.y * gridDim.z;
    unsigned sum, cnt, mine, sp = 0u;
    for (;;) {
        sum = 0u; cnt = 0u; mine = 0u;
#pragma unroll
        for (unsigned j = 0; j < 16; ++j) { const unsigned c = xb_ld(&bar[XB_XCNT(j)]); sum += c; cnt += (c > 0u) ? 1u : 0u; mine = (j == x) ? c : mine; }
        if (sum == G) break;
        __builtin_amdgcn_s_sleep(1);
        if ((++sp & 255u) == 0u) { if (xb_ld(&bar[XB_TMO])) break; if (sp > XB_SPIN_CAP) { atomicAdd(&bar[XB_TMO], 1u); break; } }
    }
    nloc = mine > 0u ? mine : 1u; nx = cnt > 0u ? cnt : 1u;
}

__device__ __forceinline__ void xcd_barrier(const XcdBarrier& b) {
    asm volatile("s_waitcnt vmcnt(0)" ::: "memory");
    __syncthreads();
    if (threadIdx.x == 0) {
        unsigned* bar = b.bar;
        __builtin_amdgcn_s_waitcnt(0);
        unsigned nloc = b.st[0], nx = b.st[1];
        if (nloc == 0u) { xcd_barrier_complete(bar, b.x, nloc, nx); b.st[0] = nloc; b.st[1] = nx; }
        const unsigned old = xb_add(&bar[XB_XSUB(b.x)], 1u);
        const unsigned gen = old / nloc;
        if (old + 1u == (gen + 1u) * nloc) {
            __builtin_amdgcn_fence(__ATOMIC_RELEASE, "agent");
            asm volatile("s_waitcnt vmcnt(0)" ::: "memory");
            const unsigned og = xb_add(&bar[XB_TOP], 1u);
            const unsigned tg = og / nx;
            if (og + 1u == (tg + 1u) * nx) xb_add(&bar[XB_TOPGEN], 1u);
            else XB_SPIN(xb_ld(&bar[XB_TOPGEN]) == tg, bar);
            __builtin_amdgcn_fence(__ATOMIC_ACQUIRE, "agent");
            xb_add(&bar[XB_XGEN(b.x)], 1u);
            asm volatile("s_waitcnt vmcnt(0)" ::: "memory");
        } else {
            XB_SPIN(xb_ld(&bar[XB_XGEN(b.x)]) == gen, bar);
            __builtin_amdgcn_fence(__ATOMIC_ACQUIRE, "agent");
            asm volatile("s_waitcnt vmcnt(0)" ::: "memory");
        }
    }
    __syncthreads();
}


typedef float f32x4m __attribute__((ext_vector_type(4)));
#define MFMA16(a, b, c) __builtin_amdgcn_mfma_f32_16x16x32_bf16((a), (b), (c), 0, 0, 0)
__device__ __forceinline__ unsigned off_b(unsigned row, unsigned ch) { return 256u * row + 16u * (ch ^ (((row & 3u) << 2) | ((row >> 2) & 3u))); }
__device__ __forceinline__ bf16x8 tr_frag(LAS unsigned char* tile, int lane, int c, int ks) {
    const unsigned g = lane >> 4, q = (lane & 15) >> 2, p = lane & 3;
    const s16x4 lo = __builtin_amdgcn_ds_read_tr16_b64_v4i16((LAS s16x4*)(tile + off_b(32 * ks + 8 * g + q, 2 * c + (p >> 1)) + 8 * (p & 1)));
    const s16x4 hi = __builtin_amdgcn_ds_read_tr16_b64_v4i16((LAS s16x4*)(tile + off_b(32 * ks + 8 * g + 4 + q, 2 * c + (p >> 1)) + 8 * (p & 1)));
    return (bf16x8){lo[0], lo[1], lo[2], lo[3], hi[0], hi[1], hi[2], hi[3]};
}
__device__ __forceinline__ bf16x8 pack8(const f32x4 a, const f32x4 b) {
    v4u w; w.x = pk2(a[0], a[1]); w.y = pk2(a[2], a[3]); w.z = pk2(b[0], b[1]); w.w = pk2(b[2], b[3]);
    return __builtin_bit_cast(bf16x8, w);
}
__device__ __forceinline__ float log_sigmoid(float x) { return -log1pf(expf(-x)); }

__device__ __forceinline__ int ret_row0(int b, int s) { return s < 2 ? ML + b * CTXL + s * 128 : b * SEQ + (s - 2) * 128; }

__device__ __forceinline__ void r1_unit(const Args& a, LAS unsigned char* lds, int unit) {
    const int tid = opaque_tid(), lane = tid & 63, wave = __builtin_amdgcn_readfirstlane(tid >> 6);
    const int s = unit % 34, bh = unit / 34, h = bh & 3, b = bh >> 2, row0 = ret_row0(b, s);
    const bf16* QKVG = (const bf16*)(a.ws + WS_QKVG);
    const float lgf = log_sigmoid(a.in[I_DECAY][h]), lgb = log_sigmoid(a.in[I_DECAY][4 + h]);
#pragma unroll
    for (int it = 0; it < 4; ++it) {
        const int n = tid + NTHREADS * it, row = n >> 4, ch = n & 15;
        const bf16* kp = QKVG + (size_t)(row0 + row) * 2048 + 512 + 128 * h + 8 * ch;
        const v4u kv = *(const v4u*)kp, vv = *(const v4u*)(kp + 512);
        const float wf = expf(lgf * (float)(127 - row)), wb = expf(lgb * (float)row);
        v4u kf, kb;
        kf.x = pk2(blo(kv.x) * wf, bhi(kv.x) * wf); kf.y = pk2(blo(kv.y) * wf, bhi(kv.y) * wf); kf.z = pk2(blo(kv.z) * wf, bhi(kv.z) * wf); kf.w = pk2(blo(kv.w) * wf, bhi(kv.w) * wf);
        kb.x = pk2(blo(kv.x) * wb, bhi(kv.x) * wb); kb.y = pk2(blo(kv.y) * wb, bhi(kv.y) * wb); kb.z = pk2(blo(kv.z) * wb, bhi(kv.z) * wb); kb.w = pk2(blo(kv.w) * wb, bhi(kv.w) * wb);
        const unsigned o = off_b(row, ch);
        *(LAS v4u*)(lds + o) = kf; *(LAS v4u*)(lds + 32768 + o) = kb; *(LAS v4u*)(lds + 65536 + o) = vv;
    }
    __syncthreads();
    f32x4 accf[8], accb[8];
#pragma unroll
    for (int c = 0; c < 8; ++c) { accf[c] = (f32x4){0.f, 0.f, 0.f, 0.f}; accb[c] = (f32x4){0.f, 0.f, 0.f, 0.f}; }
#pragma unroll
    for (int ks = 0; ks < 4; ++ks) {
        const bf16x8 kf = tr_frag(lds, lane, wave, ks), kb = tr_frag(lds + 32768, lane, wave, ks);
#pragma unroll
        for (int c = 0; c < 8; ++c) { const bf16x8 vf = tr_frag(lds + 65536, lane, c, ks); accf[c] = MFMA16(kf, vf, accf[c]); accb[c] = MFMA16(kb, vf, accb[c]); }
    }
    bf16* Sf = (bf16*)(a.ws + WS_KVS) + ((size_t)(bh * 2 + 0) * 34 + s) * 16384;
    bf16* Sb = (bf16*)(a.ws + WS_KVS) + ((size_t)(bh * 2 + 1) * 34 + s) * 16384;
    const int d0 = 16 * wave + 4 * (lane >> 4);
#pragma unroll
    for (int c = 0; c < 8; ++c) { const int e = 16 * c + (lane & 15);
        *(v2u*)(Sf + e * 128 + d0) = (v2u){pk2(accf[c][0], accf[c][1]), pk2(accf[c][2], accf[c][3])};
        *(v2u*)(Sb + e * 128 + d0) = (v2u){pk2(accb[c][0], accb[c][1]), pk2(accb[c][2], accb[c][3])}; }
    __syncthreads();
}

__device__ __forceinline__ void r2_items(const Args& a, int G) {
    const int gtid = blockIdx.x * NTHREADS + opaque_tid(), GT = G * NTHREADS;
    for (int idx = gtid; idx < 32 * 4096; idx += GT) {
        const int bhd = idx >> 12, o4 = idx & 4095, dir = bhd & 1, h = (bhd >> 1) & 3;
        const float decay = expf(log_sigmoid(a.in[I_DECAY][dir * 4 + h]) * 128.0f);
        bf16* base = (bf16*)(a.ws + WS_KVS) + (size_t)bhd * 34 * 16384 + o4 * 4;
        const long step = dir == 0 ? 16384 : -16384;
        bf16* p0 = base + (dir == 0 ? 0 : 16384); bf16* p2 = base + (dir == 0 ? 2 * 16384 : 33 * 16384);
        v2u v[34];
        { bf16* p = p0;
#pragma unroll
          for (int i = 0; i < 34; ++i) { if (i == 2) p = p2; v[i] = *(const v2u*)p; p += step; asm volatile("" : "+v"(p)); } }
        float st0 = 0.f, st1 = 0.f, st2 = 0.f, st3 = 0.f;
        { bf16* p = p0;
#pragma unroll
          for (int i = 0; i < 34; ++i) { if (i == 2) p = p2;
            *(v2u*)p = (v2u){pk2(st0, st1), pk2(st2, st3)}; p += step; asm volatile("" : "+v"(p));
            st0 = fmaf(decay, st0, blo(v[i].x)); st1 = fmaf(decay, st1, bhi(v[i].x)); st2 = fmaf(decay, st2, blo(v[i].y)); st3 = fmaf(decay, st3, bhi(v[i].y)); } }
    }
}

__device__ __forceinline__ void r3_unit(const Args& a, LAS unsigned char* lds, int unit) {
    const int tid = opaque_tid(), lane = tid & 63, wave = __builtin_amdgcn_readfirstlane(tid >> 6);
    const int s = unit % 34, bh = unit / 34, h = bh & 3, b = bh >> 2, row0 = ret_row0(b, s);
    const bf16* QKVG = (const bf16*)(a.ws + WS_QKVG);
    const float l2f = log_sigmoid(a.in[I_DECAY][h]) * 1.4426950408889634f, l2b = log_sigmoid(a.in[I_DECAY][4 + h]) * 1.4426950408889634f;
#pragma unroll
    for (int it = 0; it < 4; ++it) {
        const int n = tid + NTHREADS * it, row = n >> 4, ch = n & 15;
        *(LAS v4u*)(lds + off_b(row, ch)) = *(const v4u*)(QKVG + (size_t)(row0 + row) * 2048 + 1024 + 128 * h + 8 * ch);
    }
    __syncthreads();
    const int fr = lane & 15, g = lane >> 4;
    bf16x8 qf[4];
#pragma unroll
    for (int ks = 0; ks < 4; ++ks) qf[ks] = *(const bf16x8*)(QKVG + (size_t)(row0 + 16 * wave + fr) * 2048 + 128 * h + 32 * ks + 8 * g);
    f32x4 acco[8];
#pragma unroll
    for (int c = 0; c < 8; ++c) acco[c] = (f32x4){0.f, 0.f, 0.f, 0.f};
    const int iq = 16 * wave + fr;
#pragma unroll
    for (int jt = 0; jt < 4; ++jt) {
        f32x4 sa = (f32x4){0.f, 0.f, 0.f, 0.f}, sb = sa;
        const int ja = 32 * jt + 8 * (fr >> 2) + (fr & 3);
        const bf16* kpa = QKVG + (size_t)(row0 + ja) * 2048 + 512 + 128 * h + 8 * g;
#pragma unroll
        for (int ks = 0; ks < 4; ++ks) {
            const bf16x8 ka = *(const bf16x8*)(kpa + 32 * ks), kb = *(const bf16x8*)(kpa + 4 * 2048 + 32 * ks);
            sa = MFMA16(ka, qf[ks], sa); sb = MFMA16(kb, qf[ks], sb);
        }
        f32x4 pa, pb;
#pragma unroll
        for (int r = 0; r < 4; ++r) {
            const int j0 = 32 * jt + 8 * g + r, d0 = iq - j0, d1 = d0 - 4;
            const float w0 = (d0 >= 0 ? __builtin_amdgcn_exp2f(l2f * (float)d0) : 0.f) + (d0 <= 0 ? __builtin_amdgcn_exp2f(-l2b * (float)d0) : 0.f);
            const float w1 = (d1 >= 0 ? __builtin_amdgcn_exp2f(l2f * (float)d1) : 0.f) + (d1 <= 0 ? __builtin_amdgcn_exp2f(-l2b * (float)d1) : 0.f);
            pa[r] = sa[r] * w0; pb[r] = sb[r] * w1;
        }
        const bf16x8 pf = pack8(pa, pb);
#pragma unroll
        for (int c = 0; c < 8; ++c) { const bf16x8 vf = tr_frag(lds, lane, c, jt); acco[c] = MFMA16(pf, vf, acco[c]); }
    }
    const bf16* Sf = (const bf16*)(a.ws + WS_KVS) + ((size_t)(bh * 2 + 0) * 34 + s) * 16384;
    const bf16* Sb = (const bf16*)(a.ws + WS_KVS) + ((size_t)(bh * 2 + 1) * 34 + s) * 16384;
    float ff[4], fb[4];
#pragma unroll
    for (int r = 0; r < 4; ++r) { const int i = 16 * wave + 4 * g + r; ff[r] = __builtin_amdgcn_exp2f(l2f * (float)(i + 1)); fb[r] = __builtin_amdgcn_exp2f(l2b * (float)(128 - i)); }
    float ss[4] = {0.f, 0.f, 0.f, 0.f};
#pragma unroll
    for (int c = 0; c < 8; ++c) {
        f32x4 t1 = (f32x4){0.f, 0.f, 0.f, 0.f}, t2 = t1;
        const int e = 16 * c + fr;
#pragma unroll
        for (int ks = 0; ks < 4; ++ks) {
            const bf16x8 s1 = *(const bf16x8*)(Sf + e * 128 + 32 * ks + 8 * g), s2 = *(const bf16x8*)(Sb + e * 128 + 32 * ks + 8 * g);
            t1 = MFMA16(qf[ks], s1, t1); t2 = MFMA16(qf[ks], s2, t2);
        }
#pragma unroll
        for (int r = 0; r < 4; ++r) { const float o = acco[c][r] + ff[r] * t1[r] + fb[r] * t2[r]; acco[c][r] = o; ss[r] = fmaf(o, o, ss[r]); }
    }
#pragma unroll
    for (int r = 0; r < 4; ++r) { float v = ss[r]; v += __shfl_xor(v, 1); v += __shfl_xor(v, 2); v += __shfl_xor(v, 4); v += __shfl_xor(v, 8); ss[r] = rsqrtf(v * (1.0f / 128.0f) + EPS); }
    bf16* YM = (bf16*)(a.ws + WS_XN);
#pragma unroll
    for (int r = 0; r < 4; ++r) { const size_t row = (size_t)(row0 + 16 * wave + 4 * g + r);
#pragma unroll
        for (int c = 0; c < 8; ++c) { const int e = 16 * c + fr; const float gt = bf2f(QKVG[row * 2048 + 1536 + 128 * h + e]);
            YM[row * DM + 128 * h + e] = (bf16)f2bf(acco[c][r] * ss[r] * (gt * __builtin_amdgcn_rcpf(1.0f + __expf(-gt)))); } }
    __syncthreads();
}

__device__ __forceinline__ int s5_row0(int b, int c) { return c < 4 ? ML + b * CTXL + 64 * c : b * SEQ + 64 * (c - 4); }
constexpr int S5_WLDS = 12288;

__device__ __forceinline__ void s5_stage_u(const Args& a, LAS float* us, int rowbase, int g, int lane) {
    const bf16* up = (const bf16*)(a.ws + WS_U) + (size_t)(rowbase + lane) * 512 + 16 * g;
    const v4u u0 = *(const v4u*)up, u1 = *(const v4u*)(up + 8);
    LAS f32x4* d = (LAS f32x4*)(us + lane * 16);
    d[0] = (f32x4){blo(u0.x), bhi(u0.x), blo(u0.y), bhi(u0.y)}; d[1] = (f32x4){blo(u0.z), bhi(u0.z), blo(u0.w), bhi(u0.w)};
    d[2] = (f32x4){blo(u1.x), bhi(u1.x), blo(u1.y), bhi(u1.y)}; d[3] = (f32x4){blo(u1.z), bhi(u1.z), blo(u1.w), bhi(u1.w)};
    asm volatile("s_waitcnt lgkmcnt(0)" ::: "memory");
}
#define S5_STEP(t_)  { const LAS f32x4* up_ = (const LAS f32x4*)(us + (t_) * 16); const f32x4 ua = up_[0], ub = up_[1], uc = up_[2], ud = up_[3]; \
        float br_ = bbr[0] * ua[0], bi_ = bbi[0] * ua[0]; \
        br_ = fmaf(bbr[1], ua[1], br_); bi_ = fmaf(bbi[1], ua[1], bi_); br_ = fmaf(bbr[2], ua[2], br_); bi_ = fmaf(bbi[2], ua[2], bi_); br_ = fmaf(bbr[3], ua[3], br_); bi_ = fmaf(bbi[3], ua[3], bi_); \
        br_ = fmaf(bbr[4], ub[0], br_); bi_ = fmaf(bbi[4], ub[0], bi_); br_ = fmaf(bbr[5], ub[1], br_); bi_ = fmaf(bbi[5], ub[1], bi_); br_ = fmaf(bbr[6], ub[2], br_); bi_ = fmaf(bbi[6], ub[2], bi_); br_ = fmaf(bbr[7], ub[3], br_); bi_ = fmaf(bbi[7], ub[3], bi_); \
        br_ = fmaf(bbr[8], uc[0], br_); bi_ = fmaf(bbi[8], uc[0], bi_); br_ = fmaf(bbr[9], uc[1], br_); bi_ = fmaf(bbi[9], uc[1], bi_); br_ = fmaf(bbr[10], uc[2], br_); bi_ = fmaf(bbi[10], uc[2], bi_); br_ = fmaf(bbr[11], uc[3], br_); bi_ = fmaf(bbi[11], uc[3], bi_); \
        br_ = fmaf(bbr[12], ud[0], br_); bi_ = fmaf(bbi[12], ud[0], bi_); br_ = fmaf(bbr[13], ud[1], br_); bi_ = fmaf(bbi[13], ud[1], bi_); br_ = fmaf(bbr[14], ud[2], br_); bi_ = fmaf(bbi[14], ud[2], bi_); br_ = fmaf(bbr[15], ud[3], br_); bi_ = fmaf(bbi[15], ud[3], bi_); \
        const float nr_ = fmaf(lr, xr, fmaf(-li, xi, br_)), ni_ = fmaf(lr, xi, fmaf(li, xr, bi_)); xr = nr_; xi = ni_; }

__device__ __forceinline__ void s1_unit(const Args& a, LAS unsigned char* wl, int wu, int lane) {
    const int c = wu % 68, bgd = wu / 68, dir = bgd & 1, g = (bgd >> 1) & 31, b = bgd >> 6, dg = dir * 32 + g, p = lane;
    LAS float* us = (LAS float*)wl;
    s5_stage_u(a, us, s5_row0(b, c), g, lane);
    const f32x2 lb = ((const f32x2*)(a.ws + WS_LB))[dg * 64 + p]; const float lr = lb.x, li = lb.y;
    float bbr[16], bbi[16];
#pragma unroll
    for (int k = 0; k < 16; ++k) { bbr[k] = ((const float*)(a.ws + WS_BBR))[(dg * 16 + k) * 64 + p]; bbi[k] = ((const float*)(a.ws + WS_BBI))[(dg * 16 + k) * 64 + p]; }
    float xr = 0.f, xi = 0.f;
    if (dir == 0) { for (int t = 0; t < 64; ++t) S5_STEP(t) }
    else { for (int t = 63; t >= 0; --t) S5_STEP(t) }
    ((f32x2*)(a.ws + WS_SF))[(size_t)wu * 64 + p] = (f32x2){xr, xi};
    asm volatile("s_waitcnt lgkmcnt(0)" ::: "memory");
}
__device__ __forceinline__ void s2_items(const Args& a, int G) {
    const int gtid = blockIdx.x * NTHREADS + opaque_tid(), GT = G * NTHREADS;
    for (int idx = gtid; idx < 4 * 32 * 2 * 64; idx += GT) {
        const int p = idx & 63, bgd = idx >> 6, dir = bgd & 1, g = (bgd >> 1) & 31, dg = dir * 32 + g;
        const f32x2 lt = ((const f32x2*)(a.ws + WS_LBT))[dg * 64 + p];
        f32x2* base = (f32x2*)(a.ws + WS_SF) + (size_t)bgd * 68 * 64 + p;
        const long step = dir == 0 ? 64 : -64;
        f32x2* q0 = base + (dir == 0 ? 0 : 3 * 64); f32x2* q4 = base + (dir == 0 ? 4 * 64 : 67 * 64);
        float cr = 0.f, ci = 0.f;
        f32x2* pl = q0; f32x2* ps = q0;
#pragma unroll
        for (int hb = 0; hb < 2; ++hb) {
            f32x2 v[34];
#pragma unroll
            for (int j = 0; j < 34; ++j) { if (34 * hb + j == 4) pl = q4; v[j] = *pl; pl += step; asm volatile("" : "+v"(pl)); }
#pragma unroll
            for (int j = 0; j < 34; ++j) { if (34 * hb + j == 4) ps = q4; *ps = (f32x2){cr, ci}; ps += step; asm volatile("" : "+v"(ps));
                const float nr = fmaf(lt.x, cr, fmaf(-lt.y, ci, v[j].x)), ni = fmaf(lt.x, ci, fmaf(lt.y, cr, v[j].y)); cr = nr; ci = ni; }
        }
    }
}
__device__ __forceinline__ void s3_unit(const Args& a, LAS unsigned char* wl, int wu, int lane) {
    const int c = wu % 68, bg = wu / 68, g = bg & 31, b = bg >> 5, p = lane, fr = lane & 15, gq = lane >> 4;
    LAS float* us = (LAS float*)wl; LAS unsigned char* xs = wl + 4096;
    const int rowbase = s5_row0(b, c);
    s5_stage_u(a, us, rowbase, g, lane);
    f32x4 acc[4];
#pragma unroll
    for (int i = 0; i < 4; ++i) acc[i] = (f32x4){0.f, 0.f, 0.f, 0.f};
#pragma unroll
    for (int dir = 0; dir < 2; ++dir) {
        const int dg = dir * 32 + g;
        const f32x2 lb = ((const f32x2*)(a.ws + WS_LB))[dg * 64 + p]; const float lr = lb.x, li = lb.y;
        float bbr[16], bbi[16];
#pragma unroll
        for (int k = 0; k < 16; ++k) { bbr[k] = ((const float*)(a.ws + WS_BBR))[(dg * 16 + k) * 64 + p]; bbi[k] = ((const float*)(a.ws + WS_BBI))[(dg * 16 + k) * 64 + p]; }
        bf16x8 cm[4];
#pragma unroll
        for (int ks = 0; ks < 4; ++ks) cm[ks] = *(const bf16x8*)((const bf16*)(a.ws + WS_CM) + (size_t)(dg * 16 + fr) * 128 + 32 * ks + 8 * gq);
        const f32x2 x0 = ((const f32x2*)(a.ws + WS_SF))[((size_t)((b * 32 + g) * 2 + dir) * 68 + c) * 64 + p];
        float xr = x0.x, xi = x0.y;
#pragma unroll
        for (int half = 0; half < 2; ++half) {
            const int hs = dir ? 1 - half : half;
            for (int tt = 0; tt < 32; ++tt) {
                const int tl = dir ? 31 - tt : tt, t = 32 * hs + tl;
                S5_STEP(t)
                *(LAS unsigned*)(xs + tl * 256 + (((p >> 2) ^ (tl & 15)) * 16) + (p & 3) * 4) = pk2(xr, xi);
            }
            asm volatile("s_waitcnt lgkmcnt(0)" ::: "memory");
#pragma unroll
            for (int th = 0; th < 2; ++th) {
                const int row = 16 * th + fr;
                f32x4 d = acc[2 * hs + th];
#pragma unroll
                for (int ks = 0; ks < 4; ++ks) { const bf16x8 xf = *(const LAS bf16x8*)(xs + row * 256 + (((4 * ks + gq) ^ (row & 15)) * 16)); d = MFMA16(cm[ks], xf, d); }
                acc[2 * hs + th] = d;
            }
            asm volatile("s_waitcnt lgkmcnt(0)" ::: "memory");
        }
    }
    const f32x4 dsk = *(const f32x4*)(a.in[I_S5D] + 16 * g + 4 * gq);
    bf16* YS = (bf16*)(a.ws + WS_YS);
#pragma unroll
    for (int T4 = 0; T4 < 4; ++T4) {
        const int t = 16 * T4 + fr; const f32x4 u4 = *(const LAS f32x4*)(us + t * 16 + 4 * gq);
        const f32x4 y = acc[T4] + dsk * u4;
        *(v2u*)(YS + (size_t)(rowbase + t) * 512 + 16 * g + 4 * gq) = (v2u){pk2(gelu_tanh(y[0]), gelu_tanh(y[1])), pk2(gelu_tanh(y[2]), gelu_tanh(y[3]))};
    }
    asm volatile("s_waitcnt lgkmcnt(0)" ::: "memory");
}

__device__ __forceinline__ void na_unit(const Args& a, int wu, int lane) {
    const int r = wu & 63, cb = (wu >> 6) & 3, h = (wu >> 8) & 15, b = wu >> 12, fr = lane & 15, g = lane >> 4;
    const bf16* QK = (const bf16*)(a.ws + WS_QK); const bf16* VT = (const bf16*)(a.ws + WS_VT); bf16* AO = (bf16*)(a.ws + WS_XN);
    const int r0 = min(max(r - 4, 0), 56), kcol0 = min(max(16 * cb - 8, 0), 32);
    const int tq0 = b * SEQ + r * 64 + 16 * cb;
    const unsigned qoff = (unsigned)(fr * 2048 + 8 * g);
    const bf16* qb = QK + (size_t)tq0 * 2048 + 64 * h;
    bf16x8 qf[2]; qf[0] = *(const bf16x8*)(qb + qoff); qf[1] = *(const bf16x8*)(qb + qoff + 32);
    const unsigned koffl = (unsigned)((8 * (fr >> 2) + (fr & 3)) * 2048 + 8 * g);
    const unsigned voffl = (unsigned)(fr * MT + 8 * g);
    const int cq = 16 * cb + fr, ws = min(max(cq - 8, 0), 48);
    int bidx[8]; bool bval[8];
#pragma unroll
    for (int j = 0; j < 8; ++j) { const int kc = kcol0 + 8 * g + (j & 3) + 4 * (j >> 2); bval[j] = kc >= ws && kc < ws + 16; bidx[j] = min(max(kc - cq + 15, 0), 30); }
    const float* rpb = a.in[I_RPB] + (size_t)h * 15 * 31;
    f32x4 o[4];
#pragma unroll
    for (int dt = 0; dt < 4; ++dt) o[dt] = (f32x4){0.f, 0.f, 0.f, 0.f};
    float mrun = -1e30f, lsum = 0.f;
#pragma unroll
    for (int half = 0; half < 2; ++half) {
        f32x4 sc[8][2];
#pragma unroll
        for (int i = 0; i < 8; ++i) {
            const int tok0 = half == 0 ? b * SEQ + (r0 + i) * 64 + kcol0 : ML + b * CTXL + 32 * i;
            const bf16* kb = QK + (size_t)tok0 * 2048 + 1024 + 64 * h;
            f32x4 sa = (f32x4){0.f, 0.f, 0.f, 0.f}, sb = sa;
            sa = MFMA16(*(const bf16x8*)(kb + koffl), qf[0], sa); sa = MFMA16(*(const bf16x8*)(kb + koffl + 32), qf[1], sa);
            sb = MFMA16(*(const bf16x8*)(kb + koffl + 4 * 2048), qf[0], sb); sb = MFMA16(*(const bf16x8*)(kb + koffl + 4 * 2048 + 32), qf[1], sb);
            if (half == 0) {
                const float* bp = rpb + (r0 + i - r + 7) * 31;
#pragma unroll
                for (int rr = 0; rr < 4; ++rr) { sa[rr] = bval[rr] ? sa[rr] + bp[bidx[rr]] : -1e30f; sb[rr] = bval[4 + rr] ? sb[rr] + bp[bidx[4 + rr]] : -1e30f; }
            }
            sc[i][0] = sa; sc[i][1] = sb;
        }
        float mx = -1e30f;
#pragma unroll
        for (int i = 0; i < 8; ++i)
#pragma unroll
            for (int t = 0; t < 2; ++t) mx = fmaxf(mx, fmaxf(fmaxf(sc[i][t][0], sc[i][t][1]), fmaxf(sc[i][t][2], sc[i][t][3])));
        mx = fmaxf(mx, __shfl_xor(mx, 16)); mx = fmaxf(mx, __shfl_xor(mx, 32));
        const float mnew = fmaxf(mrun, mx);
        const float resc = __builtin_amdgcn_exp2f((mrun - mnew) * 1.4426950408889634f);
        mrun = mnew; lsum *= resc;
#pragma unroll
        for (int dt = 0; dt < 4; ++dt) o[dt] = o[dt] * resc;
        const float mneg = -mnew * 1.4426950408889634f;
        float ls = 0.f;
#pragma unroll
        for (int i = 0; i < 8; ++i)
#pragma unroll
            for (int t = 0; t < 2; ++t)
#pragma unroll
                for (int rr = 0; rr < 4; ++rr) { const float pv = __builtin_amdgcn_exp2f(fmaf(sc[i][t][rr], 1.4426950408889634f, mneg)); sc[i][t][rr] = pv; ls += pv; }
        lsum += ls;
#pragma unroll
        for (int i = 0; i < 8; ++i) {
            const bf16x8 pf = pack8(sc[i][0], sc[i][1]);
            const int tok0 = half == 0 ? b * SEQ + (r0 + i) * 64 + kcol0 : ML + b * CTXL + 32 * i;
            const bf16* vb = VT + (size_t)(64 * h) * MT + tok0;
#pragma unroll
            for (int dt = 0; dt < 4; ++dt) o[dt] = MFMA16(*(const bf16x8*)(vb + voffl + (unsigned)(16 * dt * MT)), pf, o[dt]);
        }
    }
    lsum += __shfl_xor(lsum, 16); lsum += __shfl_xor(lsum, 32);
    const float rl = 1.0f / lsum;
    bf16* ob = AO + (size_t)tq0 * DM + 64 * h;
#pragma unroll
    for (int dt = 0; dt < 4; ++dt)
        *(v2u*)(ob + (unsigned)(fr * DM + 16 * dt + 4 * g)) = (v2u){pk2(o[dt][0] * rl, o[dt][1] * rl), pk2(o[dt][2] * rl, o[dt][3] * rl)};
}

#ifndef STAGE
#define STAGE 6
#endif
#define GSYNC() xcd_barrier(bar)

template <class Epi>
__device__ __forceinline__ void run_gemm(LAS unsigned char* lds, const bf16* A, const bf16* Bt, int M, int N, int K, int G, const Epi& E) {
    pg8::Gemm g{A, Bt, M, N, K}; pg8::StaticOrder S; S.init(M, N, G, (int)blockIdx.x);
    pg8::gemm_phase<Epi, pg8::StaticOrder, true, true>(lds, g, S, E);
}

__device__ __forceinline__ void ffn_block(const Args& a, LAS unsigned char* lds, const XcdBarrier& bar, int G, int layer, int f, const float* rin_lat, const float* rin_ctx, int nrows) {
    const float* MODL = (const float*)(a.ws + WS_MOD) + (size_t)layer * 5 * MODW;
    float* hl = a.out; float* hc = (float*)(a.ws + WS_HCTX);
    bf16* XN = (bf16*)(a.ws + WS_XN); bf16* HID = (bf16*)(a.ws + WS_HID);
    const bf16* W1b = (const bf16*)(a.ws + WS_W1) + (size_t)(layer * 2 + f) * 2 * FF * DM;
    const bf16* W2b = (const bf16*)(a.ws + WS_W2) + (size_t)(layer * 2 + f) * DM * FF;
    norm_phase(rin_lat, rin_ctx, XN, a.in[I_NORMG] + (size_t)(layer * 3 + (f ? 2 : 0)) * DM, MODL, f ? 6 : 0, nrows, G);
    GSYNC();
    { pg8::EpiSwiglu E{HID, FF}; run_gemm(lds, XN, W1b, nrows, 2 * FF, DM, G, E); }
    GSYNC();
    { pg8::EpiResid E{rin_lat, rin_ctx, hl, hc, MODL + (f ? 8 : 2) * DM, 0.5f}; run_gemm(lds, HID, W2b, nrows, DM, FF, G, E); }
    GSYNC();
}

__global__ void __launch_bounds__(NTHREADS, 2) fwd_megakernel(Args a) {
    extern __shared__ __attribute__((aligned(16))) unsigned char lds_raw[];
    LAS unsigned char* lds = (LAS unsigned char*)lds_raw;
    cg::grid_group grid = cg::this_grid();
    const int G = gridDim.x;
#define LANEWAVE() const int tid = opaque_tid(), lane = tid & 63, wave = __builtin_amdgcn_readfirstlane(tid >> 6)
    float* hl = a.out; float* hc = (float*)(a.ws + WS_HCTX);
    bf16* XN = (bf16*)(a.ws + WS_XN);
    const float* MOD0 = (const float*)(a.ws + WS_MOD); const float* MOD1 = MOD0 + 5 * MODW;

    if (threadIdx.x < 8) ((LAS unsigned*)(lds + BARLDS_OFF))[threadIdx.x] = 0u;
    __syncthreads();
    const XcdBarrier bar = xcd_barrier_post((unsigned*)(a.ws + WS_BAR), (volatile LAS unsigned*)(lds + BARLDS_OFF));

    p0_prologue(a, lds, G);
    grid.sync();

    if (STAGE == 0) {
        const int gtid = blockIdx.x * NTHREADS + opaque_tid(), GT = G * NTHREADS;
        for (int i = gtid; i < ML * DM / 4; i += GT) ((f32x4*)hl)[i] = ((const f32x4*)a.in[I_X])[i];
        GSYNC();
    }
    if (STAGE >= 1) ffn_block(a, lds, bar, G, 0, 0, a.in[I_X], a.in[I_CTX], MT);
    if (STAGE >= 2) {
        norm_phase(hl, hc, XN, a.in[I_NORMG] + 1 * DM, MOD0, 3, MT, G);
        GSYNC();
        { pg8::EpiWin E{(bf16*)(a.ws + WS_QKVG), (bf16*)(a.ws + WS_U), (const float*)(a.ws + WS_ROPE)}; run_gemm(lds, XN, (const bf16*)(a.ws + WS_WIN), MT, 2560, DM, G, E); }
        GSYNC();
        { LANEWAVE(); for (int u = blockIdx.x; u < 544 + 2176; u += G) { if (u < 544) r1_unit(a, lds, u); else s1_unit(a, lds + wave * S5_WLDS, (u - 544) * 8 + wave, lane); } }
        GSYNC();
        r2_items(a, G); s2_items(a, G);
        GSYNC();
        { LANEWAVE(); for (int u = blockIdx.x; u < 544 + 1088; u += G) { if (u < 544) r3_unit(a, lds, u); else s3_unit(a, lds + wave * S5_WLDS, (u - 544) * 8 + wave, lane); } }
        GSYNC();
        { pg8::EpiGlu E{(const bf16*)(a.ws + WS_YS), XN, a.in[I_GLUB]}; run_gemm(lds, (const bf16*)(a.ws + WS_YS), (const bf16*)(a.ws + WS_GLU), MT, 512, 512, G, E); }
        GSYNC();
        { pg8::EpiResid E{hl, hc, hl, hc, MOD0 + 5 * DM, 1.0f}; run_gemm(lds, XN, (const bf16*)(a.ws + WS_WOUT), MT, DM, DM, G, E); }
        GSYNC();
    }
    if (STAGE >= 3) ffn_block(a, lds, bar, G, 0, 1, hl, hc, MT);
    if (STAGE >= 4) ffn_block(a, lds, bar, G, 1, 0, hl, hc, MT);
    if (STAGE >= 5) {
        norm_phase(hl, hc, XN, a.in[I_NORMG] + 4 * DM, MOD1, 3, MT, G);
        GSYNC();
        { pg8::EpiBf16S E{(bf16*)(a.ws + WS_QK), 2048, 4, 0.125f}; run_gemm(lds, XN, (const bf16*)(a.ws + WS_WQKV), MT, 2048, DM, G, E); }
        { pg8::EpiBf16S E{(bf16*)(a.ws + WS_VT), MT, 0, 1.0f}; run_gemm(lds, (const bf16*)(a.ws + WS_WQKV) + (size_t)2048 * DM, XN, DM, MT, DM, G, E); }
        GSYNC();
        { LANEWAVE(); for (int u = blockIdx.x; u < 2048; u += G) na_unit(a, u * 8 + wave, lane); }
        GSYNC();
        { pg8::EpiResid E{hl, hc, hl, hc, MOD1 + 5 * DM, 1.0f}; run_gemm(lds, XN, (const bf16*)(a.ws + WS_WO), ML, DM, DM, G, E); }
        GSYNC();
    }
    if (STAGE >= 6) ffn_block(a, lds, bar, G, 1, 1, hl, hc, ML);
    final_norm_phase(hl, a.in[I_FINALG], G);
}

extern "C" void kernel_launch(void* const* d_in, const int* in_sizes, int n_in, void* d_out, int out_size, void* d_ws, size_t ws_size, hipStream_t stream) {
    static int grid = 0;
    if (grid == 0) {
        if (n_in != 26 || out_size != ML * DM || ws_size < WS_END) { fprintf(stderr, "kernel_launch: unexpected problem (n_in %d, out %d, ws %zu)\n", n_in, out_size, ws_size); grid = -1; return; }
        int dev = 0, cus = 0, per_cu = 0;
        if (hipGetDevice(&dev) != hipSuccess || hipDeviceGetAttribute(&cus, hipDeviceAttributeMultiprocessorCount, dev) != hipSuccess) { grid = -1; return; }
        if (hipFuncSetAttribute((const void*)fwd_megakernel, hipFuncAttributeMaxDynamicSharedMemorySize, LDS_BYTES) != hipSuccess) { fprintf(stderr, "kernel_launch: hipFuncSetAttribute failed\n"); grid = -1; return; }
        if (hipOccupancyMaxActiveBlocksPerMultiprocessor(&per_cu, (const void*)fwd_megakernel, NTHREADS, LDS_BYTES) != hipSuccess || per_cu < 1) { fprintf(stderr, "kernel_launch: occupancy query failed (%d)\n", per_cu); (void)hipGetLastError(); grid = -1; return; }
        grid = cus * per_cu;
    }
    if (grid < 0) return;
    if (hipMemsetAsync((char*)d_ws + WS_BAR, 0, 16384, stream) != hipSuccess) { fprintf(stderr, "kernel_launch: memset failed\n"); return; }
    Args a{};
    for (int i = 0; i < 26; ++i) a.in[i] = (const float*)d_in[i];
    a.out = (float*)d_out; a.ws = (unsigned char*)d_ws; a.probe = 0; a.pad = 0;
    void* args[] = {&a};
    hipError_t e = hipLaunchCooperativeKernel((const void*)fwd_megakernel, dim3(grid), dim3(NTHREADS), args, LDS_BYTES, stream);
    if (e != hipSuccess) fprintf(stderr, "kernel_launch: cooperative launch failed: %s (grid %d)\n", hipGetErrorString(e), grid);
}
```

```cpp
#include <hip/hip_runtime.h>
#include <hip/hip_cooperative_groups.h>
#include <cstdio>
#include <cstdint>
namespace cg = cooperative_groups;

constexpr int DM = 1024, NB = 4, SEQ = 4096, CTXL = 256, FF = 2816, NMOD = 9;
constexpr int ML = NB * SEQ, MC = NB * CTXL, MT = ML + MC;
constexpr int MODW = NMOD * DM;
constexpr float EPS = 1e-6f;

namespace pg8 {
#define PG8_LAS __attribute__((address_space(3)))
typedef unsigned short bf16_t;
typedef short bf16x8 __attribute__((ext_vector_type(8)));
typedef float f32x4 __attribute__((ext_vector_type(4)));
typedef unsigned u32x4 __attribute__((ext_vector_type(4)));
constexpr int BM = 256, BK = 64, HALF = 128, HTB = HALF * BK * 2  , STAGE_BYTES = 8 * HTB, NXCD = 8, WGM = 8;

__host__ __device__ __forceinline__ int lds_byte(int r, int c) { const int st = (r >> 4) * 2 + (c >> 5), rr = r & 15, cc = c & 31, ob = rr * 64 + cc * 2; return st * 1024 + (ob ^ (((ob >> 9) & 1) << 5)); }
__host__ __device__ __forceinline__ void stage_rc(int b, int& R, int& C) { const int st = b / 1024, sb = b % 1024, swz = sb ^ (((sb >> 9) & 1) << 5); R = (st >> 1) * 16 + swz / 64; C = (st & 1) * 32 + (swz % 64) / 2; }
__host__ __device__ __forceinline__ int perm32(int rho) { const int n = rho >> 4, i = rho & 15; return 8 * (i >> 2) + 4 * n + (i & 3); }

struct Unit { int pm, pn, k0, nt, split; };
struct Gemm { const bf16_t* A; const bf16_t* Bt; int M, N, K; };

struct StaticOrder {
    int nM, nN, nwg, G, c, ntk;
    __host__ __device__ void init(int M, int N, int G_, int c_, int K_ = 0) { nM = M / BM; nN = N / BM; nwg = nM * nN; G = G_; c = c_; ntk = K_ / BK; }
    __host__ __device__ bool next(int i, Unit& u) const {
        const long L = (long)i * G + c; if (L >= nwg) return false;
        int wgid = (int)L; { const int q = nwg / NXCD, r = nwg % NXCD, xcd = wgid % NXCD, off = wgid / NXCD; wgid = (xcd < r ? xcd * (q + 1) : r * (q + 1) + (xcd - r) * q) + off; }
        const int nig = WGM * nN, gid = wgid / nig, fm = gid * WGM, gsz = (nM - fm) < WGM ? (nM - fm) : WGM;
        u.pm = fm + ((wgid % nig) % gsz); u.pn = (wgid % nig) / gsz; u.k0 = 0; u.nt = ntk; u.split = 0; return true;
    }
    __device__ __forceinline__ void a_ready(const Unit&) const {}
    __device__ __forceinline__ void done(const Unit&) const {}
};

struct SplitCtxOrder {
    StaticOrder lat; int nN, nsplit, ntp, npieces, G, c;
    __host__ __device__ void init(int MLAT, int MCTX, int N, int K, int G_, int c_, int nsplit_) { lat.init(MLAT, N, G_, c_, K); nN = N / BM; nsplit = nsplit_; ntp = (K / BK) / nsplit_; npieces = (MCTX / BM) * nN * nsplit_; G = G_; c = c_; }
    __host__ __device__ bool next(int i, Unit& u) const {
        const long L = (long)i * G + c;
        if (L < lat.nwg) return lat.next(i, u);
        const int q = (int)(L - lat.nwg); if (q >= npieces) return false;
        const int ks = q % nsplit, t = q / nsplit; u.pn = t % nN; u.pm = lat.nM + t / nN; u.k0 = ks * ntp; u.nt = ntp; u.split = 1; return true;
    }
    __device__ __forceinline__ void a_ready(const Unit&) const {}
    __device__ __forceinline__ void done(const Unit&) const {}
};

__device__ __forceinline__ unsigned cvt_pk_bf16(float lo, float hi) { unsigned r; asm volatile("v_cvt_pk_bf16_f32 %0, %1, %2" : "=v"(r) : "v"(lo), "v"(hi)); return r; }
__device__ __forceinline__ float bf_lo(unsigned w) { return __uint_as_float(w << 16); }
__device__ __forceinline__ float bf_hi(unsigned w) { return __uint_as_float(w & 0xffff0000u); }
__device__ __forceinline__ float fsilu(float a) { return a * __builtin_amdgcn_rcpf(1.0f + __expf(-a)); }
__device__ __forceinline__ float fsigmoid(float a) { return __builtin_amdgcn_rcpf(1.0f + __expf(-a)); }

struct EpiSwiglu {
    static constexpr bool PERM = true, AFTER_DRAIN = false;
    bf16_t* O; int ldo;
    __device__ __forceinline__ void operator()(const f32x4 (&acc)[2][2][4][2], const Unit& u, int wr, int wc, int fr, int fq) const {
        const int row0 = u.pm * BM + wr * 64 + fr, col0 = u.pn * HALF + wc * 32 + 8 * fq;
#pragma unroll
        for (int ai = 0; ai < 2; ++ai)
#pragma unroll
            for (int m = 0; m < 4; ++m) {
                bf16_t* rowp = O + (size_t)(row0 + ai * HALF + m * 16) * ldo + col0;
                float h[8];
#pragma unroll
                for (int n = 0; n < 2; ++n)
#pragma unroll
                    for (int i = 0; i < 4; ++i) { const float a = acc[ai][0][m][n][i], b = acc[ai][1][m][n][i]; h[4 * n + i] = fsilu(a) * b; }
                u32x4 w; w.x = cvt_pk_bf16(h[0], h[1]); w.y = cvt_pk_bf16(h[2], h[3]); w.z = cvt_pk_bf16(h[4], h[5]); w.w = cvt_pk_bf16(h[6], h[7]);
                *(u32x4*)rowp = w;
            }
    }
};

struct EpiResid {
    static constexpr bool PERM = false, AFTER_DRAIN = false;
    const float* rin_lat; const float* rin_ctx; float* rout_lat; float* rout_ctx; const float* gate; float* part; float gs;
    __device__ __forceinline__ void operator()(const f32x4 (&acc)[2][2][4][2], const Unit& u, int wr, int wc, int fr, int fq) const {
        const bool lat = u.pm < (ML / BM);
        const int bidx = lat ? (u.pm >> 4) : 4;
        const float* gp = gate + (size_t)bidx * MODW;
        const float* ri = lat ? rin_lat + (size_t)u.pm * BM * DM : rin_ctx + (size_t)(u.pm - ML / BM) * BM * DM;
        float* ro = lat ? rout_lat + (size_t)u.pm * BM * DM : rout_ctx + (size_t)(u.pm - ML / BM) * BM * DM;
        const int col0 = u.pn * BM + wc * 32 + 4 * fq;
        f32x4 gv[2][2];
#pragma unroll
        for (int bj = 0; bj < 2; ++bj)
#pragma unroll
            for (int n = 0; n < 2; ++n) gv[bj][n] = *(const f32x4*)(gp + col0 + bj * HALF + n * 16) * gs;
#pragma unroll
        for (int ai = 0; ai < 2; ++ai)
#pragma unroll
            for (int m = 0; m < 4; ++m) {
                const size_t off = (size_t)(ai * HALF + wr * 64 + m * 16 + fr) * DM + col0;
#pragma unroll
                for (int bj = 0; bj < 2; ++bj)
#pragma unroll
                    for (int n = 0; n < 2; ++n) {
                        if (u.split) { float* o = part + ((size_t)(u.k0 / u.nt) * MC + (size_t)(u.pm - ML / BM) * BM) * DM + off + bj * HALF + n * 16; *(f32x4*)o = gv[bj][n] * acc[ai][bj][m][n]; }
                        else { const f32x4 r = *(const f32x4*)(ri + off + bj * HALF + n * 16); *(f32x4*)(ro + off + bj * HALF + n * 16) = r + gv[bj][n] * acc[ai][bj][m][n]; } }
            }
    }
};

struct EpiWin {
    static constexpr bool PERM = true, AFTER_DRAIN = false;
    bf16_t* QKVG; bf16_t* U; const float* rope;
    __device__ __forceinline__ void operator()(const f32x4 (&acc)[2][2][4][2], const Unit& u, int wr, int wc, int fr, int fq) const {
        const int row0 = u.pm * BM + wr * 64 + fr;
        if (u.pn >= 4) {
            bf16_t* base = u.pn < 8 ? QKVG + u.pn * BM : U + (u.pn - 8) * BM; const int ld = u.pn < 8 ? 2048 : 512;
            const int col0 = wc * 32 + 8 * fq;
#pragma unroll
            for (int ai = 0; ai < 2; ++ai)
#pragma unroll
                for (int m = 0; m < 4; ++m) { bf16_t* rowp = base + (size_t)(row0 + ai * HALF + m * 16) * ld + col0;
#pragma unroll
                    for (int bj = 0; bj < 2; ++bj) { const f32x4 v0 = acc[ai][bj][m][0], v1 = acc[ai][bj][m][1];
                        u32x4 w; w.x = cvt_pk_bf16(v0[0], v0[1]); w.y = cvt_pk_bf16(v0[2], v0[3]); w.z = cvt_pk_bf16(v1[0], v1[1]); w.w = cvt_pk_bf16(v1[2], v1[3]);
                        *(u32x4*)(rowp + bj * HALF) = w; } }
        } else {
            const bool lat = u.pm < (ML / BM);
            const float sc = u.pn >= 2 ? 0.08838834764831845f : 1.0f;
            const int hh = wc >> 1, rot = wc & 1, f0 = 8 * fq;
            const int dcol = u.pn * BM + 128 * hh + 64 * rot + f0;
#pragma unroll
            for (int ai = 0; ai < 2; ++ai)
#pragma unroll
                for (int m = 0; m < 4; ++m) {
                    const int row = row0 + ai * HALF + m * 16;
                    float y1[8], y2[8];
                    const int t = row & (SEQ - 1), pos = rot ? (t & 63) : (t >> 6);
                    const float* rp = rope + (size_t)(pos * 32 + f0) * 2;
#pragma unroll
                    for (int n = 0; n < 2; ++n) {
                        f32x4 cs0 = (f32x4){1.f, 0.f, 1.f, 0.f}, cs1 = cs0;
                        if (lat) { cs0 = *(const f32x4*)(rp + 8 * n); cs1 = *(const f32x4*)(rp + 8 * n + 4); }
                        const f32x4 x1 = acc[ai][0][m][n], x2 = acc[ai][1][m][n];
                        y1[4 * n + 0] = (x1[0] * cs0[0] - x2[0] * cs0[1]) * sc; y2[4 * n + 0] = (x2[0] * cs0[0] + x1[0] * cs0[1]) * sc;
                        y1[4 * n + 1] = (x1[1] * cs0[2] - x2[1] * cs0[3]) * sc; y2[4 * n + 1] = (x2[1] * cs0[2] + x1[1] * cs0[3]) * sc;
                        y1[4 * n + 2] = (x1[2] * cs1[0] - x2[2] * cs1[1]) * sc; y2[4 * n + 2] = (x2[2] * cs1[0] + x1[2] * cs1[1]) * sc;
                        y1[4 * n + 3] = (x1[3] * cs1[2] - x2[3] * cs1[3]) * sc; y2[4 * n + 3] = (x2[3] * cs1[2] + x1[3] * cs1[3]) * sc;
                    }
                    bf16_t* rowp = QKVG + (size_t)row * 2048 + dcol;
                    u32x4 w; w.x = cvt_pk_bf16(y1[0], y1[1]); w.y = cvt_pk_bf16(y1[2], y1[3]); w.z = cvt_pk_bf16(y1[4], y1[5]); w.w = cvt_pk_bf16(y1[6], y1[7]);
                    *(u32x4*)rowp = w;
                    w.x = cvt_pk_bf16(y2[0], y2[1]); w.y = cvt_pk_bf16(y2[2], y2[3]); w.z = cvt_pk_bf16(y2[4], y2[5]); w.w = cvt_pk_bf16(y2[6], y2[7]);
                    *(u32x4*)(rowp + 32) = w;
                }
        }
    }
};

struct EpiGlu {
    static constexpr bool PERM = true, AFTER_DRAIN = false;
    const bf16_t* YS; bf16_t* YM; const float* bias;
    __device__ __forceinline__ void operator()(const f32x4 (&acc)[2][2][4][2], const Unit& u, int wr, int wc, int fr, int fq) const {
        const int row0 = u.pm * BM + wr * 64 + fr, col0 = u.pn * BM + wc * 32 + 8 * fq;
        f32x4 bv[2][2];
#pragma unroll
        for (int bj = 0; bj < 2; ++bj)
#pragma unroll
            for (int n = 0; n < 2; ++n) bv[bj][n] = *(const f32x4*)(bias + col0 + bj * HALF + 4 * n);
#pragma unroll
        for (int ai = 0; ai < 2; ++ai)
#pragma unroll
            for (int m = 0; m < 4; ++m) { const int row = row0 + ai * HALF + m * 16;
#pragma unroll
                for (int bj = 0; bj < 2; ++bj) {
                    const u32x4 yv = *(const u32x4*)(YS + (size_t)row * 512 + col0 + bj * HALF);
                    const f32x4 z0 = acc[ai][bj][m][0] + bv[bj][0], z1 = acc[ai][bj][m][1] + bv[bj][1];
                    u32x4 w;
                    w.x = cvt_pk_bf16(bf_lo(yv.x) * fsigmoid(z0[0]), bf_hi(yv.x) * fsigmoid(z0[1]));
                    w.y = cvt_pk_bf16(bf_lo(yv.y) * fsigmoid(z0[2]), bf_hi(yv.y) * fsigmoid(z0[3]));
                    w.z = cvt_pk_bf16(bf_lo(yv.z) * fsigmoid(z1[0]), bf_hi(yv.z) * fsigmoid(z1[1]));
                    w.w = cvt_pk_bf16(bf_lo(yv.w) * fsigmoid(z1[2]), bf_hi(yv.w) * fsigmoid(z1[3]));
                    *(u32x4*)(YM + (size_t)row * DM + 512 + col0 + bj * HALF) = w; } }
    }
};

struct EpiBf16S {
    static constexpr bool PERM = true, AFTER_DRAIN = false;
    bf16_t* O; int ldo; int nscale; float scale0;
    __device__ __forceinline__ void operator()(const f32x4 (&acc)[2][2][4][2], const Unit& u, int wr, int wc, int fr, int fq) const {
        const int row0 = u.pm * BM + wr * 64 + fr, col0 = u.pn * BM + wc * 32 + 8 * fq;
        const float sc = u.pn < nscale ? scale0 : 1.0f;
#pragma unroll
        for (int ai = 0; ai < 2; ++ai)
#pragma unroll
            for (int m = 0; m < 4; ++m) { bf16_t* rowp = O + (size_t)(row0 + ai * HALF + m * 16) * ldo + col0;
#pragma unroll
                for (int bj = 0; bj < 2; ++bj) { const f32x4 v0 = acc[ai][bj][m][0] * sc, v1 = acc[ai][bj][m][1] * sc;
                    u32x4 w; w.x = cvt_pk_bf16(v0[0], v0[1]); w.y = cvt_pk_bf16(v0[2], v0[3]); w.z = cvt_pk_bf16(v1[0], v1[1]); w.w = cvt_pk_bf16(v1[2], v1[3]);
                    *(u32x4*)(rowp + bj * HALF) = w; } }
    }
};
template <class Epi, class Sched, bool ALIGN_EPI = false, bool SP2 = false>
__device__ __forceinline__ void gemm_phase(PG8_LAS unsigned char* lds, const Gemm g, const Sched& S, const Epi& E) {
    int tid_ = threadIdx.x; asm volatile("" : "+v"(tid_));
    const int tid = tid_, wid = __builtin_amdgcn_readfirstlane(tid >> 6), lane = tid & 63, wr = wid >> 2, wc = wid & 3, fr = lane & 15, fq = lane >> 4;
    const int K = g.K;
    unsigned voffA[2], voffB[2];
#pragma unroll
    for (int i = 0; i < 2; ++i) { int R, C; stage_rc(tid * 16 + i * 8192, R, C); const int Rb = Epi::PERM ? ((R & ~31) + perm32(R & 31)) : R;
        voffA[i] = (unsigned)(R * K + C) * 2u; voffB[i] = (unsigned)(Rb * K + C) * 2u; }
    const size_t kstep = (size_t)(BK * 2);
    const size_t hstep = (size_t)HALF * K * 2;
    const size_t tstep = 2 * hstep;
    const unsigned ldsw = (unsigned)wid * 1024u;
    const int aoff = lds_byte(wr * 64 + fr, fq * 8), boff = lds_byte(wc * 32 + fr, fq * 8);
#define PG8_SA(b, h) (((b) * 2 + (h)) * HTB)
#define PG8_SB(b, h) ((4 + (b) * 2 + (h)) * HTB)
#define PG8_STAGE(bufoff, gbase, voff) do { _Pragma("unroll") for (int _i = 0; _i < 2; ++_i) \
        __builtin_amdgcn_global_load_lds((const unsigned*)((const char*)(gbase) + (voff)[_i]), (PG8_LAS unsigned*)(lds + (bufoff) + ldsw + _i * 8192), 16, 0, 0); } while (0)
#define PG8_LDA(dst, b, h) do { _Pragma("unroll") for (int m = 0; m < 4; ++m) _Pragma("unroll") for (int k = 0; k < 2; ++k) dst[m][k] = *(const PG8_LAS bf16x8*)(lds + PG8_SA(b, h) + aoff + m * 2048 + k * 1024); } while (0)
#define PG8_LDB(dst, b, h) do { _Pragma("unroll") for (int n = 0; n < 2; ++n) _Pragma("unroll") for (int k = 0; k < 2; ++k) dst[n][k] = *(const PG8_LAS bf16x8*)(lds + PG8_SB(b, h) + boff + n * 2048 + k * 1024); } while (0)
#define PG8_MMA(ai, bj, At, Bt) do { __builtin_amdgcn_s_setprio(1); _Pragma("unroll") for (int m = 0; m < 4; ++m) _Pragma("unroll") for (int n = 0; n < 2; ++n) _Pragma("unroll") for (int k = 0; k < 2; ++k) \
        acc[ai][bj][m][n] = __builtin_amdgcn_mfma_f32_16x16x32_bf16(Bt[n][k], At[m][k], acc[ai][bj][m][n], 0, 0, 0); __builtin_amdgcn_s_setprio(0); } while (0)
#define PG8_WAIT_V(n) asm volatile("s_waitcnt vmcnt(" #n ")" ::: "memory")
#define PG8_WAIT_L(n) asm volatile("s_waitcnt lgkmcnt(" #n ")" ::: "memory")
#define PG8_BAR __builtin_amdgcn_s_barrier()
#define PG8_SCHED __builtin_amdgcn_sched_barrier(0)
    Unit cur, nxt; int ui = 0;
    if (!S.next(0, cur)) return;
    f32x4 acc[2][2][4][2];
#pragma unroll
    for (int a = 0; a < 2; ++a)
#pragma unroll
        for (int b = 0; b < 2; ++b)
#pragma unroll
            for (int m = 0; m < 4; ++m)
#pragma unroll
                for (int n = 0; n < 2; ++n) acc[a][b][m][n] = (f32x4){0.f, 0.f, 0.f, 0.f};
    bf16x8 At[4][2], B0[2][2], B1[2][2];
    const char* cA = (const char*)g.A + (size_t)cur.pm * tstep + (size_t)cur.k0 * kstep; const char* cB = (const char*)g.Bt + (size_t)cur.pn * tstep + (size_t)cur.k0 * kstep;
    S.a_ready(cur);
    if constexpr (SP2) {
        PG8_STAGE(PG8_SB(0, 0), cB, voffB); PG8_STAGE(PG8_SB(0, 1), cB + hstep, voffB); PG8_STAGE(PG8_SA(0, 0), cA, voffA); PG8_STAGE(PG8_SA(0, 1), cA + hstep, voffA);
        if (wr == 1) PG8_BAR;
        PG8_WAIT_V(2); PG8_BAR;
        PG8_STAGE(PG8_SB(1, 0), cB + kstep, voffB); PG8_STAGE(PG8_SA(1, 0), cA + kstep, voffA); PG8_STAGE(PG8_SB(1, 1), cB + hstep + kstep, voffB);
        PG8_WAIT_V(6); PG8_BAR;
    } else {
        PG8_STAGE(PG8_SB(0, 0), cB, voffB); PG8_STAGE(PG8_SA(0, 0), cA, voffA); PG8_STAGE(PG8_SB(0, 1), cB + hstep, voffB); PG8_STAGE(PG8_SA(0, 1), cA + hstep, voffA);
        if (wr == 1) PG8_BAR;
        PG8_WAIT_V(4); PG8_BAR;
        PG8_STAGE(PG8_SB(1, 0), cB + kstep, voffB); PG8_STAGE(PG8_SA(1, 0), cA + kstep, voffA); PG8_STAGE(PG8_SB(1, 1), cB + hstep + kstep, voffB);
        PG8_WAIT_V(6); PG8_BAR;
    }
    for (;;) {
        const bool has_next = S.next(ui + 1, nxt);
        const char* nA = has_next ? (const char*)g.A + (size_t)nxt.pm * tstep + (size_t)nxt.k0 * kstep : cA; const char* nB = has_next ? (const char*)g.Bt + (size_t)nxt.pn * tstep + (size_t)nxt.k0 * kstep : cB;
        const int nt = cur.nt;
        for (int t = 0; t < nt; t += 2) {
            const bool last = (t == nt - 2);
            const char* a1 = cA + (size_t)(t + 1) * kstep;
            const char* a2 = last ? nA : cA + (size_t)(t + 2) * kstep; const char* b2 = last ? nB : cB + (size_t)(t + 2) * kstep;
            const char* a3 = a2 + kstep; const char* b3 = b2 + kstep;
            if (last && has_next) S.a_ready(nxt);
            if constexpr (SP2) {
            PG8_LDB(B0, 0, 0); PG8_LDB(B1, 0, 1); PG8_SCHED; PG8_LDA(At, 0, 0); PG8_STAGE(PG8_SA(1, 1), a1 + hstep, voffA);
            PG8_WAIT_V(8); PG8_WAIT_L(0); PG8_BAR; PG8_MMA(0, 0, At, B0); PG8_MMA(0, 1, At, B1); PG8_BAR; PG8_SCHED;
            PG8_LDA(At, 0, 1); PG8_STAGE(PG8_SB(0, 0), b2, voffB); PG8_STAGE(PG8_SB(0, 1), b2 + hstep, voffB); PG8_STAGE(PG8_SA(0, 0), a2, voffA);
            PG8_WAIT_V(8); PG8_WAIT_L(0); PG8_BAR; PG8_MMA(1, 0, At, B0); PG8_MMA(1, 1, At, B1); PG8_BAR; PG8_SCHED;
            PG8_LDB(B0, 1, 0); PG8_LDB(B1, 1, 1); PG8_SCHED; PG8_LDA(At, 1, 0); PG8_STAGE(PG8_SA(0, 1), a2 + hstep, voffA);
            PG8_WAIT_V(8); PG8_WAIT_L(0); PG8_BAR; PG8_MMA(0, 0, At, B0); PG8_MMA(0, 1, At, B1); PG8_BAR; PG8_SCHED;
            PG8_LDA(At, 1, 1); PG8_STAGE(PG8_SB(1, 0), b3, voffB); PG8_STAGE(PG8_SB(1, 1), b3 + hstep, voffB); PG8_STAGE(PG8_SA(1, 0), a3, voffA);
            PG8_WAIT_V(8); PG8_WAIT_L(0); PG8_BAR; PG8_MMA(1, 0, At, B0); PG8_MMA(1, 1, At, B1); PG8_BAR; PG8_SCHED;
            } else {
            PG8_LDB(B0, 0, 0); PG8_SCHED; PG8_LDA(At, 0, 0); PG8_STAGE(PG8_SA(1, 1), a1 + hstep, voffA);
            PG8_WAIT_L(8); PG8_BAR; PG8_WAIT_L(0); PG8_MMA(0, 0, At, B0); PG8_BAR; PG8_SCHED;
            PG8_LDB(B1, 0, 1); PG8_STAGE(PG8_SB(0, 0), b2, voffB);
            PG8_BAR; PG8_WAIT_L(0); PG8_MMA(0, 1, At, B1); PG8_BAR;
            PG8_LDA(At, 0, 1); PG8_STAGE(PG8_SA(0, 0), a2, voffA);
            PG8_BAR; PG8_WAIT_L(0); PG8_MMA(1, 0, At, B0); PG8_BAR; PG8_SCHED;
            PG8_STAGE(PG8_SB(0, 1), b2 + hstep, voffB);
            PG8_WAIT_V(6); PG8_BAR; PG8_MMA(1, 1, At, B1); PG8_BAR;
            PG8_LDB(B0, 1, 0); PG8_SCHED; PG8_LDA(At, 1, 0); PG8_STAGE(PG8_SA(0, 1), a2 + hstep, voffA);
            PG8_WAIT_L(8); PG8_BAR; PG8_WAIT_L(0); PG8_MMA(0, 0, At, B0); PG8_BAR; PG8_SCHED;
            PG8_LDB(B1, 1, 1); PG8_STAGE(PG8_SB(1, 0), b3, voffB);
            PG8_BAR; PG8_WAIT_L(0); PG8_MMA(0, 1, At, B1); PG8_BAR;
            PG8_LDA(At, 1, 1); PG8_STAGE(PG8_SA(1, 0), a3, voffA);
            PG8_BAR; PG8_WAIT_L(0); PG8_MMA(1, 0, At, B0); PG8_BAR; PG8_SCHED;
            PG8_STAGE(PG8_SB(1, 1), b3 + hstep, voffB);
            PG8_WAIT_V(6); PG8_BAR; PG8_MMA(1, 1, At, B1); PG8_BAR;
            }
        }
        if constexpr (ALIGN_EPI) { if (wr == 0) PG8_BAR; }
        if constexpr (!Epi::AFTER_DRAIN) { E(acc, cur, wr, wc, fr, fq); S.done(cur); }
        if (!has_next) break;
#pragma unroll
        for (int a = 0; a < 2; ++a)
#pragma unroll
            for (int b = 0; b < 2; ++b)
#pragma unroll
                for (int m = 0; m < 4; ++m)
#pragma unroll
                    for (int n = 0; n < 2; ++n) acc[a][b][m][n] = (f32x4){0.f, 0.f, 0.f, 0.f};
        cur = nxt; cA = nA; cB = nB; ++ui;
        if constexpr (ALIGN_EPI) { if (wr == 1) PG8_BAR; }
    }
    PG8_WAIT_V(0);
    if constexpr (!ALIGN_EPI) { if (wr == 0) PG8_BAR; }
    PG8_BAR;
    if constexpr (Epi::AFTER_DRAIN) { E.fused(acc, cur, wr, wc, fr, fq, lds, wid, lane); S.done(cur); }
#undef PG8_SA
#undef PG8_SB
#undef PG8_STAGE
#undef PG8_LDA
#undef PG8_LDB
#undef PG8_MMA
#undef PG8_WAIT_V
#undef PG8_WAIT_L
#undef PG8_BAR
#undef PG8_SCHED
}
}

#define LAS __attribute__((address_space(3)))
typedef unsigned short bf16;
typedef unsigned v4u __attribute__((ext_vector_type(4)));
typedef unsigned v2u __attribute__((ext_vector_type(2)));
typedef float f32x4 __attribute__((ext_vector_type(4)));
typedef float f32x2 __attribute__((ext_vector_type(2)));
typedef short bf16x8 __attribute__((ext_vector_type(8)));
typedef short s16x4 __attribute__((ext_vector_type(4)));

constexpr size_t MiB = 1u << 20;
constexpr size_t WS_MOD   = 1 * MiB;
constexpr size_t WS_ROPE  = WS_MOD + 512 * 1024;
constexpr size_t WS_LB    = WS_ROPE + 64 * 1024;
constexpr size_t WS_LBT   = WS_LB + 64 * 1024;
constexpr size_t WS_BBR   = WS_LBT + 64 * 1024;
constexpr size_t WS_BBI   = WS_BBR + 256 * 1024;
constexpr size_t WS_CM    = WS_BBI + 256 * 1024;
static_assert(WS_CM + 256 * 1024 <= 4 * MiB, "param block");
constexpr size_t WS_W1    = 4 * MiB;
constexpr size_t WS_W2    = 48 * MiB;
constexpr size_t WS_WIN   = 70 * MiB;
constexpr size_t WS_WOUT  = 75 * MiB;
constexpr size_t WS_GLU   = 77 * MiB;
constexpr size_t WS_WQKV  = 78 * MiB;
constexpr size_t WS_WO    = 84 * MiB;
constexpr size_t WS_HCTX  = 86 * MiB;
constexpr size_t WS_XN    = 90 * MiB;
constexpr size_t WS_R     = 124 * MiB;
constexpr size_t WS_HID   = WS_R;
constexpr size_t WS_QKVG  = WS_R;
constexpr size_t WS_U     = WS_R + 68 * MiB;
constexpr size_t WS_KVS   = WS_R + 85 * MiB;
constexpr size_t WS_SF    = WS_R + 119 * MiB;
constexpr size_t WS_YS    = WS_R + 128 * MiB;
constexpr size_t WS_QK    = WS_R;
constexpr size_t WS_VT    = WS_R + 68 * MiB;
constexpr size_t WS_PARTF = WS_R + 96 * MiB;
constexpr size_t WS_PARTM = WS_R;
constexpr size_t WS_END   = WS_R + 145 * MiB;

constexpr size_t WS_BAR = 0;
constexpr int BARLDS_OFF = 131072 + 320;
constexpr int NWAVES = 8, NTHREADS = 512;
constexpr int LDS_BYTES = 147456;

struct Args {
    const float* in[26]; float* out; unsigned char* ws; int probe; int pad;
};
typedef const __attribute__((address_space(4))) Args* KArgs;
__device__ __forceinline__ KArgs kargs() { KArgs p = (KArgs)__builtin_amdgcn_kernarg_segment_ptr(); asm volatile("" : "+s"(p)); return p; }
enum { I_X = 0, I_C, I_CTX, I_CCTX, I_WMOD, I_BMOD, I_NORMG, I_W1, I_W2, I_WIN, I_WOUT, I_DECAY, I_LAMRE, I_LAMIM, I_LOGDT, I_BRE, I_BIM, I_CRE, I_CIM,
       I_S5D, I_GLUW, I_GLUB, I_WQKV, I_WO, I_RPB, I_FINALG };

__device__ __forceinline__ unsigned f2bf(float f) { unsigned u = __builtin_bit_cast(unsigned, f); return (u + 0x7fffu + ((u >> 16) & 1u)) >> 16; }
__device__ __forceinline__ unsigned pk2(float lo, float hi) { return f2bf(lo) | (f2bf(hi) << 16); }
__device__ __forceinline__ float bf2f(unsigned short h) { return __uint_as_float((unsigned)h << 16); }
__device__ __forceinline__ float blo(unsigned w) { return __uint_as_float(w << 16); }
__device__ __forceinline__ float bhi(unsigned w) { return __uint_as_float(w & 0xffff0000u); }
__device__ __forceinline__ int opaque_tid() { int t = threadIdx.x; asm volatile("" : "+v"(t)); return t; }
__device__ __forceinline__ float wave_sum(float v) {
#pragma unroll
    for (int o = 1; o < 64; o <<= 1) v += __shfl_xor(v, o);
    return v;
}
__device__ __forceinline__ void sincos_acc(float x, float& s, float& c) {
    const float k = rintf(x * 0.6366197723675814f);
    float r = fmaf(k, -1.5703125f, x); r = fmaf(k, -4.837512969970703125e-4f, r); r = fmaf(k, -7.54978995489188216e-8f, r);
    const float r2 = r * r;
    float sp = 2.7557319e-6f; sp = fmaf(sp, r2, -1.9841270e-4f); sp = fmaf(sp, r2, 8.3333333e-3f); sp = fmaf(sp, r2, -1.6666667e-1f); sp = fmaf(sp * r2, r, r);
    float cp = -2.7557319e-7f; cp = fmaf(cp, r2, 2.4801587e-5f); cp = fmaf(cp, r2, -1.3888889e-3f); cp = fmaf(cp, r2, 4.1666667e-2f); cp = fmaf(cp, r2, -0.5f); cp = fmaf(cp, r2, 1.0f);
    const int q = ((int)k) & 3;
    s = (q == 0) ? sp : (q == 1) ? cp : (q == 2) ? -sp : -cp;
    c = (q == 0) ? cp : (q == 1) ? -sp : (q == 2) ? -cp : sp;
}
__device__ __forceinline__ float gelu_tanh(float v) {
    const float t = 0.7978845608028654f * (v + 0.044715f * v * v * v);
    const float e = __expf(2.0f * t);
    const float th = 1.0f - 2.0f * __builtin_amdgcn_rcpf(e + 1.0f);
    return 0.5f * v * (1.0f + th);
}

__device__ __forceinline__ int map_row(int kind, int n) {
    if (kind == 1) { const int j = n < FF ? n : n - FF; return 256 * (j >> 7) + (n < FF ? 0 : 128) + (j & 127); }
    if (kind == 2 && n < 1024) { const int tile = n >> 8, hh = (n >> 7) & 1, d = n & 127; return 256 * tile + 128 * ((d >> 5) & 1) + 64 * hh + 32 * (d >> 6) + (d & 31); }
    return n;
}
__device__ __forceinline__ void p0_transpose_item(const float* W, int K, int N, int kind, bf16* WT, LAS float* scr, int item, int lane) {
    const int nblk = N / 32, kb = item / nblk, nb = item % nblk, k0 = 64 * kb, n0 = 32 * nb;
    const int drow = map_row(kind, n0);
#pragma unroll 8
    for (int i = 0; i < 32; ++i) { const int kk = 2 * i + (lane >> 5); scr[kk * 33 + (lane & 31)] = W[(size_t)(k0 + kk) * N + n0 + (lane & 31)]; }
    asm volatile("s_waitcnt lgkmcnt(0)" ::: "memory");
    const int c = lane & 7;
#pragma unroll
    for (int j = 0; j < 4; ++j) { const int n = (lane >> 3) + 8 * j; const LAS float* s = scr + (8 * c) * 33 + n;
        v4u o; o.x = pk2(s[0 * 33], s[1 * 33]); o.y = pk2(s[2 * 33], s[3 * 33]); o.z = pk2(s[4 * 33], s[5 * 33]); o.w = pk2(s[6 * 33], s[7 * 33]);
        *(v4u*)(WT + (size_t)(drow + n) * K + k0 + 8 * c) = o; }
    asm volatile("s_waitcnt lgkmcnt(0)" ::: "memory");
}

struct WDesc { const float* W; bf16* dst; int K, N, kind, items; };
__device__ __forceinline__ WDesc wdesc(KArgs a, int mi) {
    WDesc d;
    if (mi < 4)       { d.W = a->in[I_W1] + (size_t)mi * DM * 2 * FF; d.dst = (bf16*)(a->ws + WS_W1) + (size_t)mi * 2 * FF * DM; d.K = DM; d.N = 2 * FF; d.kind = 1; }
    else if (mi < 8)  { d.W = a->in[I_W2] + (size_t)(mi - 4) * FF * DM; d.dst = (bf16*)(a->ws + WS_W2) + (size_t)(mi - 4) * DM * FF; d.K = FF; d.N = DM; d.kind = 0; }
    else if (mi == 8) { d.W = a->in[I_WIN]; d.dst = (bf16*)(a->ws + WS_WIN); d.K = DM; d.N = 2560; d.kind = 2; }
    else if (mi == 9) { d.W = a->in[I_WOUT]; d.dst = (bf16*)(a->ws + WS_WOUT); d.K = DM; d.N = DM; d.kind = 0; }
    else if (mi == 10){ d.W = a->in[I_GLUW]; d.dst = (bf16*)(a->ws + WS_GLU); d.K = 512; d.N = 512; d.kind = 0; }
    else if (mi == 11){ d.W = a->in[I_WQKV]; d.dst = (bf16*)(a->ws + WS_WQKV); d.K = DM; d.N = 3072; d.kind = 0; }
    else              { d.W = a->in[I_WO]; d.dst = (bf16*)(a->ws + WS_WO); d.K = DM; d.N = DM; d.kind = 0; }
    d.items = (d.K / 64) * (d.N / 32);
    return d;
}
constexpr int NWMAT = 13;

__device__ __forceinline__ void p0_prologue(KArgs a, LAS unsigned char* lds, int G) {
    const int tid = opaque_tid(), lane = tid & 63, wave = __builtin_amdgcn_readfirstlane(tid >> 6);
    {
        LAS float* sv = (LAS float*)lds;
        LAS float* red = (LAS float*)(lds + 32768);
        bool have = false;
        for (int it = blockIdx.x; it < 2 * (MODW / 64); it += G) {
            if (!have) {
                for (int i = tid; i < 5 * DM; i += NTHREADS) { const int b = i >> 10, k = i & 1023; const float v = b < 4 ? a->in[I_C][b * DM + k] : a->in[I_CCTX][k]; sv[k * 8 + b] = v / (1.0f + expf(-v)); }
                __syncthreads(); have = true;
            }
            const int layer = it / (MODW / 64), n = (it % (MODW / 64)) * 64 + lane;
            const float* wp = a->in[I_WMOD] + (size_t)layer * DM * MODW + n;
            float acc[5] = {0.f, 0.f, 0.f, 0.f, 0.f};
#pragma unroll 8
            for (int kk = 0; kk < 128; ++kk) { const int k = wave * 128 + kk; const float w = wp[(size_t)k * MODW];
                const f32x4 s0 = *(const LAS f32x4*)(sv + k * 8); const float s4 = sv[k * 8 + 4];
                acc[0] = fmaf(s0[0], w, acc[0]); acc[1] = fmaf(s0[1], w, acc[1]); acc[2] = fmaf(s0[2], w, acc[2]); acc[3] = fmaf(s0[3], w, acc[3]); acc[4] = fmaf(s4, w, acc[4]); }
#pragma unroll
            for (int b = 0; b < 5; ++b) red[(wave * 5 + b) * 64 + lane] = acc[b];
            __syncthreads();
            if (tid < 320) { const int b = tid >> 6, l = tid & 63, nn = (it % (MODW / 64)) * 64 + l; float s = a->in[I_BMOD][layer * MODW + nn];
#pragma unroll
                for (int w = 0; w < 8; ++w) s += red[(w * 5 + b) * 64 + l];
                ((float*)(a->ws + WS_MOD))[((size_t)layer * 5 + b) * MODW + nn] = s; }
            __syncthreads();
        }
        __syncthreads();
    }
    const int gtid = blockIdx.x * NTHREADS + tid, GT = G * NTHREADS;
    for (int i = gtid; i < MC * DM / 4; i += GT) ((f32x4*)(a->ws + WS_HCTX))[i] = ((const f32x4*)a->in[I_CTX])[i];
    for (int i = gtid; i < 64 * 32; i += GT) { const int pos = i >> 5, f = i & 31; const float inv = exp2f(-(float)f * (13.287712379549449f / 32.0f));
        float s, c; sincos_acc((float)pos * inv, s, c); ((f32x2*)(a->ws + WS_ROPE))[i] = (f32x2){c, s}; }
    for (int i = gtid; i < 2 * 32 * 64; i += GT) {
        const int p = i & 63, dg = i >> 6;
        const float lr = fminf(a->in[I_LAMRE][i], -1e-4f), li = a->in[I_LAMIM][i], dt = expf(a->in[I_LOGDT][dg]);
        float s, c; sincos_acc(li * dt, s, c); const float mg = expf(lr * dt); const float br = mg * c, bi = mg * s;
        ((f32x2*)(a->ws + WS_LB))[i] = (f32x2){br, bi};
        float s64, c64; sincos_acc(li * dt * 64.0f, s64, c64); const float m64 = expf(lr * dt * 64.0f);
        ((f32x2*)(a->ws + WS_LBT))[i] = (f32x2){m64 * c64, m64 * s64};
        const float nr = br - 1.0f, ni = bi, den = 1.0f / (lr * lr + li * li);
        const float cr = (nr * lr + ni * li) * den, ci = (ni * lr - nr * li) * den;
        for (int k = 0; k < 16; ++k) {
            const float bre = a->in[I_BRE][(size_t)i * 16 + k], bim = a->in[I_BIM][(size_t)i * 16 + k];
            ((float*)(a->ws + WS_BBR))[((size_t)dg * 16 + k) * 64 + p] = cr * bre - ci * bim;
            ((float*)(a->ws + WS_BBI))[((size_t)dg * 16 + k) * 64 + p] = cr * bim + ci * bre;
            const float cre = a->in[I_CRE][((size_t)dg * 16 + k) * 64 + p], cim = a->in[I_CIM][((size_t)dg * 16 + k) * 64 + p];
            ((unsigned*)(a->ws + WS_CM))[((size_t)dg * 16 + k) * 64 + p] = pk2(cre, -cim);
        }
    }
    {
        LAS float* scr = (LAS float*)(lds + wave * 16384);
        const int gw = blockIdx.x * NWAVES + wave, NGW = G * NWAVES;
        int total = 0;
        for (int mi = 0; mi < NWMAT; ++mi) total += wdesc(a, mi).items;
        for (int it = gw; it < total; it += NGW) {
            int r = it;
            for (int mi = 0; mi < NWMAT; ++mi) { const WDesc d = wdesc(a, mi); if (r < d.items) { p0_transpose_item(d.W, d.K, d.N, d.kind, d.dst, scr, r, lane); break; } r -= d.items; }
        }
    }
}

__device__ __forceinline__ void norm_phase(const float* src_lat, const float* src_ctx, bf16* XN, const float* g, const float* mod  , int ishift, int nrows, int G, const float* part = nullptr, int npart = 0, float* hctx_rw = nullptr) {
    const int tid = opaque_tid(), lane = tid & 63, wave = __builtin_amdgcn_readfirstlane(tid >> 6);
    const int gw = blockIdx.x * NWAVES + wave, NGW = G * NWAVES;
    f32x4 gv[4];
#pragma unroll
    for (int j = 0; j < 4; ++j) gv[j] = *((const f32x4*)g + lane + 64 * j);
    for (int row = gw; row < nrows; row += NGW) {
        const float* xr = row < ML ? src_lat + (size_t)row * DM : src_ctx + (size_t)(row - ML) * DM;
        const int bidx = row < ML ? (row >> 12) : 4;
        const float* sh = mod + (size_t)bidx * MODW + ishift * DM; const float* sc = sh + DM;
        f32x4 v[4]; float s = 0.f;
#pragma unroll
        for (int j = 0; j < 4; ++j) v[j] = *((const f32x4*)xr + lane + 64 * j);
        if (npart > 0 && row >= ML) {
            for (int pp = 0; pp < npart; ++pp) { const float* pr = part + ((size_t)pp * MC + (row - ML)) * DM;
#pragma unroll
                for (int j = 0; j < 4; ++j) v[j] += *((const f32x4*)pr + lane + 64 * j); }
#pragma unroll
            for (int j = 0; j < 4; ++j) *((f32x4*)(hctx_rw + (size_t)(row - ML) * DM) + lane + 64 * j) = v[j];
        }
#pragma unroll
        for (int j = 0; j < 4; ++j) s += (v[j][0] * v[j][0] + v[j][1] * v[j][1]) + (v[j][2] * v[j][2] + v[j][3] * v[j][3]);
        const float rstd = rsqrtf(wave_sum(s) * (1.0f / DM) + EPS);
#pragma unroll
        for (int j = 0; j < 4; ++j) {
            const f32x4 shv = *((const f32x4*)sh + lane + 64 * j), scv = *((const f32x4*)sc + lane + 64 * j);
            const f32x4 y = v[j] * rstd * gv[j] * (scv + 1.0f) + shv;
            *((v2u*)(XN + (size_t)row * DM) + lane + 64 * j) = (v2u){pk2(y[0], y[1]), pk2(y[2], y[3])};
        }
    }
}
__device__ __forceinline__ void final_norm_phase(float* io, const float* g, int G) {
    const int tid = opaque_tid(), lane = tid & 63, wave = __builtin_amdgcn_readfirstlane(tid >> 6);
    const int gw = blockIdx.x * NWAVES + wave, NGW = G * NWAVES;
    f32x4 gv[4];
#pragma unroll
    for (int j = 0; j < 4; ++j) gv[j] = *((const f32x4*)g + lane + 64 * j);
    for (int row = gw; row < ML; row += NGW) {
        float* xr = io + (size_t)row * DM;
        f32x4 v[4]; float s = 0.f;
#pragma unroll
        for (int j = 0; j < 4; ++j) { v[j] = *((const f32x4*)xr + lane + 64 * j); s += (v[j][0] * v[j][0] + v[j][1] * v[j][1]) + (v[j][2] * v[j][2] + v[j][3] * v[j][3]); }
        const float rstd = rsqrtf(wave_sum(s) * (1.0f / DM) + EPS);
#pragma unroll
        for (int j = 0; j < 4; ++j) *((f32x4*)xr + lane + 64 * j) = v[j] * rstd * gv[j];
    }
}

#define XB_TMO      128
#define XB_XCNT(j)  (256  + 64 * (j))
#define XB_XSUB(j)  (1280 + 64 * (j))
#define XB_XGEN(j)  (2304 + 64 * (j))
#define XB_TOP      3328
#define XB_TOPGEN   3392
#define XCD_BAR_WORDS 3456
#define XB_SPIN_CAP (1u << 18)

__device__ __forceinline__ unsigned xb_ld(unsigned* p)              { return __hip_atomic_load(p, __ATOMIC_RELAXED, __HIP_MEMORY_SCOPE_AGENT); }
__device__ __forceinline__ unsigned xb_add(unsigned* p, unsigned v) { return __hip_atomic_fetch_add(p, v, __ATOMIC_RELAXED, __HIP_MEMORY_SCOPE_AGENT); }
__device__ __forceinline__ unsigned xb_xcc_id() { return (unsigned)__builtin_amdgcn_s_getreg((3 << 11) | 20) & 0xFu; }
#define XB_SPIN(cond, bar) do { unsigned _sp = 0; while (cond) { __builtin_amdgcn_s_sleep(1); \
    if ((++_sp & 255u) == 0u) { if (xb_ld(&(bar)[XB_TMO])) break; if (_sp > XB_SPIN_CAP) { atomicAdd(&(bar)[XB_TMO], 1u); break; } } } } while (0)

struct XcdBarrier {
    unsigned* bar; unsigned x;
    volatile LAS unsigned* st;
};

__device__ __forceinline__ XcdBarrier xcd_barrier_post(unsigned* bar, volatile LAS unsigned* st) {
    XcdBarrier b; b.bar = bar; b.x = xb_xcc_id(); b.st = st;
    if (threadIdx.x == 0) (void)xb_add(&bar[XB_XCNT(b.x)], 1u);
    return b;
}
__device__ __forceinline__ void xcd_barrier_complete(unsigned* bar, unsigned x, unsigned& nloc, unsigned& nx) {
    const unsigned G = gridDim.x * gridDim.y * gridDim.z;
    unsigned sum, cnt, mine, sp = 0u;
    for (;;) {
        sum = 0u; cnt = 0u; mine = 0u;
#pragma unroll
        for (unsigned j = 0; j < 16; ++j) { const unsigned c = xb_ld(&bar[XB_XCNT(j)]); sum += c; cnt += (c > 0u) ? 1u : 0u; mine = (j == x) ? c : mine; }
        if (sum == G) break;
        __builtin_amdgcn_s_sleep(1);
        if ((++sp & 255u) == 0u) { if (xb_ld(&bar[XB_TMO])) break; if (sp > XB_SPIN_CAP) { atomicAdd(&bar[XB_TMO], 1u); break; } }
    }
    nloc = mine > 0u ? mine : 1u; nx = cnt > 0u ? cnt : 1u;
}

__device__ __forceinline__ void xcd_barrier(const XcdBarrier& b) {
    asm volatile("s_waitcnt vmcnt(0)" ::: "memory");
    __syncthreads();
    if (threadIdx.x == 0) {
        unsigned* bar = b.bar; unsigned bx = b.x; asm volatile("" : "+s"(bar), "+s"(bx));
        __builtin_amdgcn_s_waitcnt(0);
        unsigned nloc = b.st[0], nx = b.st[1];
        const unsigned old = xb_add(&bar[XB_XSUB(bx)], 1u);
        const unsigned gen = old / nloc;
        if (old + 1u == (gen + 1u) * nloc) {
            __builtin_amdgcn_fence(__ATOMIC_RELEASE, "agent");
            asm volatile("s_waitcnt vmcnt(0)" ::: "memory");
            const unsigned og = xb_add(&bar[XB_TOP], 1u);
            const unsigned tg = og / nx;
            if (og + 1u == (tg + 1u) * nx) xb_add(&bar[XB_TOPGEN], 1u);
            else XB_SPIN(xb_ld(&bar[XB_TOPGEN]) == tg, bar);
            __builtin_amdgcn_fence(__ATOMIC_ACQUIRE, "agent");
            xb_add(&bar[XB_XGEN(bx)], 1u);
            asm volatile("s_waitcnt vmcnt(0)" ::: "memory");
        } else {
            XB_SPIN(xb_ld(&bar[XB_XGEN(bx)]) == gen, bar);
            __builtin_amdgcn_fence(__ATOMIC_ACQUIRE, "agent");
            asm volatile("s_waitcnt vmcnt(0)" ::: "memory");
        }
    }
    __syncthreads();
}


__device__ __forceinline__ void xcd_barrier_census(const XcdBarrier& b) {
    if (threadIdx.x == 0) { unsigned nloc, nx; xcd_barrier_complete(b.bar, b.x, nloc, nx); b.st[0] = nloc; b.st[1] = nx; }
    __syncthreads();
}

typedef float f32x4m __attribute__((ext_vector_type(4)));
#define MFMA16(a, b, c) __builtin_amdgcn_mfma_f32_16x16x32_bf16((a), (b), (c), 0, 0, 0)
__device__ __forceinline__ unsigned off_b(unsigned row, unsigned ch) { return 256u * row + 16u * (ch ^ (((row & 3u) << 2) | ((row >> 2) & 3u))); }
__device__ __forceinline__ bf16x8 tr_frag(LAS unsigned char* tile, int lane, int c, int ks) {
    const unsigned g = lane >> 4, q = (lane & 15) >> 2, p = lane & 3;
    const s16x4 lo = __builtin_amdgcn_ds_read_tr16_b64_v4i16((LAS s16x4*)(tile + off_b(32 * ks + 8 * g + q, 2 * c + (p >> 1)) + 8 * (p & 1)));
    const s16x4 hi = __builtin_amdgcn_ds_read_tr16_b64_v4i16((LAS s16x4*)(tile + off_b(32 * ks + 8 * g + 4 + q, 2 * c + (p >> 1)) + 8 * (p & 1)));
    return (bf16x8){lo[0], lo[1], lo[2], lo[3], hi[0], hi[1], hi[2], hi[3]};
}
__device__ __forceinline__ bf16x8 pack8(const f32x4 a, const f32x4 b) {
    v4u w; w.x = pk2(a[0], a[1]); w.y = pk2(a[2], a[3]); w.z = pk2(b[0], b[1]); w.w = pk2(b[2], b[3]);
    return __builtin_bit_cast(bf16x8, w);
}
__device__ __forceinline__ float log_sigmoid(float x) { return -log1pf(expf(-x)); }

__device__ __forceinline__ int ret_row0(int b, int s) { return s < 2 ? ML + b * CTXL + s * 128 : b * SEQ + (s - 2) * 128; }

__device__ __forceinline__ void r1_unit(KArgs a, LAS unsigned char* lds, int unit) {
    const int tid = opaque_tid(), lane = tid & 63, wave = __builtin_amdgcn_readfirstlane(tid >> 6);
    const int s = unit % 34, bh = unit / 34, h = bh & 3, b = bh >> 2, row0 = ret_row0(b, s);
    const bf16* QKVG = (const bf16*)(a->ws + WS_QKVG);
    const float lgf = log_sigmoid(a->in[I_DECAY][h]), lgb = log_sigmoid(a->in[I_DECAY][4 + h]);
#pragma unroll
    for (int it = 0; it < 4; ++it) {
        const int n = tid + NTHREADS * it, row = n >> 4, ch = n & 15;
        const bf16* kp = QKVG + (size_t)(row0 + row) * 2048 + 512 + 128 * h + 8 * ch;
        const v4u kv = *(const v4u*)kp, vv = *(const v4u*)(kp + 512);
        const float wf = expf(lgf * (float)(127 - row)), wb = expf(lgb * (float)row);
        v4u kf, kb;
        kf.x = pk2(blo(kv.x) * wf, bhi(kv.x) * wf); kf.y = pk2(blo(kv.y) * wf, bhi(kv.y) * wf); kf.z = pk2(blo(kv.z) * wf, bhi(kv.z) * wf); kf.w = pk2(blo(kv.w) * wf, bhi(kv.w) * wf);
        kb.x = pk2(blo(kv.x) * wb, bhi(kv.x) * wb); kb.y = pk2(blo(kv.y) * wb, bhi(kv.y) * wb); kb.z = pk2(blo(kv.z) * wb, bhi(kv.z) * wb); kb.w = pk2(blo(kv.w) * wb, bhi(kv.w) * wb);
        const unsigned o = off_b(row, ch);
        *(LAS v4u*)(lds + o) = kf; *(LAS v4u*)(lds + 32768 + o) = kb; *(LAS v4u*)(lds + 65536 + o) = vv;
    }
    __syncthreads();
    f32x4 accf[8], accb[8];
#pragma unroll
    for (int c = 0; c < 8; ++c) { accf[c] = (f32x4){0.f, 0.f, 0.f, 0.f}; accb[c] = (f32x4){0.f, 0.f, 0.f, 0.f}; }
#pragma unroll
    for (int ks = 0; ks < 4; ++ks) {
        const bf16x8 kf = tr_frag(lds, lane, wave, ks), kb = tr_frag(lds + 32768, lane, wave, ks);
#pragma unroll
        for (int c = 0; c < 8; ++c) { const bf16x8 vf = tr_frag(lds + 65536, lane, c, ks); accf[c] = MFMA16(kf, vf, accf[c]); accb[c] = MFMA16(kb, vf, accb[c]); }
    }
    bf16* Sf = (bf16*)(a->ws + WS_KVS) + ((size_t)(bh * 2 + 0) * 34 + s) * 16384;
    bf16* Sb = (bf16*)(a->ws + WS_KVS) + ((size_t)(bh * 2 + 1) * 34 + s) * 16384;
    const int d0 = 16 * wave + 4 * (lane >> 4);
#pragma unroll
    for (int c = 0; c < 8; ++c) { const int e = 16 * c + (lane & 15);
        *(v2u*)(Sf + e * 128 + d0) = (v2u){pk2(accf[c][0], accf[c][1]), pk2(accf[c][2], accf[c][3])};
        *(v2u*)(Sb + e * 128 + d0) = (v2u){pk2(accb[c][0], accb[c][1]), pk2(accb[c][2], accb[c][3])}; }
    __syncthreads();
}

__device__ __forceinline__ void r2_items(KArgs a, int G) {
    const int gtid = blockIdx.x * NTHREADS + opaque_tid(), GT = G * NTHREADS;
    for (int idx = gtid; idx < 32 * 4096; idx += GT) {
        const int bhd = idx >> 12, o4 = idx & 4095, dir = bhd & 1, h = (bhd >> 1) & 3;
        const float decay = expf(log_sigmoid(a->in[I_DECAY][dir * 4 + h]) * 128.0f);
        bf16* base = (bf16*)(a->ws + WS_KVS) + (size_t)bhd * 34 * 16384 + o4 * 4;
        const long step = dir == 0 ? 16384 : -16384;
        bf16* p0 = base + (dir == 0 ? 0 : 16384); bf16* p2 = base + (dir == 0 ? 2 * 16384 : 33 * 16384);
        v2u v[34];
        { bf16* p = p0;
#pragma unroll
          for (int i = 0; i < 34; ++i) { if (i == 2) p = p2; v[i] = *(const v2u*)p; p += step; asm volatile("" : "+v"(p)); } }
        float st0 = 0.f, st1 = 0.f, st2 = 0.f, st3 = 0.f;
        { bf16* p = p0;
#pragma unroll
          for (int i = 0; i < 34; ++i) { if (i == 2) p = p2;
            *(v2u*)p = (v2u){pk2(st0, st1), pk2(st2, st3)}; p += step; asm volatile("" : "+v"(p));
            st0 = fmaf(decay, st0, blo(v[i].x)); st1 = fmaf(decay, st1, bhi(v[i].x)); st2 = fmaf(decay, st2, blo(v[i].y)); st3 = fmaf(decay, st3, bhi(v[i].y)); } }
    }
}

__device__ __forceinline__ void r3_unit(KArgs a, LAS unsigned char* lds, int unit) {
    const int tid = opaque_tid(), lane = tid & 63, wave = __builtin_amdgcn_readfirstlane(tid >> 6);
    const int s = unit % 34, bh = unit / 34, h = bh & 3, b = bh >> 2, row0 = ret_row0(b, s);
    const bf16* QKVG = (const bf16*)(a->ws + WS_QKVG);
    const float l2f = log_sigmoid(a->in[I_DECAY][h]) * 1.4426950408889634f, l2b = log_sigmoid(a->in[I_DECAY][4 + h]) * 1.4426950408889634f;
#pragma unroll
    for (int it = 0; it < 4; ++it) {
        const int n = tid + NTHREADS * it, row = n >> 4, ch = n & 15;
        *(LAS v4u*)(lds + off_b(row, ch)) = *(const v4u*)(QKVG + (size_t)(row0 + row) * 2048 + 1024 + 128 * h + 8 * ch);
    }
    __syncthreads();
    const int fr = lane & 15, g = lane >> 4;
    bf16x8 qf[4];
#pragma unroll
    for (int ks = 0; ks < 4; ++ks) qf[ks] = *(const bf16x8*)(QKVG + (size_t)(row0 + 16 * wave + fr) * 2048 + 128 * h + 32 * ks + 8 * g);
    f32x4 acco[8];
#pragma unroll
    for (int c = 0; c < 8; ++c) acco[c] = (f32x4){0.f, 0.f, 0.f, 0.f};
    const int iq = 16 * wave + fr;
#pragma unroll
    for (int jt = 0; jt < 4; ++jt) {
        f32x4 sa = (f32x4){0.f, 0.f, 0.f, 0.f}, sb = sa;
        const int ja = 32 * jt + 8 * (fr >> 2) + (fr & 3);
        const bf16* kpa = QKVG + (size_t)(row0 + ja) * 2048 + 512 + 128 * h + 8 * g;
#pragma unroll
        for (int ks = 0; ks < 4; ++ks) {
            const bf16x8 ka = *(const bf16x8*)(kpa + 32 * ks), kb = *(const bf16x8*)(kpa + 4 * 2048 + 32 * ks);
            sa = MFMA16(ka, qf[ks], sa); sb = MFMA16(kb, qf[ks], sb);
        }
        f32x4 pa, pb;
#pragma unroll
        for (int r = 0; r < 4; ++r) {
            const int j0 = 32 * jt + 8 * g + r, d0 = iq - j0, d1 = d0 - 4;
            const float w0 = (d0 >= 0 ? __builtin_amdgcn_exp2f(l2f * (float)d0) : 0.f) + (d0 <= 0 ? __builtin_amdgcn_exp2f(-l2b * (float)d0) : 0.f);
            const float w1 = (d1 >= 0 ? __builtin_amdgcn_exp2f(l2f * (float)d1) : 0.f) + (d1 <= 0 ? __builtin_amdgcn_exp2f(-l2b * (float)d1) : 0.f);
            pa[r] = sa[r] * w0; pb[r] = sb[r] * w1;
        }
        const bf16x8 pf = pack8(pa, pb);
#pragma unroll
        for (int c = 0; c < 8; ++c) { const bf16x8 vf = tr_frag(lds, lane, c, jt); acco[c] = MFMA16(pf, vf, acco[c]); }
    }
    const bf16* Sf = (const bf16*)(a->ws + WS_KVS) + ((size_t)(bh * 2 + 0) * 34 + s) * 16384;
    const bf16* Sb = (const bf16*)(a->ws + WS_KVS) + ((size_t)(bh * 2 + 1) * 34 + s) * 16384;
    float ff[4], fb[4];
#pragma unroll
    for (int r = 0; r < 4; ++r) { const int i = 16 * wave + 4 * g + r; ff[r] = __builtin_amdgcn_exp2f(l2f * (float)(i + 1)); fb[r] = __builtin_amdgcn_exp2f(l2b * (float)(128 - i)); }
    float ss[4] = {0.f, 0.f, 0.f, 0.f};
#pragma unroll
    for (int c = 0; c < 8; ++c) {
        f32x4 t1 = (f32x4){0.f, 0.f, 0.f, 0.f}, t2 = t1;
        const int e = 16 * c + fr;
#pragma unroll
        for (int ks = 0; ks < 4; ++ks) {
            const bf16x8 s1 = *(const bf16x8*)(Sf + e * 128 + 32 * ks + 8 * g), s2 = *(const bf16x8*)(Sb + e * 128 + 32 * ks + 8 * g);
            t1 = MFMA16(qf[ks], s1, t1); t2 = MFMA16(qf[ks], s2, t2);
        }
#pragma unroll
        for (int r = 0; r < 4; ++r) { const float o = acco[c][r] + ff[r] * t1[r] + fb[r] * t2[r]; acco[c][r] = o; ss[r] = fmaf(o, o, ss[r]); }
    }
#pragma unroll
    for (int r = 0; r < 4; ++r) { float v = ss[r]; v += __shfl_xor(v, 1); v += __shfl_xor(v, 2); v += __shfl_xor(v, 4); v += __shfl_xor(v, 8); ss[r] = rsqrtf(v * (1.0f / 128.0f) + EPS); }
    bf16* YM = (bf16*)(a->ws + WS_XN);
#pragma unroll
    for (int r = 0; r < 4; ++r) { const size_t row = (size_t)(row0 + 16 * wave + 4 * g + r);
#pragma unroll
        for (int c = 0; c < 8; ++c) { const int e = 16 * c + fr; const float gt = bf2f(QKVG[row * 2048 + 1536 + 128 * h + e]);
            YM[row * DM + 128 * h + e] = (bf16)f2bf(acco[c][r] * ss[r] * (gt * __builtin_amdgcn_rcpf(1.0f + __expf(-gt)))); } }
    __syncthreads();
}

__device__ __forceinline__ int s5_row0(int b, int c) { return c < 4 ? ML + b * CTXL + 64 * c : b * SEQ + 64 * (c - 4); }
constexpr int S5_WLDS = 12288;

__device__ __forceinline__ void s5_stage_u(KArgs a, LAS float* us, int rowbase, int g, int lane) {
    const bf16* up = (const bf16*)(a->ws + WS_U) + (size_t)(rowbase + lane) * 512 + 16 * g;
    const v4u u0 = *(const v4u*)up, u1 = *(const v4u*)(up + 8);
    LAS f32x4* d = (LAS f32x4*)(us + lane * 16);
    d[0] = (f32x4){blo(u0.x), bhi(u0.x), blo(u0.y), bhi(u0.y)}; d[1] = (f32x4){blo(u0.z), bhi(u0.z), blo(u0.w), bhi(u0.w)};
    d[2] = (f32x4){blo(u1.x), bhi(u1.x), blo(u1.y), bhi(u1.y)}; d[3] = (f32x4){blo(u1.z), bhi(u1.z), blo(u1.w), bhi(u1.w)};
    asm volatile("s_waitcnt lgkmcnt(0)" ::: "memory");
}
#define S5_STEP(t_)  { const LAS f32x4* up_ = (const LAS f32x4*)(us + (t_) * 16); const f32x4 ua = up_[0], ub = up_[1], uc = up_[2], ud = up_[3]; \
        float br_ = bbr[0] * ua[0], bi_ = bbi[0] * ua[0]; \
        br_ = fmaf(bbr[1], ua[1], br_); bi_ = fmaf(bbi[1], ua[1], bi_); br_ = fmaf(bbr[2], ua[2], br_); bi_ = fmaf(bbi[2], ua[2], bi_); br_ = fmaf(bbr[3], ua[3], br_); bi_ = fmaf(bbi[3], ua[3], bi_); \
        br_ = fmaf(bbr[4], ub[0], br_); bi_ = fmaf(bbi[4], ub[0], bi_); br_ = fmaf(bbr[5], ub[1], br_); bi_ = fmaf(bbi[5], ub[1], bi_); br_ = fmaf(bbr[6], ub[2], br_); bi_ = fmaf(bbi[6], ub[2], bi_); br_ = fmaf(bbr[7], ub[3], br_); bi_ = fmaf(bbi[7], ub[3], bi_); \
        br_ = fmaf(bbr[8], uc[0], br_); bi_ = fmaf(bbi[8], uc[0], bi_); br_ = fmaf(bbr[9], uc[1], br_); bi_ = fmaf(bbi[9], uc[1], bi_); br_ = fmaf(bbr[10], uc[2], br_); bi_ = fmaf(bbi[10], uc[2], bi_); br_ = fmaf(bbr[11], uc[3], br_); bi_ = fmaf(bbi[11], uc[3], bi_); \
        br_ = fmaf(bbr[12], ud[0], br_); bi_ = fmaf(bbi[12], ud[0], bi_); br_ = fmaf(bbr[13], ud[1], br_); bi_ = fmaf(bbi[13], ud[1], bi_); br_ = fmaf(bbr[14], ud[2], br_); bi_ = fmaf(bbi[14], ud[2], bi_); br_ = fmaf(bbr[15], ud[3], br_); bi_ = fmaf(bbi[15], ud[3], bi_); \
        const float nr_ = fmaf(lr, xr, fmaf(-li, xi, br_)), ni_ = fmaf(lr, xi, fmaf(li, xr, bi_)); xr = nr_; xi = ni_; }

__device__ __forceinline__ void s1_unit(KArgs a, LAS unsigned char* wl, int wu, int lane) {
    const int c = wu % 68, bgd = wu / 68, dir = bgd & 1, g = (bgd >> 1) & 31, b = bgd >> 6, dg = dir * 32 + g, p = lane;
    LAS float* us = (LAS float*)wl;
    s5_stage_u(a, us, s5_row0(b, c), g, lane);
    const f32x2 lb = ((const f32x2*)(a->ws + WS_LB))[dg * 64 + p]; const float lr = lb.x, li = lb.y;
    float bbr[16], bbi[16];
#pragma unroll
    for (int k = 0; k < 16; ++k) { bbr[k] = ((const float*)(a->ws + WS_BBR))[(dg * 16 + k) * 64 + p]; bbi[k] = ((const float*)(a->ws + WS_BBI))[(dg * 16 + k) * 64 + p]; }
    float xr = 0.f, xi = 0.f;
    if (dir == 0) { for (int t = 0; t < 64; ++t) S5_STEP(t) }
    else { for (int t = 63; t >= 0; --t) S5_STEP(t) }
    ((f32x2*)(a->ws + WS_SF))[(size_t)wu * 64 + p] = (f32x2){xr, xi};
    asm volatile("s_waitcnt lgkmcnt(0)" ::: "memory");
}
__device__ __forceinline__ void s2_items(KArgs a, int G) {
    const int gtid = blockIdx.x * NTHREADS + opaque_tid(), GT = G * NTHREADS;
    for (int idx = gtid; idx < 4 * 32 * 2 * 64; idx += GT) {
        const int p = idx & 63, bgd = idx >> 6, dir = bgd & 1, g = (bgd >> 1) & 31, dg = dir * 32 + g;
        const f32x2 lt = ((const f32x2*)(a->ws + WS_LBT))[dg * 64 + p];
        f32x2* base = (f32x2*)(a->ws + WS_SF) + (size_t)bgd * 68 * 64 + p;
        const long step = dir == 0 ? 64 : -64;
        f32x2* q0 = base + (dir == 0 ? 0 : 3 * 64); f32x2* q4 = base + (dir == 0 ? 4 * 64 : 67 * 64);
        float cr = 0.f, ci = 0.f;
        f32x2* pl = q0; f32x2* ps = q0;
#pragma unroll
        for (int hb = 0; hb < 2; ++hb) {
            f32x2 v[34];
#pragma unroll
            for (int j = 0; j < 34; ++j) { if (34 * hb + j == 4) pl = q4; v[j] = *pl; pl += step; asm volatile("" : "+v"(pl)); }
#pragma unroll
            for (int j = 0; j < 34; ++j) { if (34 * hb + j == 4) ps = q4; *ps = (f32x2){cr, ci}; ps += step; asm volatile("" : "+v"(ps));
                const float nr = fmaf(lt.x, cr, fmaf(-lt.y, ci, v[j].x)), ni = fmaf(lt.x, ci, fmaf(lt.y, cr, v[j].y)); cr = nr; ci = ni; }
        }
    }
}
__device__ __forceinline__ void s3_unit(KArgs a, LAS unsigned char* wl, int wu, int lane) {
    const int c = wu % 68, bg = wu / 68, g = bg & 31, b = bg >> 5, p = lane, fr = lane & 15, gq = lane >> 4;
    LAS float* us = (LAS float*)wl; LAS unsigned char* xs = wl + 4096;
    const int rowbase = s5_row0(b, c);
    s5_stage_u(a, us, rowbase, g, lane);
    f32x4 acc[4];
#pragma unroll
    for (int i = 0; i < 4; ++i) acc[i] = (f32x4){0.f, 0.f, 0.f, 0.f};
#pragma unroll
    for (int dir = 0; dir < 2; ++dir) {
        const int dg = dir * 32 + g;
        const f32x2 lb = ((const f32x2*)(a->ws + WS_LB))[dg * 64 + p]; const float lr = lb.x, li = lb.y;
        float bbr[16], bbi[16];
#pragma unroll
        for (int k = 0; k < 16; ++k) { bbr[k] = ((const float*)(a->ws + WS_BBR))[(dg * 16 + k) * 64 + p]; bbi[k] = ((const float*)(a->ws + WS_BBI))[(dg * 16 + k) * 64 + p]; }
        bf16x8 cm[4];
#pragma unroll
        for (int ks = 0; ks < 4; ++ks) cm[ks] = *(const bf16x8*)((const bf16*)(a->ws + WS_CM) + (size_t)(dg * 16 + fr) * 128 + 32 * ks + 8 * gq);
        const f32x2 x0 = ((const f32x2*)(a->ws + WS_SF))[((size_t)((b * 32 + g) * 2 + dir) * 68 + c) * 64 + p];
        float xr = x0.x, xi = x0.y;
#pragma unroll
        for (int half = 0; half < 2; ++half) {
            const int hs = dir ? 1 - half : half;
            for (int tt = 0; tt < 32; ++tt) {
                const int tl = dir ? 31 - tt : tt, t = 32 * hs + tl;
                S5_STEP(t)
                *(LAS unsigned*)(xs + tl * 256 + (((p >> 2) ^ (tl & 15)) * 16) + (p & 3) * 4) = pk2(xr, xi);
            }
            asm volatile("s_waitcnt lgkmcnt(0)" ::: "memory");
#pragma unroll
            for (int th = 0; th < 2; ++th) {
                const int row = 16 * th + fr;
                f32x4 d = acc[2 * hs + th];
#pragma unroll
                for (int ks = 0; ks < 4; ++ks) { const bf16x8 xf = *(const LAS bf16x8*)(xs + row * 256 + (((4 * ks + gq) ^ (row & 15)) * 16)); d = MFMA16(cm[ks], xf, d); }
                acc[2 * hs + th] = d;
            }
            asm volatile("s_waitcnt lgkmcnt(0)" ::: "memory");
        }
    }
    const f32x4 dsk = *(const f32x4*)(a->in[I_S5D] + 16 * g + 4 * gq);
    bf16* YS = (bf16*)(a->ws + WS_YS);
#pragma unroll
    for (int T4 = 0; T4 < 4; ++T4) {
        const int t = 16 * T4 + fr; const f32x4 u4 = *(const LAS f32x4*)(us + t * 16 + 4 * gq);
        const f32x4 y = acc[T4] + dsk * u4;
        *(v2u*)(YS + (size_t)(rowbase + t) * 512 + 16 * g + 4 * gq) = (v2u){pk2(gelu_tanh(y[0]), gelu_tanh(y[1])), pk2(gelu_tanh(y[2]), gelu_tanh(y[3]))};
    }
    asm volatile("s_waitcnt lgkmcnt(0)" ::: "memory");
}

__device__ __forceinline__ void na_unit(KArgs a, int wu, int lane) {
    const int r = wu & 63, cb = (wu >> 6) & 3, h = (wu >> 8) & 15, b = wu >> 12, fr = lane & 15, g = lane >> 4;
    const bf16* QK = (const bf16*)(a->ws + WS_QK); const bf16* VT = (const bf16*)(a->ws + WS_VT); bf16* AO = (bf16*)(a->ws + WS_XN);
    const int r0 = min(max(r - 4, 0), 56), kcol0 = min(max(16 * cb - 8, 0), 32);
    const int tq0 = b * SEQ + r * 64 + 16 * cb;
    const unsigned qoff = (unsigned)(fr * 2048 + 8 * g);
    const bf16* qb = QK + (size_t)tq0 * 2048 + 64 * h;
    bf16x8 qf[2]; qf[0] = *(const bf16x8*)(qb + qoff); qf[1] = *(const bf16x8*)(qb + qoff + 32);
    const unsigned koffl = (unsigned)((8 * (fr >> 2) + (fr & 3)) * 2048 + 8 * g);
    const unsigned voffl = (unsigned)(fr * MT + 8 * g);
    const int cq = 16 * cb + fr, ws = min(max(cq - 8, 0), 48);
    int bidx[8]; bool bval[8];
#pragma unroll
    for (int j = 0; j < 8; ++j) { const int kc = kcol0 + 8 * g + (j & 3) + 4 * (j >> 2); bval[j] = kc >= ws && kc < ws + 16; bidx[j] = min(max(kc - cq + 15, 0), 30); }
    const float* rpb = a->in[I_RPB] + (size_t)h * 15 * 31;
    f32x4 o[4];
#pragma unroll
    for (int dt = 0; dt < 4; ++dt) o[dt] = (f32x4){0.f, 0.f, 0.f, 0.f};
    float mrun = -1e30f, lsum = 0.f;
#pragma unroll
    for (int half = 0; half < 2; ++half) {
        f32x4 sc[8][2];
#pragma unroll
        for (int i = 0; i < 8; ++i) {
            const int tok0 = half == 0 ? b * SEQ + (r0 + i) * 64 + kcol0 : ML + b * CTXL + 32 * i;
            const bf16* kb = QK + (size_t)tok0 * 2048 + 1024 + 64 * h;
            f32x4 sa = (f32x4){0.f, 0.f, 0.f, 0.f}, sb = sa;
            sa = MFMA16(*(const bf16x8*)(kb + koffl), qf[0], sa); sa = MFMA16(*(const bf16x8*)(kb + koffl + 32), qf[1], sa);
            sb = MFMA16(*(const bf16x8*)(kb + koffl + 4 * 2048), qf[0], sb); sb = MFMA16(*(const bf16x8*)(kb + koffl + 4 * 2048 + 32), qf[1], sb);
            if (half == 0) {
                const float* bp = rpb + (r0 + i - r + 7) * 31;
#pragma unroll
                for (int rr = 0; rr < 4; ++rr) { sa[rr] = bval[rr] ? sa[rr] + bp[bidx[rr]] : -1e30f; sb[rr] = bval[4 + rr] ? sb[rr] + bp[bidx[4 + rr]] : -1e30f; }
            }
            sc[i][0] = sa; sc[i][1] = sb;
        }
        float mx = -1e30f;
#pragma unroll
        for (int i = 0; i < 8; ++i)
#pragma unroll
            for (int t = 0; t < 2; ++t) mx = fmaxf(mx, fmaxf(fmaxf(sc[i][t][0], sc[i][t][1]), fmaxf(sc[i][t][2], sc[i][t][3])));
        mx = fmaxf(mx, __shfl_xor(mx, 16)); mx = fmaxf(mx, __shfl_xor(mx, 32));
        const float mnew = fmaxf(mrun, mx);
        const float resc = __builtin_amdgcn_exp2f((mrun - mnew) * 1.4426950408889634f);
        mrun = mnew; lsum *= resc;
#pragma unroll
        for (int dt = 0; dt < 4; ++dt) o[dt] = o[dt] * resc;
        const float mneg = -mnew * 1.4426950408889634f;
        float ls = 0.f;
#pragma unroll
        for (int i = 0; i < 8; ++i)
#pragma unroll
            for (int t = 0; t < 2; ++t)
#pragma unroll
                for (int rr = 0; rr < 4; ++rr) { const float pv = __builtin_amdgcn_exp2f(fmaf(sc[i][t][rr], 1.4426950408889634f, mneg)); sc[i][t][rr] = pv; ls += pv; }
        lsum += ls;
#pragma unroll
        for (int i = 0; i < 8; ++i) {
            const bf16x8 pf = pack8(sc[i][0], sc[i][1]);
            const int tok0 = half == 0 ? b * SEQ + (r0 + i) * 64 + kcol0 : ML + b * CTXL + 32 * i;
            const bf16* vb = VT + (size_t)(64 * h) * MT + tok0;
#pragma unroll
            for (int dt = 0; dt < 4; ++dt) o[dt] = MFMA16(*(const bf16x8*)(vb + voffl + (unsigned)(16 * dt * MT)), pf, o[dt]);
        }
    }
    lsum += __shfl_xor(lsum, 16); lsum += __shfl_xor(lsum, 32);
    const float rl = 1.0f / lsum;
    bf16* ob = AO + (size_t)tq0 * DM + 64 * h;
#pragma unroll
    for (int dt = 0; dt < 4; ++dt)
        *(v2u*)(ob + (unsigned)(fr * DM + 16 * dt + 4 * g)) = (v2u){pk2(o[dt][0] * rl, o[dt][1] * rl), pk2(o[dt][2] * rl, o[dt][3] * rl)};
}

#ifndef STAGE
#define STAGE 6
#endif
#define GSYNC() xcd_barrier(bar)
#ifndef REP_A
#define REP_A 1
#endif
#ifndef REP_B
#define REP_B 1
#endif
#ifndef REP_MODE
#define REP_MODE 0
#endif
#ifndef REP_G1
#define REP_G1 1
#endif
#ifndef REP_G2
#define REP_G2 1
#endif
#ifndef REP_NORM
#define REP_NORM 1
#endif
#ifndef REP_N
#define REP_N 1
#endif

template <class Epi>
__device__ __forceinline__ void run_gemm(LAS unsigned char* lds, const bf16* A, const bf16* Bt, int M, int N, int K, int G, const Epi& E) {
    pg8::Gemm g{A, Bt, M, N, K}; pg8::StaticOrder S; S.init(M, N, G, (int)blockIdx.x, K);
    pg8::gemm_phase<Epi, pg8::StaticOrder, true, true>(lds, g, S, E);
}
template <class Epi>
__device__ __forceinline__ void run_gemm_splitctx(LAS unsigned char* lds, const bf16* A, const bf16* Bt, int N, int K, int nsplit, int G, const Epi& E) {
    pg8::Gemm g{A, Bt, MT, N, K}; pg8::SplitCtxOrder S; S.init(ML, MC, N, K, G, (int)blockIdx.x, nsplit);
    pg8::gemm_phase<Epi, pg8::SplitCtxOrder, true, true>(lds, g, S, E);
}

__device__ __forceinline__ void ffn_block(KArgs a, LAS unsigned char* lds, const XcdBarrier& bar, int G, int layer, int f, const float* rin_lat, const float* rin_ctx, int nrows, const float* part_in, int npart_in) {
    const float* MODL = (const float*)(a->ws + WS_MOD) + (size_t)layer * 5 * MODW;
    float* hl = a->out; float* hc = (float*)(a->ws + WS_HCTX);
    bf16* XN = (bf16*)(a->ws + WS_XN); bf16* HID = (bf16*)(a->ws + WS_HID);
    const bf16* W1b = (const bf16*)(a->ws + WS_W1) + (size_t)(layer * 2 + f) * 2 * FF * DM;
    const bf16* W2b = (const bf16*)(a->ws + WS_W2) + (size_t)(layer * 2 + f) * DM * FF;
    for (int rep = 1; rep < REP_NORM; ++rep) { norm_phase(rin_lat, rin_ctx, XN, a->in[I_NORMG] + (size_t)(layer * 3 + (f ? 2 : 0)) * DM, MODL, f ? 6 : 0, nrows, G, nullptr, 0, hc); GSYNC(); }
    norm_phase(rin_lat, rin_ctx, XN, a->in[I_NORMG] + (size_t)(layer * 3 + (f ? 2 : 0)) * DM, MODL, f ? 6 : 0, nrows, G, part_in, npart_in, hc);
    GSYNC();
    for (int rep = 0; rep < REP_G1; ++rep) {
    { pg8::EpiSwiglu E{HID, FF}; run_gemm(lds, XN, W1b, nrows, 2 * FF, DM, G, E); }
    GSYNC(); }
    for (int rep = 0; rep < REP_G2; ++rep) {
    { pg8::EpiResid E{rin_lat, rin_ctx, hl, hc, MODL + (f ? 8 : 2) * DM, (float*)(a->ws + WS_PARTF), rep == REP_G2 - 1 ? 0.5f : 0.0f};
      if (nrows == MT) run_gemm_splitctx(lds, HID, W2b, DM, FF, 11, G, E); else run_gemm(lds, HID, W2b, nrows, DM, FF, G, E); }
    GSYNC(); }
}

__global__ void __launch_bounds__(NTHREADS, 2) fwd_megakernel(Args a_unused) {
#define a kargs()
    extern __shared__ __attribute__((aligned(16))) unsigned char lds_raw[];
    LAS unsigned char* lds = (LAS unsigned char*)lds_raw;
    cg::grid_group grid = cg::this_grid();
    const int G = gridDim.x;
#define LANEWAVE() const int tid = opaque_tid(), lane = tid & 63, wave = __builtin_amdgcn_readfirstlane(tid >> 6)
#define hl (a->out)
#define hc ((float*)(a->ws + WS_HCTX))
#define XN ((bf16*)(a->ws + WS_XN))
#define MOD0 ((const float*)(a->ws + WS_MOD))
#define MOD1 (MOD0 + 5 * MODW)

    if (threadIdx.x < 8) ((LAS unsigned*)(lds + BARLDS_OFF))[threadIdx.x] = 0u;
    __syncthreads();
    const XcdBarrier bar = xcd_barrier_post((unsigned*)(a->ws + WS_BAR), (volatile LAS unsigned*)(lds + BARLDS_OFF));

    p0_prologue(a, lds, G);
    grid.sync();
    xcd_barrier_census(bar);

    if (STAGE == 0) {
        const int gtid = blockIdx.x * NTHREADS + opaque_tid(), GT = G * NTHREADS;
        for (int i = gtid; i < ML * DM / 4; i += GT) ((f32x4*)hl)[i] = ((const f32x4*)a->in[I_X])[i];
        GSYNC();
    }
    if (STAGE >= 1) ffn_block(a, lds, bar, G, 0, 0, a->in[I_X], hc, MT, nullptr, 0);
    if (STAGE >= 2) {
        norm_phase(hl, hc, XN, a->in[I_NORMG] + 1 * DM, MOD0, 3, MT, G, (const float*)(a->ws + WS_PARTF), 11, hc);
        GSYNC();
        { pg8::EpiWin E{(bf16*)(a->ws + WS_QKVG), (bf16*)(a->ws + WS_U), (const float*)(a->ws + WS_ROPE)}; run_gemm(lds, XN, (const bf16*)(a->ws + WS_WIN), MT, 2560, DM, G, E); }
        GSYNC();
        for (int rep = 0; rep < REP_A; ++rep) {
        { LANEWAVE(); for (int u = blockIdx.x; u < 544 + 2176; u += G) { if (rep > 0 && ((REP_MODE == 1 && u >= 544) || (REP_MODE == 2 && u < 544))) continue; if (u < 544) r1_unit(a, lds, u); else s1_unit(a, lds + wave * S5_WLDS, (u - 544) * 8 + wave, lane); } }
        GSYNC(); }
        r2_items(a, G); s2_items(a, G);
        GSYNC();
        for (int rep = 0; rep < REP_B; ++rep) {
        { LANEWAVE(); for (int u = blockIdx.x; u < 544 + 1088; u += G) { if (rep > 0 && ((REP_MODE == 1 && u >= 544) || (REP_MODE == 2 && u < 544))) continue; if (u < 544) r3_unit(a, lds, u); else s3_unit(a, lds + wave * S5_WLDS, (u - 544) * 8 + wave, lane); } }
        GSYNC(); }
        { pg8::EpiGlu E{(const bf16*)(a->ws + WS_YS), XN, a->in[I_GLUB]}; run_gemm(lds, (const bf16*)(a->ws + WS_YS), (const bf16*)(a->ws + WS_GLU), MT, 512, 512, G, E); }
        GSYNC();
        { pg8::EpiResid E{hl, hc, hl, hc, MOD0 + 5 * DM, (float*)(a->ws + WS_PARTM), 1.0f}; run_gemm_splitctx(lds, XN, (const bf16*)(a->ws + WS_WOUT), DM, DM, 8, G, E); }
        GSYNC();
    }
    if (STAGE >= 3) ffn_block(a, lds, bar, G, 0, 1, hl, hc, MT, (const float*)(a->ws + WS_PARTM), 8);
    if (STAGE >= 4) ffn_block(a, lds, bar, G, 1, 0, hl, hc, MT, (const float*)(a->ws + WS_PARTF), 11);
    if (STAGE >= 5) {
        norm_phase(hl, hc, XN, a->in[I_NORMG] + 4 * DM, MOD1, 3, MT, G, (const float*)(a->ws + WS_PARTF), 11, hc);
        GSYNC();
        { pg8::EpiBf16S E{(bf16*)(a->ws + WS_QK), 2048, 4, 0.125f}; run_gemm(lds, XN, (const bf16*)(a->ws + WS_WQKV), MT, 2048, DM, G, E); }
        { pg8::EpiBf16S E{(bf16*)(a->ws + WS_VT), MT, 0, 1.0f}; run_gemm(lds, (const bf16*)(a->ws + WS_WQKV) + (size_t)2048 * DM, XN, DM, MT, DM, G, E); }
        GSYNC();
        for (int rep = 0; rep < REP_N; ++rep) {
        { LANEWAVE(); for (int u = blockIdx.x; u < 2048; u += G) na_unit(a, u * 8 + wave, lane); }
        GSYNC(); }
        { pg8::EpiResid E{hl, hc, hl, hc, MOD1 + 5 * DM, nullptr, 1.0f}; run_gemm(lds, XN, (const bf16*)(a->ws + WS_WO), ML, DM, DM, G, E); }
        GSYNC();
    }
    if (STAGE >= 6) ffn_block(a, lds, bar, G, 1, 1, hl, hc, ML, nullptr, 0);
    final_norm_phase(a->out, a->in[I_FINALG], G);
#undef a
#undef hl
#undef hc
#undef XN
#undef MOD0
#undef MOD1
}

extern "C" void kernel_launch(void* const* d_in, const int* in_sizes, int n_in, void* d_out, int out_size, void* d_ws, size_t ws_size, hipStream_t stream) {
    static int grid = 0;
    if (grid == 0) {
        if (n_in != 26 || out_size != ML * DM || ws_size < WS_END) { fprintf(stderr, "kernel_launch: unexpected problem (n_in %d, out %d, ws %zu)\n", n_in, out_size, ws_size); grid = -1; return; }
        int dev = 0, cus = 0, per_cu = 0;
        if (hipGetDevice(&dev) != hipSuccess || hipDeviceGetAttribute(&cus, hipDeviceAttributeMultiprocessorCount, dev) != hipSuccess) { grid = -1; return; }
        if (hipFuncSetAttribute((const void*)fwd_megakernel, hipFuncAttributeMaxDynamicSharedMemorySize, LDS_BYTES) != hipSuccess) { fprintf(stderr, "kernel_launch: hipFuncSetAttribute failed\n"); grid = -1; return; }
        if (hipOccupancyMaxActiveBlocksPerMultiprocessor(&per_cu, (const void*)fwd_megakernel, NTHREADS, LDS_BYTES) != hipSuccess || per_cu < 1) { fprintf(stderr, "kernel_launch: occupancy query failed (%d)\n", per_cu); (void)hipGetLastError(); grid = -1; return; }
        grid = cus * per_cu;
    }
    if (grid < 0) return;
    if (hipMemsetAsync((char*)d_ws + WS_BAR, 0, 16384, stream) != hipSuccess) { fprintf(stderr, "kernel_launch: memset failed\n"); return; }
    Args a{};
    for (int i = 0; i < 26; ++i) a.in[i] = (const float*)d_in[i];
    a.out = (float*)d_out; a.ws = (unsigned char*)d_ws; a.probe = 0; a.pad = 0;
    void* args[] = {&a};
    hipError_t e = hipLaunchCooperativeKernel((const void*)fwd_megakernel, dim3(grid), dim3(NTHREADS), args, LDS_BYTES, stream);
    if (e != hipSuccess) fprintf(stderr, "kernel_launch: cooperative launch failed: %s (grid %d)\n", hipGetErrorString(e), grid);
}
```

```cpp
#include <hip/hip_runtime.h>
#include <hip/hip_cooperative_groups.h>
#include <cstdio>
#include <cstdint>
namespace cg = cooperative_groups;

constexpr int DM = 1024, NB = 4, SEQ = 4096, CTXL = 256, FF = 2816, NMOD = 9;
constexpr int ML = NB * SEQ, MC = NB * CTXL, MT = ML + MC;
constexpr int MODW = NMOD * DM;
constexpr float EPS = 1e-6f;

namespace pg8 {
#define PG8_LAS __attribute__((address_space(3)))
typedef unsigned short bf16_t;
typedef short bf16x8 __attribute__((ext_vector_type(8)));
typedef float f32x4 __attribute__((ext_vector_type(4)));
typedef unsigned u32x4 __attribute__((ext_vector_type(4)));
constexpr int BM = 256, BK = 64, HALF = 128, HTB = HALF * BK * 2  , STAGE_BYTES = 8 * HTB, NXCD = 8, WGM = 8;

__host__ __device__ __forceinline__ int lds_byte(int r, int c) { const int st = (r >> 4) * 2 + (c >> 5), rr = r & 15, cc = c & 31, ob = rr * 64 + cc * 2; return st * 1024 + (ob ^ (((ob >> 9) & 1) << 5)); }
__host__ __device__ __forceinline__ void stage_rc(int b, int& R, int& C) { const int st = b / 1024, sb = b % 1024, swz = sb ^ (((sb >> 9) & 1) << 5); R = (st >> 1) * 16 + swz / 64; C = (st & 1) * 32 + (swz % 64) / 2; }
__host__ __device__ __forceinline__ int perm32(int rho) { const int n = rho >> 4, i = rho & 15; return 8 * (i >> 2) + 4 * n + (i & 3); }

struct Unit { int pm, pn, k0, nt, split; };
struct Gemm { const bf16_t* A; const bf16_t* Bt; int M, N, K; };

struct StaticOrder {
    int nM, nN, nwg, G, c, ntk;
    __host__ __device__ void init(int M, int N, int G_, int c_, int K_ = 0) { nM = M / BM; nN = N / BM; nwg = nM * nN; G = G_; c = c_; ntk = K_ / BK; }
    __host__ __device__ bool next(int i, Unit& u) const {
        const long L = (long)i * G + c; if (L >= nwg) return false;
        int wgid = (int)L; { const int q = nwg / NXCD, r = nwg % NXCD, xcd = wgid % NXCD, off = wgid / NXCD; wgid = (xcd < r ? xcd * (q + 1) : r * (q + 1) + (xcd - r) * q) + off; }
        const int nig = WGM * nN, gid = wgid / nig, fm = gid * WGM, gsz = (nM - fm) < WGM ? (nM - fm) : WGM;
        u.pm = fm + ((wgid % nig) % gsz); u.pn = (wgid % nig) / gsz; u.k0 = 0; u.nt = ntk; u.split = 0; return true;
    }
    __device__ __forceinline__ void a_ready(const Unit&) const {}
    __device__ __forceinline__ void done(const Unit&) const {}
};

struct SplitCtxOrder {
    StaticOrder lat; int nN, nsplit, ntp, npieces, G, c;
    __host__ __device__ void init(int MLAT, int MCTX, int N, int K, int G_, int c_, int nsplit_) { lat.init(MLAT, N, G_, c_, K); nN = N / BM; nsplit = nsplit_; ntp = (K / BK) / nsplit_; npieces = (MCTX / BM) * nN * nsplit_; G = G_; c = c_; }
    __host__ __device__ bool next(int i, Unit& u) const {
        const long L = (long)i * G + c;
        if (L < lat.nwg) return lat.next(i, u);
        const int q = (int)(L - lat.nwg); if (q >= npieces) return false;
        const int ks = q % nsplit, t = q / nsplit; u.pn = t % nN; u.pm = lat.nM + t / nN; u.k0 = ks * ntp; u.nt = ntp; u.split = 1; return true;
    }
    __device__ __forceinline__ void a_ready(const Unit&) const {}
    __device__ __forceinline__ void done(const Unit&) const {}
};

__device__ __forceinline__ unsigned cvt_pk_bf16(float lo, float hi) { unsigned r; asm volatile("v_cvt_pk_bf16_f32 %0, %1, %2" : "=v"(r) : "v"(lo), "v"(hi)); return r; }
__device__ __forceinline__ float bf_lo(unsigned w) { return __uint_as_float(w << 16); }
__device__ __forceinline__ float bf_hi(unsigned w) { return __uint_as_float(w & 0xffff0000u); }
__device__ __forceinline__ float fsilu(float a) { return a * __builtin_amdgcn_rcpf(1.0f + __expf(-a)); }
__device__ __forceinline__ float fsigmoid(float a) { return __builtin_amdgcn_rcpf(1.0f + __expf(-a)); }

struct EpiSwiglu {
    static constexpr bool PERM = true, AFTER_DRAIN = false;
    bf16_t* O; int ldo;
    __device__ __forceinline__ void operator()(const f32x4 (&acc)[2][2][4][2], const Unit& u, int wr, int wc, int fr, int fq) const {
        const int row0 = u.pm * BM + wr * 64 + fr, col0 = u.pn * HALF + wc * 32 + 8 * fq;
#pragma unroll
        for (int ai = 0; ai < 2; ++ai)
#pragma unroll
            for (int m = 0; m < 4; ++m) {
                bf16_t* rowp = O + (size_t)(row0 + ai * HALF + m * 16) * ldo + col0;
                float h[8];
#pragma unroll
                for (int n = 0; n < 2; ++n)
#pragma unroll
                    for (int i = 0; i < 4; ++i) { const float a = acc[ai][0][m][n][i], b = acc[ai][1][m][n][i]; h[4 * n + i] = fsilu(a) * b; }
                u32x4 w; w.x = cvt_pk_bf16(h[0], h[1]); w.y = cvt_pk_bf16(h[2], h[3]); w.z = cvt_pk_bf16(h[4], h[5]); w.w = cvt_pk_bf16(h[6], h[7]);
                *(u32x4*)rowp = w;
            }
    }
};

struct EpiResid {
    static constexpr bool PERM = false, AFTER_DRAIN = false;
    const float* rin_lat; const float* rin_ctx; float* rout_lat; float* rout_ctx; const float* gate; float* part; float gs;
    __device__ __forceinline__ void operator()(const f32x4 (&acc)[2][2][4][2], const Unit& u, int wr, int wc, int fr, int fq) const {
        const bool lat = u.pm < (ML / BM);
        const int bidx = lat ? (u.pm >> 4) : 4;
        const float* gp = gate + (size_t)bidx * MODW;
        const float* ri = lat ? rin_lat + (size_t)u.pm * BM * DM : rin_ctx + (size_t)(u.pm - ML / BM) * BM * DM;
        float* ro = lat ? rout_lat + (size_t)u.pm * BM * DM : rout_ctx + (size_t)(u.pm - ML / BM) * BM * DM;
        const int col0 = u.pn * BM + wc * 32 + 4 * fq;
        f32x4 gv[2][2];
#pragma unroll
        for (int bj = 0; bj < 2; ++bj)
#pragma unroll
            for (int n = 0; n < 2; ++n) gv[bj][n] = *(const f32x4*)(gp + col0 + bj * HALF + n * 16) * gs;
#pragma unroll
        for (int ai = 0; ai < 2; ++ai)
#pragma unroll
            for (int m = 0; m < 4; ++m) {
                const size_t off = (size_t)(ai * HALF + wr * 64 + m * 16 + fr) * DM + col0;
#pragma unroll
                for (int bj = 0; bj < 2; ++bj)
#pragma unroll
                    for (int n = 0; n < 2; ++n) {
                        if (u.split) { float* o = part + ((size_t)(u.k0 / u.nt) * MC + (size_t)(u.pm - ML / BM) * BM) * DM + off + bj * HALF + n * 16; *(f32x4*)o = gv[bj][n] * acc[ai][bj][m][n]; }
                        else { const f32x4 r = *(const f32x4*)(ri + off + bj * HALF + n * 16); *(f32x4*)(ro + off + bj * HALF + n * 16) = r + gv[bj][n] * acc[ai][bj][m][n]; } }
            }
    }
};

struct EpiWin {
    static constexpr bool PERM = true, AFTER_DRAIN = false;
    bf16_t* QKVG; bf16_t* U; const float* rope;
    __device__ __forceinline__ void operator()(const f32x4 (&acc)[2][2][4][2], const Unit& u, int wr, int wc, int fr, int fq) const {
        const int row0 = u.pm * BM + wr * 64 + fr;
        if (u.pn >= 4) {
            bf16_t* base = u.pn < 8 ? QKVG + u.pn * BM : U + (u.pn - 8) * BM; const int ld = u.pn < 8 ? 2048 : 512;
            const int col0 = wc * 32 + 8 * fq;
#pragma unroll
            for (int ai = 0; ai < 2; ++ai)
#pragma unroll
                for (int m = 0; m < 4; ++m) { bf16_t* rowp = base + (size_t)(row0 + ai * HALF + m * 16) * ld + col0;
#pragma unroll
                    for (int bj = 0; bj < 2; ++bj) { const f32x4 v0 = acc[ai][bj][m][0], v1 = acc[ai][bj][m][1];
                        u32x4 w; w.x = cvt_pk_bf16(v0[0], v0[1]); w.y = cvt_pk_bf16(v0[2], v0[3]); w.z = cvt_pk_bf16(v1[0], v1[1]); w.w = cvt_pk_bf16(v1[2], v1[3]);
                        *(u32x4*)(rowp + bj * HALF) = w; } }
        } else {
            const bool lat = u.pm < (ML / BM);
            const float sc = u.pn >= 2 ? 0.08838834764831845f : 1.0f;
            const int hh = wc >> 1, rot = wc & 1, f0 = 8 * fq;
            const int dcol = u.pn * BM + 128 * hh + 64 * rot + f0;
#pragma unroll
            for (int ai = 0; ai < 2; ++ai)
#pragma unroll
                for (int m = 0; m < 4; ++m) {
                    const int row = row0 + ai * HALF + m * 16;
                    float y1[8], y2[8];
                    const int t = row & (SEQ - 1), pos = rot ? (t & 63) : (t >> 6);
                    const float* rp = rope + (size_t)(pos * 32 + f0) * 2;
#pragma unroll
                    for (int n = 0; n < 2; ++n) {
                        f32x4 cs0 = (f32x4){1.f, 0.f, 1.f, 0.f}, cs1 = cs0;
                        if (lat) { cs0 = *(const f32x4*)(rp + 8 * n); cs1 = *(const f32x4*)(rp + 8 * n + 4); }
                        const f32x4 x1 = acc[ai][0][m][n], x2 = acc[ai][1][m][n];
                        y1[4 * n + 0] = (x1[0] * cs0[0] - x2[0] * cs0[1]) * sc; y2[4 * n + 0] = (x2[0] * cs0[0] + x1[0] * cs0[1]) * sc;
                        y1[4 * n + 1] = (x1[1] * cs0[2] - x2[1] * cs0[3]) * sc; y2[4 * n + 1] = (x2[1] * cs0[2] + x1[1] * cs0[3]) * sc;
                        y1[4 * n + 2] = (x1[2] * cs1[0] - x2[2] * cs1[1]) * sc; y2[4 * n + 2] = (x2[2] * cs1[0] + x1[2] * cs1[1]) * sc;
                        y1[4 * n + 3] = (x1[3] * cs1[2] - x2[3] * cs1[3]) * sc; y2[4 * n + 3] = (x2[3] * cs1[2] + x1[3] * cs1[3]) * sc;
                    }
                    bf16_t* rowp = QKVG + (size_t)row * 2048 + dcol;
                    u32x4 w; w.x = cvt_pk_bf16(y1[0], y1[1]); w.y = cvt_pk_bf16(y1[2], y1[3]); w.z = cvt_pk_bf16(y1[4], y1[5]); w.w = cvt_pk_bf16(y1[6], y1[7]);
                    *(u32x4*)rowp = w;
                    w.x = cvt_pk_bf16(y2[0], y2[1]); w.y = cvt_pk_bf16(y2[2], y2[3]); w.z = cvt_pk_bf16(y2[4], y2[5]); w.w = cvt_pk_bf16(y2[6], y2[7]);
                    *(u32x4*)(rowp + 32) = w;
                }
        }
    }
};

struct EpiGlu {
    static constexpr bool PERM = true, AFTER_DRAIN = false;
    const bf16_t* YS; bf16_t* YM; const float* bias;
    __device__ __forceinline__ void operator()(const f32x4 (&acc)[2][2][4][2], const Unit& u, int wr, int wc, int fr, int fq) const {
        const int row0 = u.pm * BM + wr * 64 + fr, col0 = u.pn * BM + wc * 32 + 8 * fq;
        f32x4 bv[2][2];
#pragma unroll
        for (int bj = 0; bj < 2; ++bj)
#pragma unroll
            for (int n = 0; n < 2; ++n) bv[bj][n] = *(const f32x4*)(bias + col0 + bj * HALF + 4 * n);
#pragma unroll
        for (int ai = 0; ai < 2; ++ai)
#pragma unroll
            for (int m = 0; m < 4; ++m) { const int row = row0 + ai * HALF + m * 16;
#pragma unroll
                for (int bj = 0; bj < 2; ++bj) {
                    const u32x4 yv = *(const u32x4*)(YS + (size_t)row * 512 + col0 + bj * HALF);
                    const f32x4 z0 = acc[ai][bj][m][0] + bv[bj][0], z1 = acc[ai][bj][m][1] + bv[bj][1];
                    u32x4 w;
                    w.x = cvt_pk_bf16(bf_lo(yv.x) * fsigmoid(z0[0]), bf_hi(yv.x) * fsigmoid(z0[1]));
                    w.y = cvt_pk_bf16(bf_lo(yv.y) * fsigmoid(z0[2]), bf_hi(yv.y) * fsigmoid(z0[3]));
                    w.z = cvt_pk_bf16(bf_lo(yv.z) * fsigmoid(z1[0]), bf_hi(yv.z) * fsigmoid(z1[1]));
                    w.w = cvt_pk_bf16(bf_lo(yv.w) * fsigmoid(z1[2]), bf_hi(yv.w) * fsigmoid(z1[3]));
                    *(u32x4*)(YM + (size_t)row * DM + 512 + col0 + bj * HALF) = w; } }
    }
};

struct EpiBf16S {
    static constexpr bool PERM = true, AFTER_DRAIN = false;
    bf16_t* O; int ldo; int nscale; float scale0;
    __device__ __forceinline__ void operator()(const f32x4 (&acc)[2][2][4][2], const Unit& u, int wr, int wc, int fr, int fq) const {
        const int row0 = u.pm * BM + wr * 64 + fr, col0 = u.pn * BM + wc * 32 + 8 * fq;
        const float sc = u.pn < nscale ? scale0 : 1.0f;
#pragma unroll
        for (int ai = 0; ai < 2; ++ai)
#pragma unroll
            for (int m = 0; m < 4; ++m) { bf16_t* rowp = O + (size_t)(row0 + ai * HALF + m * 16) * ldo + col0;
#pragma unroll
                for (int bj = 0; bj < 2; ++bj) { const f32x4 v0 = acc[ai][bj][m][0] * sc, v1 = acc[ai][bj][m][1] * sc;
                    u32x4 w; w.x = cvt_pk_bf16(v0[0], v0[1]); w.y = cvt_pk_bf16(v0[2], v0[3]); w.z = cvt_pk_bf16(v1[0], v1[1]); w.w = cvt_pk_bf16(v1[2], v1[3]);
                    *(u32x4*)(rowp + bj * HALF) = w; } }
    }
};
template <class Epi, class Sched, bool ALIGN_EPI = false, bool SP2 = false>
__device__ __forceinline__ void gemm_phase(PG8_LAS unsigned char* lds, const Gemm g, const Sched& S, const Epi& E) {
    int tid_ = threadIdx.x; asm volatile("" : "+v"(tid_));
    const int tid = tid_, wid = __builtin_amdgcn_readfirstlane(tid >> 6), lane = tid & 63, wr = wid >> 2, wc = wid & 3, fr = lane & 15, fq = lane >> 4;
    const int K = g.K;
    unsigned voffA[2], voffB[2];
#pragma unroll
    for (int i = 0; i < 2; ++i) { int R, C; stage_rc(tid * 16 + i * 8192, R, C); const int Rb = Epi::PERM ? ((R & ~31) + perm32(R & 31)) : R;
        voffA[i] = (unsigned)(R * K + C) * 2u; voffB[i] = (unsigned)(Rb * K + C) * 2u; }
    const size_t kstep = (size_t)(BK * 2);
    const size_t hstep = (size_t)HALF * K * 2;
    const size_t tstep = 2 * hstep;
    const unsigned ldsw = (unsigned)wid * 1024u;
    const int aoff = lds_byte(wr * 64 + fr, fq * 8), boff = lds_byte(wc * 32 + fr, fq * 8);
#define PG8_SA(b, h) (((b) * 2 + (h)) * HTB)
#define PG8_SB(b, h) ((4 + (b) * 2 + (h)) * HTB)
#define PG8_STAGE(bufoff, gbase, voff) do { _Pragma("unroll") for (int _i = 0; _i < 2; ++_i) \
        __builtin_amdgcn_global_load_lds((const unsigned*)((const char*)(gbase) + (voff)[_i]), (PG8_LAS unsigned*)(lds + (bufoff) + ldsw + _i * 8192), 16, 0, 0); } while (0)
#define PG8_LDA(dst, b, h) do { _Pragma("unroll") for (int m = 0; m < 4; ++m) _Pragma("unroll") for (int k = 0; k < 2; ++k) dst[m][k] = *(const PG8_LAS bf16x8*)(lds + PG8_SA(b, h) + aoff + m * 2048 + k * 1024); } while (0)
#define PG8_LDB(dst, b, h) do { _Pragma("unroll") for (int n = 0; n < 2; ++n) _Pragma("unroll") for (int k = 0; k < 2; ++k) dst[n][k] = *(const PG8_LAS bf16x8*)(lds + PG8_SB(b, h) + boff + n * 2048 + k * 1024); } while (0)
#define PG8_MMA(ai, bj, At, Bt) do { __builtin_amdgcn_s_setprio(1); _Pragma("unroll") for (int m = 0; m < 4; ++m) _Pragma("unroll") for (int n = 0; n < 2; ++n) _Pragma("unroll") for (int k = 0; k < 2; ++k) \
        acc[ai][bj][m][n] = __builtin_amdgcn_mfma_f32_16x16x32_bf16(Bt[n][k], At[m][k], acc[ai][bj][m][n], 0, 0, 0); __builtin_amdgcn_s_setprio(0); } while (0)
#define PG8_WAIT_V(n) asm volatile("s_waitcnt vmcnt(" #n ")" ::: "memory")
#define PG8_WAIT_L(n) asm volatile("s_waitcnt lgkmcnt(" #n ")" ::: "memory")
#define PG8_BAR __builtin_amdgcn_s_barrier()
#define PG8_SCHED __builtin_amdgcn_sched_barrier(0)
    Unit cur, nxt; int ui = 0;
    if (!S.next(0, cur)) return;
    f32x4 acc[2][2][4][2];
#pragma unroll
    for (int a = 0; a < 2; ++a)
#pragma unroll
        for (int b = 0; b < 2; ++b)
#pragma unroll
            for (int m = 0; m < 4; ++m)
#pragma unroll
                for (int n = 0; n < 2; ++n) acc[a][b][m][n] = (f32x4){0.f, 0.f, 0.f, 0.f};
    bf16x8 At[4][2], B0[2][2], B1[2][2];
    const char* cA = (const char*)g.A + (size_t)cur.pm * tstep + (size_t)cur.k0 * kstep; const char* cB = (const char*)g.Bt + (size_t)cur.pn * tstep + (size_t)cur.k0 * kstep;
    S.a_ready(cur);
    if constexpr (SP2) {
        PG8_STAGE(PG8_SB(0, 0), cB, voffB); PG8_STAGE(PG8_SB(0, 1), cB + hstep, voffB); PG8_STAGE(PG8_SA(0, 0), cA, voffA); PG8_STAGE(PG8_SA(0, 1), cA + hstep, voffA);
        if (wr == 1) PG8_BAR;
        PG8_WAIT_V(2); PG8_BAR;
        PG8_STAGE(PG8_SB(1, 0), cB + kstep, voffB); PG8_STAGE(PG8_SA(1, 0), cA + kstep, voffA); PG8_STAGE(PG8_SB(1, 1), cB + hstep + kstep, voffB);
        PG8_WAIT_V(6); PG8_BAR;
    } else {
        PG8_STAGE(PG8_SB(0, 0), cB, voffB); PG8_STAGE(PG8_SA(0, 0), cA, voffA); PG8_STAGE(PG8_SB(0, 1), cB + hstep, voffB); PG8_STAGE(PG8_SA(0, 1), cA + hstep, voffA);
        if (wr == 1) PG8_BAR;
        PG8_WAIT_V(4); PG8_BAR;
        PG8_STAGE(PG8_SB(1, 0), cB + kstep, voffB); PG8_STAGE(PG8_SA(1, 0), cA + kstep, voffA); PG8_STAGE(PG8_SB(1, 1), cB + hstep + kstep, voffB);
        PG8_WAIT_V(6); PG8_BAR;
    }
    for (;;) {
        const bool has_next = S.next(ui + 1, nxt);
        const char* nA = has_next ? (const char*)g.A + (size_t)nxt.pm * tstep + (size_t)nxt.k0 * kstep : cA; const char* nB = has_next ? (const char*)g.Bt + (size_t)nxt.pn * tstep + (size_t)nxt.k0 * kstep : cB;
        const int nt = cur.nt;
        for (int t = 0; t < nt; t += 2) {
            const bool last = (t == nt - 2);
            const char* a1 = cA + (size_t)(t + 1) * kstep;
            const char* a2 = last ? nA : cA + (size_t)(t + 2) * kstep; const char* b2 = last ? nB : cB + (size_t)(t + 2) * kstep;
            const char* a3 = a2 + kstep; const char* b3 = b2 + kstep;
            if (last && has_next) S.a_ready(nxt);
            if constexpr (SP2) {
            PG8_LDB(B0, 0, 0); PG8_LDB(B1, 0, 1); PG8_SCHED; PG8_LDA(At, 0, 0); PG8_STAGE(PG8_SA(1, 1), a1 + hstep, voffA);
            PG8_WAIT_V(8); PG8_WAIT_L(0); PG8_BAR; PG8_MMA(0, 0, At, B0); PG8_MMA(0, 1, At, B1); PG8_BAR; PG8_SCHED;
            PG8_LDA(At, 0, 1); PG8_STAGE(PG8_SB(0, 0), b2, voffB); PG8_STAGE(PG8_SB(0, 1), b2 + hstep, voffB); PG8_STAGE(PG8_SA(0, 0), a2, voffA);
            PG8_WAIT_V(8); PG8_WAIT_L(0); PG8_BAR; PG8_MMA(1, 0, At, B0); PG8_MMA(1, 1, At, B1); PG8_BAR; PG8_SCHED;
            PG8_LDB(B0, 1, 0); PG8_LDB(B1, 1, 1); PG8_SCHED; PG8_LDA(At, 1, 0); PG8_STAGE(PG8_SA(0, 1), a2 + hstep, voffA);
            PG8_WAIT_V(8); PG8_WAIT_L(0); PG8_BAR; PG8_MMA(0, 0, At, B0); PG8_MMA(0, 1, At, B1); PG8_BAR; PG8_SCHED;
            PG8_LDA(At, 1, 1); PG8_STAGE(PG8_SB(1, 0), b3, voffB); PG8_STAGE(PG8_SB(1, 1), b3 + hstep, voffB); PG8_STAGE(PG8_SA(1, 0), a3, voffA);
            PG8_WAIT_V(8); PG8_WAIT_L(0); PG8_BAR; PG8_MMA(1, 0, At, B0); PG8_MMA(1, 1, At, B1); PG8_BAR; PG8_SCHED;
            } else {
            PG8_LDB(B0, 0, 0); PG8_SCHED; PG8_LDA(At, 0, 0); PG8_STAGE(PG8_SA(1, 1), a1 + hstep, voffA);
            PG8_WAIT_L(8); PG8_BAR; PG8_WAIT_L(0); PG8_MMA(0, 0, At, B0); PG8_BAR; PG8_SCHED;
            PG8_LDB(B1, 0, 1); PG8_STAGE(PG8_SB(0, 0), b2, voffB);
            PG8_BAR; PG8_WAIT_L(0); PG8_MMA(0, 1, At, B1); PG8_BAR;
            PG8_LDA(At, 0, 1); PG8_STAGE(PG8_SA(0, 0), a2, voffA);
            PG8_BAR; PG8_WAIT_L(0); PG8_MMA(1, 0, At, B0); PG8_BAR; PG8_SCHED;
            PG8_STAGE(PG8_SB(0, 1), b2 + hstep, voffB);
            PG8_WAIT_V(6); PG8_BAR; PG8_MMA(1, 1, At, B1); PG8_BAR;
            PG8_LDB(B0, 1, 0); PG8_SCHED; PG8_LDA(At, 1, 0); PG8_STAGE(PG8_SA(0, 1), a2 + hstep, voffA);
            PG8_WAIT_L(8); PG8_BAR; PG8_WAIT_L(0); PG8_MMA(0, 0, At, B0); PG8_BAR; PG8_SCHED;
            PG8_LDB(B1, 1, 1); PG8_STAGE(PG8_SB(1, 0), b3, voffB);
            PG8_BAR; PG8_WAIT_L(0); PG8_MMA(0, 1, At, B1); PG8_BAR;
            PG8_LDA(At, 1, 1); PG8_STAGE(PG8_SA(1, 0), a3, voffA);
            PG8_BAR; PG8_WAIT_L(0); PG8_MMA(1, 0, At, B0); PG8_BAR; PG8_SCHED;
            PG8_STAGE(PG8_SB(1, 1), b3 + hstep, voffB);
            PG8_WAIT_V(6); PG8_BAR; PG8_MMA(1, 1, At, B1); PG8_BAR;
            }
        }
        if constexpr (ALIGN_EPI) { if (wr == 0) PG8_BAR; }
        if constexpr (!Epi::AFTER_DRAIN) { E(acc, cur, wr, wc, fr, fq); S.done(cur); }
        if (!has_next) break;
#pragma unroll
        for (int a = 0; a < 2; ++a)
#pragma unroll
            for (int b = 0; b < 2; ++b)
#pragma unroll
                for (int m = 0; m < 4; ++m)
#pragma unroll
                    for (int n = 0; n < 2; ++n) acc[a][b][m][n] = (f32x4){0.f, 0.f, 0.f, 0.f};
        cur = nxt; cA = nA; cB = nB; ++ui;
        if constexpr (ALIGN_EPI) { if (wr == 1) PG8_BAR; }
    }
    PG8_WAIT_V(0);
    if constexpr (!ALIGN_EPI) { if (wr == 0) PG8_BAR; }
    PG8_BAR;
    if constexpr (Epi::AFTER_DRAIN) { E.fused(acc, cur, wr, wc, fr, fq, lds, wid, lane); S.done(cur); }
#undef PG8_SA
#undef PG8_SB
#undef PG8_STAGE
#undef PG8_LDA
#undef PG8_LDB
#undef PG8_MMA
#undef PG8_WAIT_V
#undef PG8_WAIT_L
#undef PG8_BAR
#undef PG8_SCHED
}
}

#define LAS __attribute__((address_space(3)))
typedef unsigned short bf16;
typedef unsigned v4u __attribute__((ext_vector_type(4)));
typedef unsigned v2u __attribute__((ext_vector_type(2)));
typedef float f32x4 __attribute__((ext_vector_type(4)));
typedef float f32x2 __attribute__((ext_vector_type(2)));
typedef short bf16x8 __attribute__((ext_vector_type(8)));
typedef short s16x4 __attribute__((ext_vector_type(4)));

constexpr size_t MiB = 1u << 20;
constexpr size_t WS_MOD   = 1 * MiB;
constexpr size_t WS_ROPE  = WS_MOD + 512 * 1024;
constexpr size_t WS_LB    = WS_ROPE + 64 * 1024;
constexpr size_t WS_LBT   = WS_LB + 64 * 1024;
constexpr size_t WS_BBR   = WS_LBT + 64 * 1024;
constexpr size_t WS_BBI   = WS_BBR + 256 * 1024;
constexpr size_t WS_CM    = WS_BBI + 256 * 1024;
static_assert(WS_CM + 256 * 1024 <= 4 * MiB, "param block");
constexpr size_t WS_W1    = 4 * MiB;
constexpr size_t WS_W2    = 48 * MiB;
constexpr size_t WS_WIN   = 70 * MiB;
constexpr size_t WS_WOUT  = 75 * MiB;
constexpr size_t WS_GLU   = 77 * MiB;
constexpr size_t WS_WQKV  = 78 * MiB;
constexpr size_t WS_WO    = 84 * MiB;
constexpr size_t WS_HCTX  = 86 * MiB;
constexpr size_t WS_XN    = 90 * MiB;
constexpr size_t WS_R     = 124 * MiB;
constexpr size_t WS_HID   = WS_R;
constexpr size_t WS_QKVG  = WS_R;
constexpr size_t WS_U     = WS_R + 68 * MiB;
constexpr size_t WS_KVS   = WS_R + 85 * MiB;
constexpr size_t WS_SF    = WS_R + 119 * MiB;
constexpr size_t WS_YS    = WS_R + 128 * MiB;
constexpr size_t WS_QK    = WS_R;
constexpr size_t WS_VT    = WS_R + 68 * MiB;
constexpr size_t WS_PARTF = WS_R + 96 * MiB;
constexpr size_t WS_PARTM = WS_R;
constexpr size_t WS_END   = WS_R + 145 * MiB;

constexpr size_t WS_BAR = 0;
constexpr int BARLDS_OFF = 147456 - 64;
constexpr int NWAVES = 8, NTHREADS = 512;
constexpr int LDS_BYTES = 147456;

struct Args {
    const float* in[26]; float* out; unsigned char* ws; int probe; int pad;
};
typedef const __attribute__((address_space(4))) Args* KArgs;
__device__ __forceinline__ KArgs kargs() { KArgs p = (KArgs)__builtin_amdgcn_kernarg_segment_ptr(); asm volatile("" : "+s"(p)); return p; }
enum { I_X = 0, I_C, I_CTX, I_CCTX, I_WMOD, I_BMOD, I_NORMG, I_W1, I_W2, I_WIN, I_WOUT, I_DECAY, I_LAMRE, I_LAMIM, I_LOGDT, I_BRE, I_BIM, I_CRE, I_CIM,
       I_S5D, I_GLUW, I_GLUB, I_WQKV, I_WO, I_RPB, I_FINALG };

__device__ __forceinline__ unsigned f2bf(float f) { unsigned u = __builtin_bit_cast(unsigned, f); return (u + 0x7fffu + ((u >> 16) & 1u)) >> 16; }
__device__ __forceinline__ unsigned pk2(float lo, float hi) { return f2bf(lo) | (f2bf(hi) << 16); }
__device__ __forceinline__ float bf2f(unsigned short h) { return __uint_as_float((unsigned)h << 16); }
__device__ __forceinline__ float blo(unsigned w) { return __uint_as_float(w << 16); }
__device__ __forceinline__ float bhi(unsigned w) { return __uint_as_float(w & 0xffff0000u); }
__device__ __forceinline__ int opaque_tid() { int t = threadIdx.x; asm volatile("" : "+v"(t)); return t; }
__device__ __forceinline__ float wave_sum(float v) {
#pragma unroll
    for (int o = 1; o < 64; o <<= 1) v += __shfl_xor(v, o);
    return v;
}
__device__ __forceinline__ void sincos_acc(float x, float& s, float& c) {
    const float k = rintf(x * 0.6366197723675814f);
    float r = fmaf(k, -1.5703125f, x); r = fmaf(k, -4.837512969970703125e-4f, r); r = fmaf(k, -7.54978995489188216e-8f, r);
    const float r2 = r * r;
    float sp = 2.7557319e-6f; sp = fmaf(sp, r2, -1.9841270e-4f); sp = fmaf(sp, r2, 8.3333333e-3f); sp = fmaf(sp, r2, -1.6666667e-1f); sp = fmaf(sp * r2, r, r);
    float cp = -2.7557319e-7f; cp = fmaf(cp, r2, 2.4801587e-5f); cp = fmaf(cp, r2, -1.3888889e-3f); cp = fmaf(cp, r2, 4.1666667e-2f); cp = fmaf(cp, r2, -0.5f); cp = fmaf(cp, r2, 1.0f);
    const int q = ((int)k) & 3;
    s = (q == 0) ? sp : (q == 1) ? cp : (q == 2) ? -sp : -cp;
    c = (q == 0) ? cp : (q == 1) ? -sp : (q == 2) ? -cp : sp;
}
__device__ __forceinline__ float gelu_tanh(float v) {
    const float t = 0.7978845608028654f * (v + 0.044715f * v * v * v);
    const float e = __expf(2.0f * t);
    const float th = 1.0f - 2.0f * __builtin_amdgcn_rcpf(e + 1.0f);
    return 0.5f * v * (1.0f + th);
}

__device__ __forceinline__ int map_row(int kind, int n) {
    if (kind == 1) { const int j = n < FF ? n : n - FF; return 256 * (j >> 7) + (n < FF ? 0 : 128) + (j & 127); }
    if (kind == 2 && n < 1024) { const int tile = n >> 8, hh = (n >> 7) & 1, d = n & 127; return 256 * tile + 128 * ((d >> 5) & 1) + 64 * hh + 32 * (d >> 6) + (d & 31); }
    return n;
}
__device__ __forceinline__ void p0_transpose_item(const float* W, int K, int N, int kind, bf16* WT, LAS float* scr, int item, int lane) {
    const int nblk = N / 32, kb = item / nblk, nb = item % nblk, k0 = 64 * kb, n0 = 32 * nb;
    const int drow = map_row(kind, n0);
#pragma unroll 8
    for (int i = 0; i < 32; ++i) { const int kk = 2 * i + (lane >> 5); scr[kk * 33 + (lane & 31)] = W[(size_t)(k0 + kk) * N + n0 + (lane & 31)]; }
    asm volatile("s_waitcnt lgkmcnt(0)" ::: "memory");
    const int c = lane & 7;
#pragma unroll
    for (int j = 0; j < 4; ++j) { const int n = (lane >> 3) + 8 * j; const LAS float* s = scr + (8 * c) * 33 + n;
        v4u o; o.x = pk2(s[0 * 33], s[1 * 33]); o.y = pk2(s[2 * 33], s[3 * 33]); o.z = pk2(s[4 * 33], s[5 * 33]); o.w = pk2(s[6 * 33], s[7 * 33]);
        *(v4u*)(WT + (size_t)(drow + n) * K + k0 + 8 * c) = o; }
    asm volatile("s_waitcnt lgkmcnt(0)" ::: "memory");
}

struct WDesc { const float* W; bf16* dst; int K, N, kind, items; };
__device__ __forceinline__ WDesc wdesc(KArgs a, int mi) {
    WDesc d;
    if (mi < 4)       { d.W = a->in[I_W1] + (size_t)mi * DM * 2 * FF; d.dst = (bf16*)(a->ws + WS_W1) + (size_t)mi * 2 * FF * DM; d.K = DM; d.N = 2 * FF; d.kind = 1; }
    else if (mi < 8)  { d.W = a->in[I_W2] + (size_t)(mi - 4) * FF * DM; d.dst = (bf16*)(a->ws + WS_W2) + (size_t)(mi - 4) * DM * FF; d.K = FF; d.N = DM; d.kind = 0; }
    else if (mi == 8) { d.W = a->in[I_WIN]; d.dst = (bf16*)(a->ws + WS_WIN); d.K = DM; d.N = 2560; d.kind = 2; }
    else if (mi == 9) { d.W = a->in[I_WOUT]; d.dst = (bf16*)(a->ws + WS_WOUT); d.K = DM; d.N = DM; d.kind = 0; }
    else if (mi == 10){ d.W = a->in[I_GLUW]; d.dst = (bf16*)(a->ws + WS_GLU); d.K = 512; d.N = 512; d.kind = 0; }
    else if (mi == 11){ d.W = a->in[I_WQKV]; d.dst = (bf16*)(a->ws + WS_WQKV); d.K = DM; d.N = 3072; d.kind = 0; }
    else              { d.W = a->in[I_WO]; d.dst = (bf16*)(a->ws + WS_WO); d.K = DM; d.N = DM; d.kind = 0; }
    d.items = (d.K / 64) * (d.N / 32);
    return d;
}
constexpr int NWMAT = 13;

__device__ __forceinline__ void p0_prologue(KArgs a, LAS unsigned char* lds, int G) {
    const int tid = opaque_tid(), lane = tid & 63, wave = __builtin_amdgcn_readfirstlane(tid >> 6);
    {
        LAS float* sv = (LAS float*)lds;
        LAS float* red = (LAS float*)(lds + 32768);
        bool have = false;
        for (int it = blockIdx.x; it < 2 * (MODW / 64); it += G) {
            if (!have) {
                for (int i = tid; i < 5 * DM; i += NTHREADS) { const int b = i >> 10, k = i & 1023; const float v = b < 4 ? a->in[I_C][b * DM + k] : a->in[I_CCTX][k]; sv[k * 8 + b] = v / (1.0f + expf(-v)); }
                __syncthreads(); have = true;
            }
            const int layer = it / (MODW / 64), n = (it % (MODW / 64)) * 64 + lane;
            const float* wp = a->in[I_WMOD] + (size_t)layer * DM * MODW + n;
            float acc[5] = {0.f, 0.f, 0.f, 0.f, 0.f};
#pragma unroll 8
            for (int kk = 0; kk < 128; ++kk) { const int k = wave * 128 + kk; const float w = wp[(size_t)k * MODW];
                const f32x4 s0 = *(const LAS f32x4*)(sv + k * 8); const float s4 = sv[k * 8 + 4];
                acc[0] = fmaf(s0[0], w, acc[0]); acc[1] = fmaf(s0[1], w, acc[1]); acc[2] = fmaf(s0[2], w, acc[2]); acc[3] = fmaf(s0[3], w, acc[3]); acc[4] = fmaf(s4, w, acc[4]); }
#pragma unroll
            for (int b = 0; b < 5; ++b) red[(wave * 5 + b) * 64 + lane] = acc[b];
            __syncthreads();
            if (tid < 320) { const int b = tid >> 6, l = tid & 63, nn = (it % (MODW / 64)) * 64 + l; float s = a->in[I_BMOD][layer * MODW + nn];
#pragma unroll
                for (int w = 0; w < 8; ++w) s += red[(w * 5 + b) * 64 + l];
                ((float*)(a->ws + WS_MOD))[((size_t)layer * 5 + b) * MODW + nn] = s; }
            __syncthreads();
        }
        __syncthreads();
    }
    const int gtid = blockIdx.x * NTHREADS + tid, GT = G * NTHREADS;
    for (int i = gtid; i < MC * DM / 4; i += GT) ((f32x4*)(a->ws + WS_HCTX))[i] = ((const f32x4*)a->in[I_CTX])[i];
    for (int i = gtid; i < 64 * 32; i += GT) { const int pos = i >> 5, f = i & 31; const float inv = exp2f(-(float)f * (13.287712379549449f / 32.0f));
        float s, c; sincos_acc((float)pos * inv, s, c); ((f32x2*)(a->ws + WS_ROPE))[i] = (f32x2){c, s}; }
    for (int i = gtid; i < 2 * 32 * 64; i += GT) {
        const int p = i & 63, dg = i >> 6;
        const float lr = fminf(a->in[I_LAMRE][i], -1e-4f), li = a->in[I_LAMIM][i], dt = expf(a->in[I_LOGDT][dg]);
        float s, c; sincos_acc(li * dt, s, c); const float mg = expf(lr * dt); const float br = mg * c, bi = mg * s;
        ((f32x2*)(a->ws + WS_LB))[i] = (f32x2){br, bi};
        float s64, c64; sincos_acc(li * dt * 64.0f, s64, c64); const float m64 = expf(lr * dt * 64.0f);
        ((f32x2*)(a->ws + WS_LBT))[i] = (f32x2){m64 * c64, m64 * s64};
        const float nr = br - 1.0f, ni = bi, den = 1.0f / (lr * lr + li * li);
        const float cr = (nr * lr + ni * li) * den, ci = (ni * lr - nr * li) * den;
        for (int k = 0; k < 16; ++k) {
            const float bre = a->in[I_BRE][(size_t)i * 16 + k], bim = a->in[I_BIM][(size_t)i * 16 + k];
            ((float*)(a->ws + WS_BBR))[((size_t)dg * 16 + k) * 64 + p] = cr * bre - ci * bim;
            ((float*)(a->ws + WS_BBI))[((size_t)dg * 16 + k) * 64 + p] = cr * bim + ci * bre;
            const float cre = a->in[I_CRE][((size_t)dg * 16 + k) * 64 + p], cim = a->in[I_CIM][((size_t)dg * 16 + k) * 64 + p];
            ((unsigned*)(a->ws + WS_CM))[((size_t)dg * 16 + k) * 64 + p] = pk2(cre, -cim);
        }
    }
    {
        LAS float* scr = (LAS float*)(lds + wave * 16384);
        const int gw = blockIdx.x * NWAVES + wave, NGW = G * NWAVES;
        int total = 0;
        for (int mi = 0; mi < NWMAT; ++mi) total += wdesc(a, mi).items;
        for (int it = gw; it < total; it += NGW) {
            int r = it;
            for (int mi = 0; mi < NWMAT; ++mi) { const WDesc d = wdesc(a, mi); if (r < d.items) { p0_transpose_item(d.W, d.K, d.N, d.kind, d.dst, scr, r, lane); break; } r -= d.items; }
        }
    }
}

__device__ __forceinline__ void norm_phase(const float* src_lat, const float* src_ctx, bf16* XN, const float* g, const float* mod  , int ishift, int nrows, int G, const float* part = nullptr, int npart = 0, float* hctx_rw = nullptr) {
    const int tid = opaque_tid(), lane = tid & 63, wave = __builtin_amdgcn_readfirstlane(tid >> 6);
    const int gw = blockIdx.x * NWAVES + wave, NGW = G * NWAVES;
    f32x4 gv[4];
#pragma unroll
    for (int j = 0; j < 4; ++j) gv[j] = *((const f32x4*)g + lane + 64 * j);
    for (int row = gw; row < nrows; row += NGW) {
        const float* xr = row < ML ? src_lat + (size_t)row * DM : src_ctx + (size_t)(row - ML) * DM;
        const int bidx = row < ML ? (row >> 12) : 4;
        const float* sh = mod + (size_t)bidx * MODW + ishift * DM; const float* sc = sh + DM;
        f32x4 v[4]; float s = 0.f;
#pragma unroll
        for (int j = 0; j < 4; ++j) v[j] = *((const f32x4*)xr + lane + 64 * j);
        if (npart > 0 && row >= ML) {
            for (int pp = 0; pp < npart; ++pp) { const float* pr = part + ((size_t)pp * MC + (row - ML)) * DM;
#pragma unroll
                for (int j = 0; j < 4; ++j) v[j] += *((const f32x4*)pr + lane + 64 * j); }
#pragma unroll
            for (int j = 0; j < 4; ++j) *((f32x4*)(hctx_rw + (size_t)(row - ML) * DM) + lane + 64 * j) = v[j];
        }
#pragma unroll
        for (int j = 0; j < 4; ++j) s += (v[j][0] * v[j][0] + v[j][1] * v[j][1]) + (v[j][2] * v[j][2] + v[j][3] * v[j][3]);
        const float rstd = rsqrtf(wave_sum(s) * (1.0f / DM) + EPS);
#pragma unroll
        for (int j = 0; j < 4; ++j) {
            const f32x4 shv = *((const f32x4*)sh + lane + 64 * j), scv = *((const f32x4*)sc + lane + 64 * j);
            const f32x4 y = v[j] * rstd * gv[j] * (scv + 1.0f) + shv;
            *((v2u*)(XN + (size_t)row * DM) + lane + 64 * j) = (v2u){pk2(y[0], y[1]), pk2(y[2], y[3])};
        }
    }
}
__device__ __forceinline__ void final_norm_phase(float* io, const float* g, int G) {
    const int tid = opaque_tid(), lane = tid & 63, wave = __builtin_amdgcn_readfirstlane(tid >> 6);
    const int gw = blockIdx.x * NWAVES + wave, NGW = G * NWAVES;
    f32x4 gv[4];
#pragma unroll
    for (int j = 0; j < 4; ++j) gv[j] = *((const f32x4*)g + lane + 64 * j);
    for (int row = gw; row < ML; row += NGW) {
        float* xr = io + (size_t)row * DM;
        f32x4 v[4]; float s = 0.f;
#pragma unroll
        for (int j = 0; j < 4; ++j) { v[j] = *((const f32x4*)xr + lane + 64 * j); s += (v[j][0] * v[j][0] + v[j][1] * v[j][1]) + (v[j][2] * v[j][2] + v[j][3] * v[j][3]); }
        const float rstd = rsqrtf(wave_sum(s) * (1.0f / DM) + EPS);
#pragma unroll
        for (int j = 0; j < 4; ++j) *((f32x4*)xr + lane + 64 * j) = v[j] * rstd * gv[j];
    }
}

#define XB_TMO      128
#define XB_XCNT(j)  (256  + 64 * (j))
#define XB_XSUB(j)  (1280 + 64 * (j))
#define XB_XGEN(j)  (2304 + 64 * (j))
#define XB_TOP      3328
#define XB_TOPGEN   3392
#define XCD_BAR_WORDS 3456
#define XB_SPIN_CAP (1u << 18)

__device__ __forceinline__ unsigned xb_ld(unsigned* p)              { return __hip_atomic_load(p, __ATOMIC_RELAXED, __HIP_MEMORY_SCOPE_AGENT); }
__device__ __forceinline__ unsigned xb_add(unsigned* p, unsigned v) { return __hip_atomic_fetch_add(p, v, __ATOMIC_RELAXED, __HIP_MEMORY_SCOPE_AGENT); }
__device__ __forceinline__ unsigned xb_xcc_id() { return (unsigned)__builtin_amdgcn_s_getreg((3 << 11) | 20) & 0xFu; }
#define XB_SPIN(cond, bar) do { unsigned _sp = 0; while (cond) { __builtin_amdgcn_s_sleep(1); \
    if ((++_sp & 255u) == 0u) { if (xb_ld(&(bar)[XB_TMO])) break; if (_sp > XB_SPIN_CAP) { atomicAdd(&(bar)[XB_TMO], 1u); break; } } } } while (0)

struct XcdBarrier {
    unsigned* bar; unsigned x;
    volatile LAS unsigned* st;
};

__device__ __forceinline__ XcdBarrier xcd_barrier_post(unsigned* bar, volatile LAS unsigned* st) {
    XcdBarrier b; b.bar = bar; b.x = xb_xcc_id(); b.st = st;
    if (threadIdx.x == 0) (void)xb_add(&bar[XB_XCNT(b.x)], 1u);
    return b;
}
__device__ __forceinline__ void xcd_barrier_complete(unsigned* bar, unsigned x, unsigned& nloc, unsigned& nx) {
    const unsigned G = gridDim.x * gridDim.y * gridDim.z;
    unsigned sum, cnt, mine, sp = 0u;
    for (;;) {
        sum = 0u; cnt = 0u; mine = 0u;
#pragma unroll
        for (unsigned j = 0; j < 16; ++j) { const unsigned c = xb_ld(&bar[XB_XCNT(j)]); sum += c; cnt += (c > 0u) ? 1u : 0u; mine = (j == x) ? c : mine; }
        if (sum == G) break;
        __builtin_amdgcn_s_sleep(1);
        if ((++sp & 255u) == 0u) { if (xb_ld(&bar[XB_TMO])) break; if (sp > XB_SPIN_CAP) { atomicAdd(&bar[XB_TMO], 1u); break; } }
    }
    nloc = mine > 0u ? mine : 1u; nx = cnt > 0u ? cnt : 1u;
}

__device__ __forceinline__ void xcd_barrier(const XcdBarrier& b) {
    asm volatile("s_waitcnt vmcnt(0)" ::: "memory");
    __syncthreads();
    if (threadIdx.x == 0) {
        unsigned* bar = b.bar; unsigned bx = b.x; asm volatile("" : "+s"(bar), "+s"(bx));
        __builtin_amdgcn_s_waitcnt(0);
        unsigned nloc = b.st[0], nx = b.st[1];
        const unsigned old = xb_add(&bar[XB_XSUB(bx)], 1u);
        const unsigned gen = old / nloc;
        if (old + 1u == (gen + 1u) * nloc) {
            __builtin_amdgcn_fence(__ATOMIC_RELEASE, "agent");
            asm volatile("s_waitcnt vmcnt(0)" ::: "memory");
            const unsigned og = xb_add(&bar[XB_TOP], 1u);
            const unsigned tg = og / nx;
            if (og + 1u == (tg + 1u) * nx) xb_add(&bar[XB_TOPGEN], 1u);
            else XB_SPIN(xb_ld(&bar[XB_TOPGEN]) == tg, bar);
            __builtin_amdgcn_fence(__ATOMIC_ACQUIRE, "agent");
            xb_add(&bar[XB_XGEN(bx)], 1u);
            asm volatile("s_waitcnt vmcnt(0)" ::: "memory");
        } else {
            XB_SPIN(xb_ld(&bar[XB_XGEN(bx)]) == gen, bar);
            __builtin_amdgcn_fence(__ATOMIC_ACQUIRE, "agent");
            asm volatile("s_waitcnt vmcnt(0)" ::: "memory");
        }
    }
    __syncthreads();
}


__device__ __forceinline__ void xcd_barrier_census(const XcdBarrier& b) {
    if (threadIdx.x == 0) { unsigned nloc, nx; xcd_barrier_complete(b.bar, b.x, nloc, nx); b.st[0] = nloc; b.st[1] = nx; }
    __syncthreads();
}

typedef float f32x4m __attribute__((ext_vector_type(4)));
#define MFMA16(a, b, c) __builtin_amdgcn_mfma_f32_16x16x32_bf16((a), (b), (c), 0, 0, 0)
__device__ __forceinline__ unsigned off_b(unsigned row, unsigned ch) { return 256u * row + 16u * (ch ^ (((row & 3u) << 2) | ((row >> 2) & 3u))); }
__device__ __forceinline__ bf16x8 tr_frag(LAS unsigned char* tile, int lane, int c, int ks) {
    const unsigned g = lane >> 4, q = (lane & 15) >> 2, p = lane & 3;
    const s16x4 lo = __builtin_amdgcn_ds_read_tr16_b64_v4i16((LAS s16x4*)(tile + off_b(32 * ks + 8 * g + q, 2 * c + (p >> 1)) + 8 * (p & 1)));
    const s16x4 hi = __builtin_amdgcn_ds_read_tr16_b64_v4i16((LAS s16x4*)(tile + off_b(32 * ks + 8 * g + 4 + q, 2 * c + (p >> 1)) + 8 * (p & 1)));
    return (bf16x8){lo[0], lo[1], lo[2], lo[3], hi[0], hi[1], hi[2], hi[3]};
}
__device__ __forceinline__ bf16x8 pack8(const f32x4 a, const f32x4 b) {
    v4u w; w.x = pk2(a[0], a[1]); w.y = pk2(a[2], a[3]); w.z = pk2(b[0], b[1]); w.w = pk2(b[2], b[3]);
    return __builtin_bit_cast(bf16x8, w);
}
__device__ __forceinline__ float log_sigmoid(float x) { return -log1pf(expf(-x)); }

__device__ __forceinline__ int ret_row0(int b, int s) { return s < 2 ? ML + b * CTXL + s * 128 : b * SEQ + (s - 2) * 128; }

__device__ __forceinline__ void r1_unit(KArgs a, LAS unsigned char* lds, int unit) {
    const int tid = opaque_tid(), lane = tid & 63, wave = __builtin_amdgcn_readfirstlane(tid >> 6);
    const int s = unit % 34, bh = unit / 34, h = bh & 3, b = bh >> 2, row0 = ret_row0(b, s);
    const bf16* QKVG = (const bf16*)(a->ws + WS_QKVG);
    const float lgf = log_sigmoid(a->in[I_DECAY][h]), lgb = log_sigmoid(a->in[I_DECAY][4 + h]);
#pragma unroll
    for (int it = 0; it < 4; ++it) {
        const int n = tid + NTHREADS * it, row = n >> 4, ch = n & 15;
        const bf16* kp = QKVG + (size_t)(row0 + row) * 2048 + 512 + 128 * h + 8 * ch;
        const v4u kv = *(const v4u*)kp, vv = *(const v4u*)(kp + 512);
        const float wf = expf(lgf * (float)(127 - row)), wb = expf(lgb * (float)row);
        v4u kf, kb;
        kf.x = pk2(blo(kv.x) * wf, bhi(kv.x) * wf); kf.y = pk2(blo(kv.y) * wf, bhi(kv.y) * wf); kf.z = pk2(blo(kv.z) * wf, bhi(kv.z) * wf); kf.w = pk2(blo(kv.w) * wf, bhi(kv.w) * wf);
        kb.x = pk2(blo(kv.x) * wb, bhi(kv.x) * wb); kb.y = pk2(blo(kv.y) * wb, bhi(kv.y) * wb); kb.z = pk2(blo(kv.z) * wb, bhi(kv.z) * wb); kb.w = pk2(blo(kv.w) * wb, bhi(kv.w) * wb);
        const unsigned o = off_b(row, ch);
        *(LAS v4u*)(lds + o) = kf; *(LAS v4u*)(lds + 32768 + o) = kb; *(LAS v4u*)(lds + 65536 + o) = vv;
    }
    __syncthreads();
    f32x4 accf[8], accb[8];
#pragma unroll
    for (int c = 0; c < 8; ++c) { accf[c] = (f32x4){0.f, 0.f, 0.f, 0.f}; accb[c] = (f32x4){0.f, 0.f, 0.f, 0.f}; }
#pragma unroll
    for (int ks = 0; ks < 4; ++ks) {
        const bf16x8 kf = tr_frag(lds, lane, wave, ks), kb = tr_frag(lds + 32768, lane, wave, ks);
#pragma unroll
        for (int c = 0; c < 8; ++c) { const bf16x8 vf = tr_frag(lds + 65536, lane, c, ks); accf[c] = MFMA16(kf, vf, accf[c]); accb[c] = MFMA16(kb, vf, accb[c]); }
    }
    bf16* Sf = (bf16*)(a->ws + WS_KVS) + ((size_t)(bh * 2 + 0) * 34 + s) * 16384;
    bf16* Sb = (bf16*)(a->ws + WS_KVS) + ((size_t)(bh * 2 + 1) * 34 + s) * 16384;
    const int d0 = 16 * wave + 4 * (lane >> 4);
#pragma unroll
    for (int c = 0; c < 8; ++c) { const int e = 16 * c + (lane & 15);
        *(v2u*)(Sf + e * 128 + d0) = (v2u){pk2(accf[c][0], accf[c][1]), pk2(accf[c][2], accf[c][3])};
        *(v2u*)(Sb + e * 128 + d0) = (v2u){pk2(accb[c][0], accb[c][1]), pk2(accb[c][2], accb[c][3])}; }
    __syncthreads();
}

__device__ __forceinline__ void r2_items(KArgs a, int G) {
    const int gtid = blockIdx.x * NTHREADS + opaque_tid(), GT = G * NTHREADS;
    for (int idx = gtid; idx < 32 * 4096; idx += GT) {
        const int bhd = idx >> 12, o4 = idx & 4095, dir = bhd & 1, h = (bhd >> 1) & 3;
        const float decay = expf(log_sigmoid(a->in[I_DECAY][dir * 4 + h]) * 128.0f);
        bf16* base = (bf16*)(a->ws + WS_KVS) + (size_t)bhd * 34 * 16384 + o4 * 4;
        const long step = dir == 0 ? 16384 : -16384;
        bf16* p0 = base + (dir == 0 ? 0 : 16384); bf16* p2 = base + (dir == 0 ? 2 * 16384 : 33 * 16384);
        v2u v[34];
        { bf16* p = p0;
#pragma unroll
          for (int i = 0; i < 34; ++i) { if (i == 2) p = p2; v[i] = *(const v2u*)p; p += step; asm volatile("" : "+v"(p)); } }
        float st0 = 0.f, st1 = 0.f, st2 = 0.f, st3 = 0.f;
        { bf16* p = p0;
#pragma unroll
          for (int i = 0; i < 34; ++i) { if (i == 2) p = p2;
            *(v2u*)p = (v2u){pk2(st0, st1), pk2(st2, st3)}; p += step; asm volatile("" : "+v"(p));
            st0 = fmaf(decay, st0, blo(v[i].x)); st1 = fmaf(decay, st1, bhi(v[i].x)); st2 = fmaf(decay, st2, blo(v[i].y)); st3 = fmaf(decay, st3, bhi(v[i].y)); } }
    }
}

__device__ __forceinline__ void r3_unit(KArgs a, LAS unsigned char* lds, int unit) {
    const int tid = opaque_tid(), lane = tid & 63, wave = __builtin_amdgcn_readfirstlane(tid >> 6);
    const int s = unit % 34, bh = unit / 34, h = bh & 3, b = bh >> 2, row0 = ret_row0(b, s);
    const bf16* QKVG = (const bf16*)(a->ws + WS_QKVG);
    const float l2f = log_sigmoid(a->in[I_DECAY][h]) * 1.4426950408889634f, l2b = log_sigmoid(a->in[I_DECAY][4 + h]) * 1.4426950408889634f;
#pragma unroll
    for (int it = 0; it < 4; ++it) {
        const int n = tid + NTHREADS * it, row = n >> 4, ch = n & 15;
        *(LAS v4u*)(lds + off_b(row, ch)) = *(const v4u*)(QKVG + (size_t)(row0 + row) * 2048 + 1024 + 128 * h + 8 * ch);
    }
    __syncthreads();
    const int fr = lane & 15, g = lane >> 4;
    bf16x8 qf[4];
#pragma unroll
    for (int ks = 0; ks < 4; ++ks) qf[ks] = *(const bf16x8*)(QKVG + (size_t)(row0 + 16 * wave + fr) * 2048 + 128 * h + 32 * ks + 8 * g);
    f32x4 acco[8];
#pragma unroll
    for (int c = 0; c < 8; ++c) acco[c] = (f32x4){0.f, 0.f, 0.f, 0.f};
    const int iq = 16 * wave + fr;
#pragma unroll
    for (int jt = 0; jt < 4; ++jt) {
        f32x4 sa = (f32x4){0.f, 0.f, 0.f, 0.f}, sb = sa;
        const int ja = 32 * jt + 8 * (fr >> 2) + (fr & 3);
        const bf16* kpa = QKVG + (size_t)(row0 + ja) * 2048 + 512 + 128 * h + 8 * g;
#pragma unroll
        for (int ks = 0; ks < 4; ++ks) {
            const bf16x8 ka = *(const bf16x8*)(kpa + 32 * ks), kb = *(const bf16x8*)(kpa + 4 * 2048 + 32 * ks);
            sa = MFMA16(ka, qf[ks], sa); sb = MFMA16(kb, qf[ks], sb);
        }
        f32x4 pa, pb;
#pragma unroll
        for (int r = 0; r < 4; ++r) {
            const int j0 = 32 * jt + 8 * g + r, d0 = iq - j0, d1 = d0 - 4;
            const float w0 = (d0 >= 0 ? __builtin_amdgcn_exp2f(l2f * (float)d0) : 0.f) + (d0 <= 0 ? __builtin_amdgcn_exp2f(-l2b * (float)d0) : 0.f);
            const float w1 = (d1 >= 0 ? __builtin_amdgcn_exp2f(l2f * (float)d1) : 0.f) + (d1 <= 0 ? __builtin_amdgcn_exp2f(-l2b * (float)d1) : 0.f);
            pa[r] = sa[r] * w0; pb[r] = sb[r] * w1;
        }
        const bf16x8 pf = pack8(pa, pb);
#pragma unroll
        for (int c = 0; c < 8; ++c) { const bf16x8 vf = tr_frag(lds, lane, c, jt); acco[c] = MFMA16(pf, vf, acco[c]); }
    }
    const bf16* Sf = (const bf16*)(a->ws + WS_KVS) + ((size_t)(bh * 2 + 0) * 34 + s) * 16384;
    const bf16* Sb = (const bf16*)(a->ws + WS_KVS) + ((size_t)(bh * 2 + 1) * 34 + s) * 16384;
    float ff[4], fb[4];
#pragma unroll
    for (int r = 0; r < 4; ++r) { const int i = 16 * wave + 4 * g + r; ff[r] = __builtin_amdgcn_exp2f(l2f * (float)(i + 1)); fb[r] = __builtin_amdgcn_exp2f(l2b * (float)(128 - i)); }
    float ss[4] = {0.f, 0.f, 0.f, 0.f};
#pragma unroll
    for (int c = 0; c < 8; ++c) {
        f32x4 t1 = (f32x4){0.f, 0.f, 0.f, 0.f}, t2 = t1;
        const int e = 16 * c + fr;
#pragma unroll
        for (int ks = 0; ks < 4; ++ks) {
            const bf16x8 s1 = *(const bf16x8*)(Sf + e * 128 + 32 * ks + 8 * g), s2 = *(const bf16x8*)(Sb + e * 128 + 32 * ks + 8 * g);
            t1 = MFMA16(qf[ks], s1, t1); t2 = MFMA16(qf[ks], s2, t2);
        }
#pragma unroll
        for (int r = 0; r < 4; ++r) { const float o = acco[c][r] + ff[r] * t1[r] + fb[r] * t2[r]; acco[c][r] = o; ss[r] = fmaf(o, o, ss[r]); }
    }
#pragma unroll
    for (int r = 0; r < 4; ++r) { float v = ss[r]; v += __shfl_xor(v, 1); v += __shfl_xor(v, 2); v += __shfl_xor(v, 4); v += __shfl_xor(v, 8); ss[r] = rsqrtf(v * (1.0f / 128.0f) + EPS); }
    bf16* YM = (bf16*)(a->ws + WS_XN);
#pragma unroll
    for (int r = 0; r < 4; ++r) { const size_t row = (size_t)(row0 + 16 * wave + 4 * g + r);
#pragma unroll
        for (int c = 0; c < 8; ++c) { const int e = 16 * c + fr; const float gt = bf2f(QKVG[row * 2048 + 1536 + 128 * h + e]);
            YM[row * DM + 128 * h + e] = (bf16)f2bf(acco[c][r] * ss[r] * (gt * __builtin_amdgcn_rcpf(1.0f + __expf(-gt)))); } }
    __syncthreads();
}

__device__ __forceinline__ int s5_row0(int b, int c) { return c < 4 ? ML + b * CTXL + 64 * c : b * SEQ + 64 * (c - 4); }
constexpr int S5_WLDS = 12288;

__device__ __forceinline__ void s5_stage_u(KArgs a, LAS float* us, int rowbase, int g, int lane) {
    const bf16* up = (const bf16*)(a->ws + WS_U) + (size_t)(rowbase + lane) * 512 + 16 * g;
    const v4u u0 = *(const v4u*)up, u1 = *(const v4u*)(up + 8);
    LAS f32x4* d = (LAS f32x4*)(us + lane * 16);
    d[0] = (f32x4){blo(u0.x), bhi(u0.x), blo(u0.y), bhi(u0.y)}; d[1] = (f32x4){blo(u0.z), bhi(u0.z), blo(u0.w), bhi(u0.w)};
    d[2] = (f32x4){blo(u1.x), bhi(u1.x), blo(u1.y), bhi(u1.y)}; d[3] = (f32x4){blo(u1.z), bhi(u1.z), blo(u1.w), bhi(u1.w)};
    asm volatile("s_waitcnt lgkmcnt(0)" ::: "memory");
}
#define S5_STEP(t_)  { const LAS f32x4* up_ = (const LAS f32x4*)(us + (t_) * 16); const f32x4 ua = up_[0], ub = up_[1], uc = up_[2], ud = up_[3]; \
        float br_ = bbr[0] * ua[0], bi_ = bbi[0] * ua[0]; \
        br_ = fmaf(bbr[1], ua[1], br_); bi_ = fmaf(bbi[1], ua[1], bi_); br_ = fmaf(bbr[2], ua[2], br_); bi_ = fmaf(bbi[2], ua[2], bi_); br_ = fmaf(bbr[3], ua[3], br_); bi_ = fmaf(bbi[3], ua[3], bi_); \
        br_ = fmaf(bbr[4], ub[0], br_); bi_ = fmaf(bbi[4], ub[0], bi_); br_ = fmaf(bbr[5], ub[1], br_); bi_ = fmaf(bbi[5], ub[1], bi_); br_ = fmaf(bbr[6], ub[2], br_); bi_ = fmaf(bbi[6], ub[2], bi_); br_ = fmaf(bbr[7], ub[3], br_); bi_ = fmaf(bbi[7], ub[3], bi_); \
        br_ = fmaf(bbr[8], uc[0], br_); bi_ = fmaf(bbi[8], uc[0], bi_); br_ = fmaf(bbr[9], uc[1], br_); bi_ = fmaf(bbi[9], uc[1], bi_); br_ = fmaf(bbr[10], uc[2], br_); bi_ = fmaf(bbi[10], uc[2], bi_); br_ = fmaf(bbr[11], uc[3], br_); bi_ = fmaf(bbi[11], uc[3], bi_); \
        br_ = fmaf(bbr[12], ud[0], br_); bi_ = fmaf(bbi[12], ud[0], bi_); br_ = fmaf(bbr[13], ud[1], br_); bi_ = fmaf(bbi[13], ud[1], bi_); br_ = fmaf(bbr[14], ud[2], br_); bi_ = fmaf(bbi[14], ud[2], bi_); br_ = fmaf(bbr[15], ud[3], br_); bi_ = fmaf(bbi[15], ud[3], bi_); \
        const float nr_ = fmaf(lr, xr, fmaf(-li, xi, br_)), ni_ = fmaf(lr, xi, fmaf(li, xr, bi_)); xr = nr_; xi = ni_; }

__device__ __forceinline__ void s1_unit(KArgs a, LAS unsigned char* wl, int wu, int lane) {
    const int c = wu % 68, bgd = wu / 68, dir = bgd & 1, g = (bgd >> 1) & 31, b = bgd >> 6, dg = dir * 32 + g, p = lane;
    LAS float* us = (LAS float*)wl;
    s5_stage_u(a, us, s5_row0(b, c), g, lane);
    const f32x2 lb = ((const f32x2*)(a->ws + WS_LB))[dg * 64 + p]; const float lr = lb.x, li = lb.y;
    float bbr[16], bbi[16];
#pragma unroll
    for (int k = 0; k < 16; ++k) { bbr[k] = ((const float*)(a->ws + WS_BBR))[(dg * 16 + k) * 64 + p]; bbi[k] = ((const float*)(a->ws + WS_BBI))[(dg * 16 + k) * 64 + p]; }
    float xr = 0.f, xi = 0.f;
    if (dir == 0) { for (int t = 0; t < 64; ++t) S5_STEP(t) }
    else { for (int t = 63; t >= 0; --t) S5_STEP(t) }
    ((f32x2*)(a->ws + WS_SF))[(size_t)wu * 64 + p] = (f32x2){xr, xi};
    asm volatile("s_waitcnt lgkmcnt(0)" ::: "memory");
}
__device__ __forceinline__ void s2_items(KArgs a, int G) {
    const int gtid = blockIdx.x * NTHREADS + opaque_tid(), GT = G * NTHREADS;
    for (int idx = gtid; idx < 4 * 32 * 2 * 64; idx += GT) {
        const int p = idx & 63, bgd = idx >> 6, dir = bgd & 1, g = (bgd >> 1) & 31, dg = dir * 32 + g;
        const f32x2 lt = ((const f32x2*)(a->ws + WS_LBT))[dg * 64 + p];
        f32x2* base = (f32x2*)(a->ws + WS_SF) + (size_t)bgd * 68 * 64 + p;
        const long step = dir == 0 ? 64 : -64;
        f32x2* q0 = base + (dir == 0 ? 0 : 3 * 64); f32x2* q4 = base + (dir == 0 ? 4 * 64 : 67 * 64);
        float cr = 0.f, ci = 0.f;
        f32x2* pl = q0; f32x2* ps = q0;
#pragma unroll
        for (int hb = 0; hb < 2; ++hb) {
            f32x2 v[34];
#pragma unroll
            for (int j = 0; j < 34; ++j) { if (34 * hb + j == 4) pl = q4; v[j] = *pl; pl += step; asm volatile("" : "+v"(pl)); }
#pragma unroll
            for (int j = 0; j < 34; ++j) { if (34 * hb + j == 4) ps = q4; *ps = (f32x2){cr, ci}; ps += step; asm volatile("" : "+v"(ps));
                const float nr = fmaf(lt.x, cr, fmaf(-lt.y, ci, v[j].x)), ni = fmaf(lt.x, ci, fmaf(lt.y, cr, v[j].y)); cr = nr; ci = ni; }
        }
    }
}
__device__ __forceinline__ void s3_unit(KArgs a, LAS unsigned char* wl, int wu, int lane) {
    const int c = wu % 68, bg = wu / 68, g = bg & 31, b = bg >> 5, p = lane, fr = lane & 15, gq = lane >> 4;
    LAS float* us = (LAS float*)wl; LAS unsigned char* xs = wl + 4096;
    const int rowbase = s5_row0(b, c);
    s5_stage_u(a, us, rowbase, g, lane);
    f32x4 acc[4];
#pragma unroll
    for (int i = 0; i < 4; ++i) acc[i] = (f32x4){0.f, 0.f, 0.f, 0.f};
#pragma unroll
    for (int dir = 0; dir < 2; ++dir) {
        const int dg = dir * 32 + g;
        const f32x2 lb = ((const f32x2*)(a->ws + WS_LB))[dg * 64 + p]; const float lr = lb.x, li = lb.y;
        float bbr[16], bbi[16];
#pragma unroll
        for (int k = 0; k < 16; ++k) { bbr[k] = ((const float*)(a->ws + WS_BBR))[(dg * 16 + k) * 64 + p]; bbi[k] = ((const float*)(a->ws + WS_BBI))[(dg * 16 + k) * 64 + p]; }
        bf16x8 cm[4];
#pragma unroll
        for (int ks = 0; ks < 4; ++ks) cm[ks] = *(const bf16x8*)((const bf16*)(a->ws + WS_CM) + (size_t)(dg * 16 + fr) * 128 + 32 * ks + 8 * gq);
        const f32x2 x0 = ((const f32x2*)(a->ws + WS_SF))[((size_t)((b * 32 + g) * 2 + dir) * 68 + c) * 64 + p];
        float xr = x0.x, xi = x0.y;
#pragma unroll
        for (int half = 0; half < 2; ++half) {
            const int hs = dir ? 1 - half : half;
            for (int tt = 0; tt < 32; ++tt) {
                const int tl = dir ? 31 - tt : tt, t = 32 * hs + tl;
                S5_STEP(t)
                *(LAS unsigned*)(xs + tl * 256 + (((p >> 2) ^ (tl & 15)) * 16) + (p & 3) * 4) = pk2(xr, xi);
            }
            asm volatile("s_waitcnt lgkmcnt(0)" ::: "memory");
#pragma unroll
            for (int th = 0; th < 2; ++th) {
                const int row = 16 * th + fr;
                f32x4 d = acc[2 * hs + th];
#pragma unroll
                for (int ks = 0; ks < 4; ++ks) { const bf16x8 xf = *(const LAS bf16x8*)(xs + row * 256 + (((4 * ks + gq) ^ (row & 15)) * 16)); d = MFMA16(cm[ks], xf, d); }
                acc[2 * hs + th] = d;
            }
            asm volatile("s_waitcnt lgkmcnt(0)" ::: "memory");
        }
    }
    const f32x4 dsk = *(const f32x4*)(a->in[I_S5D] + 16 * g + 4 * gq);
    bf16* YS = (bf16*)(a->ws + WS_YS);
#pragma unroll
    for (int T4 = 0; T4 < 4; ++T4) {
        const int t = 16 * T4 + fr; const f32x4 u4 = *(const LAS f32x4*)(us + t * 16 + 4 * gq);
        const f32x4 y = acc[T4] + dsk * u4;
        *(v2u*)(YS + (size_t)(rowbase + t) * 512 + 16 * g + 4 * gq) = (v2u){pk2(gelu_tanh(y[0]), gelu_tanh(y[1])), pk2(gelu_tanh(y[2]), gelu_tanh(y[3]))};
    }
    asm volatile("s_waitcnt lgkmcnt(0)" ::: "memory");
}

constexpr int NA_KSTR = 144, NA_VSTR = 976, NA_VCSTR = 528;
constexpr int NA_VOFF = 480 * NA_KSTR;
constexpr int NA_VCOFF = 256 * NA_KSTR;
__device__ __forceinline__ void na_unit(KArgs a, LAS unsigned char* lds, int unit) {
    const int tid = opaque_tid(), lane = tid & 63, wave = __builtin_amdgcn_readfirstlane(tid >> 6);
    const int rb = unit & 7, cb = (unit >> 3) & 3, h = (unit >> 5) & 15, b = unit >> 9, fr = lane & 15, g = lane >> 4;
    const bf16* QK = (const bf16*)(a->ws + WS_QK); const bf16* VT = (const bf16*)(a->ws + WS_VT); bf16* AO = (bf16*)(a->ws + WS_XN);
    const int kcol0 = min(max(16 * cb - 8, 0), 32);
    const int Rlo = min(max(8 * rb - 4, 0), 56), nrows = min(max(8 * rb + 3, 0), 56) + 8 - Rlo;
    const int r = 8 * rb + wave, r0 = min(max(r - 4, 0), 56);
    {
        const bf16* kg = QK + (size_t)(b * SEQ + Rlo * 64 + kcol0) * 2048 + 1024 + 64 * h;
        { v4u t[8]; const int lim = nrows * 256;
#pragma unroll
          for (int it = 0; it < 8; ++it) { const int n = tid + NTHREADS * it, key = n >> 3, ch = n & 7, kr = key >> 5, co = key & 31; if (n < lim) t[it] = *(const v4u*)(kg + (size_t)(kr * 64 + co) * 2048 + 8 * ch); }
#pragma unroll
          for (int it = 0; it < 8; ++it) { const int n = tid + NTHREADS * it, key = n >> 3, ch = n & 7; if (n < lim) *(LAS v4u*)(lds + key * NA_KSTR + ch * 16) = t[it]; } }
        const bf16* vg = VT + (size_t)(64 * h) * MT + b * SEQ + Rlo * 64 + kcol0;
        { v4u t[8];
#pragma unroll
          for (int it = 0; it < 8; ++it) { const int n = tid + NTHREADS * it, d = n / 60, rem = n - d * 60, kr = rem >> 2, c4 = rem & 3; if (n < 64 * 60 && kr < nrows) t[it] = *(const v4u*)(vg + (size_t)d * MT + kr * 64 + 8 * c4); }
#pragma unroll
          for (int it = 0; it < 8; ++it) { const int n = tid + NTHREADS * it, d = n / 60, rem = n - d * 60, kr = rem >> 2, c4 = rem & 3; if (n < 64 * 60 && kr < nrows) *(LAS v4u*)(lds + NA_VOFF + d * NA_VSTR + (kr * 32 + 8 * c4) * 2) = t[it]; } }
    }
    const int tq0 = b * SEQ + r * 64 + 16 * cb;
    const bf16* qb = QK + (size_t)tq0 * 2048 + 64 * h;
    const unsigned qoff = (unsigned)(fr * 2048 + 8 * g);
    bf16x8 qf[2]; qf[0] = *(const bf16x8*)(qb + qoff); qf[1] = *(const bf16x8*)(qb + qoff + 32);
    const int koffl = (8 * (fr >> 2) + (fr & 3)) * NA_KSTR + 16 * g;
    const int cq = 16 * cb + fr, ws = min(max(cq - 8, 0), 48);
    const int vbase = kcol0 + 8 * g - ws, ibase = kcol0 + 8 * g - cq + 15;
    const float* rpb = a->in[I_RPB] + (size_t)h * 15 * 31;
    f32x4 o[4];
#pragma unroll
    for (int dt = 0; dt < 4; ++dt) o[dt] = (f32x4){0.f, 0.f, 0.f, 0.f};
    float mrun = -1e30f, lsum = 0.f;
    __syncthreads();
#pragma unroll
    for (int half = 0; half < 2; ++half) {
        if (half == 1) {
            __syncthreads();
            const bf16* kg = QK + (size_t)(ML + b * CTXL) * 2048 + 1024 + 64 * h;
            v4u t[8];
#pragma unroll
            for (int it = 0; it < 4; ++it) { const int n = tid + NTHREADS * it, key = n >> 3, ch = n & 7; t[it] = *(const v4u*)(kg + (size_t)key * 2048 + 8 * ch); }
            const bf16* vg = VT + (size_t)(64 * h) * MT + ML + b * CTXL;
#pragma unroll
            for (int it = 0; it < 4; ++it) { const int n = tid + NTHREADS * it, d = n >> 5, c = n & 31; t[4 + it] = *(const v4u*)(vg + (size_t)d * MT + 8 * c); }
#pragma unroll
            for (int it = 0; it < 4; ++it) { const int n = tid + NTHREADS * it, key = n >> 3, ch = n & 7; *(LAS v4u*)(lds + key * NA_KSTR + ch * 16) = t[it]; }
#pragma unroll
            for (int it = 0; it < 4; ++it) { const int n = tid + NTHREADS * it, d = n >> 5, c = n & 31; *(LAS v4u*)(lds + NA_VCOFF + d * NA_VCSTR + c * 16) = t[4 + it]; }
            __syncthreads();
        }
        const int kbase = half == 0 ? (r0 - Rlo) * 32 : 0;
        const LAS unsigned char* kl = lds + kbase * NA_KSTR + koffl;
        const LAS unsigned char* vl = half == 0 ? lds + NA_VOFF + fr * NA_VSTR + (kbase + 8 * g) * 2 : lds + NA_VCOFF + fr * NA_VCSTR + (8 * g) * 2;
        const int vstr16 = 16 * (half == 0 ? NA_VSTR : NA_VCSTR);
#pragma unroll
        for (int qt = 0; qt < 2; ++qt) {
            f32x4 sc[4][2];
#pragma unroll
            for (int ii = 0; ii < 4; ++ii) {
                const int i = 4 * qt + ii;
                const LAS unsigned char* kp = kl + i * 32 * NA_KSTR;
                f32x4 sa = (f32x4){0.f, 0.f, 0.f, 0.f}, sb = sa;
                sa = MFMA16(*(const LAS bf16x8*)kp, qf[0], sa); sa = MFMA16(*(const LAS bf16x8*)(kp + 64), qf[1], sa);
                sb = MFMA16(*(const LAS bf16x8*)(kp + 4 * NA_KSTR), qf[0], sb); sb = MFMA16(*(const LAS bf16x8*)(kp + 4 * NA_KSTR + 64), qf[1], sb);
                if (half == 0) {
                    const float* bp = rpb + (r0 + i - r + 7) * 31;
#pragma unroll
                    for (int rr = 0; rr < 4; ++rr) { const float b0 = bp[min(max(ibase + rr, 0), 30)], b1 = bp[min(max(ibase + 4 + rr, 0), 30)];
                        sa[rr] = (unsigned)(vbase + rr) < 16u ? sa[rr] + b0 : -1e30f; sb[rr] = (unsigned)(vbase + 4 + rr) < 16u ? sb[rr] + b1 : -1e30f; }
                }
                sc[ii][0] = sa; sc[ii][1] = sb;
            }
            float mx = -1e30f;
#pragma unroll
            for (int ii = 0; ii < 4; ++ii)
#pragma unroll
                for (int t = 0; t < 2; ++t) mx = fmaxf(mx, fmaxf(fmaxf(sc[ii][t][0], sc[ii][t][1]), fmaxf(sc[ii][t][2], sc[ii][t][3])));
            mx = fmaxf(mx, __shfl_xor(mx, 16)); mx = fmaxf(mx, __shfl_xor(mx, 32));
            const float mnew = fmaxf(mrun, mx);
            const float resc = __builtin_amdgcn_exp2f((mrun - mnew) * 1.4426950408889634f);
            mrun = mnew; lsum *= resc;
#pragma unroll
            for (int dt = 0; dt < 4; ++dt) o[dt] = o[dt] * resc;
            const float mneg = -mnew * 1.4426950408889634f;
            float ls = 0.f;
#pragma unroll
            for (int ii = 0; ii < 4; ++ii)
#pragma unroll
                for (int t = 0; t < 2; ++t)
#pragma unroll
                    for (int rr = 0; rr < 4; ++rr) { const float pv = __builtin_amdgcn_exp2f(fmaf(sc[ii][t][rr], 1.4426950408889634f, mneg)); sc[ii][t][rr] = pv; ls += pv; }
            lsum += ls;
#pragma unroll
            for (int ii = 0; ii < 4; ++ii) {
                const bf16x8 pf = pack8(sc[ii][0], sc[ii][1]);
#pragma unroll
                for (int dt = 0; dt < 4; ++dt) o[dt] = MFMA16(*(const LAS bf16x8*)(vl + dt * vstr16 + (4 * qt + ii) * 64), pf, o[dt]);
            }
        }
    }
    lsum += __shfl_xor(lsum, 16); lsum += __shfl_xor(lsum, 32);
    const float rl = 1.0f / lsum;
    bf16* ob = AO + (size_t)tq0 * DM + 64 * h;
#pragma unroll
    for (int dt = 0; dt < 4; ++dt)
        *(v2u*)(ob + (unsigned)(fr * DM + 16 * dt + 4 * g)) = (v2u){pk2(o[dt][0] * rl, o[dt][1] * rl), pk2(o[dt][2] * rl, o[dt][3] * rl)};
    __syncthreads();
}

#ifndef STAGE
#define STAGE 6
#endif
#define GSYNC() xcd_barrier(bar)
#ifndef REP_A
#define REP_A 1
#endif
#ifndef REP_B
#define REP_B 1
#endif
#ifndef REP_MODE
#define REP_MODE 0
#endif
#ifndef REP_G1
#define REP_G1 1
#endif
#ifndef REP_G2
#define REP_G2 1
#endif
#ifndef REP_NORM
#define REP_NORM 1
#endif
#ifndef REP_N
#define REP_N 1
#endif

template <class Epi>
__device__ __forceinline__ void run_gemm(LAS unsigned char* lds, const bf16* A, const bf16* Bt, int M, int N, int K, int G, const Epi& E) {
    pg8::Gemm g{A, Bt, M, N, K}; pg8::StaticOrder S; S.init(M, N, G, (int)blockIdx.x, K);
    pg8::gemm_phase<Epi, pg8::StaticOrder, true, true>(lds, g, S, E);
}
template <class Epi>
__device__ __forceinline__ void run_gemm_splitctx(LAS unsigned char* lds, const bf16* A, const bf16* Bt, int N, int K, int nsplit, int G, const Epi& E) {
    pg8::Gemm g{A, Bt, MT, N, K}; pg8::SplitCtxOrder S; S.init(ML, MC, N, K, G, (int)blockIdx.x, nsplit);
    pg8::gemm_phase<Epi, pg8::SplitCtxOrder, true, true>(lds, g, S, E);
}

__device__ __forceinline__ void ffn_block(KArgs a, LAS unsigned char* lds, const XcdBarrier& bar, int G, int layer, int f, const float* rin_lat, const float* rin_ctx, int nrows, const float* part_in, int npart_in) {
    const float* MODL = (const float*)(a->ws + WS_MOD) + (size_t)layer * 5 * MODW;
    float* hl = a->out; float* hc = (float*)(a->ws + WS_HCTX);
    bf16* XN = (bf16*)(a->ws + WS_XN); bf16* HID = (bf16*)(a->ws + WS_HID);
    const bf16* W1b = (const bf16*)(a->ws + WS_W1) + (size_t)(layer * 2 + f) * 2 * FF * DM;
    const bf16* W2b = (const bf16*)(a->ws + WS_W2) + (size_t)(layer * 2 + f) * DM * FF;
    for (int rep = 1; rep < REP_NORM; ++rep) { norm_phase(rin_lat, rin_ctx, XN, a->in[I_NORMG] + (size_t)(layer * 3 + (f ? 2 : 0)) * DM, MODL, f ? 6 : 0, nrows, G, nullptr, 0, hc); GSYNC(); }
    norm_phase(rin_lat, rin_ctx, XN, a->in[I_NORMG] + (size_t)(layer * 3 + (f ? 2 : 0)) * DM, MODL, f ? 6 : 0, nrows, G, part_in, npart_in, hc);
    GSYNC();
    for (int rep = 0; rep < REP_G1; ++rep) {
    { pg8::EpiSwiglu E{HID, FF}; run_gemm(lds, XN, W1b, nrows, 2 * FF, DM, G, E); }
    GSYNC(); }
    for (int rep = 0; rep < REP_G2; ++rep) {
    { pg8::EpiResid E{rin_lat, rin_ctx, hl, hc, MODL + (f ? 8 : 2) * DM, (float*)(a->ws + WS_PARTF), rep == REP_G2 - 1 ? 0.5f : 0.0f};
      if (nrows == MT) run_gemm_splitctx(lds, HID, W2b, DM, FF, 11, G, E); else run_gemm(lds, HID, W2b, nrows, DM, FF, G, E); }
    GSYNC(); }
}

__global__ void __launch_bounds__(NTHREADS, 2) fwd_megakernel(Args a_unused) {
#define a kargs()
    extern __shared__ __attribute__((aligned(16))) unsigned char lds_raw[];
    LAS unsigned char* lds = (LAS unsigned char*)lds_raw;
    cg::grid_group grid = cg::this_grid();
    const int G = gridDim.x;
#define LANEWAVE() const int tid = opaque_tid(), lane = tid & 63, wave = __builtin_amdgcn_readfirstlane(tid >> 6)
#define hl (a->out)
#define hc ((float*)(a->ws + WS_HCTX))
#define XN ((bf16*)(a->ws + WS_XN))
#define MOD0 ((const float*)(a->ws + WS_MOD))
#define MOD1 (MOD0 + 5 * MODW)

    if (threadIdx.x < 8) ((LAS unsigned*)(lds + BARLDS_OFF))[threadIdx.x] = 0u;
    __syncthreads();
    const XcdBarrier bar = xcd_barrier_post((unsigned*)(a->ws + WS_BAR), (volatile LAS unsigned*)(lds + BARLDS_OFF));

    p0_prologue(a, lds, G);
    grid.sync();
    xcd_barrier_census(bar);

    if (STAGE == 0) {
        const int gtid = blockIdx.x * NTHREADS + opaque_tid(), GT = G * NTHREADS;
        for (int i = gtid; i < ML * DM / 4; i += GT) ((f32x4*)hl)[i] = ((const f32x4*)a->in[I_X])[i];
        GSYNC();
    }
    if (STAGE >= 1) ffn_block(a, lds, bar, G, 0, 0, a->in[I_X], hc, MT, nullptr, 0);
    if (STAGE >= 2) {
        norm_phase(hl, hc, XN, a->in[I_NORMG] + 1 * DM, MOD0, 3, MT, G, (const float*)(a->ws + WS_PARTF), 11, hc);
        GSYNC();
        { pg8::EpiWin E{(bf16*)(a->ws + WS_QKVG), (bf16*)(a->ws + WS_U), (const float*)(a->ws + WS_ROPE)}; run_gemm(lds, XN, (const bf16*)(a->ws + WS_WIN), MT, 2560, DM, G, E); }
        GSYNC();
        for (int rep = 0; rep < REP_A; ++rep) {
        { LANEWAVE(); for (int u = blockIdx.x; u < 544 + 2176; u += G) { if (rep > 0 && ((REP_MODE == 1 && u >= 544) || (REP_MODE == 2 && u < 544))) continue; if (u < 544) r1_unit(a, lds, u); else s1_unit(a, lds + wave * S5_WLDS, (u - 544) * 8 + wave, lane); } }
        GSYNC(); }
        r2_items(a, G); s2_items(a, G);
        GSYNC();
        for (int rep = 0; rep < REP_B; ++rep) {
        { LANEWAVE(); for (int u = blockIdx.x; u < 544 + 1088; u += G) { if (rep > 0 && ((REP_MODE == 1 && u >= 544) || (REP_MODE == 2 && u < 544))) continue; if (u < 544) r3_unit(a, lds, u); else s3_unit(a, lds + wave * S5_WLDS, (u - 544) * 8 + wave, lane); } }
        GSYNC(); }
        { pg8::EpiGlu E{(const bf16*)(a->ws + WS_YS), XN, a->in[I_GLUB]}; run_gemm(lds, (const bf16*)(a->ws + WS_YS), (const bf16*)(a->ws + WS_GLU), MT, 512, 512, G, E); }
        GSYNC();
        { pg8::EpiResid E{hl, hc, hl, hc, MOD0 + 5 * DM, (float*)(a->ws + WS_PARTM), 1.0f}; run_gemm_splitctx(lds, XN, (const bf16*)(a->ws + WS_WOUT), DM, DM, 8, G, E); }
        GSYNC();
    }
    if (STAGE >= 3) ffn_block(a, lds, bar, G, 0, 1, hl, hc, MT, (const float*)(a->ws + WS_PARTM), 8);
    if (STAGE >= 4) ffn_block(a, lds, bar, G, 1, 0, hl, hc, MT, (const float*)(a->ws + WS_PARTF), 11);
    if (STAGE >= 5) {
        norm_phase(hl, hc, XN, a->in[I_NORMG] + 4 * DM, MOD1, 3, MT, G, (const float*)(a->ws + WS_PARTF), 11, hc);
        GSYNC();
        { pg8::EpiBf16S E{(bf16*)(a->ws + WS_QK), 2048, 4, 0.125f}; run_gemm(lds, XN, (const bf16*)(a->ws + WS_WQKV), MT, 2048, DM, G, E); }
        { pg8::EpiBf16S E{(bf16*)(a->ws + WS_VT), MT, 0, 1.0f}; run_gemm(lds, (const bf16*)(a->ws + WS_WQKV) + (size_t)2048 * DM, XN, DM, MT, DM, G, E); }
        GSYNC();
        for (int rep = 0; rep < REP_N; ++rep) {
        for (int u = blockIdx.x; u < 2048; u += G) na_unit(a, lds, u);
        GSYNC(); }
        { pg8::EpiResid E{hl, hc, hl, hc, MOD1 + 5 * DM, nullptr, 1.0f}; run_gemm(lds, XN, (const bf16*)(a->ws + WS_WO), ML, DM, DM, G, E); }
        GSYNC();
    }
    if (STAGE >= 6) ffn_block(a, lds, bar, G, 1, 1, hl, hc, ML, nullptr, 0);
    final_norm_phase(a->out, a->in[I_FINALG], G);
#undef a
#undef hl
#undef hc
#undef XN
#undef MOD0
#undef MOD1
}

extern "C" void kernel_launch(void* const* d_in, const int* in_sizes, int n_in, void* d_out, int out_size, void* d_ws, size_t ws_size, hipStream_t stream) {
    static int grid = 0;
    if (grid == 0) {
        if (n_in != 26 || out_size != ML * DM || ws_size < WS_END) { fprintf(stderr, "kernel_launch: unexpected problem (n_in %d, out %d, ws %zu)\n", n_in, out_size, ws_size); grid = -1; return; }
        int dev = 0, cus = 0, per_cu = 0;
        if (hipGetDevice(&dev) != hipSuccess || hipDeviceGetAttribute(&cus, hipDeviceAttributeMultiprocessorCount, dev) != hipSuccess) { grid = -1; return; }
        if (hipFuncSetAttribute((const void*)fwd_megakernel, hipFuncAttributeMaxDynamicSharedMemorySize, LDS_BYTES) != hipSuccess) { fprintf(stderr, "kernel_launch: hipFuncSetAttribute failed\n"); grid = -1; return; }
        if (hipOccupancyMaxActiveBlocksPerMultiprocessor(&per_cu, (const void*)fwd_megakernel, NTHREADS, LDS_BYTES) != hipSuccess || per_cu < 1) { fprintf(stderr, "kernel_launch: occupancy query failed (%d)\n", per_cu); (void)hipGetLastError(); grid = -1; return; }
        grid = cus * per_cu;
    }
    if (grid < 0) return;
    if (hipMemsetAsync((char*)d_ws + WS_BAR, 0, 16384, stream) != hipSuccess) { fprintf(stderr, "kernel_launch: memset failed\n"); return; }
    Args a{};
    for (int i = 0; i < 26; ++i) a.in[i] = (const float*)d_in[i];
    a.out = (float*)d_out; a.ws = (unsigned char*)d_ws; a.probe = 0; a.pad = 0;
    void* args[] = {&a};
    hipError_t e = hipLaunchCooperativeKernel((const void*)fwd_megakernel, dim3(grid), dim3(NTHREADS), args, LDS_BYTES, stream);
    if (e != hipSuccess) fprintf(stderr, "kernel_launch: cooperative launch failed: %s (grid %d)\n", hipGetErrorString(e), grid);
}
```

```cpp
#include <hip/hip_runtime.h>
#include <hip/hip_cooperative_groups.h>
#include <cstdio>
#include <cstdint>
namespace cg = cooperative_groups;

constexpr int DM = 1024, NB = 4, SEQ = 4096, CTXL = 256, FF = 2816, NMOD = 9;
constexpr int ML = NB * SEQ, MC = NB * CTXL, MT = ML + MC;
constexpr int MODW = NMOD * DM;
constexpr float EPS = 1e-6f;

namespace pg8 {
#define PG8_LAS __attribute__((address_space(3)))
typedef unsigned short bf16_t;
typedef short bf16x8 __attribute__((ext_vector_type(8)));
typedef float f32x4 __attribute__((ext_vector_type(4)));
typedef unsigned u32x4 __attribute__((ext_vector_type(4)));
constexpr int BM = 256, BK = 64, HALF = 128, HTB = HALF * BK * 2  , STAGE_BYTES = 8 * HTB, NXCD = 8, WGM = 8;

__host__ __device__ __forceinline__ int lds_byte(int r, int c) { const int st = (r >> 4) * 2 + (c >> 5), rr = r & 15, cc = c & 31, ob = rr * 64 + cc * 2; return st * 1024 + (ob ^ (((ob >> 9) & 1) << 5)); }
__host__ __device__ __forceinline__ void stage_rc(int b, int& R, int& C) { const int st = b / 1024, sb = b % 1024, swz = sb ^ (((sb >> 9) & 1) << 5); R = (st >> 1) * 16 + swz / 64; C = (st & 1) * 32 + (swz % 64) / 2; }
__host__ __device__ __forceinline__ int perm32(int rho) { const int n = rho >> 4, i = rho & 15; return 8 * (i >> 2) + 4 * n + (i & 3); }

struct Unit { int pm, pn, k0, nt, split, which; };
struct Gemm { const bf16_t* A; const bf16_t* Bt; int M, N, K; const bf16_t* A2; const bf16_t* Bt2; };

struct StaticOrder {
    int nM, nN, nwg, G, c, ntk;
    __host__ __device__ void init(int M, int N, int G_, int c_, int K_ = 0) { nM = M / BM; nN = N / BM; nwg = nM * nN; G = G_; c = c_; ntk = K_ / BK; }
    __host__ __device__ bool next(int i, Unit& u) const {
        const long L = (long)i * G + c; if (L >= nwg) return false;
        int wgid = (int)L; { const int q = nwg / NXCD, r = nwg % NXCD, xcd = wgid % NXCD, off = wgid / NXCD; wgid = (xcd < r ? xcd * (q + 1) : r * (q + 1) + (xcd - r) * q) + off; }
        const int nig = WGM * nN, gid = wgid / nig, fm = gid * WGM, gsz = (nM - fm) < WGM ? (nM - fm) : WGM;
        u.pm = fm + ((wgid % nig) % gsz); u.pn = (wgid % nig) / gsz; u.k0 = 0; u.nt = ntk; u.split = 0; u.which = 0; return true;
    }
    __device__ __forceinline__ void a_ready(const Unit&) const {}
    __device__ __forceinline__ void done(const Unit&) const {}
};

struct SplitCtxOrder {
    StaticOrder lat; int nN, nsplit, ntp, npieces, G, c;
    __host__ __device__ void init(int MLAT, int MCTX, int N, int K, int G_, int c_, int nsplit_) { lat.init(MLAT, N, G_, c_, K); nN = N / BM; nsplit = nsplit_; ntp = (K / BK) / nsplit_; npieces = (MCTX / BM) * nN * nsplit_; G = G_; c = c_; }
    __host__ __device__ bool next(int i, Unit& u) const {
        const long L = (long)i * G + c;
        if (L < lat.nwg) return lat.next(i, u);
        const int q = (int)(L - lat.nwg); if (q >= npieces) return false;
        const int ks = q % nsplit, t = q / nsplit; u.pn = t % nN; u.pm = lat.nM + t / nN; u.k0 = ks * ntp; u.nt = ntp; u.split = 1; u.which = 0; return true;
    }
    __device__ __forceinline__ void a_ready(const Unit&) const {}
    __device__ __forceinline__ void done(const Unit&) const {}
};

struct QkVtOrder {
    int G, c, ntk; static constexpr int NLATQK = (ML / BM) * 8, NCTXK = (MC / BM) * 4, NVT = 4 * (MT / BM);
    __host__ __device__ void init(int K, int G_, int c_) { G = G_; c = c_; ntk = K / BK; }
    __host__ __device__ bool next(int i, Unit& u) const {
        long L = (long)i * G + c; if (L >= NLATQK + NCTXK + NVT) return false;
        u.k0 = 0; u.nt = ntk; u.split = 0;
        if (L < NLATQK) { u.which = 0; u.pm = (int)(L >> 3); u.pn = (int)(L & 7); return true; } L -= NLATQK;
        if (L < NVT) { u.which = 1; u.pm = (int)(L & 3); u.pn = (int)(L >> 2); return true; } L -= NVT;
        u.which = 0; u.pm = ML / BM + (int)(L >> 2); u.pn = 4 + (int)(L & 3); return true;
    }
    __device__ __forceinline__ void a_ready(const Unit&) const {}
    __device__ __forceinline__ void done(const Unit&) const {}
};

__device__ __forceinline__ unsigned cvt_pk_bf16(float lo, float hi) { unsigned r; asm volatile("v_cvt_pk_bf16_f32 %0, %1, %2" : "=v"(r) : "v"(lo), "v"(hi)); return r; }
__device__ __forceinline__ float bf_lo(unsigned w) { return __uint_as_float(w << 16); }
__device__ __forceinline__ float bf_hi(unsigned w) { return __uint_as_float(w & 0xffff0000u); }
__device__ __forceinline__ float fsilu(float a) { return a * __builtin_amdgcn_rcpf(1.0f + __expf(-a)); }
__device__ __forceinline__ float fsigmoid(float a) { return __builtin_amdgcn_rcpf(1.0f + __expf(-a)); }

struct EpiSwiglu {
    static constexpr bool PERM = true, AFTER_DRAIN = false;
    bf16_t* O; int ldo;
    __device__ __forceinline__ void operator()(const f32x4 (&acc)[2][2][4][2], const Unit& u, int wr, int wc, int fr, int fq) const {
        const int row0 = u.pm * BM + wr * 64 + fr, col0 = u.pn * HALF + wc * 32 + 8 * fq;
#pragma unroll
        for (int ai = 0; ai < 2; ++ai)
#pragma unroll
            for (int m = 0; m < 4; ++m) {
                bf16_t* rowp = O + (size_t)(row0 + ai * HALF + m * 16) * ldo + col0;
                float h[8];
#pragma unroll
                for (int n = 0; n < 2; ++n)
#pragma unroll
                    for (int i = 0; i < 4; ++i) { const float a = acc[ai][0][m][n][i], b = acc[ai][1][m][n][i]; h[4 * n + i] = fsilu(a) * b; }
                u32x4 w; w.x = cvt_pk_bf16(h[0], h[1]); w.y = cvt_pk_bf16(h[2], h[3]); w.z = cvt_pk_bf16(h[4], h[5]); w.w = cvt_pk_bf16(h[6], h[7]);
                *(u32x4*)rowp = w;
            }
    }
};

struct EpiResid {
    static constexpr bool PERM = false, AFTER_DRAIN = false;
    const float* rin_lat; const float* rin_ctx; float* rout_lat; float* rout_ctx; const float* gate; float* part; float gs;
    __device__ __forceinline__ void operator()(const f32x4 (&acc)[2][2][4][2], const Unit& u, int wr, int wc, int fr, int fq) const {
        const bool lat = u.pm < (ML / BM);
        const int bidx = lat ? (u.pm >> 4) : 4;
        const float* gp = gate + (size_t)bidx * MODW;
        const float* ri = lat ? rin_lat + (size_t)u.pm * BM * DM : rin_ctx + (size_t)(u.pm - ML / BM) * BM * DM;
        float* ro = lat ? rout_lat + (size_t)u.pm * BM * DM : rout_ctx + (size_t)(u.pm - ML / BM) * BM * DM;
        const int col0 = u.pn * BM + wc * 32 + 4 * fq;
        f32x4 gv[2][2];
#pragma unroll
        for (int bj = 0; bj < 2; ++bj)
#pragma unroll
            for (int n = 0; n < 2; ++n) gv[bj][n] = *(const f32x4*)(gp + col0 + bj * HALF + n * 16) * gs;
#pragma unroll
        for (int ai = 0; ai < 2; ++ai)
#pragma unroll
            for (int m = 0; m < 4; ++m) {
                const size_t off = (size_t)(ai * HALF + wr * 64 + m * 16 + fr) * DM + col0;
#pragma unroll
                for (int bj = 0; bj < 2; ++bj)
#pragma unroll
                    for (int n = 0; n < 2; ++n) {
                        if (u.split) { float* o = part + ((size_t)(u.k0 / u.nt) * MC + (size_t)(u.pm - ML / BM) * BM) * DM + off + bj * HALF + n * 16; *(f32x4*)o = gv[bj][n] * acc[ai][bj][m][n]; }
                        else { const f32x4 r = *(const f32x4*)(ri + off + bj * HALF + n * 16); *(f32x4*)(ro + off + bj * HALF + n * 16) = r + gv[bj][n] * acc[ai][bj][m][n]; } }
            }
    }
};

struct EpiWin {
    static constexpr bool PERM = true, AFTER_DRAIN = false;
    bf16_t* QKVG; bf16_t* U; const float* rope;
    __device__ __forceinline__ void operator()(const f32x4 (&acc)[2][2][4][2], const Unit& u, int wr, int wc, int fr, int fq) const {
        const int row0 = u.pm * BM + wr * 64 + fr;
        if (u.pn >= 4) {
            bf16_t* base = u.pn < 8 ? QKVG + u.pn * BM : U + (u.pn - 8) * BM; const int ld = u.pn < 8 ? 2048 : 512;
            const int col0 = wc * 32 + 8 * fq;
#pragma unroll
            for (int ai = 0; ai < 2; ++ai)
#pragma unroll
                for (int m = 0; m < 4; ++m) { bf16_t* rowp = base + (size_t)(row0 + ai * HALF + m * 16) * ld + col0;
#pragma unroll
                    for (int bj = 0; bj < 2; ++bj) { const f32x4 v0 = acc[ai][bj][m][0], v1 = acc[ai][bj][m][1];
                        u32x4 w; w.x = cvt_pk_bf16(v0[0], v0[1]); w.y = cvt_pk_bf16(v0[2], v0[3]); w.z = cvt_pk_bf16(v1[0], v1[1]); w.w = cvt_pk_bf16(v1[2], v1[3]);
                        *(u32x4*)(rowp + bj * HALF) = w; } }
        } else {
            const bool lat = u.pm < (ML / BM);
            const float sc = u.pn >= 2 ? 0.08838834764831845f : 1.0f;
            const int hh = wc >> 1, rot = wc & 1, f0 = 8 * fq;
            const int dcol = u.pn * BM + 128 * hh + 64 * rot + f0;
#pragma unroll
            for (int ai = 0; ai < 2; ++ai)
#pragma unroll
                for (int m = 0; m < 4; ++m) {
                    const int row = row0 + ai * HALF + m * 16;
                    float y1[8], y2[8];
                    const int t = row & (SEQ - 1), pos = rot ? (t & 63) : (t >> 6);
                    const float* rp = rope + (size_t)(pos * 32 + f0) * 2;
#pragma unroll
                    for (int n = 0; n < 2; ++n) {
                        f32x4 cs0 = (f32x4){1.f, 0.f, 1.f, 0.f}, cs1 = cs0;
                        if (lat) { cs0 = *(const f32x4*)(rp + 8 * n); cs1 = *(const f32x4*)(rp + 8 * n + 4); }
                        const f32x4 x1 = acc[ai][0][m][n], x2 = acc[ai][1][m][n];
                        y1[4 * n + 0] = (x1[0] * cs0[0] - x2[0] * cs0[1]) * sc; y2[4 * n + 0] = (x2[0] * cs0[0] + x1[0] * cs0[1]) * sc;
                        y1[4 * n + 1] = (x1[1] * cs0[2] - x2[1] * cs0[3]) * sc; y2[4 * n + 1] = (x2[1] * cs0[2] + x1[1] * cs0[3]) * sc;
                        y1[4 * n + 2] = (x1[2] * cs1[0] - x2[2] * cs1[1]) * sc; y2[4 * n + 2] = (x2[2] * cs1[0] + x1[2] * cs1[1]) * sc;
                        y1[4 * n + 3] = (x1[3] * cs1[2] - x2[3] * cs1[3]) * sc; y2[4 * n + 3] = (x2[3] * cs1[2] + x1[3] * cs1[3]) * sc;
                    }
                    bf16_t* rowp = QKVG + (size_t)row * 2048 + dcol;
                    u32x4 w; w.x = cvt_pk_bf16(y1[0], y1[1]); w.y = cvt_pk_bf16(y1[2], y1[3]); w.z = cvt_pk_bf16(y1[4], y1[5]); w.w = cvt_pk_bf16(y1[6], y1[7]);
                    *(u32x4*)rowp = w;
                    w.x = cvt_pk_bf16(y2[0], y2[1]); w.y = cvt_pk_bf16(y2[2], y2[3]); w.z = cvt_pk_bf16(y2[4], y2[5]); w.w = cvt_pk_bf16(y2[6], y2[7]);
                    *(u32x4*)(rowp + 32) = w;
                }
        }
    }
};

struct EpiGlu {
    static constexpr bool PERM = true, AFTER_DRAIN = false;
    const bf16_t* YS; bf16_t* YM; const float* bias;
    __device__ __forceinline__ void operator()(const f32x4 (&acc)[2][2][4][2], const Unit& u, int wr, int wc, int fr, int fq) const {
        const int row0 = u.pm * BM + wr * 64 + fr, col0 = u.pn * BM + wc * 32 + 8 * fq;
        f32x4 bv[2][2];
#pragma unroll
        for (int bj = 0; bj < 2; ++bj)
#pragma unroll
            for (int n = 0; n < 2; ++n) bv[bj][n] = *(const f32x4*)(bias + col0 + bj * HALF + 4 * n);
#pragma unroll
        for (int ai = 0; ai < 2; ++ai)
#pragma unroll
            for (int m = 0; m < 4; ++m) { const int row = row0 + ai * HALF + m * 16;
#pragma unroll
                for (int bj = 0; bj < 2; ++bj) {
                    const u32x4 yv = *(const u32x4*)(YS + (size_t)row * 512 + col0 + bj * HALF);
                    const f32x4 z0 = acc[ai][bj][m][0] + bv[bj][0], z1 = acc[ai][bj][m][1] + bv[bj][1];
                    u32x4 w;
                    w.x = cvt_pk_bf16(bf_lo(yv.x) * fsigmoid(z0[0]), bf_hi(yv.x) * fsigmoid(z0[1]));
                    w.y = cvt_pk_bf16(bf_lo(yv.y) * fsigmoid(z0[2]), bf_hi(yv.y) * fsigmoid(z0[3]));
                    w.z = cvt_pk_bf16(bf_lo(yv.z) * fsigmoid(z1[0]), bf_hi(yv.z) * fsigmoid(z1[1]));
                    w.w = cvt_pk_bf16(bf_lo(yv.w) * fsigmoid(z1[2]), bf_hi(yv.w) * fsigmoid(z1[3]));
                    *(u32x4*)(YM + (size_t)row * DM + 512 + col0 + bj * HALF) = w; } }
    }
};

struct EpiBf16S {
    static constexpr bool PERM = true, AFTER_DRAIN = false;
    bf16_t* O; int ldo; int nscale; float scale0;
    __device__ __forceinline__ void operator()(const f32x4 (&acc)[2][2][4][2], const Unit& u, int wr, int wc, int fr, int fq) const {
        const int row0 = u.pm * BM + wr * 64 + fr, col0 = u.pn * BM + wc * 32 + 8 * fq;
        const float sc = u.pn < nscale ? scale0 : 1.0f;
#pragma unroll
        for (int ai = 0; ai < 2; ++ai)
#pragma unroll
            for (int m = 0; m < 4; ++m) { bf16_t* rowp = O + (size_t)(row0 + ai * HALF + m * 16) * ldo + col0;
#pragma unroll
                for (int bj = 0; bj < 2; ++bj) { const f32x4 v0 = acc[ai][bj][m][0] * sc, v1 = acc[ai][bj][m][1] * sc;
                    u32x4 w; w.x = cvt_pk_bf16(v0[0], v0[1]); w.y = cvt_pk_bf16(v0[2], v0[3]); w.z = cvt_pk_bf16(v1[0], v1[1]); w.w = cvt_pk_bf16(v1[2], v1[3]);
                    *(u32x4*)(rowp + bj * HALF) = w; } }
    }
};

struct EpiQkVt {
    static constexpr bool PERM = true, AFTER_DRAIN = false;
    bf16_t* QK; bf16_t* VT;
    __device__ __forceinline__ void operator()(const f32x4 (&acc)[2][2][4][2], const Unit& u, int wr, int wc, int fr, int fq) const {
        const int row0 = u.pm * BM + wr * 64 + fr, col0 = u.pn * BM + wc * 32 + 8 * fq;
        bf16_t* O = u.which ? VT : QK; const int ldo = u.which ? MT : 2048;
        const float sc = (!u.which && u.pn < 4) ? 0.125f : 1.0f;
#pragma unroll
        for (int ai = 0; ai < 2; ++ai)
#pragma unroll
            for (int m = 0; m < 4; ++m) { bf16_t* rowp = O + (size_t)(row0 + ai * HALF + m * 16) * ldo + col0;
#pragma unroll
                for (int bj = 0; bj < 2; ++bj) { const f32x4 v0 = acc[ai][bj][m][0] * sc, v1 = acc[ai][bj][m][1] * sc;
                    u32x4 w; w.x = cvt_pk_bf16(v0[0], v0[1]); w.y = cvt_pk_bf16(v0[2], v0[3]); w.z = cvt_pk_bf16(v1[0], v1[1]); w.w = cvt_pk_bf16(v1[2], v1[3]);
                    *(u32x4*)(rowp + bj * HALF) = w; } }
    }
};
template <class Epi, class Sched, bool ALIGN_EPI = false, bool SP2 = false>
__device__ __forceinline__ void gemm_phase(PG8_LAS unsigned char* lds, const Gemm g, const Sched& S, const Epi& E) {
    int tid_ = threadIdx.x; asm volatile("" : "+v"(tid_));
    const int tid = tid_, wid = __builtin_amdgcn_readfirstlane(tid >> 6), lane = tid & 63, wr = wid >> 2, wc = wid & 3, fr = lane & 15, fq = lane >> 4;
    const int K = g.K;
    unsigned voffA[2], voffB[2];
#pragma unroll
    for (int i = 0; i < 2; ++i) { int R, C; stage_rc(tid * 16 + i * 8192, R, C); const int Rb = Epi::PERM ? ((R & ~31) + perm32(R & 31)) : R;
        voffA[i] = (unsigned)(R * K + C) * 2u; voffB[i] = (unsigned)(Rb * K + C) * 2u; }
    const size_t kstep = (size_t)(BK * 2);
    const size_t hstep = (size_t)HALF * K * 2;
    const size_t tstep = 2 * hstep;
    const unsigned ldsw = (unsigned)wid * 1024u;
    const int aoff = lds_byte(wr * 64 + fr, fq * 8), boff = lds_byte(wc * 32 + fr, fq * 8);
#define PG8_SA(b, h) (((b) * 2 + (h)) * HTB)
#define PG8_SB(b, h) ((4 + (b) * 2 + (h)) * HTB)
#define PG8_STAGE(bufoff, gbase, voff) do { _Pragma("unroll") for (int _i = 0; _i < 2; ++_i) \
        __builtin_amdgcn_global_load_lds((const unsigned*)((const char*)(gbase) + (voff)[_i]), (PG8_LAS unsigned*)(lds + (bufoff) + ldsw + _i * 8192), 16, 0, 0); } while (0)
#define PG8_LDA(dst, b, h) do { _Pragma("unroll") for (int m = 0; m < 4; ++m) _Pragma("unroll") for (int k = 0; k < 2; ++k) dst[m][k] = *(const PG8_LAS bf16x8*)(lds + PG8_SA(b, h) + aoff + m * 2048 + k * 1024); } while (0)
#define PG8_LDB(dst, b, h) do { _Pragma("unroll") for (int n = 0; n < 2; ++n) _Pragma("unroll") for (int k = 0; k < 2; ++k) dst[n][k] = *(const PG8_LAS bf16x8*)(lds + PG8_SB(b, h) + boff + n * 2048 + k * 1024); } while (0)
#define PG8_MMA(ai, bj, At, Bt) do { __builtin_amdgcn_s_setprio(1); _Pragma("unroll") for (int m = 0; m < 4; ++m) _Pragma("unroll") for (int n = 0; n < 2; ++n) _Pragma("unroll") for (int k = 0; k < 2; ++k) \
        acc[ai][bj][m][n] = __builtin_amdgcn_mfma_f32_16x16x32_bf16(Bt[n][k], At[m][k], acc[ai][bj][m][n], 0, 0, 0); __builtin_amdgcn_s_setprio(0); } while (0)
#define PG8_WAIT_V(n) asm volatile("s_waitcnt vmcnt(" #n ")" ::: "memory")
#define PG8_WAIT_L(n) asm volatile("s_waitcnt lgkmcnt(" #n ")" ::: "memory")
#define PG8_BAR __builtin_amdgcn_s_barrier()
#define PG8_SCHED __builtin_amdgcn_sched_barrier(0)
    Unit cur, nxt; int ui = 0;
    if (!S.next(0, cur)) return;
    f32x4 acc[2][2][4][2];
#pragma unroll
    for (int a = 0; a < 2; ++a)
#pragma unroll
        for (int b = 0; b < 2; ++b)
#pragma unroll
            for (int m = 0; m < 4; ++m)
#pragma unroll
                for (int n = 0; n < 2; ++n) acc[a][b][m][n] = (f32x4){0.f, 0.f, 0.f, 0.f};
    bf16x8 At[4][2], B0[2][2], B1[2][2];
    const char* cA = (const char*)(cur.which ? g.A2 : g.A) + (size_t)cur.pm * tstep + (size_t)cur.k0 * kstep; const char* cB = (const char*)(cur.which ? g.Bt2 : g.Bt) + (size_t)cur.pn * tstep + (size_t)cur.k0 * kstep;
    S.a_ready(cur);
    if constexpr (SP2) {
        PG8_STAGE(PG8_SB(0, 0), cB, voffB); PG8_STAGE(PG8_SB(0, 1), cB + hstep, voffB); PG8_STAGE(PG8_SA(0, 0), cA, voffA); PG8_STAGE(PG8_SA(0, 1), cA + hstep, voffA);
        if (wr == 1) PG8_BAR;
        PG8_WAIT_V(2); PG8_BAR;
        PG8_STAGE(PG8_SB(1, 0), cB + kstep, voffB); PG8_STAGE(PG8_SA(1, 0), cA + kstep, voffA); PG8_STAGE(PG8_SB(1, 1), cB + hstep + kstep, voffB);
        PG8_WAIT_V(6); PG8_BAR;
    } else {
        PG8_STAGE(PG8_SB(0, 0), cB, voffB); PG8_STAGE(PG8_SA(0, 0), cA, voffA); PG8_STAGE(PG8_SB(0, 1), cB + hstep, voffB); PG8_STAGE(PG8_SA(0, 1), cA + hstep, voffA);
        if (wr == 1) PG8_BAR;
        PG8_WAIT_V(4); PG8_BAR;
        PG8_STAGE(PG8_SB(1, 0), cB + kstep, voffB); PG8_STAGE(PG8_SA(1, 0), cA + kstep, voffA); PG8_STAGE(PG8_SB(1, 1), cB + hstep + kstep, voffB);
        PG8_WAIT_V(6); PG8_BAR;
    }
    for (;;) {
        const bool has_next = S.next(ui + 1, nxt);
        const char* nA = has_next ? (const char*)(nxt.which ? g.A2 : g.A) + (size_t)nxt.pm * tstep + (size_t)nxt.k0 * kstep : cA; const char* nB = has_next ? (const char*)(nxt.which ? g.Bt2 : g.Bt) + (size_t)nxt.pn * tstep + (size_t)nxt.k0 * kstep : cB;
        const int nt = cur.nt;
        for (int t = 0; t < nt; t += 2) {
            const bool last = (t == nt - 2);
            const char* a1 = cA + (size_t)(t + 1) * kstep;
            const char* a2 = last ? nA : cA + (size_t)(t + 2) * kstep; const char* b2 = last ? nB : cB + (size_t)(t + 2) * kstep;
            const char* a3 = a2 + kstep; const char* b3 = b2 + kstep;
            if (last && has_next) S.a_ready(nxt);
            if constexpr (SP2) {
            PG8_LDB(B0, 0, 0); PG8_LDB(B1, 0, 1); PG8_SCHED; PG8_LDA(At, 0, 0); PG8_STAGE(PG8_SA(1, 1), a1 + hstep, voffA);
            PG8_WAIT_V(8); PG8_WAIT_L(0); PG8_BAR; PG8_MMA(0, 0, At, B0); PG8_MMA(0, 1, At, B1); PG8_BAR; PG8_SCHED;
            PG8_LDA(At, 0, 1); PG8_STAGE(PG8_SB(0, 0), b2, voffB); PG8_STAGE(PG8_SB(0, 1), b2 + hstep, voffB); PG8_STAGE(PG8_SA(0, 0), a2, voffA);
            PG8_WAIT_V(8); PG8_WAIT_L(0); PG8_BAR; PG8_MMA(1, 0, At, B0); PG8_MMA(1, 1, At, B1); PG8_BAR; PG8_SCHED;
            PG8_LDB(B0, 1, 0); PG8_LDB(B1, 1, 1); PG8_SCHED; PG8_LDA(At, 1, 0); PG8_STAGE(PG8_SA(0, 1), a2 + hstep, voffA);
            PG8_WAIT_V(8); PG8_WAIT_L(0); PG8_BAR; PG8_MMA(0, 0, At, B0); PG8_MMA(0, 1, At, B1); PG8_BAR; PG8_SCHED;
            PG8_LDA(At, 1, 1); PG8_STAGE(PG8_SB(1, 0), b3, voffB); PG8_STAGE(PG8_SB(1, 1), b3 + hstep, voffB); PG8_STAGE(PG8_SA(1, 0), a3, voffA);
            PG8_WAIT_V(8); PG8_WAIT_L(0); PG8_BAR; PG8_MMA(1, 0, At, B0); PG8_MMA(1, 1, At, B1); PG8_BAR; PG8_SCHED;
            } else {
            PG8_LDB(B0, 0, 0); PG8_SCHED; PG8_LDA(At, 0, 0); PG8_STAGE(PG8_SA(1, 1), a1 + hstep, voffA);
            PG8_WAIT_L(8); PG8_BAR; PG8_WAIT_L(0); PG8_MMA(0, 0, At, B0); PG8_BAR; PG8_SCHED;
            PG8_LDB(B1, 0, 1); PG8_STAGE(PG8_SB(0, 0), b2, voffB);
            PG8_BAR; PG8_WAIT_L(0); PG8_MMA(0, 1, At, B1); PG8_BAR;
            PG8_LDA(At, 0, 1); PG8_STAGE(PG8_SA(0, 0), a2, voffA);
            PG8_BAR; PG8_WAIT_L(0); PG8_MMA(1, 0, At, B0); PG8_BAR; PG8_SCHED;
            PG8_STAGE(PG8_SB(0, 1), b2 + hstep, voffB);
            PG8_WAIT_V(6); PG8_BAR; PG8_MMA(1, 1, At, B1); PG8_BAR;
            PG8_LDB(B0, 1, 0); PG8_SCHED; PG8_LDA(At, 1, 0); PG8_STAGE(PG8_SA(0, 1), a2 + hstep, voffA);
            PG8_WAIT_L(8); PG8_BAR; PG8_WAIT_L(0); PG8_MMA(0, 0, At, B0); PG8_BAR; PG8_SCHED;
            PG8_LDB(B1, 1, 1); PG8_STAGE(PG8_SB(1, 0), b3, voffB);
            PG8_BAR; PG8_WAIT_L(0); PG8_MMA(0, 1, At, B1); PG8_BAR;
            PG8_LDA(At, 1, 1); PG8_STAGE(PG8_SA(1, 0), a3, voffA);
            PG8_BAR; PG8_WAIT_L(0); PG8_MMA(1, 0, At, B0); PG8_BAR; PG8_SCHED;
            PG8_STAGE(PG8_SB(1, 1), b3 + hstep, voffB);
            PG8_WAIT_V(6); PG8_BAR; PG8_MMA(1, 1, At, B1); PG8_BAR;
            }
        }
        if constexpr (ALIGN_EPI) { if (wr == 0) PG8_BAR; }
        if constexpr (!Epi::AFTER_DRAIN) { E(acc, cur, wr, wc, fr, fq); S.done(cur); }
        if (!has_next) break;
#pragma unroll
        for (int a = 0; a < 2; ++a)
#pragma unroll
            for (int b = 0; b < 2; ++b)
#pragma unroll
                for (int m = 0; m < 4; ++m)
#pragma unroll
                    for (int n = 0; n < 2; ++n) acc[a][b][m][n] = (f32x4){0.f, 0.f, 0.f, 0.f};
        cur = nxt; cA = nA; cB = nB; ++ui;
        if constexpr (ALIGN_EPI) { if (wr == 1) PG8_BAR; }
    }
    PG8_WAIT_V(0);
    if constexpr (!ALIGN_EPI) { if (wr == 0) PG8_BAR; }
    PG8_BAR;
    if constexpr (Epi::AFTER_DRAIN) { E.fused(acc, cur, wr, wc, fr, fq, lds, wid, lane); S.done(cur); }
#undef PG8_SA
#undef PG8_SB
#undef PG8_STAGE
#undef PG8_LDA
#undef PG8_LDB
#undef PG8_MMA
#undef PG8_WAIT_V
#undef PG8_WAIT_L
#undef PG8_BAR
#undef PG8_SCHED
}
}

#define LAS __attribute__((address_space(3)))
typedef unsigned short bf16;
typedef unsigned v4u __attribute__((ext_vector_type(4)));
typedef unsigned v2u __attribute__((ext_vector_type(2)));
typedef float f32x4 __attribute__((ext_vector_type(4)));
typedef float f32x2 __attribute__((ext_vector_type(2)));
typedef short bf16x8 __attribute__((ext_vector_type(8)));
typedef short s16x4 __attribute__((ext_vector_type(4)));

constexpr size_t MiB = 1u << 20;
constexpr size_t WS_MOD   = 1 * MiB;
constexpr size_t WS_ROPE  = WS_MOD + 512 * 1024;
constexpr size_t WS_LB    = WS_ROPE + 64 * 1024;
constexpr size_t WS_LBT   = WS_LB + 64 * 1024;
constexpr size_t WS_BBR   = WS_LBT + 64 * 1024;
constexpr size_t WS_BBI   = WS_BBR + 256 * 1024;
constexpr size_t WS_CM    = WS_BBI + 256 * 1024;
constexpr size_t WS_BBM   = WS_CM + 256 * 1024;
static_assert(WS_BBM + 256 * 1024 <= 4 * MiB, "param block");
constexpr size_t WS_W1    = 4 * MiB;
constexpr size_t WS_W2    = 48 * MiB;
constexpr size_t WS_WIN   = 70 * MiB;
constexpr size_t WS_WOUT  = 75 * MiB;
constexpr size_t WS_GLU   = 77 * MiB;
constexpr size_t WS_WQKV  = 78 * MiB;
constexpr size_t WS_WO    = 84 * MiB;
constexpr size_t WS_HCTX  = 86 * MiB;
constexpr size_t WS_XN    = 90 * MiB;
constexpr size_t WS_R     = 124 * MiB;
constexpr size_t WS_HID   = WS_R;
constexpr size_t WS_QKVG  = WS_R;
constexpr size_t WS_U     = WS_R + 68 * MiB;
constexpr size_t WS_KVS   = WS_R + 85 * MiB;
constexpr size_t WS_SF    = WS_R + 119 * MiB;
constexpr size_t WS_YS    = WS_R + 128 * MiB;
constexpr size_t WS_QK    = WS_R;
constexpr size_t WS_VT    = WS_R + 68 * MiB;
constexpr size_t WS_PARTF = WS_R + 96 * MiB;
constexpr size_t WS_PARTM = WS_R;
constexpr size_t WS_END   = WS_R + 145 * MiB;

constexpr size_t WS_BAR = 0;
constexpr int BARLDS_OFF = 147456 - 64;
constexpr int NWAVES = 8, NTHREADS = 512;
constexpr int LDS_BYTES = 147456;

struct Args {
    const float* in[26]; float* out; unsigned char* ws; int probe; int pad;
};
typedef const __attribute__((address_space(4))) Args* KArgs;
__device__ __forceinline__ KArgs kargs() { KArgs p = (KArgs)__builtin_amdgcn_kernarg_segment_ptr(); asm volatile("" : "+s"(p)); return p; }
enum { I_X = 0, I_C, I_CTX, I_CCTX, I_WMOD, I_BMOD, I_NORMG, I_W1, I_W2, I_WIN, I_WOUT, I_DECAY, I_LAMRE, I_LAMIM, I_LOGDT, I_BRE, I_BIM, I_CRE, I_CIM,
       I_S5D, I_GLUW, I_GLUB, I_WQKV, I_WO, I_RPB, I_FINALG };

__device__ __forceinline__ unsigned f2bf(float f) { unsigned u = __builtin_bit_cast(unsigned, f); return (u + 0x7fffu + ((u >> 16) & 1u)) >> 16; }
__device__ __forceinline__ unsigned pk2(float lo, float hi) { return f2bf(lo) | (f2bf(hi) << 16); }
typedef __bf16 bf16x2_t __attribute__((ext_vector_type(2)));
__device__ __forceinline__ unsigned cvtpk(float lo, float hi) { const f32x2 v = {lo, hi}; const bf16x2_t b = __builtin_convertvector(v, bf16x2_t); return __builtin_bit_cast(unsigned, b); }
__device__ __forceinline__ float bf2f(unsigned short h) { return __uint_as_float((unsigned)h << 16); }
__device__ __forceinline__ float blo(unsigned w) { return __uint_as_float(w << 16); }
__device__ __forceinline__ float bhi(unsigned w) { return __uint_as_float(w & 0xffff0000u); }
__device__ __forceinline__ int opaque_tid() { int t = threadIdx.x; asm volatile("" : "+v"(t)); return t; }
__device__ __forceinline__ float wave_sum(float v) {
#pragma unroll
    for (int o = 1; o < 64; o <<= 1) v += __shfl_xor(v, o);
    return v;
}
__device__ __forceinline__ void sincos_acc(float x, float& s, float& c) {
    const float k = rintf(x * 0.6366197723675814f);
    float r = fmaf(k, -1.5703125f, x); r = fmaf(k, -4.837512969970703125e-4f, r); r = fmaf(k, -7.54978995489188216e-8f, r);
    const float r2 = r * r;
    float sp = 2.7557319e-6f; sp = fmaf(sp, r2, -1.9841270e-4f); sp = fmaf(sp, r2, 8.3333333e-3f); sp = fmaf(sp, r2, -1.6666667e-1f); sp = fmaf(sp * r2, r, r);
    float cp = -2.7557319e-7f; cp = fmaf(cp, r2, 2.4801587e-5f); cp = fmaf(cp, r2, -1.3888889e-3f); cp = fmaf(cp, r2, 4.1666667e-2f); cp = fmaf(cp, r2, -0.5f); cp = fmaf(cp, r2, 1.0f);
    const int q = ((int)k) & 3;
    s = (q == 0) ? sp : (q == 1) ? cp : (q == 2) ? -sp : -cp;
    c = (q == 0) ? cp : (q == 1) ? -sp : (q == 2) ? -cp : sp;
}
__device__ __forceinline__ float gelu_tanh(float v) {
    const float t = 0.7978845608028654f * (v + 0.044715f * v * v * v);
    const float e = __expf(2.0f * t);
    const float th = 1.0f - 2.0f * __builtin_amdgcn_rcpf(e + 1.0f);
    return 0.5f * v * (1.0f + th);
}

__device__ __forceinline__ int map_row(int kind, int n) {
    if (kind == 1) { const int j = n < FF ? n : n - FF; return 256 * (j >> 7) + (n < FF ? 0 : 128) + (j & 127); }
    if (kind == 2 && n < 1024) { const int tile = n >> 8, hh = (n >> 7) & 1, d = n & 127; return 256 * tile + 128 * ((d >> 5) & 1) + 64 * hh + 32 * (d >> 6) + (d & 31); }
    return n;
}
__device__ __forceinline__ void p0_transpose_item(const float* W, int K, int N, int kind, bf16* WT, LAS float* scr, int item, int lane) {
    const int nblk = N / 32, kb = item / nblk, nb = item % nblk, k0 = 64 * kb, n0 = 32 * nb;
    const int drow = map_row(kind, n0);
    float wv[32];
#pragma unroll
    for (int i = 0; i < 32; ++i) { const int kk = 2 * i + (lane >> 5); wv[i] = W[(size_t)(k0 + kk) * N + n0 + (lane & 31)]; }
#pragma unroll
    for (int i = 0; i < 32; ++i) { const int kk = 2 * i + (lane >> 5); scr[kk * 33 + (lane & 31)] = wv[i]; }
    asm volatile("s_waitcnt lgkmcnt(0)" ::: "memory");
    const int c = lane & 7;
#pragma unroll
    for (int j = 0; j < 4; ++j) { const int n = (lane >> 3) + 8 * j; const LAS float* s = scr + (8 * c) * 33 + n;
        v4u o; o.x = cvtpk(s[0 * 33], s[1 * 33]); o.y = cvtpk(s[2 * 33], s[3 * 33]); o.z = cvtpk(s[4 * 33], s[5 * 33]); o.w = cvtpk(s[6 * 33], s[7 * 33]);
        *(v4u*)(WT + (size_t)(drow + n) * K + k0 + 8 * c) = o; }
    asm volatile("s_waitcnt lgkmcnt(0)" ::: "memory");
}

struct WDesc { const float* W; bf16* dst; int K, N, kind, items; };
__device__ __forceinline__ WDesc wdesc(KArgs a, int mi) {
    WDesc d;
    if (mi < 4)       { d.W = a->in[I_W1] + (size_t)mi * DM * 2 * FF; d.dst = (bf16*)(a->ws + WS_W1) + (size_t)mi * 2 * FF * DM; d.K = DM; d.N = 2 * FF; d.kind = 1; }
    else if (mi < 8)  { d.W = a->in[I_W2] + (size_t)(mi - 4) * FF * DM; d.dst = (bf16*)(a->ws + WS_W2) + (size_t)(mi - 4) * DM * FF; d.K = FF; d.N = DM; d.kind = 0; }
    else if (mi == 8) { d.W = a->in[I_WIN]; d.dst = (bf16*)(a->ws + WS_WIN); d.K = DM; d.N = 2560; d.kind = 2; }
    else if (mi == 9) { d.W = a->in[I_WOUT]; d.dst = (bf16*)(a->ws + WS_WOUT); d.K = DM; d.N = DM; d.kind = 0; }
    else if (mi == 10){ d.W = a->in[I_GLUW]; d.dst = (bf16*)(a->ws + WS_GLU); d.K = 512; d.N = 512; d.kind = 0; }
    else if (mi == 11){ d.W = a->in[I_WQKV]; d.dst = (bf16*)(a->ws + WS_WQKV); d.K = DM; d.N = 3072; d.kind = 0; }
    else              { d.W = a->in[I_WO]; d.dst = (bf16*)(a->ws + WS_WO); d.K = DM; d.N = DM; d.kind = 0; }
    d.items = (d.K / 64) * (d.N / 32);
    return d;
}
constexpr int NWMAT = 13;

__device__ __forceinline__ void p0_prologue(KArgs a, LAS unsigned char* lds, int G) {
    const int tid = opaque_tid(), lane = tid & 63, wave = __builtin_amdgcn_readfirstlane(tid >> 6);
    {
        LAS float* sv = (LAS float*)lds;
        LAS float* red = (LAS float*)(lds + 32768);
        bool have = false;
        for (int it = blockIdx.x; it < 2 * (MODW / 64); it += G) {
            if (!have) {
                for (int i = tid; i < 5 * DM; i += NTHREADS) { const int b = i >> 10, k = i & 1023; const float v = b < 4 ? a->in[I_C][b * DM + k] : a->in[I_CCTX][k]; sv[k * 8 + b] = v / (1.0f + expf(-v)); }
                __syncthreads(); have = true;
            }
            const int layer = it / (MODW / 64), n = (it % (MODW / 64)) * 64 + lane;
            const float* wp = a->in[I_WMOD] + (size_t)layer * DM * MODW + n;
            float acc[5] = {0.f, 0.f, 0.f, 0.f, 0.f};
#pragma unroll 16
            for (int kk = 0; kk < 128; ++kk) { const int k = wave * 128 + kk; const float w = wp[(size_t)k * MODW];
                const f32x4 s0 = *(const LAS f32x4*)(sv + k * 8); const float s4 = sv[k * 8 + 4];
                acc[0] = fmaf(s0[0], w, acc[0]); acc[1] = fmaf(s0[1], w, acc[1]); acc[2] = fmaf(s0[2], w, acc[2]); acc[3] = fmaf(s0[3], w, acc[3]); acc[4] = fmaf(s4, w, acc[4]); }
#pragma unroll
            for (int b = 0; b < 5; ++b) red[(wave * 5 + b) * 64 + lane] = acc[b];
            __syncthreads();
            if (tid < 320) { const int b = tid >> 6, l = tid & 63, nn = (it % (MODW / 64)) * 64 + l; float s = a->in[I_BMOD][layer * MODW + nn];
#pragma unroll
                for (int w = 0; w < 8; ++w) s += red[(w * 5 + b) * 64 + l];
                ((float*)(a->ws + WS_MOD))[((size_t)layer * 5 + b) * MODW + nn] = s; }
            __syncthreads();
        }
        __syncthreads();
    }
    const int gtid = blockIdx.x * NTHREADS + tid, GT = G * NTHREADS;
    for (int i = gtid; i < MC * DM / 4; i += GT) ((f32x4*)(a->ws + WS_HCTX))[i] = ((const f32x4*)a->in[I_CTX])[i];
    for (int i = gtid; i < 64 * 32; i += GT) { const int pos = i >> 5, f = i & 31; const float inv = exp2f(-(float)f * (13.287712379549449f / 32.0f));
        float s, c; sincos_acc((float)pos * inv, s, c); ((f32x2*)(a->ws + WS_ROPE))[i] = (f32x2){c, s}; }
    for (int i = gtid; i < 2 * 32 * 64; i += GT) {
        const int p = i & 63, dg = i >> 6;
        const float lr = fminf(a->in[I_LAMRE][i], -1e-4f), li = a->in[I_LAMIM][i], dt = expf(a->in[I_LOGDT][dg]);
        float s, c; sincos_acc(li * dt, s, c); const float mg = expf(lr * dt); const float br = mg * c, bi = mg * s;
        ((f32x2*)(a->ws + WS_LB))[i] = (f32x2){br, bi};
        float s64, c64; sincos_acc(li * dt * 64.0f, s64, c64); const float m64 = expf(lr * dt * 64.0f);
        ((f32x2*)(a->ws + WS_LBT))[i] = (f32x2){m64 * c64, m64 * s64};
        const float nr = br - 1.0f, ni = bi, den = 1.0f / (lr * lr + li * li);
        const float cr = (nr * lr + ni * li) * den, ci = (ni * lr - nr * li) * den;
        for (int k = 0; k < 16; ++k) {
            const float bre = a->in[I_BRE][(size_t)i * 16 + k], bim = a->in[I_BIM][(size_t)i * 16 + k];
            ((bf16*)(a->ws + WS_BBM))[((size_t)dg * 128 + 2 * p) * 16 + k] = (bf16)f2bf(cr * bre - ci * bim);
            ((bf16*)(a->ws + WS_BBM))[((size_t)dg * 128 + 2 * p + 1) * 16 + k] = (bf16)f2bf(cr * bim + ci * bre);
            const float cre = a->in[I_CRE][((size_t)dg * 16 + k) * 64 + p], cim = a->in[I_CIM][((size_t)dg * 16 + k) * 64 + p];
            ((unsigned*)(a->ws + WS_CM))[((size_t)dg * 16 + k) * 64 + p] = cvtpk(cre, -cim);
        }
    }
    {
        LAS float* scr = (LAS float*)(lds + wave * 16384);
        const int gw = blockIdx.x * NWAVES + wave, NGW = G * NWAVES;
        int total = 0;
        for (int mi = 0; mi < NWMAT; ++mi) total += wdesc(a, mi).items;
        for (int it = gw; it < total; it += NGW) {
            int r = it;
            for (int mi = 0; mi < NWMAT; ++mi) { const WDesc d = wdesc(a, mi); if (r < d.items) { p0_transpose_item(d.W, d.K, d.N, d.kind, d.dst, scr, r, lane); break; } r -= d.items; }
        }
    }
}

__device__ __forceinline__ void norm_phase(const float* src_lat, const float* src_ctx, bf16* XN, const float* g, const float* mod  , int ishift, int nrows, int G, const float* part = nullptr, int npart = 0, float* hctx_rw = nullptr) {
    const int tid = opaque_tid(), lane = tid & 63, wave = __builtin_amdgcn_readfirstlane(tid >> 6);
    const int gw = blockIdx.x * NWAVES + wave, NGW = G * NWAVES;
    f32x4 gv[4];
#pragma unroll
    for (int j = 0; j < 4; ++j) gv[j] = *((const f32x4*)g + lane + 64 * j);
    for (int row = gw; row < nrows; row += NGW) {
        const float* xr = row < ML ? src_lat + (size_t)row * DM : src_ctx + (size_t)(row - ML) * DM;
        const int bidx = row < ML ? (row >> 12) : 4;
        const float* sh = mod + (size_t)bidx * MODW + ishift * DM; const float* sc = sh + DM;
        f32x4 v[4]; float s = 0.f;
#pragma unroll
        for (int j = 0; j < 4; ++j) v[j] = *((const f32x4*)xr + lane + 64 * j);
        if (npart > 0 && row >= ML) {
            for (int pp = 0; pp < npart; ++pp) { const float* pr = part + ((size_t)pp * MC + (row - ML)) * DM;
#pragma unroll
                for (int j = 0; j < 4; ++j) v[j] += *((const f32x4*)pr + lane + 64 * j); }
#pragma unroll
            for (int j = 0; j < 4; ++j) *((f32x4*)(hctx_rw + (size_t)(row - ML) * DM) + lane + 64 * j) = v[j];
        }
#pragma unroll
        for (int j = 0; j < 4; ++j) s += (v[j][0] * v[j][0] + v[j][1] * v[j][1]) + (v[j][2] * v[j][2] + v[j][3] * v[j][3]);
        const float rstd = rsqrtf(wave_sum(s) * (1.0f / DM) + EPS);
#pragma unroll
        for (int j = 0; j < 4; ++j) {
            const f32x4 shv = *((const f32x4*)sh + lane + 64 * j), scv = *((const f32x4*)sc + lane + 64 * j);
            const f32x4 y = v[j] * rstd * gv[j] * (scv + 1.0f) + shv;
            *((v2u*)(XN + (size_t)row * DM) + lane + 64 * j) = (v2u){cvtpk(y[0], y[1]), cvtpk(y[2], y[3])};
        }
    }
}
__device__ __forceinline__ void final_norm_phase(float* io, const float* g, int G) {
    const int tid = opaque_tid(), lane = tid & 63, wave = __builtin_amdgcn_readfirstlane(tid >> 6);
    const int gw = blockIdx.x * NWAVES + wave, NGW = G * NWAVES;
    f32x4 gv[4];
#pragma unroll
    for (int j = 0; j < 4; ++j) gv[j] = *((const f32x4*)g + lane + 64 * j);
    for (int row = gw; row < ML; row += NGW) {
        float* xr = io + (size_t)row * DM;
        f32x4 v[4]; float s = 0.f;
#pragma unroll
        for (int j = 0; j < 4; ++j) { v[j] = *((const f32x4*)xr + lane + 64 * j); s += (v[j][0] * v[j][0] + v[j][1] * v[j][1]) + (v[j][2] * v[j][2] + v[j][3] * v[j][3]); }
        const float rstd = rsqrtf(wave_sum(s) * (1.0f / DM) + EPS);
#pragma unroll
        for (int j = 0; j < 4; ++j) *((f32x4*)xr + lane + 64 * j) = v[j] * rstd * gv[j];
    }
}

#define XB_TMO      128
#define XB_XCNT(j)  (256  + 64 * (j))
#define XB_XSUB(j)  (1280 + 64 * (j))
#define XB_XGEN(j)  (2304 + 64 * (j))
#define XB_TOP      3328
#define XB_TOPGEN   3392
#define XCD_BAR_WORDS 3456
#define XB_SPIN_CAP (1u << 18)

__device__ __forceinline__ unsigned xb_ld(unsigned* p)              { return __hip_atomic_load(p, __ATOMIC_RELAXED, __HIP_MEMORY_SCOPE_AGENT); }
__device__ __forceinline__ unsigned xb_add(unsigned* p, unsigned v) { return __hip_atomic_fetch_add(p, v, __ATOMIC_RELAXED, __HIP_MEMORY_SCOPE_AGENT); }
__device__ __forceinline__ unsigned xb_xcc_id() { return (unsigned)__builtin_amdgcn_s_getreg((3 << 11) | 20) & 0xFu; }
#define XB_SPIN(cond, bar) do { unsigned _sp = 0; while (cond) { __builtin_amdgcn_s_sleep(1); \
    if ((++_sp & 255u) == 0u) { if (xb_ld(&(bar)[XB_TMO])) break; if (_sp > XB_SPIN_CAP) { atomicAdd(&(bar)[XB_TMO], 1u); break; } } } } while (0)

struct XcdBarrier {
    unsigned* bar; unsigned x;
    volatile LAS unsigned* st;
};

__device__ __forceinline__ XcdBarrier xcd_barrier_post(unsigned* bar, volatile LAS unsigned* st) {
    XcdBarrier b; b.bar = bar; b.x = xb_xcc_id(); b.st = st;
    if (threadIdx.x == 0) (void)xb_add(&bar[XB_XCNT(b.x)], 1u);
    return b;
}
__device__ __forceinline__ void xcd_barrier_complete(unsigned* bar, unsigned x, unsigned& nloc, unsigned& nx) {
    const unsigned G = gridDim.x * gridDim.y * gridDim.z;
    unsigned sum, cnt, mine, sp = 0u;
    for (;;) {
        sum = 0u; cnt = 0u; mine = 0u;
#pragma unroll
        for (unsigned j = 0; j < 16; ++j) { const unsigned c = xb_ld(&bar[XB_XCNT(j)]); sum += c; cnt += (c > 0u) ? 1u : 0u; mine = (j == x) ? c : mine; }
        if (sum == G) break;
        __builtin_amdgcn_s_sleep(1);
        if ((++sp & 255u) == 0u) { if (xb_ld(&bar[XB_TMO])) break; if (sp > XB_SPIN_CAP) { atomicAdd(&bar[XB_TMO], 1u); break; } }
    }
    nloc = mine > 0u ? mine : 1u; nx = cnt > 0u ? cnt : 1u;
}

__device__ __forceinline__ void xcd_barrier(const XcdBarrier& b) {
    asm volatile("s_waitcnt vmcnt(0)" ::: "memory");
    __syncthreads();
    if (threadIdx.x == 0) {
        unsigned* bar = b.bar; unsigned bx = b.x; asm volatile("" : "+s"(bar), "+s"(bx));
        __builtin_amdgcn_s_waitcnt(0);
        unsigned nloc = b.st[0], nx = b.st[1];
        const unsigned old = xb_add(&bar[XB_XSUB(bx)], 1u);
        const unsigned gen = old / nloc;
        if (old + 1u == (gen + 1u) * nloc) {
            __builtin_amdgcn_fence(__ATOMIC_RELEASE, "agent");
            asm volatile("s_waitcnt vmcnt(0)" ::: "memory");
            const unsigned og = xb_add(&bar[XB_TOP], 1u);
            const unsigned tg = og / nx;
            if (og + 1u == (tg + 1u) * nx) xb_add(&bar[XB_TOPGEN], 1u);
            else XB_SPIN(xb_ld(&bar[XB_TOPGEN]) == tg, bar);
            __builtin_amdgcn_fence(__ATOMIC_ACQUIRE, "agent");
            xb_add(&bar[XB_XGEN(bx)], 1u);
            asm volatile("s_waitcnt vmcnt(0)" ::: "memory");
        } else {
            XB_SPIN(xb_ld(&bar[XB_XGEN(bx)]) == gen, bar);
            __builtin_amdgcn_fence(__ATOMIC_ACQUIRE, "agent");
            asm volatile("s_waitcnt vmcnt(0)" ::: "memory");
        }
    }
    __syncthreads();
}


__device__ __forceinline__ void xcd_barrier_census(const XcdBarrier& b) {
    if (threadIdx.x == 0) { unsigned nloc, nx; xcd_barrier_complete(b.bar, b.x, nloc, nx); b.st[0] = nloc; b.st[1] = nx; }
    __syncthreads();
}

typedef float f32x4m __attribute__((ext_vector_type(4)));
#define MFMA16(a, b, c) __builtin_amdgcn_mfma_f32_16x16x32_bf16((a), (b), (c), 0, 0, 0)
__device__ __forceinline__ unsigned off_b(unsigned row, unsigned ch) { return 256u * row + 16u * (ch ^ (((row & 3u) << 2) | ((row >> 2) & 3u))); }
__device__ __forceinline__ bf16x8 tr_frag(LAS unsigned char* tile, int lane, int c, int ks) {
    const unsigned g = lane >> 4, q = (lane & 15) >> 2, p = lane & 3;
    const s16x4 lo = __builtin_amdgcn_ds_read_tr16_b64_v4i16((LAS s16x4*)(tile + off_b(32 * ks + 8 * g + q, 2 * c + (p >> 1)) + 8 * (p & 1)));
    const s16x4 hi = __builtin_amdgcn_ds_read_tr16_b64_v4i16((LAS s16x4*)(tile + off_b(32 * ks + 8 * g + 4 + q, 2 * c + (p >> 1)) + 8 * (p & 1)));
    return (bf16x8){lo[0], lo[1], lo[2], lo[3], hi[0], hi[1], hi[2], hi[3]};
}
__device__ __forceinline__ bf16x8 pack8(const f32x4 a, const f32x4 b) {
    v4u w; w.x = cvtpk(a[0], a[1]); w.y = cvtpk(a[2], a[3]); w.z = cvtpk(b[0], b[1]); w.w = cvtpk(b[2], b[3]);
    return __builtin_bit_cast(bf16x8, w);
}
__device__ __forceinline__ float log_sigmoid(float x) { return -log1pf(expf(-x)); }

__device__ __forceinline__ int ret_row0(int b, int s) { return s < 2 ? ML + b * CTXL + s * 128 : b * SEQ + (s - 2) * 128; }

__device__ __forceinline__ void r1_unit(KArgs a, LAS unsigned char* lds, int unit) {
    const int tid = opaque_tid(), lane = tid & 63, wave = __builtin_amdgcn_readfirstlane(tid >> 6);
    const int s = unit % 34, bh = unit / 34, h = bh & 3, b = bh >> 2, row0 = ret_row0(b, s);
    const bf16* QKVG = (const bf16*)(a->ws + WS_QKVG);
    const float lgf = log_sigmoid(a->in[I_DECAY][h]), lgb = log_sigmoid(a->in[I_DECAY][4 + h]);
#pragma unroll
    for (int it = 0; it < 4; ++it) {
        const int n = tid + NTHREADS * it, row = n >> 4, ch = n & 15;
        const bf16* kp = QKVG + (size_t)(row0 + row) * 2048 + 512 + 128 * h + 8 * ch;
        const v4u kv = *(const v4u*)kp, vv = *(const v4u*)(kp + 512);
        const float wf = expf(lgf * (float)(127 - row)), wb = expf(lgb * (float)row);
        v4u kf, kb;
        kf.x = cvtpk(blo(kv.x) * wf, bhi(kv.x) * wf); kf.y = cvtpk(blo(kv.y) * wf, bhi(kv.y) * wf); kf.z = cvtpk(blo(kv.z) * wf, bhi(kv.z) * wf); kf.w = cvtpk(blo(kv.w) * wf, bhi(kv.w) * wf);
        kb.x = cvtpk(blo(kv.x) * wb, bhi(kv.x) * wb); kb.y = cvtpk(blo(kv.y) * wb, bhi(kv.y) * wb); kb.z = cvtpk(blo(kv.z) * wb, bhi(kv.z) * wb); kb.w = cvtpk(blo(kv.w) * wb, bhi(kv.w) * wb);
        const unsigned o = off_b(row, ch);
        *(LAS v4u*)(lds + o) = kf; *(LAS v4u*)(lds + 32768 + o) = kb; *(LAS v4u*)(lds + 65536 + o) = vv;
    }
    __syncthreads();
    f32x4 accf[8], accb[8];
#pragma unroll
    for (int c = 0; c < 8; ++c) { accf[c] = (f32x4){0.f, 0.f, 0.f, 0.f}; accb[c] = (f32x4){0.f, 0.f, 0.f, 0.f}; }
#pragma unroll
    for (int ks = 0; ks < 4; ++ks) {
        const bf16x8 kf = tr_frag(lds, lane, wave, ks), kb = tr_frag(lds + 32768, lane, wave, ks);
#pragma unroll
        for (int c = 0; c < 8; ++c) { const bf16x8 vf = tr_frag(lds + 65536, lane, c, ks); accf[c] = MFMA16(kf, vf, accf[c]); accb[c] = MFMA16(kb, vf, accb[c]); }
    }
    bf16* Sf = (bf16*)(a->ws + WS_KVS) + ((size_t)(bh * 2 + 0) * 34 + s) * 16384;
    bf16* Sb = (bf16*)(a->ws + WS_KVS) + ((size_t)(bh * 2 + 1) * 34 + s) * 16384;
    const int d0 = 16 * wave + 4 * (lane >> 4);
#pragma unroll
    for (int c = 0; c < 8; ++c) { const int e = 16 * c + (lane & 15);
        *(v2u*)(Sf + e * 128 + d0) = (v2u){cvtpk(accf[c][0], accf[c][1]), cvtpk(accf[c][2], accf[c][3])};
        *(v2u*)(Sb + e * 128 + d0) = (v2u){cvtpk(accb[c][0], accb[c][1]), cvtpk(accb[c][2], accb[c][3])}; }
    __syncthreads();
}

__device__ __forceinline__ void r2_items(KArgs a, int G) {
    const int gtid = blockIdx.x * NTHREADS + opaque_tid(), GT = G * NTHREADS;
    for (int idx = gtid; idx < 32 * 4096; idx += GT) {
        const int bhd = idx >> 12, o4 = idx & 4095, dir = bhd & 1, h = (bhd >> 1) & 3;
        const float decay = expf(log_sigmoid(a->in[I_DECAY][dir * 4 + h]) * 128.0f);
        bf16* base = (bf16*)(a->ws + WS_KVS) + (size_t)bhd * 34 * 16384 + o4 * 4;
        const long step = dir == 0 ? 16384 : -16384;
        bf16* p0 = base + (dir == 0 ? 0 : 16384); bf16* p2 = base + (dir == 0 ? 2 * 16384 : 33 * 16384);
        v2u v[34];
        { bf16* p = p0;
#pragma unroll
          for (int i = 0; i < 34; ++i) { if (i == 2) p = p2; v[i] = *(const v2u*)p; p += step; asm volatile("" : "+v"(p)); } }
        float st0 = 0.f, st1 = 0.f, st2 = 0.f, st3 = 0.f;
        { bf16* p = p0;
#pragma unroll
          for (int i = 0; i < 34; ++i) { if (i == 2) p = p2;
            *(v2u*)p = (v2u){cvtpk(st0, st1), cvtpk(st2, st3)}; p += step; asm volatile("" : "+v"(p));
            st0 = fmaf(decay, st0, blo(v[i].x)); st1 = fmaf(decay, st1, bhi(v[i].x)); st2 = fmaf(decay, st2, blo(v[i].y)); st3 = fmaf(decay, st3, bhi(v[i].y)); } }
    }
}

__device__ __forceinline__ void r3_unit(KArgs a, LAS unsigned char* lds, int unit) {
    const int tid = opaque_tid(), lane = tid & 63, wave = __builtin_amdgcn_readfirstlane(tid >> 6);
    const int s = unit % 34, bh = unit / 34, h = bh & 3, b = bh >> 2, row0 = ret_row0(b, s);
    const bf16* QKVG = (const bf16*)(a->ws + WS_QKVG);
    const float l2f = log_sigmoid(a->in[I_DECAY][h]) * 1.4426950408889634f, l2b = log_sigmoid(a->in[I_DECAY][4 + h]) * 1.4426950408889634f;
    const bf16* Sf = (const bf16*)(a->ws + WS_KVS) + ((size_t)(bh * 2 + 0) * 34 + s) * 16384;
    const bf16* Sb = (const bf16*)(a->ws + WS_KVS) + ((size_t)(bh * 2 + 1) * 34 + s) * 16384;
    {
        v4u t[8];
#pragma unroll
        for (int it = 0; it < 4; ++it) { const int n = tid + NTHREADS * it, row = n >> 4, ch = n & 15; const bf16* gp = QKVG + (size_t)(row0 + row) * 2048 + 512 + 128 * h + 8 * ch;
            t[it] = *(const v4u*)(gp + 512); t[4 + it] = *(const v4u*)gp; }
#pragma unroll
        for (int it = 0; it < 4; ++it) { const int n = tid + NTHREADS * it, row = n >> 4, ch = n & 15; const unsigned o = off_b(row, ch);
            *(LAS v4u*)(lds + o) = t[it]; *(LAS v4u*)(lds + 32768 + o) = t[4 + it]; }
#pragma unroll
        for (int it = 0; it < 4; ++it) { const int n = tid + NTHREADS * it; t[it] = *(const v4u*)(Sf + (size_t)n * 8); t[4 + it] = *(const v4u*)(Sb + (size_t)n * 8); }
#pragma unroll
        for (int it = 0; it < 4; ++it) { const int n = tid + NTHREADS * it, row = n >> 4, ch = n & 15; const unsigned o = off_b(row, ch);
            *(LAS v4u*)(lds + 65536 + o) = t[it]; *(LAS v4u*)(lds + 98304 + o) = t[4 + it]; }
    }
    const int fr = lane & 15, g = lane >> 4;
    bf16x8 qf[4];
#pragma unroll
    for (int ks = 0; ks < 4; ++ks) qf[ks] = *(const bf16x8*)(QKVG + (size_t)(row0 + 16 * wave + fr) * 2048 + 128 * h + 32 * ks + 8 * g);
    __syncthreads();
    f32x4 acco[8];
#pragma unroll
    for (int c = 0; c < 8; ++c) acco[c] = (f32x4){0.f, 0.f, 0.f, 0.f};
    const int iq = 16 * wave + fr;
#pragma unroll
    for (int jt = 0; jt < 4; ++jt) {
        f32x4 sa = (f32x4){0.f, 0.f, 0.f, 0.f}, sb = sa;
        const int ja = 32 * jt + 8 * (fr >> 2) + (fr & 3);
#pragma unroll
        for (int ks = 0; ks < 4; ++ks) {
            const bf16x8 ka = *(const LAS bf16x8*)(lds + 32768 + off_b(ja, 4 * ks + g)), kb = *(const LAS bf16x8*)(lds + 32768 + off_b(ja + 4, 4 * ks + g));
            sa = MFMA16(ka, qf[ks], sa); sb = MFMA16(kb, qf[ks], sb);
        }
        f32x4 pa, pb;
#pragma unroll
        for (int r = 0; r < 4; ++r) {
            const int j0 = 32 * jt + 8 * g + r, d0 = iq - j0, d1 = d0 - 4;
            const float w0 = (d0 >= 0 ? __builtin_amdgcn_exp2f(l2f * (float)d0) : 0.f) + (d0 <= 0 ? __builtin_amdgcn_exp2f(-l2b * (float)d0) : 0.f);
            const float w1 = (d1 >= 0 ? __builtin_amdgcn_exp2f(l2f * (float)d1) : 0.f) + (d1 <= 0 ? __builtin_amdgcn_exp2f(-l2b * (float)d1) : 0.f);
            pa[r] = sa[r] * w0; pb[r] = sb[r] * w1;
        }
        const bf16x8 pf = pack8(pa, pb);
#pragma unroll
        for (int c = 0; c < 8; ++c) { const bf16x8 vf = tr_frag(lds, lane, c, jt); acco[c] = MFMA16(pf, vf, acco[c]); }
    }
    float ff[4], fb[4];
#pragma unroll
    for (int r = 0; r < 4; ++r) { const int i = 16 * wave + 4 * g + r; ff[r] = __builtin_amdgcn_exp2f(l2f * (float)(i + 1)); fb[r] = __builtin_amdgcn_exp2f(l2b * (float)(128 - i)); }
    float ss[4] = {0.f, 0.f, 0.f, 0.f};
#pragma unroll
    for (int c = 0; c < 8; ++c) {
        f32x4 t1 = (f32x4){0.f, 0.f, 0.f, 0.f}, t2 = t1;
#pragma unroll
        for (int ks = 0; ks < 4; ++ks) {
            const unsigned o = off_b(16 * c + fr, 4 * ks + g);
            t1 = MFMA16(qf[ks], *(const LAS bf16x8*)(lds + 65536 + o), t1); t2 = MFMA16(qf[ks], *(const LAS bf16x8*)(lds + 98304 + o), t2);
        }
#pragma unroll
        for (int r = 0; r < 4; ++r) { const float o = acco[c][r] + ff[r] * t1[r] + fb[r] * t2[r]; acco[c][r] = o; ss[r] = fmaf(o, o, ss[r]); }
    }
#pragma unroll
    for (int r = 0; r < 4; ++r) { float v = ss[r]; v += __shfl_xor(v, 1); v += __shfl_xor(v, 2); v += __shfl_xor(v, 4); v += __shfl_xor(v, 8); ss[r] = rsqrtf(v * (1.0f / 128.0f) + EPS); }
    __syncthreads();
    LAS unsigned short* ost = (LAS unsigned short*)(lds + 32768 + wave * 4096);
#pragma unroll
    for (int r = 0; r < 4; ++r)
#pragma unroll
        for (int c = 0; c < 8; ++c) ost[(4 * g + r) * 128 + 16 * c + fr] = (unsigned short)f2bf(acco[c][r] * ss[r]);
    asm volatile("s_waitcnt lgkmcnt(0)" ::: "memory");
    bf16* YM = (bf16*)(a->ws + WS_XN);
#pragma unroll
    for (int it = 0; it < 4; ++it) {
        const int n = lane + 64 * it, rr = n >> 4, ch = n & 15; const size_t row = (size_t)(row0 + 16 * wave + rr);
        const v4u ov = *(const LAS v4u*)(ost + rr * 128 + 8 * ch), gv = *(const v4u*)(QKVG + row * 2048 + 1536 + 128 * h + 8 * ch);
        v4u y;
        y.x = cvtpk(blo(ov.x) * pg8::fsilu(blo(gv.x)), bhi(ov.x) * pg8::fsilu(bhi(gv.x))); y.y = cvtpk(blo(ov.y) * pg8::fsilu(blo(gv.y)), bhi(ov.y) * pg8::fsilu(bhi(gv.y)));
        y.z = cvtpk(blo(ov.z) * pg8::fsilu(blo(gv.z)), bhi(ov.z) * pg8::fsilu(bhi(gv.z))); y.w = cvtpk(blo(ov.w) * pg8::fsilu(blo(gv.w)), bhi(ov.w) * pg8::fsilu(bhi(gv.w)));
        *(v4u*)(YM + row * DM + 128 * h + 8 * ch) = y;
    }
    __syncthreads();
}

__device__ __forceinline__ int s5_row0(int b, int c) { return c < 4 ? ML + b * CTXL + 64 * c : b * SEQ + 64 * (c - 4); }
constexpr int S5_WLDS = 12288;

__device__ __forceinline__ void s5_bu_block(const bf16x8 (&bbm)[8], const bf16* urow  , LAS unsigned char* bu, int fr, int gq) {
    bf16x8 uf = (bf16x8){0, 0, 0, 0, 0, 0, 0, 0};
    if (gq < 2) uf = *(const bf16x8*)urow;
#pragma unroll
    for (int j = 0; j < 8; ++j) {
        const f32x4 d = MFMA16(bbm[j], uf, ((f32x4){0.f, 0.f, 0.f, 0.f}));
        *(LAS v2u*)(bu + fr * 256 + (((2 * j + (gq >> 1)) ^ fr) * 16) + (gq & 1) * 8) = (v2u){cvtpk(d[0], d[1]), cvtpk(d[2], d[3])};
    }
    asm volatile("s_waitcnt lgkmcnt(0)" ::: "memory");
}
#define S5_BUREAD(tl_) ({ const unsigned w_ = *(const LAS unsigned*)(bu + (tl_) * 256 + (((p >> 2) ^ (tl_)) * 16) + (p & 3) * 4); (f32x2){blo(w_), bhi(w_)}; })
#define S5_UPD(bu_)  { const f32x2 xs_ = (f32x2){xv.y, xv.x}; xv = lrr * xv + (lmi * xs_ + (bu_)); }

__device__ __forceinline__ void s1_unit(KArgs a, LAS unsigned char* wl, int wu, int lane) {
    const int c = wu % 68, bgd = wu / 68, dir = bgd & 1, g = (bgd >> 1) & 31, b = bgd >> 6, dg = dir * 32 + g, p = lane, fr = lane & 15, gq = lane >> 4;
    LAS unsigned char* bu = wl;
    const f32x2 lb = ((const f32x2*)(a->ws + WS_LB))[dg * 64 + p]; const f32x2 lrr = (f32x2){lb.x, lb.x}, lmi = (f32x2){-lb.y, lb.y};
    bf16x8 bbm[8];
#pragma unroll
    for (int j = 0; j < 8; ++j) { bbm[j] = (bf16x8){0, 0, 0, 0, 0, 0, 0, 0}; if (gq < 2) bbm[j] = *(const bf16x8*)((const bf16*)(a->ws + WS_BBM) + ((size_t)dg * 128 + 16 * j + fr) * 16 + 8 * gq); }
    const bf16* ub = (const bf16*)(a->ws + WS_U) + (size_t)(s5_row0(b, c) + fr) * 512 + 16 * g + 8 * (gq & 1);
    f32x2 xv = (f32x2){0.f, 0.f};
    for (int blk = 0; blk < 4; ++blk) {
        const int tb = dir ? 3 - blk : blk;
        s5_bu_block(bbm, ub + (size_t)(16 * tb) * 512, bu, fr, gq);
        if (dir == 0) {
#pragma unroll
            for (int tl = 0; tl < 16; ++tl) { const f32x2 bv = S5_BUREAD(tl); S5_UPD(bv) }
        } else {
#pragma unroll
            for (int tl = 15; tl >= 0; --tl) { const f32x2 bv = S5_BUREAD(tl); S5_UPD(bv) }
        }
        asm volatile("s_waitcnt lgkmcnt(0)" ::: "memory");
    }
    ((f32x2*)(a->ws + WS_SF))[(size_t)wu * 64 + p] = xv;
}
__device__ __forceinline__ void s2_items(KArgs a, int G) {
    const int gtid = blockIdx.x * NTHREADS + opaque_tid(), GT = G * NTHREADS;
    for (int idx = gtid; idx < 4 * 32 * 2 * 64; idx += GT) {
        const int p = idx & 63, bgd = idx >> 6, dir = bgd & 1, g = (bgd >> 1) & 31, dg = dir * 32 + g;
        const f32x2 lt = ((const f32x2*)(a->ws + WS_LBT))[dg * 64 + p];
        f32x2* base = (f32x2*)(a->ws + WS_SF) + (size_t)bgd * 68 * 64 + p;
        const long step = dir == 0 ? 64 : -64;
        f32x2* q0 = base + (dir == 0 ? 0 : 3 * 64); f32x2* q4 = base + (dir == 0 ? 4 * 64 : 67 * 64);
        float cr = 0.f, ci = 0.f;
        f32x2* pl = q0; f32x2* ps = q0;
#pragma unroll
        for (int hb = 0; hb < 2; ++hb) {
            f32x2 v[34];
#pragma unroll
            for (int j = 0; j < 34; ++j) { if (34 * hb + j == 4) pl = q4; v[j] = *pl; pl += step; asm volatile("" : "+v"(pl)); }
#pragma unroll
            for (int j = 0; j < 34; ++j) { if (34 * hb + j == 4) ps = q4; *ps = (f32x2){cr, ci}; ps += step; asm volatile("" : "+v"(ps));
                const float nr = fmaf(lt.x, cr, fmaf(-lt.y, ci, v[j].x)), ni = fmaf(lt.x, ci, fmaf(lt.y, cr, v[j].y)); cr = nr; ci = ni; }
        }
    }
}
__device__ __forceinline__ void s3_unit(KArgs a, LAS unsigned char* wl, int wu, int lane) {
    const int c = wu % 68, bg = wu / 68, g = bg & 31, b = bg >> 5, p = lane, fr = lane & 15, gq = lane >> 4;
    LAS unsigned char* bu = wl; LAS unsigned char* xs = wl + 4096;
    const int rowbase = s5_row0(b, c);
    const bf16* ub = (const bf16*)(a->ws + WS_U) + (size_t)(rowbase + fr) * 512 + 16 * g + 8 * (gq & 1);
    f32x4 acc[4];
#pragma unroll
    for (int i = 0; i < 4; ++i) acc[i] = (f32x4){0.f, 0.f, 0.f, 0.f};
#pragma unroll
    for (int dir = 0; dir < 2; ++dir) {
        const int dg = dir * 32 + g;
        const f32x2 lb = ((const f32x2*)(a->ws + WS_LB))[dg * 64 + p]; const f32x2 lrr = (f32x2){lb.x, lb.x}, lmi = (f32x2){-lb.y, lb.y};
        bf16x8 bbm[8];
#pragma unroll
        for (int j = 0; j < 8; ++j) { bbm[j] = (bf16x8){0, 0, 0, 0, 0, 0, 0, 0}; if (gq < 2) bbm[j] = *(const bf16x8*)((const bf16*)(a->ws + WS_BBM) + ((size_t)dg * 128 + 16 * j + fr) * 16 + 8 * gq); }
        bf16x8 cm[4];
#pragma unroll
        for (int ks = 0; ks < 4; ++ks) cm[ks] = *(const bf16x8*)((const bf16*)(a->ws + WS_CM) + (size_t)(dg * 16 + fr) * 128 + 32 * ks + 8 * gq);
        f32x2 xv = ((const f32x2*)(a->ws + WS_SF))[((size_t)((b * 32 + g) * 2 + dir) * 68 + c) * 64 + p];
#pragma unroll
        for (int half = 0; half < 2; ++half) {
            const int hs = dir ? 1 - half : half;
#pragma unroll
            for (int q = 0; q < 2; ++q) {
                const int tq = dir ? 1 - q : q;
                s5_bu_block(bbm, ub + (size_t)(32 * hs + 16 * tq) * 512, bu, fr, gq);
#define S5_XST(tl_) *(LAS unsigned*)(xs + (16 * tq + (tl_)) * 256 + (((p >> 2) ^ (tl_)) * 16) + (p & 3) * 4) = cvtpk(xv.x, xv.y);
                if (dir == 0) {
#pragma unroll
                    for (int tl = 0; tl < 16; ++tl) { const f32x2 bv = S5_BUREAD(tl); S5_UPD(bv) S5_XST(tl) }
                } else {
#pragma unroll
                    for (int tl = 15; tl >= 0; --tl) { const f32x2 bv = S5_BUREAD(tl); S5_UPD(bv) S5_XST(tl) }
                }
#undef S5_XST
                asm volatile("s_waitcnt lgkmcnt(0)" ::: "memory");
            }
#pragma unroll
            for (int th = 0; th < 2; ++th) {
                const int row = 16 * th + fr;
                f32x4 d = acc[2 * hs + th];
#pragma unroll
                for (int ks = 0; ks < 4; ++ks) { const bf16x8 xf = *(const LAS bf16x8*)(xs + row * 256 + (((4 * ks + gq) ^ (row & 15)) * 16)); d = MFMA16(cm[ks], xf, d); }
                acc[2 * hs + th] = d;
            }
            asm volatile("s_waitcnt lgkmcnt(0)" ::: "memory");
        }
    }
    const f32x4 dsk = *(const f32x4*)(a->in[I_S5D] + 16 * g + 4 * gq);
    bf16* YS = (bf16*)(a->ws + WS_YS);
#pragma unroll
    for (int T4 = 0; T4 < 4; ++T4) {
        const int t = 16 * T4 + fr; const v2u uw = *(const v2u*)((const bf16*)(a->ws + WS_U) + (size_t)(rowbase + t) * 512 + 16 * g + 4 * gq);
        const f32x4 y = acc[T4] + dsk * (f32x4){blo(uw.x), bhi(uw.x), blo(uw.y), bhi(uw.y)};
        *(v2u*)(YS + (size_t)(rowbase + t) * 512 + 16 * g + 4 * gq) = (v2u){cvtpk(gelu_tanh(y[0]), gelu_tanh(y[1])), cvtpk(gelu_tanh(y[2]), gelu_tanh(y[3]))};
    }
}

constexpr int NA_KSTR = 144, NA_VSTR = 976, NA_VCSTR = 528;
constexpr int NA_VOFF = 480 * NA_KSTR;
constexpr int NA_VCOFF = 256 * NA_KSTR;
__device__ __forceinline__ void na_unit(KArgs a, LAS unsigned char* lds, int unit) {
    const int tid = opaque_tid(), lane = tid & 63, wave = __builtin_amdgcn_readfirstlane(tid >> 6);
    const int rb = unit & 7, cb = (unit >> 3) & 3, h = (unit >> 5) & 15, b = unit >> 9, fr = lane & 15, g = lane >> 4;
    const bf16* QK = (const bf16*)(a->ws + WS_QK); const bf16* VT = (const bf16*)(a->ws + WS_VT); bf16* AO = (bf16*)(a->ws + WS_XN);
    const int kcol0 = min(max(16 * cb - 8, 0), 32);
    const int Rlo = min(max(8 * rb - 4, 0), 56), nrows = min(max(8 * rb + 3, 0), 56) + 8 - Rlo;
    const int r = 8 * rb + wave, r0 = min(max(r - 4, 0), 56);
    {
        const bf16* kg = QK + (size_t)(b * SEQ + Rlo * 64 + kcol0) * 2048 + 1024 + 64 * h;
        { v4u t[8]; const int lim = nrows * 256;
#pragma unroll
          for (int it = 0; it < 8; ++it) { const int n = tid + NTHREADS * it, key = n >> 3, ch = n & 7, kr = key >> 5, co = key & 31; if (n < lim) t[it] = *(const v4u*)(kg + (size_t)(kr * 64 + co) * 2048 + 8 * ch); }
#pragma unroll
          for (int it = 0; it < 8; ++it) { const int n = tid + NTHREADS * it, key = n >> 3, ch = n & 7; if (n < lim) *(LAS v4u*)(lds + key * NA_KSTR + ch * 16) = t[it]; } }
        const bf16* vg = VT + (size_t)(64 * h) * MT + b * SEQ + Rlo * 64 + kcol0;
        { v4u t[8];
#pragma unroll
          for (int it = 0; it < 8; ++it) { const int n = tid + NTHREADS * it, d = n / 60, rem = n - d * 60, kr = rem >> 2, c4 = rem & 3; if (n < 64 * 60 && kr < nrows) t[it] = *(const v4u*)(vg + (size_t)d * MT + kr * 64 + 8 * c4); }
#pragma unroll
          for (int it = 0; it < 8; ++it) { const int n = tid + NTHREADS * it, d = n / 60, rem = n - d * 60, kr = rem >> 2, c4 = rem & 3; if (n < 64 * 60 && kr < nrows) *(LAS v4u*)(lds + NA_VOFF + d * NA_VSTR + (kr * 32 + 8 * c4) * 2) = t[it]; } }
    }
    const int tq0 = b * SEQ + r * 64 + 16 * cb;
    const bf16* qb = QK + (size_t)tq0 * 2048 + 64 * h;
    const unsigned qoff = (unsigned)(fr * 2048 + 8 * g);
    bf16x8 qf[2]; qf[0] = *(const bf16x8*)(qb + qoff); qf[1] = *(const bf16x8*)(qb + qoff + 32);
    const int koffl = (8 * (fr >> 2) + (fr & 3)) * NA_KSTR + 16 * g;
    const int cq = 16 * cb + fr, ws = min(max(cq - 8, 0), 48);
    const int vbase = kcol0 + 8 * g - ws, ibase = kcol0 + 8 * g - cq + 15;
    const float* rpb = a->in[I_RPB] + (size_t)h * 15 * 31;
    f32x4 o[4];
#pragma unroll
    for (int dt = 0; dt < 4; ++dt) o[dt] = (f32x4){0.f, 0.f, 0.f, 0.f};
    float mrun = -1e30f, lsum = 0.f;
    __syncthreads();
#pragma unroll 1
    for (int half = 0; half < 2; ++half) {
        if (half == 1) {
            __syncthreads();
            const bf16* kg = QK + (size_t)(ML + b * CTXL) * 2048 + 1024 + 64 * h;
            v4u t[8];
#pragma unroll
            for (int it = 0; it < 4; ++it) { const int n = tid + NTHREADS * it, key = n >> 3, ch = n & 7; t[it] = *(const v4u*)(kg + (size_t)key * 2048 + 8 * ch); }
            const bf16* vg = VT + (size_t)(64 * h) * MT + ML + b * CTXL;
#pragma unroll
            for (int it = 0; it < 4; ++it) { const int n = tid + NTHREADS * it, d = n >> 5, c = n & 31; t[4 + it] = *(const v4u*)(vg + (size_t)d * MT + 8 * c); }
#pragma unroll
            for (int it = 0; it < 4; ++it) { const int n = tid + NTHREADS * it, key = n >> 3, ch = n & 7; *(LAS v4u*)(lds + key * NA_KSTR + ch * 16) = t[it]; }
#pragma unroll
            for (int it = 0; it < 4; ++it) { const int n = tid + NTHREADS * it, d = n >> 5, c = n & 31; *(LAS v4u*)(lds + NA_VCOFF + d * NA_VCSTR + c * 16) = t[4 + it]; }
            __syncthreads();
        }
        const int kbase = half == 0 ? (r0 - Rlo) * 32 : 0;
        const LAS unsigned char* kl = lds + kbase * NA_KSTR + koffl;
        const LAS unsigned char* vl = half == 0 ? lds + NA_VOFF + fr * NA_VSTR + (kbase + 8 * g) * 2 : lds + NA_VCOFF + fr * NA_VCSTR + (8 * g) * 2;
        const int vstr16 = 16 * (half == 0 ? NA_VSTR : NA_VCSTR);
#pragma unroll 1
        for (int qt = 0; qt < 2; ++qt) {
            f32x4 sc[4][2];
#pragma unroll
            for (int ii = 0; ii < 4; ++ii) {
                const int i = 4 * qt + ii;
                const LAS unsigned char* kp = kl + i * 32 * NA_KSTR;
                f32x4 sa = (f32x4){0.f, 0.f, 0.f, 0.f}, sb = sa;
                sa = MFMA16(*(const LAS bf16x8*)kp, qf[0], sa); sa = MFMA16(*(const LAS bf16x8*)(kp + 64), qf[1], sa);
                sb = MFMA16(*(const LAS bf16x8*)(kp + 4 * NA_KSTR), qf[0], sb); sb = MFMA16(*(const LAS bf16x8*)(kp + 4 * NA_KSTR + 64), qf[1], sb);
                if (half == 0) {
                    const float* bp = rpb + (r0 + i - r + 7) * 31;
#pragma unroll
                    for (int rr = 0; rr < 4; ++rr) { const float b0 = bp[min(max(ibase + rr, 0), 30)], b1 = bp[min(max(ibase + 4 + rr, 0), 30)];
                        sa[rr] = (unsigned)(vbase + rr) < 16u ? sa[rr] + b0 : -1e30f; sb[rr] = (unsigned)(vbase + 4 + rr) < 16u ? sb[rr] + b1 : -1e30f; }
                }
                sc[ii][0] = sa; sc[ii][1] = sb;
            }
            float mx = -1e30f;
#pragma unroll
            for (int ii = 0; ii < 4; ++ii)
#pragma unroll
                for (int t = 0; t < 2; ++t) mx = fmaxf(mx, fmaxf(fmaxf(sc[ii][t][0], sc[ii][t][1]), fmaxf(sc[ii][t][2], sc[ii][t][3])));
            mx = fmaxf(mx, __shfl_xor(mx, 16)); mx = fmaxf(mx, __shfl_xor(mx, 32));
            const float mnew = fmaxf(mrun, mx);
            const float resc = __builtin_amdgcn_exp2f((mrun - mnew) * 1.4426950408889634f);
            mrun = mnew; lsum *= resc;
#pragma unroll
            for (int dt = 0; dt < 4; ++dt) o[dt] = o[dt] * resc;
            const float mneg = -mnew * 1.4426950408889634f;
            float ls = 0.f;
#pragma unroll
            for (int ii = 0; ii < 4; ++ii)
#pragma unroll
                for (int t = 0; t < 2; ++t)
#pragma unroll
                    for (int rr = 0; rr < 4; ++rr) { const float pv = __builtin_amdgcn_exp2f(fmaf(sc[ii][t][rr], 1.4426950408889634f, mneg)); sc[ii][t][rr] = pv; ls += pv; }
            lsum += ls;
#pragma unroll
            for (int ii = 0; ii < 4; ++ii) {
                const bf16x8 pf = pack8(sc[ii][0], sc[ii][1]);
#pragma unroll
                for (int dt = 0; dt < 4; ++dt) o[dt] = MFMA16(*(const LAS bf16x8*)(vl + dt * vstr16 + (4 * qt + ii) * 64), pf, o[dt]);
            }
        }
    }
    lsum += __shfl_xor(lsum, 16); lsum += __shfl_xor(lsum, 32);
    const float rl = 1.0f / lsum;
    bf16* ob = AO + (size_t)tq0 * DM + 64 * h;
#pragma unroll
    for (int dt = 0; dt < 4; ++dt)
        *(v2u*)(ob + (unsigned)(fr * DM + 16 * dt + 4 * g)) = (v2u){cvtpk(o[dt][0] * rl, o[dt][1] * rl), cvtpk(o[dt][2] * rl, o[dt][3] * rl)};
    __syncthreads();
}

#ifndef STAGE
#define STAGE 6
#endif
#define GSYNC() xcd_barrier(bar)
#ifndef REP_A
#define REP_A 1
#endif
#ifndef REP_B
#define REP_B 1
#endif
#ifndef REP_MODE
#define REP_MODE 0
#endif
#ifndef REP_G1
#define REP_G1 1
#endif
#ifndef REP_G2
#define REP_G2 1
#endif
#ifndef REP_P0
#define REP_P0 1
#endif
#ifndef REP_NORM
#define REP_NORM 1
#endif
#ifndef REP_N
#define REP_N 1
#endif

template <class Epi>
__device__ __forceinline__ void run_gemm(LAS unsigned char* lds, const bf16* A, const bf16* Bt, int M, int N, int K, int G, const Epi& E) {
    pg8::Gemm g{A, Bt, M, N, K, A, Bt}; pg8::StaticOrder S; S.init(M, N, G, (int)blockIdx.x, K);
    pg8::gemm_phase<Epi, pg8::StaticOrder, true, true>(lds, g, S, E);
}
template <class Epi>
__device__ __forceinline__ void run_gemm_splitctx(LAS unsigned char* lds, const bf16* A, const bf16* Bt, int N, int K, int nsplit, int G, const Epi& E) {
    pg8::Gemm g{A, Bt, MT, N, K, A, Bt}; pg8::SplitCtxOrder S; S.init(ML, MC, N, K, G, (int)blockIdx.x, nsplit);
    pg8::gemm_phase<Epi, pg8::SplitCtxOrder, true, true>(lds, g, S, E);
}

__device__ __forceinline__ void ffn_block(KArgs a, LAS unsigned char* lds, const XcdBarrier& bar, int G, int layer, int f, const float* rin_lat, const float* rin_ctx, int nrows, const float* part_in, int npart_in) {
    const float* MODL = (const float*)(a->ws + WS_MOD) + (size_t)layer * 5 * MODW;
    float* hl = a->out; float* hc = (float*)(a->ws + WS_HCTX);
    bf16* XN = (bf16*)(a->ws + WS_XN); bf16* HID = (bf16*)(a->ws + WS_HID);
    const bf16* W1b = (const bf16*)(a->ws + WS_W1) + (size_t)(layer * 2 + f) * 2 * FF * DM;
    const bf16* W2b = (const bf16*)(a->ws + WS_W2) + (size_t)(layer * 2 + f) * DM * FF;
    for (int rep = 1; rep < REP_NORM; ++rep) { norm_phase(rin_lat, rin_ctx, XN, a->in[I_NORMG] + (size_t)(layer * 3 + (f ? 2 : 0)) * DM, MODL, f ? 6 : 0, nrows, G, nullptr, 0, hc); GSYNC(); }
    norm_phase(rin_lat, rin_ctx, XN, a->in[I_NORMG] + (size_t)(layer * 3 + (f ? 2 : 0)) * DM, MODL, f ? 6 : 0, nrows, G, part_in, npart_in, hc);
    GSYNC();
    for (int rep = 0; rep < REP_G1; ++rep) {
    { pg8::EpiSwiglu E{HID, FF}; run_gemm(lds, XN, W1b, nrows, 2 * FF, DM, G, E); }
    GSYNC(); }
    for (int rep = 0; rep < REP_G2; ++rep) {
    { pg8::EpiResid E{rin_lat, rin_ctx, hl, hc, MODL + (f ? 8 : 2) * DM, (float*)(a->ws + WS_PARTF), rep == REP_G2 - 1 ? 0.5f : 0.0f};
      if (nrows == MT) run_gemm_splitctx(lds, HID, W2b, DM, FF, 11, G, E); else run_gemm(lds, HID, W2b, nrows, DM, FF, G, E); }
    GSYNC(); }
}

__global__ void __launch_bounds__(NTHREADS, 2) fwd_megakernel(Args a_unused) {
#define a kargs()
    extern __shared__ __attribute__((aligned(16))) unsigned char lds_raw[];
    LAS unsigned char* lds = (LAS unsigned char*)lds_raw;
    cg::grid_group grid = cg::this_grid();
    const int G = gridDim.x;
#define LANEWAVE() const int tid = opaque_tid(), lane = tid & 63, wave = __builtin_amdgcn_readfirstlane(tid >> 6)
#define hl (a->out)
#define hc ((float*)(a->ws + WS_HCTX))
#define XN ((bf16*)(a->ws + WS_XN))
#define MOD0 ((const float*)(a->ws + WS_MOD))
#define MOD1 (MOD0 + 5 * MODW)

    if (threadIdx.x < 8) ((LAS unsigned*)(lds + BARLDS_OFF))[threadIdx.x] = 0u;
    __syncthreads();
    const XcdBarrier bar = xcd_barrier_post((unsigned*)(a->ws + WS_BAR), (volatile LAS unsigned*)(lds + BARLDS_OFF));

    for (int rep = 1; rep < REP_P0; ++rep) { p0_prologue(a, lds, G); __syncthreads(); }
    p0_prologue(a, lds, G);
    grid.sync();
    xcd_barrier_census(bar);

    if (STAGE == 0) {
        const int gtid = blockIdx.x * NTHREADS + opaque_tid(), GT = G * NTHREADS;
        for (int i = gtid; i < ML * DM / 4; i += GT) ((f32x4*)hl)[i] = ((const f32x4*)a->in[I_X])[i];
        GSYNC();
    }
    if (STAGE >= 1) ffn_block(a, lds, bar, G, 0, 0, a->in[I_X], hc, MT, nullptr, 0);
    if (STAGE >= 2) {
        norm_phase(hl, hc, XN, a->in[I_NORMG] + 1 * DM, MOD0, 3, MT, G, (const float*)(a->ws + WS_PARTF), 11, hc);
        GSYNC();
        { pg8::EpiWin E{(bf16*)(a->ws + WS_QKVG), (bf16*)(a->ws + WS_U), (const float*)(a->ws + WS_ROPE)}; run_gemm(lds, XN, (const bf16*)(a->ws + WS_WIN), MT, 2560, DM, G, E); }
        GSYNC();
        for (int rep = 0; rep < REP_A; ++rep) {
        { LANEWAVE(); for (int u = blockIdx.x; u < 544 + 2176; u += G) { if (rep > 0 && ((REP_MODE == 1 && u >= 544) || (REP_MODE == 2 && u < 544))) continue; if (u < 544) r1_unit(a, lds, u); else s1_unit(a, lds + wave * S5_WLDS, (u - 544) * 8 + wave, lane); } }
        GSYNC(); }
        r2_items(a, G); s2_items(a, G);
        GSYNC();
        for (int rep = 0; rep < REP_B; ++rep) {
        { LANEWAVE(); for (int u = blockIdx.x; u < 544 + 1088; u += G) { if (rep > 0 && ((REP_MODE == 1 && u >= 544) || (REP_MODE == 2 && u < 544))) continue; if (u < 544) r3_unit(a, lds, u); else s3_unit(a, lds + wave * S5_WLDS, (u - 544) * 8 + wave, lane); } }
        GSYNC(); }
        { pg8::EpiGlu E{(const bf16*)(a->ws + WS_YS), XN, a->in[I_GLUB]}; run_gemm(lds, (const bf16*)(a->ws + WS_YS), (const bf16*)(a->ws + WS_GLU), MT, 512, 512, G, E); }
        GSYNC();
        { pg8::EpiResid E{hl, hc, hl, hc, MOD0 + 5 * DM, (float*)(a->ws + WS_PARTM), 1.0f}; run_gemm_splitctx(lds, XN, (const bf16*)(a->ws + WS_WOUT), DM, DM, 8, G, E); }
        GSYNC();
    }
    if (STAGE >= 3) ffn_block(a, lds, bar, G, 0, 1, hl, hc, MT, (const float*)(a->ws + WS_PARTM), 8);
    if (STAGE >= 4) ffn_block(a, lds, bar, G, 1, 0, hl, hc, MT, (const float*)(a->ws + WS_PARTF), 11);
    if (STAGE >= 5) {
        norm_phase(hl, hc, XN, a->in[I_NORMG] + 4 * DM, MOD1, 3, MT, G, (const float*)(a->ws + WS_PARTF), 11, hc);
        GSYNC();
        { pg8::EpiQkVt E{(bf16*)(a->ws + WS_QK), (bf16*)(a->ws + WS_VT)};
          pg8::Gemm g{XN, (const bf16*)(a->ws + WS_WQKV), MT, 2048, DM, (const bf16*)(a->ws + WS_WQKV) + (size_t)2048 * DM, XN};
          pg8::QkVtOrder S; S.init(DM, G, (int)blockIdx.x);
          pg8::gemm_phase<pg8::EpiQkVt, pg8::QkVtOrder, true, true>(lds, g, S, E); }
        GSYNC();
        for (int rep = 0; rep < REP_N; ++rep) {
        for (int u = blockIdx.x; u < 2048; u += G) na_unit(a, lds, u);
        GSYNC(); }
        { pg8::EpiResid E{hl, hc, hl, hc, MOD1 + 5 * DM, nullptr, 1.0f}; run_gemm(lds, XN, (const bf16*)(a->ws + WS_WO), ML, DM, DM, G, E); }
        GSYNC();
    }
    if (STAGE >= 6) ffn_block(a, lds, bar, G, 1, 1, hl, hc, ML, nullptr, 0);
    final_norm_phase(a->out, a->in[I_FINALG], G);
#undef a
#undef hl
#undef hc
#undef XN
#undef MOD0
#undef MOD1
}

extern "C" void kernel_launch(void* const* d_in, const int* in_sizes, int n_in, void* d_out, int out_size, void* d_ws, size_t ws_size, hipStream_t stream) {
    static int grid = 0;
    if (grid == 0) {
        if (n_in != 26 || out_size != ML * DM || ws_size < WS_END) { fprintf(stderr, "kernel_launch: unexpected problem (n_in %d, out %d, ws %zu)\n", n_in, out_size, ws_size); grid = -1; return; }
        int dev = 0, cus = 0, per_cu = 0;
        if (hipGetDevice(&dev) != hipSuccess || hipDeviceGetAttribute(&cus, hipDeviceAttributeMultiprocessorCount, dev) != hipSuccess) { grid = -1; return; }
        if (hipFuncSetAttribute((const void*)fwd_megakernel, hipFuncAttributeMaxDynamicSharedMemorySize, LDS_BYTES) != hipSuccess) { fprintf(stderr, "kernel_launch: hipFuncSetAttribute failed\n"); grid = -1; return; }
        if (hipOccupancyMaxActiveBlocksPerMultiprocessor(&per_cu, (const void*)fwd_megakernel, NTHREADS, LDS_BYTES) != hipSuccess || per_cu < 1) { fprintf(stderr, "kernel_launch: occupancy query failed (%d)\n", per_cu); (void)hipGetLastError(); grid = -1; return; }
        grid = cus * per_cu;
    }
    if (grid < 0) return;
    if (hipMemsetAsync((char*)d_ws + WS_BAR, 0, 16384, stream) != hipSuccess) { fprintf(stderr, "kernel_launch: memset failed\n"); return; }
    Args a{};
    for (int i = 0; i < 26; ++i) a.in[i] = (const float*)d_in[i];
    a.out = (float*)d_out; a.ws = (unsigned char*)d_ws; a.probe = 0; a.pad = 0;
    void* args[] = {&a};
    hipError_t e = hipLaunchCooperativeKernel((const void*)fwd_megakernel, dim3(grid), dim3(NTHREADS), args, LDS_BYTES, stream);
    if (e != hipSuccess) fprintf(stderr, "kernel_launch: cooperative launch failed: %s (grid %d)\n", hipGetErrorString(e), grid);
}
```

```cpp
#include <hip/hip_runtime.h>
#include <hip/hip_cooperative_groups.h>
#include <cstdio>
#include <cstdint>
namespace cg = cooperative_groups;

constexpr int DM = 1024, NB = 4, SEQ = 4096, CTXL = 256, FF = 2816, NMOD = 9;
constexpr int ML = NB * SEQ, MC = NB * CTXL, MT = ML + MC;
constexpr int MODW = NMOD * DM;
constexpr float EPS = 1e-6f;

namespace pg8 {
#define PG8_LAS __attribute__((address_space(3)))
typedef unsigned short bf16_t;
typedef short bf16x8 __attribute__((ext_vector_type(8)));
typedef float f32x4 __attribute__((ext_vector_type(4)));
typedef unsigned u32x4 __attribute__((ext_vector_type(4)));
constexpr int BM = 256, BK = 64, HALF = 128, HTB = HALF * BK * 2  , STAGE_BYTES = 8 * HTB, NXCD = 8, WGM = 8;

__host__ __device__ __forceinline__ int lds_byte(int r, int c) { const int st = (r >> 4) * 2 + (c >> 5), rr = r & 15, cc = c & 31, ob = rr * 64 + cc * 2; return st * 1024 + (ob ^ (((ob >> 9) & 1) << 5)); }
__host__ __device__ __forceinline__ void stage_rc(int b, int& R, int& C) { const int st = b / 1024, sb = b % 1024, swz = sb ^ (((sb >> 9) & 1) << 5); R = (st >> 1) * 16 + swz / 64; C = (st & 1) * 32 + (swz % 64) / 2; }
__host__ __device__ __forceinline__ int perm32(int rho) { const int n = rho >> 4, i = rho & 15; return 8 * (i >> 2) + 4 * n + (i & 3); }

struct Unit { int pm, pn, k0, nt, split, which; };
struct Gemm { const bf16_t* A; const bf16_t* Bt; int M, N, K; const bf16_t* A2; const bf16_t* Bt2; };

struct StaticOrder {
    int nM, nN, nwg, G, c, ntk;
    __host__ __device__ void init(int M, int N, int G_, int c_, int K_ = 0) { nM = M / BM; nN = N / BM; nwg = nM * nN; G = G_; c = c_; ntk = K_ / BK; }
    __host__ __device__ bool next(int i, Unit& u) const {
        const long L = (long)i * G + c; if (L >= nwg) return false;
        int wgid = (int)L; { const int q = nwg / NXCD, r = nwg % NXCD, xcd = wgid % NXCD, off = wgid / NXCD; wgid = (xcd < r ? xcd * (q + 1) : r * (q + 1) + (xcd - r) * q) + off; }
        const int nig = WGM * nN, gid = wgid / nig, fm = gid * WGM, gsz = (nM - fm) < WGM ? (nM - fm) : WGM;
        u.pm = fm + ((wgid % nig) % gsz); u.pn = (wgid % nig) / gsz; u.k0 = 0; u.nt = ntk; u.split = 0; u.which = 0; return true;
    }
    __device__ __forceinline__ void a_ready(const Unit&) const {}
    __device__ __forceinline__ void done(const Unit&) const {}
};

struct SplitCtxOrder {
    StaticOrder lat; int nN, nsplit, ntp, npieces, G, c;
    __host__ __device__ void init(int MLAT, int MCTX, int N, int K, int G_, int c_, int nsplit_) { lat.init(MLAT, N, G_, c_, K); nN = N / BM; nsplit = nsplit_; ntp = (K / BK) / nsplit_; npieces = (MCTX / BM) * nN * nsplit_; G = G_; c = c_; }
    __host__ __device__ bool next(int i, Unit& u) const {
        const long L = (long)i * G + c;
        if (L < lat.nwg) return lat.next(i, u);
        const int q = (int)(L - lat.nwg); if (q >= npieces) return false;
        const int ks = q % nsplit, t = q / nsplit; u.pn = t % nN; u.pm = lat.nM + t / nN; u.k0 = ks * ntp; u.nt = ntp; u.split = 1; u.which = 0; return true;
    }
    __device__ __forceinline__ void a_ready(const Unit&) const {}
    __device__ __forceinline__ void done(const Unit&) const {}
};

struct QkVtOrder {
    int G, c, ntk; static constexpr int NLATQK = (ML / BM) * 8, NCTXK = (MC / BM) * 4, NVT = 4 * (MT / BM);
    __host__ __device__ void init(int K, int G_, int c_) { G = G_; c = c_; ntk = K / BK; }
    __host__ __device__ bool next(int i, Unit& u) const {
        long L = (long)i * G + c; if (L >= NLATQK + NCTXK + NVT) return false;
        u.k0 = 0; u.nt = ntk; u.split = 0;
        if (L < NLATQK) { u.which = 0; u.pm = (int)(L >> 3); u.pn = (int)(L & 7); return true; } L -= NLATQK;
        if (L < NVT) { u.which = 1; u.pm = (int)(L & 3); u.pn = (int)(L >> 2); return true; } L -= NVT;
        u.which = 0; u.pm = ML / BM + (int)(L >> 2); u.pn = 4 + (int)(L & 3); return true;
    }
    __device__ __forceinline__ void a_ready(const Unit&) const {}
    __device__ __forceinline__ void done(const Unit&) const {}
};

__device__ __forceinline__ unsigned cvt_pk_bf16(float lo, float hi) { unsigned r; asm volatile("v_cvt_pk_bf16_f32 %0, %1, %2" : "=v"(r) : "v"(lo), "v"(hi)); return r; }
__device__ __forceinline__ float bf_lo(unsigned w) { return __uint_as_float(w << 16); }
__device__ __forceinline__ float bf_hi(unsigned w) { return __uint_as_float(w & 0xffff0000u); }
__device__ __forceinline__ float fsilu(float a) { return a * __builtin_amdgcn_rcpf(1.0f + __expf(-a)); }
__device__ __forceinline__ float fsigmoid(float a) { return __builtin_amdgcn_rcpf(1.0f + __expf(-a)); }

__device__ __forceinline__ void wt_store16(const void* base, unsigned off, u32x4 v) {
    const __amdgpu_buffer_rsrc_t rs = __builtin_amdgcn_make_buffer_rsrc((void*)base, 0, 0x7fffffff, 0x00020000);
    __builtin_amdgcn_raw_buffer_store_b128(v, rs, off, 0, 16);
}
struct EpiSwiglu {
    static constexpr bool PERM = true, AFTER_DRAIN = false;
    bf16_t* O; int ldo;
    __device__ __forceinline__ void operator()(const f32x4 (&acc)[2][2][4][2], const Unit& u, int wr, int wc, int fr, int fq) const {
        const int row0 = u.pm * BM + wr * 64 + fr, col0 = u.pn * HALF + wc * 32 + 8 * fq;
#pragma unroll
        for (int ai = 0; ai < 2; ++ai)
#pragma unroll
            for (int m = 0; m < 4; ++m) {
                bf16_t* rowp = O + (size_t)(row0 + ai * HALF + m * 16) * ldo + col0;
                float h[8];
#pragma unroll
                for (int n = 0; n < 2; ++n)
#pragma unroll
                    for (int i = 0; i < 4; ++i) { const float a = acc[ai][0][m][n][i], b = acc[ai][1][m][n][i]; h[4 * n + i] = fsilu(a) * b; }
                u32x4 w; w.x = cvt_pk_bf16(h[0], h[1]); w.y = cvt_pk_bf16(h[2], h[3]); w.z = cvt_pk_bf16(h[4], h[5]); w.w = cvt_pk_bf16(h[6], h[7]);
                *(u32x4*)rowp = w;
            }
    }
};

struct EpiResid {
    static constexpr bool PERM = false, AFTER_DRAIN = false;
    const float* rin_lat; const float* rin_ctx; float* rout_lat; float* rout_ctx; const float* gate; float* part; float gs;
    __device__ __forceinline__ void operator()(const f32x4 (&acc)[2][2][4][2], const Unit& u, int wr, int wc, int fr, int fq) const {
        const bool lat = u.pm < (ML / BM);
        const int bidx = lat ? (u.pm >> 4) : 4;
        const float* gp = gate + (size_t)bidx * MODW;
        const float* ri = lat ? rin_lat + (size_t)u.pm * BM * DM : rin_ctx + (size_t)(u.pm - ML / BM) * BM * DM;
        float* ro = lat ? rout_lat + (size_t)u.pm * BM * DM : rout_ctx + (size_t)(u.pm - ML / BM) * BM * DM;
        const int col0 = u.pn * BM + wc * 32 + 4 * fq;
        f32x4 gv[2][2];
#pragma unroll
        for (int bj = 0; bj < 2; ++bj)
#pragma unroll
            for (int n = 0; n < 2; ++n) gv[bj][n] = *(const f32x4*)(gp + col0 + bj * HALF + n * 16) * gs;
#pragma unroll
        for (int ai = 0; ai < 2; ++ai)
#pragma unroll
            for (int m = 0; m < 4; ++m) {
                const size_t off = (size_t)(ai * HALF + wr * 64 + m * 16 + fr) * DM + col0;
#pragma unroll
                for (int bj = 0; bj < 2; ++bj)
#pragma unroll
                    for (int n = 0; n < 2; ++n) {
                        if (u.split) { float* o = part + ((size_t)(u.k0 / u.nt) * MC + (size_t)(u.pm - ML / BM) * BM) * DM + off + bj * HALF + n * 16; *(f32x4*)o = gv[bj][n] * acc[ai][bj][m][n]; }
                        else { const f32x4 r = *(const f32x4*)(ri + off + bj * HALF + n * 16); *(f32x4*)(ro + off + bj * HALF + n * 16) = r + gv[bj][n] * acc[ai][bj][m][n]; } }
            }
    }
};

struct EpiWin {
    static constexpr bool PERM = true, AFTER_DRAIN = false;
    bf16_t* QKVG; bf16_t* U; const float* rope;
    __device__ __forceinline__ void operator()(const f32x4 (&acc)[2][2][4][2], const Unit& u, int wr, int wc, int fr, int fq) const {
        const int row0 = u.pm * BM + wr * 64 + fr;
        if (u.pn >= 4) {
            bf16_t* base = u.pn < 8 ? QKVG + u.pn * BM : U + (u.pn - 8) * BM; const int ld = u.pn < 8 ? 2048 : 512;
            const int col0 = wc * 32 + 8 * fq;
#pragma unroll
            for (int ai = 0; ai < 2; ++ai)
#pragma unroll
                for (int m = 0; m < 4; ++m) { bf16_t* rowp = base + (size_t)(row0 + ai * HALF + m * 16) * ld + col0;
#pragma unroll
                    for (int bj = 0; bj < 2; ++bj) { const f32x4 v0 = acc[ai][bj][m][0], v1 = acc[ai][bj][m][1];
                        u32x4 w; w.x = cvt_pk_bf16(v0[0], v0[1]); w.y = cvt_pk_bf16(v0[2], v0[3]); w.z = cvt_pk_bf16(v1[0], v1[1]); w.w = cvt_pk_bf16(v1[2], v1[3]);
                        *(u32x4*)(rowp + bj * HALF) = w; } }
        } else {
            const bool lat = u.pm < (ML / BM);
            const float sc = u.pn >= 2 ? 0.08838834764831845f : 1.0f;
            const int hh = wc >> 1, rot = wc & 1, f0 = 8 * fq;
            const int dcol = u.pn * BM + 128 * hh + 64 * rot + f0;
#pragma unroll
            for (int ai = 0; ai < 2; ++ai)
#pragma unroll
                for (int m = 0; m < 4; ++m) {
                    const int row = row0 + ai * HALF + m * 16;
                    float y1[8], y2[8];
                    const int t = row & (SEQ - 1), pos = rot ? (t & 63) : (t >> 6);
                    const float* rp = rope + (size_t)(pos * 32 + f0) * 2;
#pragma unroll
                    for (int n = 0; n < 2; ++n) {
                        f32x4 cs0 = (f32x4){1.f, 0.f, 1.f, 0.f}, cs1 = cs0;
                        if (lat) { cs0 = *(const f32x4*)(rp + 8 * n); cs1 = *(const f32x4*)(rp + 8 * n + 4); }
                        const f32x4 x1 = acc[ai][0][m][n], x2 = acc[ai][1][m][n];
                        y1[4 * n + 0] = (x1[0] * cs0[0] - x2[0] * cs0[1]) * sc; y2[4 * n + 0] = (x2[0] * cs0[0] + x1[0] * cs0[1]) * sc;
                        y1[4 * n + 1] = (x1[1] * cs0[2] - x2[1] * cs0[3]) * sc; y2[4 * n + 1] = (x2[1] * cs0[2] + x1[1] * cs0[3]) * sc;
                        y1[4 * n + 2] = (x1[2] * cs1[0] - x2[2] * cs1[1]) * sc; y2[4 * n + 2] = (x2[2] * cs1[0] + x1[2] * cs1[1]) * sc;
                        y1[4 * n + 3] = (x1[3] * cs1[2] - x2[3] * cs1[3]) * sc; y2[4 * n + 3] = (x2[3] * cs1[2] + x1[3] * cs1[3]) * sc;
                    }
                    bf16_t* rowp = QKVG + (size_t)row * 2048 + dcol;
                    u32x4 w; w.x = cvt_pk_bf16(y1[0], y1[1]); w.y = cvt_pk_bf16(y1[2], y1[3]); w.z = cvt_pk_bf16(y1[4], y1[5]); w.w = cvt_pk_bf16(y1[6], y1[7]);
                    *(u32x4*)rowp = w;
                    w.x = cvt_pk_bf16(y2[0], y2[1]); w.y = cvt_pk_bf16(y2[2], y2[3]); w.z = cvt_pk_bf16(y2[4], y2[5]); w.w = cvt_pk_bf16(y2[6], y2[7]);
                    *(u32x4*)(rowp + 32) = w;
                }
        }
    }
};

struct EpiGlu {
    static constexpr bool PERM = true, AFTER_DRAIN = false;
    const bf16_t* YS; bf16_t* YM; const float* bias;
    __device__ __forceinline__ void operator()(const f32x4 (&acc)[2][2][4][2], const Unit& u, int wr, int wc, int fr, int fq) const {
        const int row0 = u.pm * BM + wr * 64 + fr, col0 = u.pn * BM + wc * 32 + 8 * fq;
        f32x4 bv[2][2];
#pragma unroll
        for (int bj = 0; bj < 2; ++bj)
#pragma unroll
            for (int n = 0; n < 2; ++n) bv[bj][n] = *(const f32x4*)(bias + col0 + bj * HALF + 4 * n);
#pragma unroll
        for (int ai = 0; ai < 2; ++ai)
#pragma unroll
            for (int m = 0; m < 4; ++m) { const int row = row0 + ai * HALF + m * 16;
#pragma unroll
                for (int bj = 0; bj < 2; ++bj) {
                    const u32x4 yv = *(const u32x4*)(YS + (size_t)row * 512 + col0 + bj * HALF);
                    const f32x4 z0 = acc[ai][bj][m][0] + bv[bj][0], z1 = acc[ai][bj][m][1] + bv[bj][1];
                    u32x4 w;
                    w.x = cvt_pk_bf16(bf_lo(yv.x) * fsigmoid(z0[0]), bf_hi(yv.x) * fsigmoid(z0[1]));
                    w.y = cvt_pk_bf16(bf_lo(yv.y) * fsigmoid(z0[2]), bf_hi(yv.y) * fsigmoid(z0[3]));
                    w.z = cvt_pk_bf16(bf_lo(yv.z) * fsigmoid(z1[0]), bf_hi(yv.z) * fsigmoid(z1[1]));
                    w.w = cvt_pk_bf16(bf_lo(yv.w) * fsigmoid(z1[2]), bf_hi(yv.w) * fsigmoid(z1[3]));
                    *(u32x4*)(YM + (size_t)row * DM + 512 + col0 + bj * HALF) = w; } }
    }
};

struct EpiBf16S {
    static constexpr bool PERM = true, AFTER_DRAIN = false;
    bf16_t* O; int ldo; int nscale; float scale0;
    __device__ __forceinline__ void operator()(const f32x4 (&acc)[2][2][4][2], const Unit& u, int wr, int wc, int fr, int fq) const {
        const int row0 = u.pm * BM + wr * 64 + fr, col0 = u.pn * BM + wc * 32 + 8 * fq;
        const float sc = u.pn < nscale ? scale0 : 1.0f;
#pragma unroll
        for (int ai = 0; ai < 2; ++ai)
#pragma unroll
            for (int m = 0; m < 4; ++m) { bf16_t* rowp = O + (size_t)(row0 + ai * HALF + m * 16) * ldo + col0;
#pragma unroll
                for (int bj = 0; bj < 2; ++bj) { const f32x4 v0 = acc[ai][bj][m][0] * sc, v1 = acc[ai][bj][m][1] * sc;
                    u32x4 w; w.x = cvt_pk_bf16(v0[0], v0[1]); w.y = cvt_pk_bf16(v0[2], v0[3]); w.z = cvt_pk_bf16(v1[0], v1[1]); w.w = cvt_pk_bf16(v1[2], v1[3]);
                    *(u32x4*)(rowp + bj * HALF) = w; } }
    }
};

struct EpiQkVt {
    static constexpr bool PERM = true, AFTER_DRAIN = false;
    bf16_t* QK; bf16_t* VT;
    __device__ __forceinline__ void operator()(const f32x4 (&acc)[2][2][4][2], const Unit& u, int wr, int wc, int fr, int fq) const {
        const int row0 = u.pm * BM + wr * 64 + fr, col0 = u.pn * BM + wc * 32 + 8 * fq;
        bf16_t* O = u.which ? VT : QK; const int ldo = u.which ? MT : 2048;
        const float sc = (!u.which && u.pn < 4) ? 0.125f : 1.0f;
#pragma unroll
        for (int ai = 0; ai < 2; ++ai)
#pragma unroll
            for (int m = 0; m < 4; ++m) { bf16_t* rowp = O + (size_t)(row0 + ai * HALF + m * 16) * ldo + col0;
#pragma unroll
                for (int bj = 0; bj < 2; ++bj) { const f32x4 v0 = acc[ai][bj][m][0] * sc, v1 = acc[ai][bj][m][1] * sc;
                    u32x4 w; w.x = cvt_pk_bf16(v0[0], v0[1]); w.y = cvt_pk_bf16(v0[2], v0[3]); w.z = cvt_pk_bf16(v1[0], v1[1]); w.w = cvt_pk_bf16(v1[2], v1[3]);
                    *(u32x4*)(rowp + bj * HALF) = w; } }
    }
};
template <class Epi, class Sched, bool ALIGN_EPI = false, bool SP2 = false>
__device__ __forceinline__ void gemm_phase(PG8_LAS unsigned char* lds, const Gemm g, const Sched& S, const Epi& E) {
    int tid_ = threadIdx.x; asm volatile("" : "+v"(tid_));
    const int tid = tid_, wid = __builtin_amdgcn_readfirstlane(tid >> 6), lane = tid & 63, wr = wid >> 2, wc = wid & 3, fr = lane & 15, fq = lane >> 4;
    const int K = g.K;
    unsigned voffA[2], voffB[2];
#pragma unroll
    for (int i = 0; i < 2; ++i) { int R, C; stage_rc(tid * 16 + i * 8192, R, C); const int Rb = Epi::PERM ? ((R & ~31) + perm32(R & 31)) : R;
        voffA[i] = (unsigned)(R * K + C) * 2u; voffB[i] = (unsigned)(Rb * K + C) * 2u; }
    const size_t kstep = (size_t)(BK * 2);
    const size_t hstep = (size_t)HALF * K * 2;
    const size_t tstep = 2 * hstep;
    const unsigned ldsw = (unsigned)wid * 1024u;
    const int aoff = lds_byte(wr * 64 + fr, fq * 8), boff = lds_byte(wc * 32 + fr, fq * 8);
#define PG8_SA(b, h) (((b) * 2 + (h)) * HTB)
#define PG8_SB(b, h) ((4 + (b) * 2 + (h)) * HTB)
#define PG8_STAGE(bufoff, gbase, voff) do { _Pragma("unroll") for (int _i = 0; _i < 2; ++_i) \
        __builtin_amdgcn_global_load_lds((const unsigned*)((const char*)(gbase) + (voff)[_i]), (PG8_LAS unsigned*)(lds + (bufoff) + ldsw + _i * 8192), 16, 0, 0); } while (0)
#define PG8_LDA(dst, b, h) do { _Pragma("unroll") for (int m = 0; m < 4; ++m) _Pragma("unroll") for (int k = 0; k < 2; ++k) dst[m][k] = *(const PG8_LAS bf16x8*)(lds + PG8_SA(b, h) + aoff + m * 2048 + k * 1024); } while (0)
#define PG8_LDB(dst, b, h) do { _Pragma("unroll") for (int n = 0; n < 2; ++n) _Pragma("unroll") for (int k = 0; k < 2; ++k) dst[n][k] = *(const PG8_LAS bf16x8*)(lds + PG8_SB(b, h) + boff + n * 2048 + k * 1024); } while (0)
#define PG8_MMA(ai, bj, At, Bt) do { __builtin_amdgcn_s_setprio(1); _Pragma("unroll") for (int m = 0; m < 4; ++m) _Pragma("unroll") for (int n = 0; n < 2; ++n) _Pragma("unroll") for (int k = 0; k < 2; ++k) \
        acc[ai][bj][m][n] = __builtin_amdgcn_mfma_f32_16x16x32_bf16(Bt[n][k], At[m][k], acc[ai][bj][m][n], 0, 0, 0); __builtin_amdgcn_s_setprio(0); } while (0)
#define PG8_WAIT_V(n) asm volatile("s_waitcnt vmcnt(" #n ")" ::: "memory")
#define PG8_WAIT_L(n) asm volatile("s_waitcnt lgkmcnt(" #n ")" ::: "memory")
#define PG8_BAR __builtin_amdgcn_s_barrier()
#define PG8_SCHED __builtin_amdgcn_sched_barrier(0)
    Unit cur, nxt; int ui = 0;
    if (!S.next(0, cur)) return;
    f32x4 acc[2][2][4][2];
#pragma unroll
    for (int a = 0; a < 2; ++a)
#pragma unroll
        for (int b = 0; b < 2; ++b)
#pragma unroll
            for (int m = 0; m < 4; ++m)
#pragma unroll
                for (int n = 0; n < 2; ++n) acc[a][b][m][n] = (f32x4){0.f, 0.f, 0.f, 0.f};
    bf16x8 At[4][2], B0[2][2], B1[2][2];
    const char* cA = (const char*)(cur.which ? g.A2 : g.A) + (size_t)cur.pm * tstep + (size_t)cur.k0 * kstep; const char* cB = (const char*)(cur.which ? g.Bt2 : g.Bt) + (size_t)cur.pn * tstep + (size_t)cur.k0 * kstep;
    S.a_ready(cur);
    if constexpr (SP2) {
        PG8_STAGE(PG8_SB(0, 0), cB, voffB); PG8_STAGE(PG8_SB(0, 1), cB + hstep, voffB); PG8_STAGE(PG8_SA(0, 0), cA, voffA); PG8_STAGE(PG8_SA(0, 1), cA + hstep, voffA);
        if (wr == 1) PG8_BAR;
        PG8_WAIT_V(2); PG8_BAR;
        PG8_STAGE(PG8_SB(1, 0), cB + kstep, voffB); PG8_STAGE(PG8_SA(1, 0), cA + kstep, voffA); PG8_STAGE(PG8_SB(1, 1), cB + hstep + kstep, voffB);
        PG8_WAIT_V(6); PG8_BAR;
    } else {
        PG8_STAGE(PG8_SB(0, 0), cB, voffB); PG8_STAGE(PG8_SA(0, 0), cA, voffA); PG8_STAGE(PG8_SB(0, 1), cB + hstep, voffB); PG8_STAGE(PG8_SA(0, 1), cA + hstep, voffA);
        if (wr == 1) PG8_BAR;
        PG8_WAIT_V(4); PG8_BAR;
        PG8_STAGE(PG8_SB(1, 0), cB + kstep, voffB); PG8_STAGE(PG8_SA(1, 0), cA + kstep, voffA); PG8_STAGE(PG8_SB(1, 1), cB + hstep + kstep, voffB);
        PG8_WAIT_V(6); PG8_BAR;
    }
    for (;;) {
        const bool has_next = S.next(ui + 1, nxt);
        const char* nA = has_next ? (const char*)(nxt.which ? g.A2 : g.A) + (size_t)nxt.pm * tstep + (size_t)nxt.k0 * kstep : cA; const char* nB = has_next ? (const char*)(nxt.which ? g.Bt2 : g.Bt) + (size_t)nxt.pn * tstep + (size_t)nxt.k0 * kstep : cB;
        const int nt = cur.nt;
        for (int t = 0; t < nt; t += 2) {
            const bool last = (t == nt - 2);
            const char* a1 = cA + (size_t)(t + 1) * kstep;
            const char* a2 = last ? nA : cA + (size_t)(t + 2) * kstep; const char* b2 = last ? nB : cB + (size_t)(t + 2) * kstep;
            const char* a3 = a2 + kstep; const char* b3 = b2 + kstep;
            if (last && has_next) S.a_ready(nxt);
            if constexpr (SP2) {
            PG8_LDB(B0, 0, 0); PG8_LDB(B1, 0, 1); PG8_SCHED; PG8_LDA(At, 0, 0); PG8_STAGE(PG8_SA(1, 1), a1 + hstep, voffA);
            PG8_WAIT_V(8); PG8_WAIT_L(0); PG8_BAR; PG8_MMA(0, 0, At, B0); PG8_MMA(0, 1, At, B1); PG8_BAR; PG8_SCHED;
            PG8_LDA(At, 0, 1); PG8_STAGE(PG8_SB(0, 0), b2, voffB); PG8_STAGE(PG8_SB(0, 1), b2 + hstep, voffB); PG8_STAGE(PG8_SA(0, 0), a2, voffA);
            PG8_WAIT_V(8); PG8_WAIT_L(0); PG8_BAR; PG8_MMA(1, 0, At, B0); PG8_MMA(1, 1, At, B1); PG8_BAR; PG8_SCHED;
            PG8_LDB(B0, 1, 0); PG8_LDB(B1, 1, 1); PG8_SCHED; PG8_LDA(At, 1, 0); PG8_STAGE(PG8_SA(0, 1), a2 + hstep, voffA);
            PG8_WAIT_V(8); PG8_WAIT_L(0); PG8_BAR; PG8_MMA(0, 0, At, B0); PG8_MMA(0, 1, At, B1); PG8_BAR; PG8_SCHED;
            PG8_LDA(At, 1, 1); PG8_STAGE(PG8_SB(1, 0), b3, voffB); PG8_STAGE(PG8_SB(1, 1), b3 + hstep, voffB); PG8_STAGE(PG8_SA(1, 0), a3, voffA);
            PG8_WAIT_V(8); PG8_WAIT_L(0); PG8_BAR; PG8_MMA(1, 0, At, B0); PG8_MMA(1, 1, At, B1); PG8_BAR; PG8_SCHED;
            } else {
            PG8_LDB(B0, 0, 0); PG8_SCHED; PG8_LDA(At, 0, 0); PG8_STAGE(PG8_SA(1, 1), a1 + hstep, voffA);
            PG8_WAIT_L(8); PG8_BAR; PG8_WAIT_L(0); PG8_MMA(0, 0, At, B0); PG8_BAR; PG8_SCHED;
            PG8_LDB(B1, 0, 1); PG8_STAGE(PG8_SB(0, 0), b2, voffB);
            PG8_BAR; PG8_WAIT_L(0); PG8_MMA(0, 1, At, B1); PG8_BAR;
            PG8_LDA(At, 0, 1); PG8_STAGE(PG8_SA(0, 0), a2, voffA);
            PG8_BAR; PG8_WAIT_L(0); PG8_MMA(1, 0, At, B0); PG8_BAR; PG8_SCHED;
            PG8_STAGE(PG8_SB(0, 1), b2 + hstep, voffB);
            PG8_WAIT_V(6); PG8_BAR; PG8_MMA(1, 1, At, B1); PG8_BAR;
            PG8_LDB(B0, 1, 0); PG8_SCHED; PG8_LDA(At, 1, 0); PG8_STAGE(PG8_SA(0, 1), a2 + hstep, voffA);
            PG8_WAIT_L(8); PG8_BAR; PG8_WAIT_L(0); PG8_MMA(0, 0, At, B0); PG8_BAR; PG8_SCHED;
            PG8_LDB(B1, 1, 1); PG8_STAGE(PG8_SB(1, 0), b3, voffB);
            PG8_BAR; PG8_WAIT_L(0); PG8_MMA(0, 1, At, B1); PG8_BAR;
            PG8_LDA(At, 1, 1); PG8_STAGE(PG8_SA(1, 0), a3, voffA);
            PG8_BAR; PG8_WAIT_L(0); PG8_MMA(1, 0, At, B0); PG8_BAR; PG8_SCHED;
            PG8_STAGE(PG8_SB(1, 1), b3 + hstep, voffB);
            PG8_WAIT_V(6); PG8_BAR; PG8_MMA(1, 1, At, B1); PG8_BAR;
            }
        }
        if constexpr (ALIGN_EPI) { if (wr == 0) PG8_BAR; }
        if constexpr (!Epi::AFTER_DRAIN) { E(acc, cur, wr, wc, fr, fq); S.done(cur); }
        if (!has_next) break;
#pragma unroll
        for (int a = 0; a < 2; ++a)
#pragma unroll
            for (int b = 0; b < 2; ++b)
#pragma unroll
                for (int m = 0; m < 4; ++m)
#pragma unroll
                    for (int n = 0; n < 2; ++n) acc[a][b][m][n] = (f32x4){0.f, 0.f, 0.f, 0.f};
        cur = nxt; cA = nA; cB = nB; ++ui;
        if constexpr (ALIGN_EPI) { if (wr == 1) PG8_BAR; }
    }
    PG8_WAIT_V(0);
    if constexpr (!ALIGN_EPI) { if (wr == 0) PG8_BAR; }
    PG8_BAR;
    if constexpr (Epi::AFTER_DRAIN) { E.fused(acc, cur, wr, wc, fr, fq, lds, wid, lane); S.done(cur); }
#undef PG8_SA
#undef PG8_SB
#undef PG8_STAGE
#undef PG8_LDA
#undef PG8_LDB
#undef PG8_MMA
#undef PG8_WAIT_V
#undef PG8_WAIT_L
#undef PG8_BAR
#undef PG8_SCHED
}
}

#define LAS __attribute__((address_space(3)))
typedef unsigned short bf16;
typedef unsigned v4u __attribute__((ext_vector_type(4)));
typedef unsigned v2u __attribute__((ext_vector_type(2)));
typedef float f32x4 __attribute__((ext_vector_type(4)));
typedef float f32x2 __attribute__((ext_vector_type(2)));
typedef short bf16x8 __attribute__((ext_vector_type(8)));
typedef short s16x4 __attribute__((ext_vector_type(4)));

constexpr size_t MiB = 1u << 20;
constexpr size_t WS_MOD   = 1 * MiB;
constexpr size_t WS_ROPE  = WS_MOD + 512 * 1024;
constexpr size_t WS_LB    = WS_ROPE + 64 * 1024;
constexpr size_t WS_LBT   = WS_LB + 64 * 1024;
constexpr size_t WS_BBR   = WS_LBT + 64 * 1024;
constexpr size_t WS_BBI   = WS_BBR + 256 * 1024;
constexpr size_t WS_CM    = WS_BBI + 256 * 1024;
constexpr size_t WS_BBM   = WS_CM + 256 * 1024;
static_assert(WS_BBM + 256 * 1024 <= 4 * MiB, "param block");
constexpr size_t WS_W1    = 4 * MiB;
constexpr size_t WS_W2    = 48 * MiB;
constexpr size_t WS_WIN   = 70 * MiB;
constexpr size_t WS_WOUT  = 75 * MiB;
constexpr size_t WS_GLU   = 77 * MiB;
constexpr size_t WS_WQKV  = 78 * MiB;
constexpr size_t WS_WO    = 84 * MiB;
constexpr size_t WS_HCTX  = 86 * MiB;
constexpr size_t WS_XN    = 90 * MiB;
constexpr size_t WS_R     = 124 * MiB;
constexpr size_t WS_HID   = WS_R;
constexpr size_t WS_QKVG  = WS_R;
constexpr size_t WS_U     = WS_R + 68 * MiB;
constexpr size_t WS_KVS   = WS_R + 85 * MiB;
constexpr size_t WS_SF    = WS_R + 119 * MiB;
constexpr size_t WS_YS    = WS_R + 128 * MiB;
constexpr size_t WS_QK    = WS_R;
constexpr size_t WS_VT    = WS_R + 68 * MiB;
constexpr size_t WS_PARTF = WS_R + 96 * MiB;
constexpr size_t WS_PARTM = WS_R;
constexpr size_t WS_END   = WS_R + 145 * MiB;

constexpr size_t WS_BAR = 0;
constexpr int BARLDS_OFF = 147456 - 64;
constexpr int NWAVES = 8, NTHREADS = 512;
constexpr int LDS_BYTES = 147456;

struct Args {
    const float* in[26]; float* out; unsigned char* ws; int probe; int pad;
};
typedef const __attribute__((address_space(4))) Args* KArgs;
__device__ __forceinline__ KArgs kargs() { KArgs p = (KArgs)__builtin_amdgcn_kernarg_segment_ptr(); asm volatile("" : "+s"(p)); return p; }
enum { I_X = 0, I_C, I_CTX, I_CCTX, I_WMOD, I_BMOD, I_NORMG, I_W1, I_W2, I_WIN, I_WOUT, I_DECAY, I_LAMRE, I_LAMIM, I_LOGDT, I_BRE, I_BIM, I_CRE, I_CIM,
       I_S5D, I_GLUW, I_GLUB, I_WQKV, I_WO, I_RPB, I_FINALG };

__device__ __forceinline__ unsigned f2bf(float f) { unsigned u = __builtin_bit_cast(unsigned, f); return (u + 0x7fffu + ((u >> 16) & 1u)) >> 16; }
__device__ __forceinline__ unsigned pk2(float lo, float hi) { return f2bf(lo) | (f2bf(hi) << 16); }
typedef __bf16 bf16x2_t __attribute__((ext_vector_type(2)));
__device__ __forceinline__ unsigned cvtpk(float lo, float hi) { const f32x2 v = {lo, hi}; const bf16x2_t b = __builtin_convertvector(v, bf16x2_t); return __builtin_bit_cast(unsigned, b); }
__device__ __forceinline__ float bf2f(unsigned short h) { return __uint_as_float((unsigned)h << 16); }
__device__ __forceinline__ float blo(unsigned w) { return __uint_as_float(w << 16); }
__device__ __forceinline__ float bhi(unsigned w) { return __uint_as_float(w & 0xffff0000u); }
__device__ __forceinline__ int opaque_tid() { int t = threadIdx.x; asm volatile("" : "+v"(t)); return t; }
__device__ __forceinline__ float wave_sum(float v) {
#pragma unroll
    for (int o = 1; o < 64; o <<= 1) v += __shfl_xor(v, o);
    return v;
}
__device__ __forceinline__ void sincos_acc(float x, float& s, float& c) {
    const float k = rintf(x * 0.6366197723675814f);
    float r = fmaf(k, -1.5703125f, x); r = fmaf(k, -4.837512969970703125e-4f, r); r = fmaf(k, -7.54978995489188216e-8f, r);
    const float r2 = r * r;
    float sp = 2.7557319e-6f; sp = fmaf(sp, r2, -1.9841270e-4f); sp = fmaf(sp, r2, 8.3333333e-3f); sp = fmaf(sp, r2, -1.6666667e-1f); sp = fmaf(sp * r2, r, r);
    float cp = -2.7557319e-7f; cp = fmaf(cp, r2, 2.4801587e-5f); cp = fmaf(cp, r2, -1.3888889e-3f); cp = fmaf(cp, r2, 4.1666667e-2f); cp = fmaf(cp, r2, -0.5f); cp = fmaf(cp, r2, 1.0f);
    const int q = ((int)k) & 3;
    s = (q == 0) ? sp : (q == 1) ? cp : (q == 2) ? -sp : -cp;
    c = (q == 0) ? cp : (q == 1) ? -sp : (q == 2) ? -cp : sp;
}
__device__ __forceinline__ float gelu_tanh(float v) {
    const float t = 0.7978845608028654f * (v + 0.044715f * v * v * v);
    const float e = __expf(2.0f * t);
    const float th = 1.0f - 2.0f * __builtin_amdgcn_rcpf(e + 1.0f);
    return 0.5f * v * (1.0f + th);
}

__device__ __forceinline__ int map_row(int kind, int n) {
    if (kind == 1) { const int j = n < FF ? n : n - FF; return 256 * (j >> 7) + (n < FF ? 0 : 128) + (j & 127); }
    if (kind == 2 && n < 1024) { const int tile = n >> 8, hh = (n >> 7) & 1, d = n & 127; return 256 * tile + 128 * ((d >> 5) & 1) + 64 * hh + 32 * (d >> 6) + (d & 31); }
    return n;
}
__device__ __forceinline__ void p0_transpose_item(const float* W, int K, int N, int kind, bf16* WT, LAS float* scr, int item, int lane) {
    const int nblk = N / 32, kb = item / nblk, nb = item % nblk, k0 = 64 * kb, n0 = 32 * nb;
    const int drow = map_row(kind, n0);
    float wv[32];
#pragma unroll
    for (int i = 0; i < 32; ++i) { const int kk = 2 * i + (lane >> 5); wv[i] = W[(size_t)(k0 + kk) * N + n0 + (lane & 31)]; }
#pragma unroll
    for (int i = 0; i < 32; ++i) { const int kk = 2 * i + (lane >> 5); scr[kk * 33 + (lane & 31)] = wv[i]; }
    asm volatile("s_waitcnt lgkmcnt(0)" ::: "memory");
    const int c = lane & 7;
#pragma unroll
    for (int j = 0; j < 4; ++j) { const int n = (lane >> 3) + 8 * j; const LAS float* s = scr + (8 * c) * 33 + n;
        v4u o; o.x = cvtpk(s[0 * 33], s[1 * 33]); o.y = cvtpk(s[2 * 33], s[3 * 33]); o.z = cvtpk(s[4 * 33], s[5 * 33]); o.w = cvtpk(s[6 * 33], s[7 * 33]);
        *(v4u*)(WT + (size_t)(drow + n) * K + k0 + 8 * c) = o; }
    asm volatile("s_waitcnt lgkmcnt(0)" ::: "memory");
}

struct WDesc { const float* W; bf16* dst; int K, N, kind, items; };
__device__ __forceinline__ WDesc wdesc(KArgs a, int mi) {
    WDesc d;
    if (mi < 4)       { d.W = a->in[I_W1] + (size_t)mi * DM * 2 * FF; d.dst = (bf16*)(a->ws + WS_W1) + (size_t)mi * 2 * FF * DM; d.K = DM; d.N = 2 * FF; d.kind = 1; }
    else if (mi < 8)  { d.W = a->in[I_W2] + (size_t)(mi - 4) * FF * DM; d.dst = (bf16*)(a->ws + WS_W2) + (size_t)(mi - 4) * DM * FF; d.K = FF; d.N = DM; d.kind = 0; }
    else if (mi == 8) { d.W = a->in[I_WIN]; d.dst = (bf16*)(a->ws + WS_WIN); d.K = DM; d.N = 2560; d.kind = 2; }
    else if (mi == 9) { d.W = a->in[I_WOUT]; d.dst = (bf16*)(a->ws + WS_WOUT); d.K = DM; d.N = DM; d.kind = 0; }
    else if (mi == 10){ d.W = a->in[I_GLUW]; d.dst = (bf16*)(a->ws + WS_GLU); d.K = 512; d.N = 512; d.kind = 0; }
    else if (mi == 11){ d.W = a->in[I_WQKV]; d.dst = (bf16*)(a->ws + WS_WQKV); d.K = DM; d.N = 3072; d.kind = 0; }
    else              { d.W = a->in[I_WO]; d.dst = (bf16*)(a->ws + WS_WO); d.K = DM; d.N = DM; d.kind = 0; }
    d.items = (d.K / 64) * (d.N / 32);
    return d;
}
constexpr int NWMAT = 13;

__device__ __forceinline__ void p0_prologue(KArgs a, LAS unsigned char* lds, int G, int parts = 7) {
    const int tid = opaque_tid(), lane = tid & 63, wave = __builtin_amdgcn_readfirstlane(tid >> 6);
    if (parts & 1)
    {
        LAS float* sv = (LAS float*)lds;
        LAS float* red = (LAS float*)(lds + 32768);
        bool have = false;
        for (int it = blockIdx.x; it < 2 * (MODW / 64); it += G) {
            if (!have) {
                for (int i = tid; i < 5 * DM; i += NTHREADS) { const int b = i >> 10, k = i & 1023; const float v = b < 4 ? a->in[I_C][b * DM + k] : a->in[I_CCTX][k]; sv[k * 8 + b] = v / (1.0f + expf(-v)); }
                __syncthreads(); have = true;
            }
            const int layer = it / (MODW / 64), n = (it % (MODW / 64)) * 64 + lane;
            const float* wp = a->in[I_WMOD] + (size_t)layer * DM * MODW + n;
            float acc[5] = {0.f, 0.f, 0.f, 0.f, 0.f};
#pragma unroll 16
            for (int kk = 0; kk < 128; ++kk) { const int k = wave * 128 + kk; const float w = wp[(size_t)k * MODW];
                const f32x4 s0 = *(const LAS f32x4*)(sv + k * 8); const float s4 = sv[k * 8 + 4];
                acc[0] = fmaf(s0[0], w, acc[0]); acc[1] = fmaf(s0[1], w, acc[1]); acc[2] = fmaf(s0[2], w, acc[2]); acc[3] = fmaf(s0[3], w, acc[3]); acc[4] = fmaf(s4, w, acc[4]); }
#pragma unroll
            for (int b = 0; b < 5; ++b) red[(wave * 5 + b) * 64 + lane] = acc[b];
            __syncthreads();
            if (tid < 320) { const int b = tid >> 6, l = tid & 63, nn = (it % (MODW / 64)) * 64 + l; float s = a->in[I_BMOD][layer * MODW + nn];
#pragma unroll
                for (int w = 0; w < 8; ++w) s += red[(w * 5 + b) * 64 + l];
                ((float*)(a->ws + WS_MOD))[((size_t)layer * 5 + b) * MODW + nn] = s; }
            __syncthreads();
        }
        __syncthreads();
    }
    const int gtid = blockIdx.x * NTHREADS + tid, GT = G * NTHREADS;
    for (int i = gtid; i < MC * DM / 4; i += GT) ((f32x4*)(a->ws + WS_HCTX))[i] = ((const f32x4*)a->in[I_CTX])[i];
    for (int i = gtid; i < 64 * 32; i += GT) { const int pos = i >> 5, f = i & 31; const float inv = exp2f(-(float)f * (13.287712379549449f / 32.0f));
        float s, c; sincos_acc((float)pos * inv, s, c); ((f32x2*)(a->ws + WS_ROPE))[i] = (f32x2){c, s}; }
    for (int i = gtid; i < 2 * 32 * 64; i += GT) {
        const int p = i & 63, dg = i >> 6;
        const float lr = fminf(a->in[I_LAMRE][i], -1e-4f), li = a->in[I_LAMIM][i], dt = expf(a->in[I_LOGDT][dg]);
        float s, c; sincos_acc(li * dt, s, c); const float mg = expf(lr * dt); const float br = mg * c, bi = mg * s;
        ((f32x2*)(a->ws + WS_LB))[i] = (f32x2){br, bi};
        float s64, c64; sincos_acc(li * dt * 64.0f, s64, c64); const float m64 = expf(lr * dt * 64.0f);
        ((f32x2*)(a->ws + WS_LBT))[i] = (f32x2){m64 * c64, m64 * s64};
        const float nr = br - 1.0f, ni = bi, den = 1.0f / (lr * lr + li * li);
        const float cr = (nr * lr + ni * li) * den, ci = (ni * lr - nr * li) * den;
        for (int k = 0; k < 16; ++k) {
            const float bre = a->in[I_BRE][(size_t)i * 16 + k], bim = a->in[I_BIM][(size_t)i * 16 + k];
            ((bf16*)(a->ws + WS_BBM))[((size_t)dg * 128 + 2 * p) * 16 + k] = (bf16)f2bf(cr * bre - ci * bim);
            ((bf16*)(a->ws + WS_BBM))[((size_t)dg * 128 + 2 * p + 1) * 16 + k] = (bf16)f2bf(cr * bim + ci * bre);
            const float cre = a->in[I_CRE][((size_t)dg * 16 + k) * 64 + p], cim = a->in[I_CIM][((size_t)dg * 16 + k) * 64 + p];
            ((unsigned*)(a->ws + WS_CM))[((size_t)dg * 16 + k) * 64 + p] = cvtpk(cre, -cim);
        }
    }
    if (parts & 4) {
        LAS float* scr = (LAS float*)(lds + wave * 16384);
        const int gw = blockIdx.x * NWAVES + wave, NGW = G * NWAVES;
        int total = 0;
        for (int mi = 0; mi < NWMAT; ++mi) total += wdesc(a, mi).items;
        const int nshort = G == 256 ? 32 : 0, per_s = 8, per_l = G == 256 ? 11 : (total + NGW - 1) / NGW;
        const int it0 = (int)blockIdx.x < nshort ? gw * per_s : nshort * NWAVES * per_s + (gw - nshort * NWAVES) * per_l;
        const int it1 = min(total, it0 + ((int)blockIdx.x < nshort ? per_s : per_l));
        for (int it = it0; it < it1; ++it) {
            int r = it;
            for (int mi = 0; mi < NWMAT; ++mi) { const WDesc d = wdesc(a, mi); if (r < d.items) { p0_transpose_item(d.W, d.K, d.N, d.kind, d.dst, scr, r, lane); break; } r -= d.items; }
        }
    }
}

__device__ __forceinline__ void norm_phase(const float* src_lat, const float* src_ctx, bf16* XN, const float* g, const float* mod  , int ishift, int nrows, int G, const float* part = nullptr, int npart = 0, float* hctx_rw = nullptr) {
    const int tid = opaque_tid(), lane = tid & 63, wave = __builtin_amdgcn_readfirstlane(tid >> 6);
    const int gw = blockIdx.x * NWAVES + wave, NGW = G * NWAVES;
    f32x4 gv[4];
#pragma unroll
    for (int j = 0; j < 4; ++j) gv[j] = *((const f32x4*)g + lane + 64 * j);
    for (int row = gw; row < nrows; row += NGW) {
        const float* xr = row < ML ? src_lat + (size_t)row * DM : src_ctx + (size_t)(row - ML) * DM;
        const int bidx = row < ML ? (row >> 12) : 4;
        const float* sh = mod + (size_t)bidx * MODW + ishift * DM; const float* sc = sh + DM;
        f32x4 v[4]; float s = 0.f;
#pragma unroll
        for (int j = 0; j < 4; ++j) v[j] = *((const f32x4*)xr + lane + 64 * j);
        if (npart > 0 && row >= ML) {
            for (int pp = 0; pp < npart; ++pp) { const float* pr = part + ((size_t)pp * MC + (row - ML)) * DM;
#pragma unroll
                for (int j = 0; j < 4; ++j) v[j] += *((const f32x4*)pr + lane + 64 * j); }
#pragma unroll
            for (int j = 0; j < 4; ++j) *((f32x4*)(hctx_rw + (size_t)(row - ML) * DM) + lane + 64 * j) = v[j];
        }
#pragma unroll
        for (int j = 0; j < 4; ++j) s += (v[j][0] * v[j][0] + v[j][1] * v[j][1]) + (v[j][2] * v[j][2] + v[j][3] * v[j][3]);
        const float rstd = rsqrtf(wave_sum(s) * (1.0f / DM) + EPS);
#pragma unroll
        for (int j = 0; j < 4; ++j) {
            const f32x4 shv = *((const f32x4*)sh + lane + 64 * j), scv = *((const f32x4*)sc + lane + 64 * j);
            const f32x4 y = v[j] * rstd * gv[j] * (scv + 1.0f) + shv;
            *((v2u*)(XN + (size_t)row * DM) + lane + 64 * j) = (v2u){cvtpk(y[0], y[1]), cvtpk(y[2], y[3])};
        }
    }
}
__device__ __forceinline__ void final_norm_phase(float* io, const float* g, int G) {
    const int tid = opaque_tid(), lane = tid & 63, wave = __builtin_amdgcn_readfirstlane(tid >> 6);
    const int gw = blockIdx.x * NWAVES + wave, NGW = G * NWAVES;
    f32x4 gv[4];
#pragma unroll
    for (int j = 0; j < 4; ++j) gv[j] = *((const f32x4*)g + lane + 64 * j);
    for (int row = gw; row < ML; row += NGW) {
        float* xr = io + (size_t)row * DM;
        f32x4 v[4]; float s = 0.f;
#pragma unroll
        for (int j = 0; j < 4; ++j) { v[j] = *((const f32x4*)xr + lane + 64 * j); s += (v[j][0] * v[j][0] + v[j][1] * v[j][1]) + (v[j][2] * v[j][2] + v[j][3] * v[j][3]); }
        const float rstd = rsqrtf(wave_sum(s) * (1.0f / DM) + EPS);
#pragma unroll
        for (int j = 0; j < 4; ++j) *((f32x4*)xr + lane + 64 * j) = v[j] * rstd * gv[j];
    }
}

#define XB_TMO      128
#define XB_XCNT(j)  (256  + 64 * (j))
#define XB_XSUB(j)  (1280 + 64 * (j))
#define XB_XGEN(j)  (2304 + 64 * (j))
#define XB_TOP      3328
#define XB_TOPGEN   3392
#define XCD_BAR_WORDS 3456
#define XB_SPIN_CAP (1u << 18)

__device__ __forceinline__ unsigned xb_ld(unsigned* p)              { return __hip_atomic_load(p, __ATOMIC_RELAXED, __HIP_MEMORY_SCOPE_AGENT); }
__device__ __forceinline__ unsigned xb_add(unsigned* p, unsigned v) { return __hip_atomic_fetch_add(p, v, __ATOMIC_RELAXED, __HIP_MEMORY_SCOPE_AGENT); }
__device__ __forceinline__ unsigned xb_xcc_id() { return (unsigned)__builtin_amdgcn_s_getreg((3 << 11) | 20) & 0xFu; }
#define XB_SPIN(cond, bar) do { unsigned _sp = 0; while (cond) { __builtin_amdgcn_s_sleep(1); \
    if ((++_sp & 255u) == 0u) { if (xb_ld(&(bar)[XB_TMO])) break; if (_sp > XB_SPIN_CAP) { atomicAdd(&(bar)[XB_TMO], 1u); break; } } } } while (0)

struct XcdBarrier {
    unsigned* bar; unsigned x;
    volatile LAS unsigned* st;
};

__device__ __forceinline__ XcdBarrier xcd_barrier_post(unsigned* bar, volatile LAS unsigned* st) {
    XcdBarrier b; b.bar = bar; b.x = xb_xcc_id(); b.st = st;
    if (threadIdx.x == 0) (void)xb_add(&bar[XB_XCNT(b.x)], 1u);
    return b;
}
__device__ __forceinline__ void xcd_barrier_complete(unsigned* bar, unsigned x, unsigned& nloc, unsigned& nx) {
    const unsigned G = gridDim.x * gridDim.y * gridDim.z;
    unsigned sum, cnt, mine, sp = 0u;
    for (;;) {
        sum = 0u; cnt = 0u; mine = 0u;
#pragma unroll
        for (unsigned j = 0; j < 16; ++j) { const unsigned c = xb_ld(&bar[XB_XCNT(j)]); sum += c; cnt += (c > 0u) ? 1u : 0u; mine = (j == x) ? c : mine; }
        if (sum == G) break;
        __builtin_amdgcn_s_sleep(1);
        if ((++sp & 255u) == 0u) { if (xb_ld(&bar[XB_TMO])) break; if (sp > XB_SPIN_CAP) { atomicAdd(&bar[XB_TMO], 1u); break; } }
    }
    nloc = mine > 0u ? mine : 1u; nx = cnt > 0u ? cnt : 1u;
}

__device__ __forceinline__ void xcd_barrier(const XcdBarrier& b) {
    asm volatile("s_waitcnt vmcnt(0)" ::: "memory");
    __syncthreads();
    if (threadIdx.x == 0) {
        unsigned* bar = b.bar; unsigned bx = b.x; asm volatile("" : "+s"(bar), "+s"(bx));
        __builtin_amdgcn_s_waitcnt(0);
        unsigned nloc = b.st[0], nx = b.st[1];
        const unsigned old = xb_add(&bar[XB_XSUB(bx)], 1u);
        const unsigned gen = old / nloc;
        if (old + 1u == (gen + 1u) * nloc) {
            __builtin_amdgcn_fence(__ATOMIC_RELEASE, "agent");
            asm volatile("s_waitcnt vmcnt(0)" ::: "memory");
            const unsigned og = xb_add(&bar[XB_TOP], 1u);
            const unsigned tg = og / nx;
            if (og + 1u == (tg + 1u) * nx) xb_add(&bar[XB_TOPGEN], 1u);
            else XB_SPIN(xb_ld(&bar[XB_TOPGEN]) == tg, bar);
            __builtin_amdgcn_fence(__ATOMIC_ACQUIRE, "agent");
            xb_add(&bar[XB_XGEN(bx)], 1u);
            asm volatile("s_waitcnt vmcnt(0)" ::: "memory");
        } else {
            XB_SPIN(xb_ld(&bar[XB_XGEN(bx)]) == gen, bar);
            __builtin_amdgcn_fence(__ATOMIC_ACQUIRE, "agent");
            asm volatile("s_waitcnt vmcnt(0)" ::: "memory");
        }
    }
    __syncthreads();
}


__device__ __forceinline__ void xcd_barrier_census(const XcdBarrier& b) {
    if (threadIdx.x == 0) { unsigned nloc, nx; xcd_barrier_complete(b.bar, b.x, nloc, nx); b.st[0] = nloc; b.st[1] = nx; }
    __syncthreads();
}

typedef float f32x4m __attribute__((ext_vector_type(4)));
#define MFMA16(a, b, c) __builtin_amdgcn_mfma_f32_16x16x32_bf16((a), (b), (c), 0, 0, 0)
__device__ __forceinline__ unsigned off_b(unsigned row, unsigned ch) { return 256u * row + 16u * (ch ^ (((row & 3u) << 2) | ((row >> 2) & 3u))); }
__device__ __forceinline__ bf16x8 tr_frag(LAS unsigned char* tile, int lane, int c, int ks) {
    const unsigned g = lane >> 4, q = (lane & 15) >> 2, p = lane & 3;
    const s16x4 lo = __builtin_amdgcn_ds_read_tr16_b64_v4i16((LAS s16x4*)(tile + off_b(32 * ks + 8 * g + q, 2 * c + (p >> 1)) + 8 * (p & 1)));
    const s16x4 hi = __builtin_amdgcn_ds_read_tr16_b64_v4i16((LAS s16x4*)(tile + off_b(32 * ks + 8 * g + 4 + q, 2 * c + (p >> 1)) + 8 * (p & 1)));
    return (bf16x8){lo[0], lo[1], lo[2], lo[3], hi[0], hi[1], hi[2], hi[3]};
}
__device__ __forceinline__ bf16x8 pack8(const f32x4 a, const f32x4 b) {
    v4u w; w.x = cvtpk(a[0], a[1]); w.y = cvtpk(a[2], a[3]); w.z = cvtpk(b[0], b[1]); w.w = cvtpk(b[2], b[3]);
    return __builtin_bit_cast(bf16x8, w);
}
__device__ __forceinline__ float log_sigmoid(float x) { return -log1pf(expf(-x)); }

__device__ __forceinline__ int ret_row0(int b, int s) { return s < 2 ? ML + b * CTXL + s * 128 : b * SEQ + (s - 2) * 128; }

__device__ __forceinline__ void r1_unit(KArgs a, LAS unsigned char* lds, int unit) {
    const int tid = opaque_tid(), lane = tid & 63, wave = __builtin_amdgcn_readfirstlane(tid >> 6);
    const int s = unit % 34, bh = unit / 34, h = bh & 3, b = bh >> 2, row0 = ret_row0(b, s);
    const bf16* QKVG = (const bf16*)(a->ws + WS_QKVG);
    const float lgf = log_sigmoid(a->in[I_DECAY][h]), lgb = log_sigmoid(a->in[I_DECAY][4 + h]);
#pragma unroll
    for (int it = 0; it < 4; ++it) {
        const int n = tid + NTHREADS * it, row = n >> 4, ch = n & 15;
        const bf16* kp = QKVG + (size_t)(row0 + row) * 2048 + 512 + 128 * h + 8 * ch;
        const v4u kv = *(const v4u*)kp, vv = *(const v4u*)(kp + 512);
        const float wf = expf(lgf * (float)(127 - row)), wb = expf(lgb * (float)row);
        v4u kf, kb;
        kf.x = cvtpk(blo(kv.x) * wf, bhi(kv.x) * wf); kf.y = cvtpk(blo(kv.y) * wf, bhi(kv.y) * wf); kf.z = cvtpk(blo(kv.z) * wf, bhi(kv.z) * wf); kf.w = cvtpk(blo(kv.w) * wf, bhi(kv.w) * wf);
        kb.x = cvtpk(blo(kv.x) * wb, bhi(kv.x) * wb); kb.y = cvtpk(blo(kv.y) * wb, bhi(kv.y) * wb); kb.z = cvtpk(blo(kv.z) * wb, bhi(kv.z) * wb); kb.w = cvtpk(blo(kv.w) * wb, bhi(kv.w) * wb);
        const unsigned o = off_b(row, ch);
        *(LAS v4u*)(lds + o) = kf; *(LAS v4u*)(lds + 32768 + o) = kb; *(LAS v4u*)(lds + 65536 + o) = vv;
    }
    __syncthreads();
    f32x4 accf[8], accb[8];
#pragma unroll
    for (int c = 0; c < 8; ++c) { accf[c] = (f32x4){0.f, 0.f, 0.f, 0.f}; accb[c] = (f32x4){0.f, 0.f, 0.f, 0.f}; }
#pragma unroll
    for (int ks = 0; ks < 4; ++ks) {
        const bf16x8 kf = tr_frag(lds, lane, wave, ks), kb = tr_frag(lds + 32768, lane, wave, ks);
#pragma unroll
        for (int c = 0; c < 8; ++c) { const bf16x8 vf = tr_frag(lds + 65536, lane, c, ks); accf[c] = MFMA16(kf, vf, accf[c]); accb[c] = MFMA16(kb, vf, accb[c]); }
    }
    bf16* Sf = (bf16*)(a->ws + WS_KVS) + ((size_t)(bh * 2 + 0) * 34 + s) * 16384;
    bf16* Sb = (bf16*)(a->ws + WS_KVS) + ((size_t)(bh * 2 + 1) * 34 + s) * 16384;
    const int d0 = 16 * wave + 4 * (lane >> 4);
#pragma unroll
    for (int c = 0; c < 8; ++c) { const int e = 16 * c + (lane & 15);
        *(v2u*)(Sf + e * 128 + d0) = (v2u){cvtpk(accf[c][0], accf[c][1]), cvtpk(accf[c][2], accf[c][3])};
        *(v2u*)(Sb + e * 128 + d0) = (v2u){cvtpk(accb[c][0], accb[c][1]), cvtpk(accb[c][2], accb[c][3])}; }
    __syncthreads();
}

__device__ __forceinline__ void r2_items(KArgs a, int G) {
    const int gtid = blockIdx.x * NTHREADS + opaque_tid(), GT = G * NTHREADS;
    for (int idx = gtid; idx < 32 * 4096; idx += GT) {
        const int bhd = idx >> 12, o4 = idx & 4095, dir = bhd & 1, h = (bhd >> 1) & 3;
        const float decay = expf(log_sigmoid(a->in[I_DECAY][dir * 4 + h]) * 128.0f);
        bf16* base = (bf16*)(a->ws + WS_KVS) + (size_t)bhd * 34 * 16384 + o4 * 4;
        const long step = dir == 0 ? 16384 : -16384;
        bf16* p0 = base + (dir == 0 ? 0 : 16384); bf16* p2 = base + (dir == 0 ? 2 * 16384 : 33 * 16384);
        v2u v[34];
        { bf16* p = p0;
#pragma unroll
          for (int i = 0; i < 34; ++i) { if (i == 2) p = p2; v[i] = *(const v2u*)p; p += step; asm volatile("" : "+v"(p)); } }
        float st0 = 0.f, st1 = 0.f, st2 = 0.f, st3 = 0.f;
        { bf16* p = p0;
#pragma unroll
          for (int i = 0; i < 34; ++i) { if (i == 2) p = p2;
            *(v2u*)p = (v2u){cvtpk(st0, st1), cvtpk(st2, st3)}; p += step; asm volatile("" : "+v"(p));
            st0 = fmaf(decay, st0, blo(v[i].x)); st1 = fmaf(decay, st1, bhi(v[i].x)); st2 = fmaf(decay, st2, blo(v[i].y)); st3 = fmaf(decay, st3, bhi(v[i].y)); } }
    }
}

__device__ __forceinline__ void r3_unit(KArgs a, LAS unsigned char* lds, int unit) {
    const int tid = opaque_tid(), lane = tid & 63, wave = __builtin_amdgcn_readfirstlane(tid >> 6);
    const int s = unit % 34, bh = unit / 34, h = bh & 3, b = bh >> 2, row0 = ret_row0(b, s);
    const bf16* QKVG = (const bf16*)(a->ws + WS_QKVG);
    const float l2f = log_sigmoid(a->in[I_DECAY][h]) * 1.4426950408889634f, l2b = log_sigmoid(a->in[I_DECAY][4 + h]) * 1.4426950408889634f;
    const bf16* Sf = (const bf16*)(a->ws + WS_KVS) + ((size_t)(bh * 2 + 0) * 34 + s) * 16384;
    const bf16* Sb = (const bf16*)(a->ws + WS_KVS) + ((size_t)(bh * 2 + 1) * 34 + s) * 16384;
    {
        v4u t[8];
#pragma unroll
        for (int it = 0; it < 4; ++it) { const int n = tid + NTHREADS * it, row = n >> 4, ch = n & 15; const bf16* gp = QKVG + (size_t)(row0 + row) * 2048 + 512 + 128 * h + 8 * ch;
            t[it] = *(const v4u*)(gp + 512); t[4 + it] = *(const v4u*)gp; }
#pragma unroll
        for (int it = 0; it < 4; ++it) { const int n = tid + NTHREADS * it, row = n >> 4, ch = n & 15; const unsigned o = off_b(row, ch);
            *(LAS v4u*)(lds + o) = t[it]; *(LAS v4u*)(lds + 32768 + o) = t[4 + it]; }
#pragma unroll
        for (int it = 0; it < 4; ++it) { const int n = tid + NTHREADS * it; t[it] = *(const v4u*)(Sf + (size_t)n * 8); t[4 + it] = *(const v4u*)(Sb + (size_t)n * 8); }
#pragma unroll
        for (int it = 0; it < 4; ++it) { const int n = tid + NTHREADS * it, row = n >> 4, ch = n & 15; const unsigned o = off_b(row, ch);
            *(LAS v4u*)(lds + 65536 + o) = t[it]; *(LAS v4u*)(lds + 98304 + o) = t[4 + it]; }
    }
    const int fr = lane & 15, g = lane >> 4;
    bf16x8 qf[4];
#pragma unroll
    for (int ks = 0; ks < 4; ++ks) qf[ks] = *(const bf16x8*)(QKVG + (size_t)(row0 + 16 * wave + fr) * 2048 + 128 * h + 32 * ks + 8 * g);
    __syncthreads();
    f32x4 acco[8];
#pragma unroll
    for (int c = 0; c < 8; ++c) acco[c] = (f32x4){0.f, 0.f, 0.f, 0.f};
    const int iq = 16 * wave + fr;
#pragma unroll
    for (int jt = 0; jt < 4; ++jt) {
        f32x4 sa = (f32x4){0.f, 0.f, 0.f, 0.f}, sb = sa;
        const int ja = 32 * jt + 8 * (fr >> 2) + (fr & 3);
#pragma unroll
        for (int ks = 0; ks < 4; ++ks) {
            const bf16x8 ka = *(const LAS bf16x8*)(lds + 32768 + off_b(ja, 4 * ks + g)), kb = *(const LAS bf16x8*)(lds + 32768 + off_b(ja + 4, 4 * ks + g));
            sa = MFMA16(ka, qf[ks], sa); sb = MFMA16(kb, qf[ks], sb);
        }
        f32x4 pa, pb;
#pragma unroll
        for (int r = 0; r < 4; ++r) {
            const int j0 = 32 * jt + 8 * g + r, d0 = iq - j0, d1 = d0 - 4;
            const float w0 = (d0 >= 0 ? __builtin_amdgcn_exp2f(l2f * (float)d0) : 0.f) + (d0 <= 0 ? __builtin_amdgcn_exp2f(-l2b * (float)d0) : 0.f);
            const float w1 = (d1 >= 0 ? __builtin_amdgcn_exp2f(l2f * (float)d1) : 0.f) + (d1 <= 0 ? __builtin_amdgcn_exp2f(-l2b * (float)d1) : 0.f);
            pa[r] = sa[r] * w0; pb[r] = sb[r] * w1;
        }
        const bf16x8 pf = pack8(pa, pb);
#pragma unroll
        for (int c = 0; c < 8; ++c) { const bf16x8 vf = tr_frag(lds, lane, c, jt); acco[c] = MFMA16(pf, vf, acco[c]); }
    }
    float ff[4], fb[4];
#pragma unroll
    for (int r = 0; r < 4; ++r) { const int i = 16 * wave + 4 * g + r; ff[r] = __builtin_amdgcn_exp2f(l2f * (float)(i + 1)); fb[r] = __builtin_amdgcn_exp2f(l2b * (float)(128 - i)); }
    float ss[4] = {0.f, 0.f, 0.f, 0.f};
#pragma unroll
    for (int c = 0; c < 8; ++c) {
        f32x4 t1 = (f32x4){0.f, 0.f, 0.f, 0.f}, t2 = t1;
#pragma unroll
        for (int ks = 0; ks < 4; ++ks) {
            const unsigned o = off_b(16 * c + fr, 4 * ks + g);
            t1 = MFMA16(qf[ks], *(const LAS bf16x8*)(lds + 65536 + o), t1); t2 = MFMA16(qf[ks], *(const LAS bf16x8*)(lds + 98304 + o), t2);
        }
#pragma unroll
        for (int r = 0; r < 4; ++r) { const float o = acco[c][r] + ff[r] * t1[r] + fb[r] * t2[r]; acco[c][r] = o; ss[r] = fmaf(o, o, ss[r]); }
    }
#pragma unroll
    for (int r = 0; r < 4; ++r) { float v = ss[r]; v += __shfl_xor(v, 1); v += __shfl_xor(v, 2); v += __shfl_xor(v, 4); v += __shfl_xor(v, 8); ss[r] = rsqrtf(v * (1.0f / 128.0f) + EPS); }
    __syncthreads();
    LAS unsigned short* ost = (LAS unsigned short*)(lds + 32768 + wave * 4096);
#pragma unroll
    for (int r = 0; r < 4; ++r)
#pragma unroll
        for (int c = 0; c < 8; ++c) ost[(4 * g + r) * 128 + 16 * c + fr] = (unsigned short)f2bf(acco[c][r] * ss[r]);
    asm volatile("s_waitcnt lgkmcnt(0)" ::: "memory");
    bf16* YM = (bf16*)(a->ws + WS_XN);
#pragma unroll
    for (int it = 0; it < 4; ++it) {
        const int n = lane + 64 * it, rr = n >> 4, ch = n & 15; const size_t row = (size_t)(row0 + 16 * wave + rr);
        const v4u ov = *(const LAS v4u*)(ost + rr * 128 + 8 * ch), gv = *(const v4u*)(QKVG + row * 2048 + 1536 + 128 * h + 8 * ch);
        v4u y;
        y.x = cvtpk(blo(ov.x) * pg8::fsilu(blo(gv.x)), bhi(ov.x) * pg8::fsilu(bhi(gv.x))); y.y = cvtpk(blo(ov.y) * pg8::fsilu(blo(gv.y)), bhi(ov.y) * pg8::fsilu(bhi(gv.y)));
        y.z = cvtpk(blo(ov.z) * pg8::fsilu(blo(gv.z)), bhi(ov.z) * pg8::fsilu(bhi(gv.z))); y.w = cvtpk(blo(ov.w) * pg8::fsilu(blo(gv.w)), bhi(ov.w) * pg8::fsilu(bhi(gv.w)));
        *(v4u*)(YM + row * DM + 128 * h + 8 * ch) = y;
    }
    __syncthreads();
}

__device__ __forceinline__ int s5_row0(int b, int c) { return c < 4 ? ML + b * CTXL + 64 * c : b * SEQ + 64 * (c - 4); }
constexpr int S5_WLDS = 12288;

__device__ __forceinline__ void s5_bu_block(const bf16x8 (&bbm)[8], const bf16* urow  , LAS unsigned char* bu, int fr, int gq) {
    bf16x8 uf = (bf16x8){0, 0, 0, 0, 0, 0, 0, 0};
    if (gq < 2) uf = *(const bf16x8*)urow;
#pragma unroll
    for (int j = 0; j < 8; ++j) {
        const f32x4 d = MFMA16(bbm[j], uf, ((f32x4){0.f, 0.f, 0.f, 0.f}));
        *(LAS v2u*)(bu + fr * 256 + (((2 * j + (gq >> 1)) ^ fr) * 16) + (gq & 1) * 8) = (v2u){cvtpk(d[0], d[1]), cvtpk(d[2], d[3])};
    }
    asm volatile("s_waitcnt lgkmcnt(0)" ::: "memory");
}
#define S5_BUREAD(tl_) ({ const unsigned w_ = *(const LAS unsigned*)(bu + (tl_) * 256 + (((p >> 2) ^ (tl_)) * 16) + (p & 3) * 4); (f32x2){blo(w_), bhi(w_)}; })
#define S5_UPD(bu_)  { const f32x2 xs_ = (f32x2){xv.y, xv.x}; xv = lrr * xv + (lmi * xs_ + (bu_)); }

__device__ __forceinline__ void s1_unit(KArgs a, LAS unsigned char* wl, int wu, int lane) {
    const int c = wu % 68, bgd = wu / 68, dir = bgd & 1, g = (bgd >> 1) & 31, b = bgd >> 6, dg = dir * 32 + g, p = lane, fr = lane & 15, gq = lane >> 4;
    LAS unsigned char* bu = wl;
    const f32x2 lb = ((const f32x2*)(a->ws + WS_LB))[dg * 64 + p]; const f32x2 lrr = (f32x2){lb.x, lb.x}, lmi = (f32x2){-lb.y, lb.y};
    bf16x8 bbm[8];
#pragma unroll
    for (int j = 0; j < 8; ++j) { bbm[j] = (bf16x8){0, 0, 0, 0, 0, 0, 0, 0}; if (gq < 2) bbm[j] = *(const bf16x8*)((const bf16*)(a->ws + WS_BBM) + ((size_t)dg * 128 + 16 * j + fr) * 16 + 8 * gq); }
    const bf16* ub = (const bf16*)(a->ws + WS_U) + (size_t)(s5_row0(b, c) + fr) * 512 + 16 * g + 8 * (gq & 1);
    f32x2 xv = (f32x2){0.f, 0.f};
    for (int blk = 0; blk < 4; ++blk) {
        const int tb = dir ? 3 - blk : blk;
        s5_bu_block(bbm, ub + (size_t)(16 * tb) * 512, bu, fr, gq);
        if (dir == 0) {
#pragma unroll
            for (int tl = 0; tl < 16; ++tl) { const f32x2 bv = S5_BUREAD(tl); S5_UPD(bv) }
        } else {
#pragma unroll
            for (int tl = 15; tl >= 0; --tl) { const f32x2 bv = S5_BUREAD(tl); S5_UPD(bv) }
        }
        asm volatile("s_waitcnt lgkmcnt(0)" ::: "memory");
    }
    ((f32x2*)(a->ws + WS_SF))[(size_t)wu * 64 + p] = xv;
}
__device__ __forceinline__ void s2_items(KArgs a, int G) {
    const int gtid = blockIdx.x * NTHREADS + opaque_tid(), GT = G * NTHREADS;
    for (int idx = gtid; idx < 4 * 32 * 2 * 64; idx += GT) {
        const int p = idx & 63, bgd = idx >> 6, dir = bgd & 1, g = (bgd >> 1) & 31, dg = dir * 32 + g;
        const f32x2 lt = ((const f32x2*)(a->ws + WS_LBT))[dg * 64 + p];
        f32x2* base = (f32x2*)(a->ws + WS_SF) + (size_t)bgd * 68 * 64 + p;
        const long step = dir == 0 ? 64 : -64;
        f32x2* q0 = base + (dir == 0 ? 0 : 3 * 64); f32x2* q4 = base + (dir == 0 ? 4 * 64 : 67 * 64);
        float cr = 0.f, ci = 0.f;
        f32x2* pl = q0; f32x2* ps = q0;
#pragma unroll
        for (int hb = 0; hb < 2; ++hb) {
            f32x2 v[34];
#pragma unroll
            for (int j = 0; j < 34; ++j) { if (34 * hb + j == 4) pl = q4; v[j] = *pl; pl += step; asm volatile("" : "+v"(pl)); }
#pragma unroll
            for (int j = 0; j < 34; ++j) { if (34 * hb + j == 4) ps = q4; *ps = (f32x2){cr, ci}; ps += step; asm volatile("" : "+v"(ps));
                const float nr = fmaf(lt.x, cr, fmaf(-lt.y, ci, v[j].x)), ni = fmaf(lt.x, ci, fmaf(lt.y, cr, v[j].y)); cr = nr; ci = ni; }
        }
    }
}
__device__ __forceinline__ void s3_unit(KArgs a, LAS unsigned char* wl, int wu, int lane) {
    const int c = wu % 68, bg = wu / 68, g = bg & 31, b = bg >> 5, p = lane, fr = lane & 15, gq = lane >> 4;
    LAS unsigned char* bu = wl; LAS unsigned char* xs = wl + 4096;
    const int rowbase = s5_row0(b, c);
    const bf16* ub = (const bf16*)(a->ws + WS_U) + (size_t)(rowbase + fr) * 512 + 16 * g + 8 * (gq & 1);
    f32x4 acc[4];
#pragma unroll
    for (int i = 0; i < 4; ++i) acc[i] = (f32x4){0.f, 0.f, 0.f, 0.f};
#pragma unroll
    for (int dir = 0; dir < 2; ++dir) {
        const int dg = dir * 32 + g;
        const f32x2 lb = ((const f32x2*)(a->ws + WS_LB))[dg * 64 + p]; const f32x2 lrr = (f32x2){lb.x, lb.x}, lmi = (f32x2){-lb.y, lb.y};
        bf16x8 bbm[8];
#pragma unroll
        for (int j = 0; j < 8; ++j) { bbm[j] = (bf16x8){0, 0, 0, 0, 0, 0, 0, 0}; if (gq < 2) bbm[j] = *(const bf16x8*)((const bf16*)(a->ws + WS_BBM) + ((size_t)dg * 128 + 16 * j + fr) * 16 + 8 * gq); }
        bf16x8 cm[4];
#pragma unroll
        for (int ks = 0; ks < 4; ++ks) cm[ks] = *(const bf16x8*)((const bf16*)(a->ws + WS_CM) + (size_t)(dg * 16 + fr) * 128 + 32 * ks + 8 * gq);
        f32x2 xv = ((const f32x2*)(a->ws + WS_SF))[((size_t)((b * 32 + g) * 2 + dir) * 68 + c) * 64 + p];
#pragma unroll
        for (int half = 0; half < 2; ++half) {
            const int hs = dir ? 1 - half : half;
#pragma unroll
            for (int q = 0; q < 2; ++q) {
                const int tq = dir ? 1 - q : q;
                s5_bu_block(bbm, ub + (size_t)(32 * hs + 16 * tq) * 512, bu, fr, gq);
#define S5_XST(tl_) *(LAS unsigned*)(xs + (16 * tq + (tl_)) * 256 + (((p >> 2) ^ (tl_)) * 16) + (p & 3) * 4) = cvtpk(xv.x, xv.y);
                if (dir == 0) {
#pragma unroll
                    for (int tl = 0; tl < 16; ++tl) { const f32x2 bv = S5_BUREAD(tl); S5_UPD(bv) S5_XST(tl) }
                } else {
#pragma unroll
                    for (int tl = 15; tl >= 0; --tl) { const f32x2 bv = S5_BUREAD(tl); S5_UPD(bv) S5_XST(tl) }
                }
#undef S5_XST
                asm volatile("s_waitcnt lgkmcnt(0)" ::: "memory");
            }
#pragma unroll
            for (int th = 0; th < 2; ++th) {
                const int row = 16 * th + fr;
                f32x4 d = acc[2 * hs + th];
#pragma unroll
                for (int ks = 0; ks < 4; ++ks) { const bf16x8 xf = *(const LAS bf16x8*)(xs + row * 256 + (((4 * ks + gq) ^ (row & 15)) * 16)); d = MFMA16(cm[ks], xf, d); }
                acc[2 * hs + th] = d;
            }
            asm volatile("s_waitcnt lgkmcnt(0)" ::: "memory");
        }
    }
    const f32x4 dsk = *(const f32x4*)(a->in[I_S5D] + 16 * g + 4 * gq);
    bf16* YS = (bf16*)(a->ws + WS_YS);
#pragma unroll
    for (int T4 = 0; T4 < 4; ++T4) {
        const int t = 16 * T4 + fr; const v2u uw = *(const v2u*)((const bf16*)(a->ws + WS_U) + (size_t)(rowbase + t) * 512 + 16 * g + 4 * gq);
        const f32x4 y = acc[T4] + dsk * (f32x4){blo(uw.x), bhi(uw.x), blo(uw.y), bhi(uw.y)};
        *(v2u*)(YS + (size_t)(rowbase + t) * 512 + 16 * g + 4 * gq) = (v2u){cvtpk(gelu_tanh(y[0]), gelu_tanh(y[1])), cvtpk(gelu_tanh(y[2]), gelu_tanh(y[3]))};
    }
}

constexpr int NA_KSTR = 144, NA_VSTR = 976, NA_VCSTR = 528;
constexpr int NA_VOFF = 480 * NA_KSTR;
constexpr int NA_VCOFF = 256 * NA_KSTR;
constexpr int NA_RPBOFF = NA_VOFF + 64 * NA_VSTR;
__device__ __forceinline__ void na_unit(KArgs a, LAS unsigned char* lds, int unit) {
    const int tid = opaque_tid(), lane = tid & 63, wave = __builtin_amdgcn_readfirstlane(tid >> 6);
    const int rb = unit & 7, cb = (unit >> 3) & 3, h = (unit >> 5) & 15, b = unit >> 9, fr = lane & 15, g = lane >> 4;
    const bf16* QK = (const bf16*)(a->ws + WS_QK); const bf16* VT = (const bf16*)(a->ws + WS_VT); bf16* AO = (bf16*)(a->ws + WS_XN);
    const int kcol0 = min(max(16 * cb - 8, 0), 32);
    const int Rlo = min(max(8 * rb - 4, 0), 56), nrows = min(max(8 * rb + 3, 0), 56) + 8 - Rlo;
    const int r = 8 * rb + wave, r0 = min(max(r - 4, 0), 56);
    {
        const bf16* kg = QK + (size_t)(b * SEQ + Rlo * 64 + kcol0) * 2048 + 1024 + 64 * h;
        { v4u t[8]; const int lim = nrows * 256;
#pragma unroll
          for (int it = 0; it < 8; ++it) { const int n = tid + NTHREADS * it, key = n >> 3, ch = n & 7, kr = key >> 5, co = key & 31; if (n < lim) t[it] = *(const v4u*)(kg + (size_t)(kr * 64 + co) * 2048 + 8 * ch); }
#pragma unroll
          for (int it = 0; it < 8; ++it) { const int n = tid + NTHREADS * it, key = n >> 3, ch = n & 7; if (n < lim) *(LAS v4u*)(lds + key * NA_KSTR + ch * 16) = t[it]; } }
        const bf16* vg = VT + (size_t)(64 * h) * MT + b * SEQ + Rlo * 64 + kcol0;
        { v4u t[8];
#pragma unroll
          for (int it = 0; it < 8; ++it) { const int n = tid + NTHREADS * it, d = n / 60, rem = n - d * 60, kr = rem >> 2, c4 = rem & 3; if (n < 64 * 60 && kr < nrows) t[it] = *(const v4u*)(vg + (size_t)d * MT + kr * 64 + 8 * c4); }
#pragma unroll
          for (int it = 0; it < 8; ++it) { const int n = tid + NTHREADS * it, d = n / 60, rem = n - d * 60, kr = rem >> 2, c4 = rem & 3; if (n < 64 * 60 && kr < nrows) *(LAS v4u*)(lds + NA_VOFF + d * NA_VSTR + (kr * 32 + 8 * c4) * 2) = t[it]; } }
    }
    const int tq0 = b * SEQ + r * 64 + 16 * cb;
    const bf16* qb = QK + (size_t)tq0 * 2048 + 64 * h;
    const unsigned qoff = (unsigned)(fr * 2048 + 8 * g);
    bf16x8 qf[2]; qf[0] = *(const bf16x8*)(qb + qoff); qf[1] = *(const bf16x8*)(qb + qoff + 32);
    const int koffl = (8 * (fr >> 2) + (fr & 3)) * NA_KSTR + 16 * g;
    const int cq = 16 * cb + fr, ws = min(max(cq - 8, 0), 48);
    const int vbase = kcol0 + 8 * g - ws, ibase = kcol0 + 8 * g - cq + 15;
    LAS float* rpbl = (LAS float*)(lds + NA_RPBOFF);
    if (tid < 15 * 31) rpbl[tid] = a->in[I_RPB][(size_t)h * 15 * 31 + tid];
    f32x4 o[4];
#pragma unroll
    for (int dt = 0; dt < 4; ++dt) o[dt] = (f32x4){0.f, 0.f, 0.f, 0.f};
    float mrun = -1e30f, lsum = 0.f;
    __syncthreads();
#pragma unroll 1
    for (int half = 0; half < 2; ++half) {
        if (half == 1) {
            __syncthreads();
            const bf16* kg = QK + (size_t)(ML + b * CTXL) * 2048 + 1024 + 64 * h;
            v4u t[8];
#pragma unroll
            for (int it = 0; it < 4; ++it) { const int n = tid + NTHREADS * it, key = n >> 3, ch = n & 7; t[it] = *(const v4u*)(kg + (size_t)key * 2048 + 8 * ch); }
            const bf16* vg = VT + (size_t)(64 * h) * MT + ML + b * CTXL;
#pragma unroll
            for (int it = 0; it < 4; ++it) { const int n = tid + NTHREADS * it, d = n >> 5, c = n & 31; t[4 + it] = *(const v4u*)(vg + (size_t)d * MT + 8 * c); }
#pragma unroll
            for (int it = 0; it < 4; ++it) { const int n = tid + NTHREADS * it, key = n >> 3, ch = n & 7; *(LAS v4u*)(lds + key * NA_KSTR + ch * 16) = t[it]; }
#pragma unroll
            for (int it = 0; it < 4; ++it) { const int n = tid + NTHREADS * it, d = n >> 5, c = n & 31; *(LAS v4u*)(lds + NA_VCOFF + d * NA_VCSTR + c * 16) = t[4 + it]; }
            __syncthreads();
        }
        const int kbase = half == 0 ? (r0 - Rlo) * 32 : 0;
        const LAS unsigned char* kl = lds + kbase * NA_KSTR + koffl;
        const LAS unsigned char* vl = half == 0 ? lds + NA_VOFF + fr * NA_VSTR + (kbase + 8 * g) * 2 : lds + NA_VCOFF + fr * NA_VCSTR + (8 * g) * 2;
        const int vstr16 = 16 * (half == 0 ? NA_VSTR : NA_VCSTR);
#pragma unroll 1
        for (int qt = 0; qt < 2; ++qt) {
            f32x4 sc[4][2];
#pragma unroll
            for (int ii = 0; ii < 4; ++ii) {
                const int i = 4 * qt + ii;
                const LAS unsigned char* kp = kl + i * 32 * NA_KSTR;
                f32x4 sa = (f32x4){0.f, 0.f, 0.f, 0.f}, sb = sa;
                sa = MFMA16(*(const LAS bf16x8*)kp, qf[0], sa); sa = MFMA16(*(const LAS bf16x8*)(kp + 64), qf[1], sa);
                sb = MFMA16(*(const LAS bf16x8*)(kp + 4 * NA_KSTR), qf[0], sb); sb = MFMA16(*(const LAS bf16x8*)(kp + 4 * NA_KSTR + 64), qf[1], sb);
                if (half == 0) {
                    const LAS float* bp = rpbl + (r0 + i - r + 7) * 31;
#pragma unroll
                    for (int rr = 0; rr < 4; ++rr) { const float b0 = bp[min(max(ibase + rr, 0), 30)], b1 = bp[min(max(ibase + 4 + rr, 0), 30)];
                        sa[rr] = (unsigned)(vbase + rr) < 16u ? sa[rr] + b0 : -1e30f; sb[rr] = (unsigned)(vbase + 4 + rr) < 16u ? sb[rr] + b1 : -1e30f; }
                }
                sc[ii][0] = sa; sc[ii][1] = sb;
            }
            float mx = -1e30f;
#pragma unroll
            for (int ii = 0; ii < 4; ++ii)
#pragma unroll
                for (int t = 0; t < 2; ++t) mx = fmaxf(mx, fmaxf(fmaxf(sc[ii][t][0], sc[ii][t][1]), fmaxf(sc[ii][t][2], sc[ii][t][3])));
            mx = fmaxf(mx, __shfl_xor(mx, 16)); mx = fmaxf(mx, __shfl_xor(mx, 32));
            const float mnew = fmaxf(mrun, mx);
            const float resc = __builtin_amdgcn_exp2f((mrun - mnew) * 1.4426950408889634f);
            mrun = mnew; lsum *= resc;
#pragma unroll
            for (int dt = 0; dt < 4; ++dt) o[dt] = o[dt] * resc;
            const float mneg = -mnew * 1.4426950408889634f;
            float ls = 0.f;
#pragma unroll
            for (int ii = 0; ii < 4; ++ii)
#pragma unroll
                for (int t = 0; t < 2; ++t)
#pragma unroll
                    for (int rr = 0; rr < 4; ++rr) { const float pv = __builtin_amdgcn_exp2f(fmaf(sc[ii][t][rr], 1.4426950408889634f, mneg)); sc[ii][t][rr] = pv; ls += pv; }
            lsum += ls;
#pragma unroll
            for (int ii = 0; ii < 4; ++ii) {
                const bf16x8 pf = pack8(sc[ii][0], sc[ii][1]);
#pragma unroll
                for (int dt = 0; dt < 4; ++dt) o[dt] = MFMA16(*(const LAS bf16x8*)(vl + dt * vstr16 + (4 * qt + ii) * 64), pf, o[dt]);
            }
        }
    }
    lsum += __shfl_xor(lsum, 16); lsum += __shfl_xor(lsum, 32);
    const float rl = 1.0f / lsum;
    bf16* ob = AO + (size_t)tq0 * DM + 64 * h;
#pragma unroll
    for (int dt = 0; dt < 4; ++dt)
        *(v2u*)(ob + (unsigned)(fr * DM + 16 * dt + 4 * g)) = (v2u){cvtpk(o[dt][0] * rl, o[dt][1] * rl), cvtpk(o[dt][2] * rl, o[dt][3] * rl)};
    __syncthreads();
}

#ifndef STAGE
#define STAGE 6
#endif
#define GSYNC() xcd_barrier(bar)
#ifndef REP_A
#define REP_A 1
#endif
#ifndef REP_B
#define REP_B 1
#endif
#ifndef REP_MODE
#define REP_MODE 0
#endif
#ifndef REP_G1
#define REP_G1 1
#endif
#ifndef REP_G2
#define REP_G2 1
#endif
#ifndef REP_P0
#define REP_P0 1
#endif
#ifndef REP_NORM
#define REP_NORM 1
#endif
#ifndef REP_N
#define REP_N 1
#endif

__device__ __forceinline__ int s_deal(int c, int j, int G, int nS, int n_lo) {
    if (G != 256) { const int v = c + j * G; return v < nS ? v : -1; }
    if (c < 32) return j < n_lo ? c * n_lo + j : -1;
    const int v = 32 * n_lo + (c - 32) + 224 * j; return v < nS ? v : -1;
}
template <class Epi>
__device__ __forceinline__ void run_gemm(LAS unsigned char* lds, const bf16* A, const bf16* Bt, int M, int N, int K, int G, const Epi& E) {
    pg8::Gemm g{A, Bt, M, N, K, A, Bt}; pg8::StaticOrder S; S.init(M, N, G, (int)blockIdx.x, K);
    pg8::gemm_phase<Epi, pg8::StaticOrder, true, true>(lds, g, S, E);
}
template <class Epi>
__device__ __forceinline__ void run_gemm_splitctx(LAS unsigned char* lds, const bf16* A, const bf16* Bt, int N, int K, int nsplit, int G, const Epi& E) {
    pg8::Gemm g{A, Bt, MT, N, K, A, Bt}; pg8::SplitCtxOrder S; S.init(ML, MC, N, K, G, (int)blockIdx.x, nsplit);
    pg8::gemm_phase<Epi, pg8::SplitCtxOrder, true, true>(lds, g, S, E);
}

__device__ __forceinline__ void ffn_block(KArgs a, LAS unsigned char* lds, const XcdBarrier& bar, int G, int layer, int f, const float* rin_lat, const float* rin_ctx, int nrows, const float* part_in, int npart_in) {
    const float* MODL = (const float*)(a->ws + WS_MOD) + (size_t)layer * 5 * MODW;
    float* hl = a->out; float* hc = (float*)(a->ws + WS_HCTX);
    bf16* XN = (bf16*)(a->ws + WS_XN); bf16* HID = (bf16*)(a->ws + WS_HID);
    const bf16* W1b = (const bf16*)(a->ws + WS_W1) + (size_t)(layer * 2 + f) * 2 * FF * DM;
    const bf16* W2b = (const bf16*)(a->ws + WS_W2) + (size_t)(layer * 2 + f) * DM * FF;
    for (int rep = 1; rep < REP_NORM; ++rep) { norm_phase(rin_lat, rin_ctx, XN, a->in[I_NORMG] + (size_t)(layer * 3 + (f ? 2 : 0)) * DM, MODL, f ? 6 : 0, nrows, G, nullptr, 0, hc); GSYNC(); }
    norm_phase(rin_lat, rin_ctx, XN, a->in[I_NORMG] + (size_t)(layer * 3 + (f ? 2 : 0)) * DM, MODL, f ? 6 : 0, nrows, G, part_in, npart_in, hc);
    GSYNC();
    for (int rep = 0; rep < REP_G1; ++rep) {
    { pg8::EpiSwiglu E{HID, FF}; run_gemm(lds, XN, W1b, nrows, 2 * FF, DM, G, E); }
    GSYNC(); }
    for (int rep = 0; rep < REP_G2; ++rep) {
    { pg8::EpiResid E{rin_lat, rin_ctx, hl, hc, MODL + (f ? 8 : 2) * DM, (float*)(a->ws + WS_PARTF), rep == REP_G2 - 1 ? 0.5f : 0.0f};
      if (nrows == MT) run_gemm_splitctx(lds, HID, W2b, DM, FF, 11, G, E); else run_gemm(lds, HID, W2b, nrows, DM, FF, G, E); }
    GSYNC(); }
}

__global__ void __launch_bounds__(NTHREADS, 2) fwd_megakernel(Args a_unused) {
#define a kargs()
    extern __shared__ __attribute__((aligned(16))) unsigned char lds_raw[];
    LAS unsigned char* lds = (LAS unsigned char*)lds_raw;
    cg::grid_group grid = cg::this_grid();
    const int G = gridDim.x;
#define LANEWAVE() const int tid = opaque_tid(), lane = tid & 63, wave = __builtin_amdgcn_readfirstlane(tid >> 6)
#define hl (a->out)
#define hc ((float*)(a->ws + WS_HCTX))
#define XN ((bf16*)(a->ws + WS_XN))
#define MOD0 ((const float*)(a->ws + WS_MOD))
#define MOD1 (MOD0 + 5 * MODW)

    if (threadIdx.x < 8) ((LAS unsigned*)(lds + BARLDS_OFF))[threadIdx.x] = 0u;
    __syncthreads();
    const XcdBarrier bar = xcd_barrier_post((unsigned*)(a->ws + WS_BAR), (volatile LAS unsigned*)(lds + BARLDS_OFF));

#ifndef REP_P0_PARTS
#define REP_P0_PARTS 7
#endif
    for (int rep = 1; rep < REP_P0; ++rep) { p0_prologue(a, lds, G, REP_P0_PARTS); __syncthreads(); }
    p0_prologue(a, lds, G);
    grid.sync();
    xcd_barrier_census(bar);

    if (STAGE == 0) {
        const int gtid = blockIdx.x * NTHREADS + opaque_tid(), GT = G * NTHREADS;
        for (int i = gtid; i < ML * DM / 4; i += GT) ((f32x4*)hl)[i] = ((const f32x4*)a->in[I_X])[i];
        GSYNC();
    }
    if (STAGE >= 1) ffn_block(a, lds, bar, G, 0, 0, a->in[I_X], hc, MT, nullptr, 0);
    if (STAGE >= 2) {
        norm_phase(hl, hc, XN, a->in[I_NORMG] + 1 * DM, MOD0, 3, MT, G, (const float*)(a->ws + WS_PARTF), 11, hc);
        GSYNC();
        { pg8::EpiWin E{(bf16*)(a->ws + WS_QKVG), (bf16*)(a->ws + WS_U), (const float*)(a->ws + WS_ROPE)}; run_gemm(lds, XN, (const bf16*)(a->ws + WS_WIN), MT, 2560, DM, G, E); }
        GSYNC();
        for (int rep = 0; rep < REP_A; ++rep) {
        { LANEWAVE(); if (!(rep > 0 && REP_MODE == 2)) for (int u = blockIdx.x; u < 544; u += G) r1_unit(a, lds, u);
          if (!(rep > 0 && REP_MODE == 1)) for (int j = 0; ; ++j) { const int v = s_deal((int)blockIdx.x, j, G, 2176, 5); if (v < 0) break; s1_unit(a, lds + wave * S5_WLDS, v * 8 + wave, lane); } }
        GSYNC(); }
        r2_items(a, G); s2_items(a, G);
        GSYNC();
        for (int rep = 0; rep < REP_B; ++rep) {
        { LANEWAVE(); if (!(rep > 0 && REP_MODE == 2)) for (int u = blockIdx.x; u < 544; u += G) r3_unit(a, lds, u);
          if (!(rep > 0 && REP_MODE == 1)) for (int j = 0; ; ++j) { const int v = s_deal((int)blockIdx.x, j, G, 1088, 3); if (v < 0) break; s3_unit(a, lds + wave * S5_WLDS, v * 8 + wave, lane); } }
        GSYNC(); }
        { pg8::EpiGlu E{(const bf16*)(a->ws + WS_YS), XN, a->in[I_GLUB]}; run_gemm(lds, (const bf16*)(a->ws + WS_YS), (const bf16*)(a->ws + WS_GLU), MT, 512, 512, G, E); }
        GSYNC();
        { pg8::EpiResid E{hl, hc, hl, hc, MOD0 + 5 * DM, (float*)(a->ws + WS_PARTM), 1.0f}; run_gemm_splitctx(lds, XN, (const bf16*)(a->ws + WS_WOUT), DM, DM, 8, G, E); }
        GSYNC();
    }
    if (STAGE >= 3) ffn_block(a, lds, bar, G, 0, 1, hl, hc, MT, (const float*)(a->ws + WS_PARTM), 8);
    if (STAGE >= 4) ffn_block(a, lds, bar, G, 1, 0, hl, hc, MT, (const float*)(a->ws + WS_PARTF), 11);
    if (STAGE >= 5) {
        norm_phase(hl, hc, XN, a->in[I_NORMG] + 4 * DM, MOD1, 3, MT, G, (const float*)(a->ws + WS_PARTF), 11, hc);
        GSYNC();
        { pg8::EpiQkVt E{(bf16*)(a->ws + WS_QK), (bf16*)(a->ws + WS_VT)};
          pg8::Gemm g{XN, (const bf16*)(a->ws + WS_WQKV), MT, 2048, DM, (const bf16*)(a->ws + WS_WQKV) + (size_t)2048 * DM, XN};
          pg8::QkVtOrder S; S.init(DM, G, (int)blockIdx.x);
          pg8::gemm_phase<pg8::EpiQkVt, pg8::QkVtOrder, true, true>(lds, g, S, E); }
        GSYNC();
        for (int rep = 0; rep < REP_N; ++rep) {
        for (int u = blockIdx.x; u < 2048; u += G) na_unit(a, lds, u);
        GSYNC(); }
        { pg8::EpiResid E{hl, hc, hl, hc, MOD1 + 5 * DM, nullptr, 1.0f}; run_gemm(lds, XN, (const bf16*)(a->ws + WS_WO), ML, DM, DM, G, E); }
        GSYNC();
    }
    if (STAGE >= 6) ffn_block(a, lds, bar, G, 1, 1, hl, hc, ML, nullptr, 0);
    final_norm_phase(a->out, a->in[I_FINALG], G);
#undef a
#undef hl
#undef hc
#undef XN
#undef MOD0
#undef MOD1
}

extern "C" void kernel_launch(void* const* d_in, const int* in_sizes, int n_in, void* d_out, int out_size, void* d_ws, size_t ws_size, hipStream_t stream) {
    static int grid = 0;
    if (grid == 0) {
        if (n_in != 26 || out_size != ML * DM || ws_size < WS_END) { fprintf(stderr, "kernel_launch: unexpected problem (n_in %d, out %d, ws %zu)\n", n_in, out_size, ws_size); grid = -1; return; }
        int dev = 0, cus = 0, per_cu = 0;
        if (hipGetDevice(&dev) != hipSuccess || hipDeviceGetAttribute(&cus, hipDeviceAttributeMultiprocessorCount, dev) != hipSuccess) { grid = -1; return; }
        if (hipFuncSetAttribute((const void*)fwd_megakernel, hipFuncAttributeMaxDynamicSharedMemorySize, LDS_BYTES) != hipSuccess) { fprintf(stderr, "kernel_launch: hipFuncSetAttribute failed\n"); grid = -1; return; }
        if (hipOccupancyMaxActiveBlocksPerMultiprocessor(&per_cu, (const void*)fwd_megakernel, NTHREADS, LDS_BYTES) != hipSuccess || per_cu < 1) { fprintf(stderr, "kernel_launch: occupancy query failed (%d)\n", per_cu); (void)hipGetLastError(); grid = -1; return; }
        grid = cus * per_cu;
    }
    if (grid < 0) return;
    if (hipMemsetAsync((char*)d_ws + WS_BAR, 0, 16384, stream) != hipSuccess) { fprintf(stderr, "kernel_launch: memset failed\n"); return; }
    Args a{};
    for (int i = 0; i < 26; ++i) a.in[i] = (const float*)d_in[i];
    a.out = (float*)d_out; a.ws = (unsigned char*)d_ws; a.probe = 0; a.pad = 0;
    void* args[] = {&a};
    hipError_t e = hipLaunchCooperativeKernel((const void*)fwd_megakernel, dim3(grid), dim3(NTHREADS), args, LDS_BYTES, stream);
    if (e != hipSuccess) fprintf(stderr, "kernel_launch: cooperative launch failed: %s (grid %d)\n", hipGetErrorString(e), grid);
}
```

```cpp
#include <hip/hip_runtime.h>
#include <hip/hip_cooperative_groups.h>
#include <cstdio>
#include <cstdint>
namespace cg = cooperative_groups;

constexpr int DM = 1024, NB = 4, SEQ = 4096, CTXL = 256, FF = 2816, NMOD = 9;
constexpr int ML = NB * SEQ, MC = NB * CTXL, MT = ML + MC;
constexpr int MODW = NMOD * DM;
constexpr float EPS = 1e-6f;

namespace pg8 {
#define PG8_LAS __attribute__((address_space(3)))
typedef unsigned short bf16_t;
typedef short bf16x8 __attribute__((ext_vector_type(8)));
typedef float f32x4 __attribute__((ext_vector_type(4)));
typedef unsigned u32x4 __attribute__((ext_vector_type(4)));
constexpr int BM = 256, BK = 64, HALF = 128, HTB = HALF * BK * 2  , STAGE_BYTES = 8 * HTB, NXCD = 8, WGM = 8;

__host__ __device__ __forceinline__ int lds_byte(int r, int c) { const int st = (r >> 4) * 2 + (c >> 5), rr = r & 15, cc = c & 31, ob = rr * 64 + cc * 2; return st * 1024 + (ob ^ (((ob >> 9) & 1) << 5)); }
__host__ __device__ __forceinline__ void stage_rc(int b, int& R, int& C) { const int st = b / 1024, sb = b % 1024, swz = sb ^ (((sb >> 9) & 1) << 5); R = (st >> 1) * 16 + swz / 64; C = (st & 1) * 32 + (swz % 64) / 2; }
__host__ __device__ __forceinline__ int perm32(int rho) { const int n = rho >> 4, i = rho & 15; return 8 * (i >> 2) + 4 * n + (i & 3); }

struct Unit { int pm, pn, k0, nt, split, which; };
struct Gemm { const bf16_t* A; const bf16_t* Bt; int M, N, K; const bf16_t* A2; const bf16_t* Bt2; };

struct StaticOrder {
    int nM, nN, nwg, G, c, ntk;
    __host__ __device__ void init(int M, int N, int G_, int c_, int K_ = 0) { nM = M / BM; nN = N / BM; nwg = nM * nN; G = G_; c = c_; ntk = K_ / BK; }
    __host__ __device__ bool next(int i, Unit& u) const {
        const long L = (long)i * G + c; if (L >= nwg) return false;
        int wgid = (int)L; { const int q = nwg / NXCD, r = nwg % NXCD, xcd = wgid % NXCD, off = wgid / NXCD; wgid = (xcd < r ? xcd * (q + 1) : r * (q + 1) + (xcd - r) * q) + off; }
        const int nig = WGM * nN, gid = wgid / nig, fm = gid * WGM, gsz = (nM - fm) < WGM ? (nM - fm) : WGM;
        u.pm = fm + ((wgid % nig) % gsz); u.pn = (wgid % nig) / gsz; u.k0 = 0; u.nt = ntk; u.split = 0; u.which = 0; return true;
    }
    __device__ __forceinline__ void a_ready(const Unit&) const {}
    __device__ __forceinline__ void done(const Unit&) const {}
};

struct SplitCtxOrder {
    StaticOrder lat; int nN, nsplit, ntp, npieces, G, c;
    __host__ __device__ void init(int MLAT, int MCTX, int N, int K, int G_, int c_, int nsplit_) { lat.init(MLAT, N, G_, c_, K); nN = N / BM; nsplit = nsplit_; ntp = (K / BK) / nsplit_; npieces = (MCTX / BM) * nN * nsplit_; G = G_; c = c_; }
    __host__ __device__ bool next(int i, Unit& u) const {
        const long L = (long)i * G + c;
        if (L < lat.nwg) return lat.next(i, u);
        const int q = (int)(L - lat.nwg); if (q >= npieces) return false;
        const int ks = q % nsplit, t = q / nsplit; u.pn = t % nN; u.pm = lat.nM + t / nN; u.k0 = ks * ntp; u.nt = ntp; u.split = 1; u.which = 0; return true;
    }
    __device__ __forceinline__ void a_ready(const Unit&) const {}
    __device__ __forceinline__ void done(const Unit&) const {}
};

struct QkVtOrder {
    int G, c, ntk; static constexpr int NLATQK = (ML / BM) * 8, NCTXK = (MC / BM) * 4, NVT = 4 * (MT / BM);
    __host__ __device__ void init(int K, int G_, int c_) { G = G_; c = c_; ntk = K / BK; }
    __host__ __device__ bool next(int i, Unit& u) const {
        long L = (long)i * G + c; if (L >= NLATQK + NCTXK + NVT) return false;
        u.k0 = 0; u.nt = ntk; u.split = 0;
        if (L < NLATQK) { u.which = 0; u.pm = (int)(L >> 3); u.pn = (int)(L & 7); return true; } L -= NLATQK;
        if (L < NVT) { u.which = 1; u.pm = (int)(L & 3); u.pn = (int)(L >> 2); return true; } L -= NVT;
        u.which = 0; u.pm = ML / BM + (int)(L >> 2); u.pn = 4 + (int)(L & 3); return true;
    }
    __device__ __forceinline__ void a_ready(const Unit&) const {}
    __device__ __forceinline__ void done(const Unit&) const {}
};

__device__ __forceinline__ unsigned cvt_pk_bf16(float lo, float hi) { unsigned r; asm volatile("v_cvt_pk_bf16_f32 %0, %1, %2" : "=v"(r) : "v"(lo), "v"(hi)); return r; }
__device__ __forceinline__ float bf_lo(unsigned w) { return __uint_as_float(w << 16); }
__device__ __forceinline__ float bf_hi(unsigned w) { return __uint_as_float(w & 0xffff0000u); }
__device__ __forceinline__ float fsilu(float a) { return a * __builtin_amdgcn_rcpf(1.0f + __expf(-a)); }
__device__ __forceinline__ float fsigmoid(float a) { return __builtin_amdgcn_rcpf(1.0f + __expf(-a)); }

__device__ __forceinline__ void wt_store16(const void* base, unsigned off, u32x4 v) {
    const __amdgpu_buffer_rsrc_t rs = __builtin_amdgcn_make_buffer_rsrc((void*)base, 0, 0x7fffffff, 0x00020000);
    __builtin_amdgcn_raw_buffer_store_b128(v, rs, off, 0, 16);
}
struct EpiSwiglu {
    static constexpr bool PERM = true, AFTER_DRAIN = false;
    bf16_t* O; int ldo;
    __device__ __forceinline__ void operator()(const f32x4 (&acc)[2][2][4][2], const Unit& u, int wr, int wc, int fr, int fq) const {
        const int row0 = u.pm * BM + wr * 64 + fr, col0 = u.pn * HALF + wc * 32 + 8 * fq;
#pragma unroll
        for (int ai = 0; ai < 2; ++ai)
#pragma unroll
            for (int m = 0; m < 4; ++m) {
                bf16_t* rowp = O + (size_t)(row0 + ai * HALF + m * 16) * ldo + col0;
                float h[8];
#pragma unroll
                for (int n = 0; n < 2; ++n)
#pragma unroll
                    for (int i = 0; i < 4; ++i) { const float a = acc[ai][0][m][n][i], b = acc[ai][1][m][n][i]; h[4 * n + i] = fsilu(a) * b; }
                u32x4 w; w.x = cvt_pk_bf16(h[0], h[1]); w.y = cvt_pk_bf16(h[2], h[3]); w.z = cvt_pk_bf16(h[4], h[5]); w.w = cvt_pk_bf16(h[6], h[7]);
                *(u32x4*)rowp = w;
            }
    }
};

struct EpiResid {
    static constexpr bool PERM = false, AFTER_DRAIN = false;
    const float* rin_lat; const float* rin_ctx; float* rout_lat; float* rout_ctx; const float* gate; float* part; float gs;
    __device__ __forceinline__ void operator()(const f32x4 (&acc)[2][2][4][2], const Unit& u, int wr, int wc, int fr, int fq) const {
        const bool lat = u.pm < (ML / BM);
        const int bidx = lat ? (u.pm >> 4) : 4;
        const float* gp = gate + (size_t)bidx * MODW;
        const float* ri = lat ? rin_lat + (size_t)u.pm * BM * DM : rin_ctx + (size_t)(u.pm - ML / BM) * BM * DM;
        float* ro = lat ? rout_lat + (size_t)u.pm * BM * DM : rout_ctx + (size_t)(u.pm - ML / BM) * BM * DM;
        const int col0 = u.pn * BM + wc * 32 + 4 * fq;
        f32x4 gv[2][2];
#pragma unroll
        for (int bj = 0; bj < 2; ++bj)
#pragma unroll
            for (int n = 0; n < 2; ++n) gv[bj][n] = *(const f32x4*)(gp + col0 + bj * HALF + n * 16) * gs;
#pragma unroll
        for (int ai = 0; ai < 2; ++ai)
#pragma unroll
            for (int m = 0; m < 4; ++m) {
                const size_t off = (size_t)(ai * HALF + wr * 64 + m * 16 + fr) * DM + col0;
#pragma unroll
                for (int bj = 0; bj < 2; ++bj)
#pragma unroll
                    for (int n = 0; n < 2; ++n) {
                        if (u.split) { float* o = part + ((size_t)(u.k0 / u.nt) * MC + (size_t)(u.pm - ML / BM) * BM) * DM + off + bj * HALF + n * 16; *(f32x4*)o = gv[bj][n] * acc[ai][bj][m][n]; }
                        else { const f32x4 r = *(const f32x4*)(ri + off + bj * HALF + n * 16); *(f32x4*)(ro + off + bj * HALF + n * 16) = r + gv[bj][n] * acc[ai][bj][m][n]; } }
            }
    }
};

struct EpiWin {
    static constexpr bool PERM = true, AFTER_DRAIN = false;
    bf16_t* QKVG; bf16_t* U; const float* rope;
    __device__ __forceinline__ void operator()(const f32x4 (&acc)[2][2][4][2], const Unit& u, int wr, int wc, int fr, int fq) const {
        const int row0 = u.pm * BM + wr * 64 + fr;
        if (u.pn >= 4) {
            bf16_t* base = u.pn < 8 ? QKVG + u.pn * BM : U + (u.pn - 8) * BM; const int ld = u.pn < 8 ? 2048 : 512;
            const int col0 = wc * 32 + 8 * fq;
#pragma unroll
            for (int ai = 0; ai < 2; ++ai)
#pragma unroll
                for (int m = 0; m < 4; ++m) { bf16_t* rowp = base + (size_t)(row0 + ai * HALF + m * 16) * ld + col0;
#pragma unroll
                    for (int bj = 0; bj < 2; ++bj) { const f32x4 v0 = acc[ai][bj][m][0], v1 = acc[ai][bj][m][1];
                        u32x4 w; w.x = cvt_pk_bf16(v0[0], v0[1]); w.y = cvt_pk_bf16(v0[2], v0[3]); w.z = cvt_pk_bf16(v1[0], v1[1]); w.w = cvt_pk_bf16(v1[2], v1[3]);
                        *(u32x4*)(rowp + bj * HALF) = w; } }
        } else {
            const bool lat = u.pm < (ML / BM);
            const float sc = u.pn >= 2 ? 0.08838834764831845f : 1.0f;
            const int hh = wc >> 1, rot = wc & 1, f0 = 8 * fq;
            const int dcol = u.pn * BM + 128 * hh + 64 * rot + f0;
#pragma unroll
            for (int ai = 0; ai < 2; ++ai)
#pragma unroll
                for (int m = 0; m < 4; ++m) {
                    const int row = row0 + ai * HALF + m * 16;
                    float y1[8], y2[8];
                    const int t = row & (SEQ - 1), pos = rot ? (t & 63) : (t >> 6);
                    const float* rp = rope + (size_t)(pos * 32 + f0) * 2;
#pragma unroll
                    for (int n = 0; n < 2; ++n) {
                        f32x4 cs0 = (f32x4){1.f, 0.f, 1.f, 0.f}, cs1 = cs0;
                        if (lat) { cs0 = *(const f32x4*)(rp + 8 * n); cs1 = *(const f32x4*)(rp + 8 * n + 4); }
                        const f32x4 x1 = acc[ai][0][m][n], x2 = acc[ai][1][m][n];
                        y1[4 * n + 0] = (x1[0] * cs0[0] - x2[0] * cs0[1]) * sc; y2[4 * n + 0] = (x2[0] * cs0[0] + x1[0] * cs0[1]) * sc;
                        y1[4 * n + 1] = (x1[1] * cs0[2] - x2[1] * cs0[3]) * sc; y2[4 * n + 1] = (x2[1] * cs0[2] + x1[1] * cs0[3]) * sc;
                        y1[4 * n + 2] = (x1[2] * cs1[0] - x2[2] * cs1[1]) * sc; y2[4 * n + 2] = (x2[2] * cs1[0] + x1[2] * cs1[1]) * sc;
                        y1[4 * n + 3] = (x1[3] * cs1[2] - x2[3] * cs1[3]) * sc; y2[4 * n + 3] = (x2[3] * cs1[2] + x1[3] * cs1[3]) * sc;
                    }
                    bf16_t* rowp = QKVG + (size_t)row * 2048 + dcol;
                    u32x4 w; w.x = cvt_pk_bf16(y1[0], y1[1]); w.y = cvt_pk_bf16(y1[2], y1[3]); w.z = cvt_pk_bf16(y1[4], y1[5]); w.w = cvt_pk_bf16(y1[6], y1[7]);
                    *(u32x4*)rowp = w;
                    w.x = cvt_pk_bf16(y2[0], y2[1]); w.y = cvt_pk_bf16(y2[2], y2[3]); w.z = cvt_pk_bf16(y2[4], y2[5]); w.w = cvt_pk_bf16(y2[6], y2[7]);
                    *(u32x4*)(rowp + 32) = w;
                }
        }
    }
};

struct EpiGlu {
    static constexpr bool PERM = true, AFTER_DRAIN = false;
    const bf16_t* YS; bf16_t* YM; const float* bias;
    __device__ __forceinline__ void operator()(const f32x4 (&acc)[2][2][4][2], const Unit& u, int wr, int wc, int fr, int fq) const {
        const int row0 = u.pm * BM + wr * 64 + fr, col0 = u.pn * BM + wc * 32 + 8 * fq;
        f32x4 bv[2][2];
#pragma unroll
        for (int bj = 0; bj < 2; ++bj)
#pragma unroll
            for (int n = 0; n < 2; ++n) bv[bj][n] = *(const f32x4*)(bias + col0 + bj * HALF + 4 * n);
#pragma unroll
        for (int ai = 0; ai < 2; ++ai)
#pragma unroll
            for (int m = 0; m < 4; ++m) { const int row = row0 + ai * HALF + m * 16;
#pragma unroll
                for (int bj = 0; bj < 2; ++bj) {
                    const u32x4 yv = *(const u32x4*)(YS + (size_t)row * 512 + col0 + bj * HALF);
                    const f32x4 z0 = acc[ai][bj][m][0] + bv[bj][0], z1 = acc[ai][bj][m][1] + bv[bj][1];
                    u32x4 w;
                    w.x = cvt_pk_bf16(bf_lo(yv.x) * fsigmoid(z0[0]), bf_hi(yv.x) * fsigmoid(z0[1]));
                    w.y = cvt_pk_bf16(bf_lo(yv.y) * fsigmoid(z0[2]), bf_hi(yv.y) * fsigmoid(z0[3]));
                    w.z = cvt_pk_bf16(bf_lo(yv.z) * fsigmoid(z1[0]), bf_hi(yv.z) * fsigmoid(z1[1]));
                    w.w = cvt_pk_bf16(bf_lo(yv.w) * fsigmoid(z1[2]), bf_hi(yv.w) * fsigmoid(z1[3]));
                    *(u32x4*)(YM + (size_t)row * DM + 512 + col0 + bj * HALF) = w; } }
    }
};

struct EpiBf16S {
    static constexpr bool PERM = true, AFTER_DRAIN = false;
    bf16_t* O; int ldo; int nscale; float scale0;
    __device__ __forceinline__ void operator()(const f32x4 (&acc)[2][2][4][2], const Unit& u, int wr, int wc, int fr, int fq) const {
        const int row0 = u.pm * BM + wr * 64 + fr, col0 = u.pn * BM + wc * 32 + 8 * fq;
        const float sc = u.pn < nscale ? scale0 : 1.0f;
#pragma unroll
        for (int ai = 0; ai < 2; ++ai)
#pragma unroll
            for (int m = 0; m < 4; ++m) { bf16_t* rowp = O + (size_t)(row0 + ai * HALF + m * 16) * ldo + col0;
#pragma unroll
                for (int bj = 0; bj < 2; ++bj) { const f32x4 v0 = acc[ai][bj][m][0] * sc, v1 = acc[ai][bj][m][1] * sc;
                    u32x4 w; w.x = cvt_pk_bf16(v0[0], v0[1]); w.y = cvt_pk_bf16(v0[2], v0[3]); w.z = cvt_pk_bf16(v1[0], v1[1]); w.w = cvt_pk_bf16(v1[2], v1[3]);
                    *(u32x4*)(rowp + bj * HALF) = w; } }
    }
};

struct EpiQkVt {
    static constexpr bool PERM = true, AFTER_DRAIN = false;
    bf16_t* QK; bf16_t* VT;
    __device__ __forceinline__ void operator()(const f32x4 (&acc)[2][2][4][2], const Unit& u, int wr, int wc, int fr, int fq) const {
        const int row0 = u.pm * BM + wr * 64 + fr, col0 = u.pn * BM + wc * 32 + 8 * fq;
        bf16_t* O = u.which ? VT : QK; const int ldo = u.which ? MT : 2048;
        const float sc = (!u.which && u.pn < 4) ? 0.125f : 1.0f;
#pragma unroll
        for (int ai = 0; ai < 2; ++ai)
#pragma unroll
            for (int m = 0; m < 4; ++m) { bf16_t* rowp = O + (size_t)(row0 + ai * HALF + m * 16) * ldo + col0;
#pragma unroll
                for (int bj = 0; bj < 2; ++bj) { const f32x4 v0 = acc[ai][bj][m][0] * sc, v1 = acc[ai][bj][m][1] * sc;
                    u32x4 w; w.x = cvt_pk_bf16(v0[0], v0[1]); w.y = cvt_pk_bf16(v0[2], v0[3]); w.z = cvt_pk_bf16(v1[0], v1[1]); w.w = cvt_pk_bf16(v1[2], v1[3]);
                    *(u32x4*)(rowp + bj * HALF) = w; } }
    }
};
template <class Epi, class Sched, bool ALIGN_EPI = false, bool SP2 = false>
__device__ __forceinline__ void gemm_phase(PG8_LAS unsigned char* lds, const Gemm g, const Sched& S, const Epi& E) {
    int tid_ = threadIdx.x; asm volatile("" : "+v"(tid_));
    const int tid = tid_, wid = __builtin_amdgcn_readfirstlane(tid >> 6), lane = tid & 63, wr = wid >> 2, wc = wid & 3, fr = lane & 15, fq = lane >> 4;
    const int K = g.K;
    unsigned voffA[2], voffB[2];
#pragma unroll
    for (int i = 0; i < 2; ++i) { int R, C; stage_rc(tid * 16 + i * 8192, R, C); const int Rb = Epi::PERM ? ((R & ~31) + perm32(R & 31)) : R;
        voffA[i] = (unsigned)(R * K + C) * 2u; voffB[i] = (unsigned)(Rb * K + C) * 2u; }
    const size_t kstep = (size_t)(BK * 2);
    const size_t hstep = (size_t)HALF * K * 2;
    const size_t tstep = 2 * hstep;
    const unsigned ldsw = (unsigned)wid * 1024u;
    const int aoff = lds_byte(wr * 64 + fr, fq * 8), boff = lds_byte(wc * 32 + fr, fq * 8);
#define PG8_SA(b, h) (((b) * 2 + (h)) * HTB)
#define PG8_SB(b, h) ((4 + (b) * 2 + (h)) * HTB)
#define PG8_STAGE(bufoff, gbase, voff) do { _Pragma("unroll") for (int _i = 0; _i < 2; ++_i) \
        __builtin_amdgcn_global_load_lds((const unsigned*)((const char*)(gbase) + (voff)[_i]), (PG8_LAS unsigned*)(lds + (bufoff) + ldsw + _i * 8192), 16, 0, 0); } while (0)
#define PG8_LDA(dst, b, h) do { _Pragma("unroll") for (int m = 0; m < 4; ++m) _Pragma("unroll") for (int k = 0; k < 2; ++k) dst[m][k] = *(const PG8_LAS bf16x8*)(lds + PG8_SA(b, h) + aoff + m * 2048 + k * 1024); } while (0)
#define PG8_LDB(dst, b, h) do { _Pragma("unroll") for (int n = 0; n < 2; ++n) _Pragma("unroll") for (int k = 0; k < 2; ++k) dst[n][k] = *(const PG8_LAS bf16x8*)(lds + PG8_SB(b, h) + boff + n * 2048 + k * 1024); } while (0)
#define PG8_MMA(ai, bj, At, Bt) do { __builtin_amdgcn_s_setprio(1); _Pragma("unroll") for (int m = 0; m < 4; ++m) _Pragma("unroll") for (int n = 0; n < 2; ++n) _Pragma("unroll") for (int k = 0; k < 2; ++k) \
        acc[ai][bj][m][n] = __builtin_amdgcn_mfma_f32_16x16x32_bf16(Bt[n][k], At[m][k], acc[ai][bj][m][n], 0, 0, 0); __builtin_amdgcn_s_setprio(0); } while (0)
#define PG8_WAIT_V(n) asm volatile("s_waitcnt vmcnt(" #n ")" ::: "memory")
#define PG8_WAIT_L(n) asm volatile("s_waitcnt lgkmcnt(" #n ")" ::: "memory")
#define PG8_BAR __builtin_amdgcn_s_barrier()
#define PG8_SCHED __builtin_amdgcn_sched_barrier(0)
    Unit cur, nxt; int ui = 0;
    if (!S.next(0, cur)) return;
    f32x4 acc[2][2][4][2];
#pragma unroll
    for (int a = 0; a < 2; ++a)
#pragma unroll
        for (int b = 0; b < 2; ++b)
#pragma unroll
            for (int m = 0; m < 4; ++m)
#pragma unroll
                for (int n = 0; n < 2; ++n) acc[a][b][m][n] = (f32x4){0.f, 0.f, 0.f, 0.f};
    bf16x8 At[4][2], B0[2][2], B1[2][2];
    const char* cA = (const char*)(cur.which ? g.A2 : g.A) + (size_t)cur.pm * tstep + (size_t)cur.k0 * kstep; const char* cB = (const char*)(cur.which ? g.Bt2 : g.Bt) + (size_t)cur.pn * tstep + (size_t)cur.k0 * kstep;
    S.a_ready(cur);
    if constexpr (SP2) {
        PG8_STAGE(PG8_SB(0, 0), cB, voffB); PG8_STAGE(PG8_SB(0, 1), cB + hstep, voffB); PG8_STAGE(PG8_SA(0, 0), cA, voffA); PG8_STAGE(PG8_SA(0, 1), cA + hstep, voffA);
        if (wr == 1) PG8_BAR;
        PG8_WAIT_V(2); PG8_BAR;
        PG8_STAGE(PG8_SB(1, 0), cB + kstep, voffB); PG8_STAGE(PG8_SA(1, 0), cA + kstep, voffA); PG8_STAGE(PG8_SB(1, 1), cB + hstep + kstep, voffB);
        PG8_WAIT_V(6); PG8_BAR;
    } else {
        PG8_STAGE(PG8_SB(0, 0), cB, voffB); PG8_STAGE(PG8_SA(0, 0), cA, voffA); PG8_STAGE(PG8_SB(0, 1), cB + hstep, voffB); PG8_STAGE(PG8_SA(0, 1), cA + hstep, voffA);
        if (wr == 1) PG8_BAR;
        PG8_WAIT_V(4); PG8_BAR;
        PG8_STAGE(PG8_SB(1, 0), cB + kstep, voffB); PG8_STAGE(PG8_SA(1, 0), cA + kstep, voffA); PG8_STAGE(PG8_SB(1, 1), cB + hstep + kstep, voffB);
        PG8_WAIT_V(6); PG8_BAR;
    }
    for (;;) {
        const bool has_next = S.next(ui + 1, nxt);
        const char* nA = has_next ? (const char*)(nxt.which ? g.A2 : g.A) + (size_t)nxt.pm * tstep + (size_t)nxt.k0 * kstep : cA; const char* nB = has_next ? (const char*)(nxt.which ? g.Bt2 : g.Bt) + (size_t)nxt.pn * tstep + (size_t)nxt.k0 * kstep : cB;
        const int nt = cur.nt;
        for (int t = 0; t < nt; t += 2) {
            const bool last = (t == nt - 2);
            const char* a1 = cA + (size_t)(t + 1) * kstep;
            const char* a2 = last ? nA : cA + (size_t)(t + 2) * kstep; const char* b2 = last ? nB : cB + (size_t)(t + 2) * kstep;
            const char* a3 = a2 + kstep; const char* b3 = b2 + kstep;
            if (last && has_next) S.a_ready(nxt);
            if constexpr (SP2) {
            PG8_LDB(B0, 0, 0); PG8_LDB(B1, 0, 1); PG8_SCHED; PG8_LDA(At, 0, 0); PG8_STAGE(PG8_SA(1, 1), a1 + hstep, voffA);
            PG8_WAIT_V(8); PG8_WAIT_L(0); PG8_BAR; PG8_MMA(0, 0, At, B0); PG8_MMA(0, 1, At, B1); PG8_BAR; PG8_SCHED;
            PG8_LDA(At, 0, 1); PG8_STAGE(PG8_SB(0, 0), b2, voffB); PG8_STAGE(PG8_SB(0, 1), b2 + hstep, voffB); PG8_STAGE(PG8_SA(0, 0), a2, voffA);
            PG8_WAIT_V(8); PG8_WAIT_L(0); PG8_BAR; PG8_MMA(1, 0, At, B0); PG8_MMA(1, 1, At, B1); PG8_BAR; PG8_SCHED;
            PG8_LDB(B0, 1, 0); PG8_LDB(B1, 1, 1); PG8_SCHED; PG8_LDA(At, 1, 0); PG8_STAGE(PG8_SA(0, 1), a2 + hstep, voffA);
            PG8_WAIT_V(8); PG8_WAIT_L(0); PG8_BAR; PG8_MMA(0, 0, At, B0); PG8_MMA(0, 1, At, B1); PG8_BAR; PG8_SCHED;
            PG8_LDA(At, 1, 1); PG8_STAGE(PG8_SB(1, 0), b3, voffB); PG8_STAGE(PG8_SB(1, 1), b3 + hstep, voffB); PG8_STAGE(PG8_SA(1, 0), a3, voffA);
            PG8_WAIT_V(8); PG8_WAIT_L(0); PG8_BAR; PG8_MMA(1, 0, At, B0); PG8_MMA(1, 1, At, B1); PG8_BAR; PG8_SCHED;
            } else {
            PG8_LDB(B0, 0, 0); PG8_SCHED; PG8_LDA(At, 0, 0); PG8_STAGE(PG8_SA(1, 1), a1 + hstep, voffA);
            PG8_WAIT_L(8); PG8_BAR; PG8_WAIT_L(0); PG8_MMA(0, 0, At, B0); PG8_BAR; PG8_SCHED;
            PG8_LDB(B1, 0, 1); PG8_STAGE(PG8_SB(0, 0), b2, voffB);
            PG8_BAR; PG8_WAIT_L(0); PG8_MMA(0, 1, At, B1); PG8_BAR;
            PG8_LDA(At, 0, 1); PG8_STAGE(PG8_SA(0, 0), a2, voffA);
            PG8_BAR; PG8_WAIT_L(0); PG8_MMA(1, 0, At, B0); PG8_BAR; PG8_SCHED;
            PG8_STAGE(PG8_SB(0, 1), b2 + hstep, voffB);
            PG8_WAIT_V(6); PG8_BAR; PG8_MMA(1, 1, At, B1); PG8_BAR;
            PG8_LDB(B0, 1, 0); PG8_SCHED; PG8_LDA(At, 1, 0); PG8_STAGE(PG8_SA(0, 1), a2 + hstep, voffA);
            PG8_WAIT_L(8); PG8_BAR; PG8_WAIT_L(0); PG8_MMA(0, 0, At, B0); PG8_BAR; PG8_SCHED;
            PG8_LDB(B1, 1, 1); PG8_STAGE(PG8_SB(1, 0), b3, voffB);
            PG8_BAR; PG8_WAIT_L(0); PG8_MMA(0, 1, At, B1); PG8_BAR;
            PG8_LDA(At, 1, 1); PG8_STAGE(PG8_SA(1, 0), a3, voffA);
            PG8_BAR; PG8_WAIT_L(0); PG8_MMA(1, 0, At, B0); PG8_BAR; PG8_SCHED;
            PG8_STAGE(PG8_SB(1, 1), b3 + hstep, voffB);
            PG8_WAIT_V(6); PG8_BAR; PG8_MMA(1, 1, At, B1); PG8_BAR;
            }
        }
        if constexpr (ALIGN_EPI) { if (wr == 0) PG8_BAR; }
        if constexpr (!Epi::AFTER_DRAIN) { E(acc, cur, wr, wc, fr, fq); S.done(cur); }
        if (!has_next) break;
#pragma unroll
        for (int a = 0; a < 2; ++a)
#pragma unroll
            for (int b = 0; b < 2; ++b)
#pragma unroll
                for (int m = 0; m < 4; ++m)
#pragma unroll
                    for (int n = 0; n < 2; ++n) acc[a][b][m][n] = (f32x4){0.f, 0.f, 0.f, 0.f};
        cur = nxt; cA = nA; cB = nB; ++ui;
        if constexpr (ALIGN_EPI) { if (wr == 1) PG8_BAR; }
    }
    PG8_WAIT_V(0);
    if constexpr (!ALIGN_EPI) { if (wr == 0) PG8_BAR; }
    PG8_BAR;
    if constexpr (Epi::AFTER_DRAIN) { E.fused(acc, cur, wr, wc, fr, fq, lds, wid, lane); S.done(cur); }
#undef PG8_SA
#undef PG8_SB
#undef PG8_STAGE
#undef PG8_LDA
#undef PG8_LDB
#undef PG8_MMA
#undef PG8_WAIT_V
#undef PG8_WAIT_L
#undef PG8_BAR
#undef PG8_SCHED
}
}

#define LAS __attribute__((address_space(3)))
typedef unsigned short bf16;
typedef unsigned v4u __attribute__((ext_vector_type(4)));
typedef unsigned v2u __attribute__((ext_vector_type(2)));
typedef float f32x4 __attribute__((ext_vector_type(4)));
typedef float f32x2 __attribute__((ext_vector_type(2)));
typedef short bf16x8 __attribute__((ext_vector_type(8)));
typedef short s16x4 __attribute__((ext_vector_type(4)));

constexpr size_t MiB = 1u << 20;
constexpr size_t WS_MOD   = 1 * MiB;
constexpr size_t WS_ROPE  = WS_MOD + 512 * 1024;
constexpr size_t WS_LB    = WS_ROPE + 64 * 1024;
constexpr size_t WS_LBT   = WS_LB + 64 * 1024;
constexpr size_t WS_BBR   = WS_LBT + 64 * 1024;
constexpr size_t WS_BBI   = WS_BBR + 256 * 1024;
constexpr size_t WS_CM    = WS_BBI + 256 * 1024;
constexpr size_t WS_BBM   = WS_CM + 256 * 1024;
static_assert(WS_BBM + 256 * 1024 <= 4 * MiB, "param block");
constexpr size_t WS_W1    = 4 * MiB;
constexpr size_t WS_W2    = 48 * MiB;
constexpr size_t WS_WIN   = 70 * MiB;
constexpr size_t WS_WOUT  = 75 * MiB;
constexpr size_t WS_GLU   = 77 * MiB;
constexpr size_t WS_WQKV  = 78 * MiB;
constexpr size_t WS_WO    = 84 * MiB;
constexpr size_t WS_HCTX  = 86 * MiB;
constexpr size_t WS_XN    = 90 * MiB;
constexpr size_t WS_R     = 124 * MiB;
constexpr size_t WS_HID   = WS_R;
constexpr size_t WS_QKVG  = WS_R;
constexpr size_t WS_U     = WS_R + 68 * MiB;
constexpr size_t WS_KVS   = WS_R + 85 * MiB;
constexpr size_t WS_SF    = WS_R + 119 * MiB;
constexpr size_t WS_YS    = WS_R + 128 * MiB;
constexpr size_t WS_QK    = WS_R;
constexpr size_t WS_VT    = WS_R + 68 * MiB;
constexpr size_t WS_PARTF = WS_R + 96 * MiB;
constexpr size_t WS_PARTM = WS_R;
constexpr size_t WS_END   = WS_R + 145 * MiB;

constexpr size_t WS_BAR = 0;
constexpr int BARLDS_OFF = 147456 - 64;
constexpr int NWAVES = 8, NTHREADS = 512;
constexpr int LDS_BYTES = 147456;

struct Args {
    const float* in[26]; float* out; unsigned char* ws; int probe; int pad;
};
typedef const __attribute__((address_space(4))) Args* KArgs;
__device__ __forceinline__ KArgs kargs() { KArgs p = (KArgs)__builtin_amdgcn_kernarg_segment_ptr(); asm volatile("" : "+s"(p)); return p; }
enum { I_X = 0, I_C, I_CTX, I_CCTX, I_WMOD, I_BMOD, I_NORMG, I_W1, I_W2, I_WIN, I_WOUT, I_DECAY, I_LAMRE, I_LAMIM, I_LOGDT, I_BRE, I_BIM, I_CRE, I_CIM,
       I_S5D, I_GLUW, I_GLUB, I_WQKV, I_WO, I_RPB, I_FINALG };

__device__ __forceinline__ unsigned f2bf(float f) { unsigned u = __builtin_bit_cast(unsigned, f); return (u + 0x7fffu + ((u >> 16) & 1u)) >> 16; }
__device__ __forceinline__ unsigned pk2(float lo, float hi) { return f2bf(lo) | (f2bf(hi) << 16); }
typedef __bf16 bf16x2_t __attribute__((ext_vector_type(2)));
__device__ __forceinline__ unsigned cvtpk(float lo, float hi) { const f32x2 v = {lo, hi}; const bf16x2_t b = __builtin_convertvector(v, bf16x2_t); return __builtin_bit_cast(unsigned, b); }
__device__ __forceinline__ float bf2f(unsigned short h) { return __uint_as_float((unsigned)h << 16); }
__device__ __forceinline__ float blo(unsigned w) { return __uint_as_float(w << 16); }
__device__ __forceinline__ float bhi(unsigned w) { return __uint_as_float(w & 0xffff0000u); }
__device__ __forceinline__ int opaque_tid() { int t = threadIdx.x; asm volatile("" : "+v"(t)); return t; }
__device__ __forceinline__ float wave_sum(float v) {
#pragma unroll
    for (int o = 1; o < 64; o <<= 1) v += __shfl_xor(v, o);
    return v;
}
__device__ __forceinline__ void sincos_acc(float x, float& s, float& c) {
    const float k = rintf(x * 0.6366197723675814f);
    float r = fmaf(k, -1.5703125f, x); r = fmaf(k, -4.837512969970703125e-4f, r); r = fmaf(k, -7.54978995489188216e-8f, r);
    const float r2 = r * r;
    float sp = 2.7557319e-6f; sp = fmaf(sp, r2, -1.9841270e-4f); sp = fmaf(sp, r2, 8.3333333e-3f); sp = fmaf(sp, r2, -1.6666667e-1f); sp = fmaf(sp * r2, r, r);
    float cp = -2.7557319e-7f; cp = fmaf(cp, r2, 2.4801587e-5f); cp = fmaf(cp, r2, -1.3888889e-3f); cp = fmaf(cp, r2, 4.1666667e-2f); cp = fmaf(cp, r2, -0.5f); cp = fmaf(cp, r2, 1.0f);
    const int q = ((int)k) & 3;
    s = (q == 0) ? sp : (q == 1) ? cp : (q == 2) ? -sp : -cp;
    c = (q == 0) ? cp : (q == 1) ? -sp : (q == 2) ? -cp : sp;
}
__device__ __forceinline__ float gelu_tanh(float v) {
    const float t = 0.7978845608028654f * (v + 0.044715f * v * v * v);
    const float e = __expf(2.0f * t);
    const float th = 1.0f - 2.0f * __builtin_amdgcn_rcpf(e + 1.0f);
    return 0.5f * v * (1.0f + th);
}

__device__ __forceinline__ int map_row(int kind, int n) {
    if (kind == 1) { const int j = n < FF ? n : n - FF; return 256 * (j >> 7) + (n < FF ? 0 : 128) + (j & 127); }
    if (kind == 2 && n < 1024) { const int tile = n >> 8, hh = (n >> 7) & 1, d = n & 127; return 256 * tile + 128 * ((d >> 5) & 1) + 64 * hh + 32 * (d >> 6) + (d & 31); }
    return n;
}
__device__ __forceinline__ void p0_transpose_item(const float* W, int K, int N, int kind, bf16* WT, LAS float* scr, int item, int lane) {
    const int nblk = N / 32, kb = item / nblk, nb = item % nblk, k0 = 64 * kb, n0 = 32 * nb;
    const int drow = map_row(kind, n0);
    float wv[32];
#pragma unroll
    for (int i = 0; i < 32; ++i) { const int kk = 2 * i + (lane >> 5); wv[i] = W[(size_t)(k0 + kk) * N + n0 + (lane & 31)]; }
#pragma unroll
    for (int i = 0; i < 32; ++i) { const int kk = 2 * i + (lane >> 5); scr[kk * 33 + (lane & 31)] = wv[i]; }
    asm volatile("s_waitcnt lgkmcnt(0)" ::: "memory");
    const int c = lane & 7;
#pragma unroll
    for (int j = 0; j < 4; ++j) { const int n = (lane >> 3) + 8 * j; const LAS float* s = scr + (8 * c) * 33 + n;
        v4u o; o.x = cvtpk(s[0 * 33], s[1 * 33]); o.y = cvtpk(s[2 * 33], s[3 * 33]); o.z = cvtpk(s[4 * 33], s[5 * 33]); o.w = cvtpk(s[6 * 33], s[7 * 33]);
        *(v4u*)(WT + (size_t)(drow + n) * K + k0 + 8 * c) = o; }
    asm volatile("s_waitcnt lgkmcnt(0)" ::: "memory");
}

struct WDesc { const float* W; bf16* dst; int K, N, kind, items; };
__device__ __forceinline__ WDesc wdesc(KArgs a, int mi) {
    WDesc d;
    if (mi < 4)       { d.W = a->in[I_W1] + (size_t)mi * DM * 2 * FF; d.dst = (bf16*)(a->ws + WS_W1) + (size_t)mi * 2 * FF * DM; d.K = DM; d.N = 2 * FF; d.kind = 1; }
    else if (mi < 8)  { d.W = a->in[I_W2] + (size_t)(mi - 4) * FF * DM; d.dst = (bf16*)(a->ws + WS_W2) + (size_t)(mi - 4) * DM * FF; d.K = FF; d.N = DM; d.kind = 0; }
    else if (mi == 8) { d.W = a->in[I_WIN]; d.dst = (bf16*)(a->ws + WS_WIN); d.K = DM; d.N = 2560; d.kind = 2; }
    else if (mi == 9) { d.W = a->in[I_WOUT]; d.dst = (bf16*)(a->ws + WS_WOUT); d.K = DM; d.N = DM; d.kind = 0; }
    else if (mi == 10){ d.W = a->in[I_GLUW]; d.dst = (bf16*)(a->ws + WS_GLU); d.K = 512; d.N = 512; d.kind = 0; }
    else if (mi == 11){ d.W = a->in[I_WQKV]; d.dst = (bf16*)(a->ws + WS_WQKV); d.K = DM; d.N = 3072; d.kind = 0; }
    else              { d.W = a->in[I_WO]; d.dst = (bf16*)(a->ws + WS_WO); d.K = DM; d.N = DM; d.kind = 0; }
    d.items = (d.K / 64) * (d.N / 32);
    return d;
}
constexpr int NWMAT = 13;

__device__ __forceinline__ void p0_prologue(KArgs a, LAS unsigned char* lds, int G, int parts = 7) {
    const int tid = opaque_tid(), lane = tid & 63, wave = __builtin_amdgcn_readfirstlane(tid >> 6);
    if (parts & 1)
    {
        LAS float* sv = (LAS float*)lds;
        LAS float* red = (LAS float*)(lds + 32768);
        bool have = false;
        for (int it = blockIdx.x; it < 2 * (MODW / 64); it += G) {
            if (!have) {
                for (int i = tid; i < 5 * DM; i += NTHREADS) { const int b = i >> 10, k = i & 1023; const float v = b < 4 ? a->in[I_C][b * DM + k] : a->in[I_CCTX][k]; sv[k * 8 + b] = v / (1.0f + expf(-v)); }
                __syncthreads(); have = true;
            }
            const int layer = it / (MODW / 64), n = (it % (MODW / 64)) * 64 + lane;
            const float* wp = a->in[I_WMOD] + (size_t)layer * DM * MODW + n;
            float acc[5] = {0.f, 0.f, 0.f, 0.f, 0.f};
#pragma unroll 16
            for (int kk = 0; kk < 128; ++kk) { const int k = wave * 128 + kk; const float w = wp[(size_t)k * MODW];
                const f32x4 s0 = *(const LAS f32x4*)(sv + k * 8); const float s4 = sv[k * 8 + 4];
                acc[0] = fmaf(s0[0], w, acc[0]); acc[1] = fmaf(s0[1], w, acc[1]); acc[2] = fmaf(s0[2], w, acc[2]); acc[3] = fmaf(s0[3], w, acc[3]); acc[4] = fmaf(s4, w, acc[4]); }
#pragma unroll
            for (int b = 0; b < 5; ++b) red[(wave * 5 + b) * 64 + lane] = acc[b];
            __syncthreads();
            if (tid < 320) { const int b = tid >> 6, l = tid & 63, nn = (it % (MODW / 64)) * 64 + l; float s = a->in[I_BMOD][layer * MODW + nn];
#pragma unroll
                for (int w = 0; w < 8; ++w) s += red[(w * 5 + b) * 64 + l];
                ((float*)(a->ws + WS_MOD))[((size_t)layer * 5 + b) * MODW + nn] = s; }
            __syncthreads();
        }
        __syncthreads();
    }
    const int gtid = blockIdx.x * NTHREADS + tid, GT = G * NTHREADS;
    for (int i = gtid; i < MC * DM / 4; i += GT) ((f32x4*)(a->ws + WS_HCTX))[i] = ((const f32x4*)a->in[I_CTX])[i];
    for (int i = gtid; i < 64 * 32; i += GT) { const int pos = i >> 5, f = i & 31; const float inv = exp2f(-(float)f * (13.287712379549449f / 32.0f));
        float s, c; sincos_acc((float)pos * inv, s, c); ((f32x2*)(a->ws + WS_ROPE))[i] = (f32x2){c, s}; }
    for (int i = gtid; i < 2 * 32 * 64; i += GT) {
        const int p = i & 63, dg = i >> 6;
        const float lr = fminf(a->in[I_LAMRE][i], -1e-4f), li = a->in[I_LAMIM][i], dt = expf(a->in[I_LOGDT][dg]);
        float s, c; sincos_acc(li * dt, s, c); const float mg = expf(lr * dt); const float br = mg * c, bi = mg * s;
        ((f32x2*)(a->ws + WS_LB))[i] = (f32x2){br, bi};
        float s64, c64; sincos_acc(li * dt * 64.0f, s64, c64); const float m64 = expf(lr * dt * 64.0f);
        ((f32x2*)(a->ws + WS_LBT))[i] = (f32x2){m64 * c64, m64 * s64};
        const float nr = br - 1.0f, ni = bi, den = 1.0f / (lr * lr + li * li);
        const float cr = (nr * lr + ni * li) * den, ci = (ni * lr - nr * li) * den;
        for (int k = 0; k < 16; ++k) {
            const float bre = a->in[I_BRE][(size_t)i * 16 + k], bim = a->in[I_BIM][(size_t)i * 16 + k];
            ((bf16*)(a->ws + WS_BBM))[((size_t)dg * 128 + 2 * p) * 16 + k] = (bf16)f2bf(cr * bre - ci * bim);
            ((bf16*)(a->ws + WS_BBM))[((size_t)dg * 128 + 2 * p + 1) * 16 + k] = (bf16)f2bf(cr * bim + ci * bre);
            const float cre = a->in[I_CRE][((size_t)dg * 16 + k) * 64 + p], cim = a->in[I_CIM][((size_t)dg * 16 + k) * 64 + p];
            ((unsigned*)(a->ws + WS_CM))[((size_t)dg * 16 + k) * 64 + p] = cvtpk(cre, -cim);
        }
    }
    if (parts & 4) {
        LAS float* scr = (LAS float*)(lds + wave * 16384);
        const int gw = blockIdx.x * NWAVES + wave, NGW = G * NWAVES;
        int total = 0;
        for (int mi = 0; mi < NWMAT; ++mi) total += wdesc(a, mi).items;
        const int nshort = G == 256 ? 32 : 0, per_s = 8, per_l = G == 256 ? 11 : (total + NGW - 1) / NGW;
        const int it0 = (int)blockIdx.x < nshort ? gw * per_s : nshort * NWAVES * per_s + (gw - nshort * NWAVES) * per_l;
        const int it1 = min(total, it0 + ((int)blockIdx.x < nshort ? per_s : per_l));
        for (int it = it0; it < it1; ++it) {
            int r = it;
            for (int mi = 0; mi < NWMAT; ++mi) { const WDesc d = wdesc(a, mi); if (r < d.items) { p0_transpose_item(d.W, d.K, d.N, d.kind, d.dst, scr, r, lane); break; } r -= d.items; }
        }
    }
}

__device__ __forceinline__ void norm_phase(const float* src_lat, const float* src_ctx, bf16* XN, const float* g, const float* mod  , int ishift, int nrows, int G, const float* part = nullptr, int npart = 0, float* hctx_rw = nullptr) {
    const int tid = opaque_tid(), lane = tid & 63, wave = __builtin_amdgcn_readfirstlane(tid >> 6);
    const int gw = blockIdx.x * NWAVES + wave, NGW = G * NWAVES;
    f32x4 gv[4];
#pragma unroll
    for (int j = 0; j < 4; ++j) gv[j] = *((const f32x4*)g + lane + 64 * j);
    for (int row = gw; row < nrows; row += NGW) {
        const float* xr = row < ML ? src_lat + (size_t)row * DM : src_ctx + (size_t)(row - ML) * DM;
        const int bidx = row < ML ? (row >> 12) : 4;
        const float* sh = mod + (size_t)bidx * MODW + ishift * DM; const float* sc = sh + DM;
        f32x4 v[4]; float s = 0.f;
#pragma unroll
        for (int j = 0; j < 4; ++j) v[j] = *((const f32x4*)xr + lane + 64 * j);
        if (npart > 0 && row >= ML) {
            for (int pp = 0; pp < npart; ++pp) { const float* pr = part + ((size_t)pp * MC + (row - ML)) * DM;
#pragma unroll
                for (int j = 0; j < 4; ++j) v[j] += *((const f32x4*)pr + lane + 64 * j); }
#pragma unroll
            for (int j = 0; j < 4; ++j) *((f32x4*)(hctx_rw + (size_t)(row - ML) * DM) + lane + 64 * j) = v[j];
        }
#pragma unroll
        for (int j = 0; j < 4; ++j) s += (v[j][0] * v[j][0] + v[j][1] * v[j][1]) + (v[j][2] * v[j][2] + v[j][3] * v[j][3]);
        const float rstd = rsqrtf(wave_sum(s) * (1.0f / DM) + EPS);
#pragma unroll
        for (int j = 0; j < 4; ++j) {
            const f32x4 shv = *((const f32x4*)sh + lane + 64 * j), scv = *((const f32x4*)sc + lane + 64 * j);
            const f32x4 y = v[j] * rstd * gv[j] * (scv + 1.0f) + shv;
            *((v2u*)(XN + (size_t)row * DM) + lane + 64 * j) = (v2u){cvtpk(y[0], y[1]), cvtpk(y[2], y[3])};
        }
    }
}
__device__ __forceinline__ void final_norm_phase(float* io, const float* g, int G) {
    const int tid = opaque_tid(), lane = tid & 63, wave = __builtin_amdgcn_readfirstlane(tid >> 6);
    const int gw = blockIdx.x * NWAVES + wave, NGW = G * NWAVES;
    f32x4 gv[4];
#pragma unroll
    for (int j = 0; j < 4; ++j) gv[j] = *((const f32x4*)g + lane + 64 * j);
    for (int row = gw; row < ML; row += NGW) {
        float* xr = io + (size_t)row * DM;
        f32x4 v[4]; float s = 0.f;
#pragma unroll
        for (int j = 0; j < 4; ++j) { v[j] = *((const f32x4*)xr + lane + 64 * j); s += (v[j][0] * v[j][0] + v[j][1] * v[j][1]) + (v[j][2] * v[j][2] + v[j][3] * v[j][3]); }
        const float rstd = rsqrtf(wave_sum(s) * (1.0f / DM) + EPS);
#pragma unroll
        for (int j = 0; j < 4; ++j) *((f32x4*)xr + lane + 64 * j) = v[j] * rstd * gv[j];
    }
}

#define XB_TMO      128
#define XB_XCNT(j)  (256  + 64 * (j))
#define XB_XSUB(j)  (1280 + 64 * (j))
#define XB_XGEN(j)  (2304 + 64 * (j))
#define XB_TOP      3328
#define XB_TOPGEN   3392
#define XCD_BAR_WORDS 3456
#define XB_SPIN_CAP (1u << 18)

__device__ __forceinline__ unsigned xb_ld(unsigned* p)              { return __hip_atomic_load(p, __ATOMIC_RELAXED, __HIP_MEMORY_SCOPE_AGENT); }
__device__ __forceinline__ unsigned xb_add(unsigned* p, unsigned v) { return __hip_atomic_fetch_add(p, v, __ATOMIC_RELAXED, __HIP_MEMORY_SCOPE_AGENT); }
__device__ __forceinline__ unsigned xb_xcc_id() { return (unsigned)__builtin_amdgcn_s_getreg((3 << 11) | 20) & 0xFu; }
#define XB_SPIN(cond, bar) do { unsigned _sp = 0; while (cond) { __builtin_amdgcn_s_sleep(1); \
    if ((++_sp & 255u) == 0u) { if (xb_ld(&(bar)[XB_TMO])) break; if (_sp > XB_SPIN_CAP) { atomicAdd(&(bar)[XB_TMO], 1u); break; } } } } while (0)

struct XcdBarrier {
    unsigned* bar; unsigned x;
    volatile LAS unsigned* st;
};

__device__ __forceinline__ XcdBarrier xcd_barrier_post(unsigned* bar, volatile LAS unsigned* st) {
    XcdBarrier b; b.bar = bar; b.x = xb_xcc_id(); b.st = st;
    if (threadIdx.x == 0) (void)xb_add(&bar[XB_XCNT(b.x)], 1u);
    return b;
}
__device__ __forceinline__ void xcd_barrier_complete(unsigned* bar, unsigned x, unsigned& nloc, unsigned& nx) {
    const unsigned G = gridDim.x * gridDim.y * gridDim.z;
    unsigned sum, cnt, mine, sp = 0u;
    for (;;) {
        sum = 0u; cnt = 0u; mine = 0u;
#pragma unroll
        for (unsigned j = 0; j < 16; ++j) { const unsigned c = xb_ld(&bar[XB_XCNT(j)]); sum += c; cnt += (c > 0u) ? 1u : 0u; mine = (j == x) ? c : mine; }
        if (sum == G) break;
        __builtin_amdgcn_s_sleep(1);
        if ((++sp & 255u) == 0u) { if (xb_ld(&bar[XB_TMO])) break; if (sp > XB_SPIN_CAP) { atomicAdd(&bar[XB_TMO], 1u); break; } }
    }
    nloc = mine > 0u ? mine : 1u; nx = cnt > 0u ? cnt : 1u;
}

__device__ __forceinline__ void xcd_barrier(const XcdBarrier& b) {
    asm volatile("s_waitcnt vmcnt(0)" ::: "memory");
    __syncthreads();
    if (threadIdx.x == 0) {
        unsigned* bar = b.bar; unsigned bx = b.x; asm volatile("" : "+s"(bar), "+s"(bx));
        __builtin_amdgcn_s_waitcnt(0);
        unsigned nloc = b.st[0], nx = b.st[1];
        const unsigned old = xb_add(&bar[XB_XSUB(bx)], 1u);
        const unsigned gen = old / nloc;
        if (old + 1u == (gen + 1u) * nloc) {
            __builtin_amdgcn_fence(__ATOMIC_RELEASE, "agent");
            asm volatile("s_waitcnt vmcnt(0)" ::: "memory");
            const unsigned og = xb_add(&bar[XB_TOP], 1u);
            const unsigned tg = og / nx;
            if (og + 1u == (tg + 1u) * nx) xb_add(&bar[XB_TOPGEN], 1u);
            else XB_SPIN(xb_ld(&bar[XB_TOPGEN]) == tg, bar);
            __builtin_amdgcn_fence(__ATOMIC_ACQUIRE, "agent");
            xb_add(&bar[XB_XGEN(bx)], 1u);
            asm volatile("s_waitcnt vmcnt(0)" ::: "memory");
        } else {
            XB_SPIN(xb_ld(&bar[XB_XGEN(bx)]) == gen, bar);
            __builtin_amdgcn_fence(__ATOMIC_ACQUIRE, "agent");
            asm volatile("s_waitcnt vmcnt(0)" ::: "memory");
        }
    }
    __syncthreads();
}


__device__ __forceinline__ void xcd_barrier_census(const XcdBarrier& b) {
    if (threadIdx.x == 0) { unsigned nloc, nx; xcd_barrier_complete(b.bar, b.x, nloc, nx); b.st[0] = nloc; b.st[1] = nx; }
    __syncthreads();
}

typedef float f32x4m __attribute__((ext_vector_type(4)));
#define MFMA16(a, b, c) __builtin_amdgcn_mfma_f32_16x16x32_bf16((a), (b), (c), 0, 0, 0)
__device__ __forceinline__ unsigned off_b(unsigned row, unsigned ch) { return 256u * row + 16u * (ch ^ (((row & 3u) << 2) | ((row >> 2) & 3u))); }
__device__ __forceinline__ bf16x8 tr_frag(LAS unsigned char* tile, int lane, int c, int ks) {
    const unsigned g = lane >> 4, q = (lane & 15) >> 2, p = lane & 3;
    const s16x4 lo = __builtin_amdgcn_ds_read_tr16_b64_v4i16((LAS s16x4*)(tile + off_b(32 * ks + 8 * g + q, 2 * c + (p >> 1)) + 8 * (p & 1)));
    const s16x4 hi = __builtin_amdgcn_ds_read_tr16_b64_v4i16((LAS s16x4*)(tile + off_b(32 * ks + 8 * g + 4 + q, 2 * c + (p >> 1)) + 8 * (p & 1)));
    return (bf16x8){lo[0], lo[1], lo[2], lo[3], hi[0], hi[1], hi[2], hi[3]};
}
__device__ __forceinline__ bf16x8 pack8(const f32x4 a, const f32x4 b) {
    v4u w; w.x = cvtpk(a[0], a[1]); w.y = cvtpk(a[2], a[3]); w.z = cvtpk(b[0], b[1]); w.w = cvtpk(b[2], b[3]);
    return __builtin_bit_cast(bf16x8, w);
}
__device__ __forceinline__ float log_sigmoid(float x) { return -log1pf(expf(-x)); }

__device__ __forceinline__ int ret_row0(int b, int s) { return s < 2 ? ML + b * CTXL + s * 128 : b * SEQ + (s - 2) * 128; }

__device__ __forceinline__ void r1_unit(KArgs a, LAS unsigned char* lds, int unit) {
    const int tid = opaque_tid(), lane = tid & 63, wave = __builtin_amdgcn_readfirstlane(tid >> 6);
    const int s = unit % 34, bh = unit / 34, h = bh & 3, b = bh >> 2, row0 = ret_row0(b, s);
    const bf16* QKVG = (const bf16*)(a->ws + WS_QKVG);
    const float lgf = log_sigmoid(a->in[I_DECAY][h]), lgb = log_sigmoid(a->in[I_DECAY][4 + h]);
#pragma unroll
    for (int it = 0; it < 4; ++it) {
        const int n = tid + NTHREADS * it, row = n >> 4, ch = n & 15;
        const bf16* kp = QKVG + (size_t)(row0 + row) * 2048 + 512 + 128 * h + 8 * ch;
        const v4u kv = *(const v4u*)kp, vv = *(const v4u*)(kp + 512);
        const float wf = expf(lgf * (float)(127 - row)), wb = expf(lgb * (float)row);
        v4u kf, kb;
        kf.x = cvtpk(blo(kv.x) * wf, bhi(kv.x) * wf); kf.y = cvtpk(blo(kv.y) * wf, bhi(kv.y) * wf); kf.z = cvtpk(blo(kv.z) * wf, bhi(kv.z) * wf); kf.w = cvtpk(blo(kv.w) * wf, bhi(kv.w) * wf);
        kb.x = cvtpk(blo(kv.x) * wb, bhi(kv.x) * wb); kb.y = cvtpk(blo(kv.y) * wb, bhi(kv.y) * wb); kb.z = cvtpk(blo(kv.z) * wb, bhi(kv.z) * wb); kb.w = cvtpk(blo(kv.w) * wb, bhi(kv.w) * wb);
        const unsigned o = off_b(row, ch);
        *(LAS v4u*)(lds + o) = kf; *(LAS v4u*)(lds + 32768 + o) = kb; *(LAS v4u*)(lds + 65536 + o) = vv;
    }
    __syncthreads();
    f32x4 accf[8], accb[8];
#pragma unroll
    for (int c = 0; c < 8; ++c) { accf[c] = (f32x4){0.f, 0.f, 0.f, 0.f}; accb[c] = (f32x4){0.f, 0.f, 0.f, 0.f}; }
#pragma unroll
    for (int ks = 0; ks < 4; ++ks) {
        const bf16x8 kf = tr_frag(lds, lane, wave, ks), kb = tr_frag(lds + 32768, lane, wave, ks);
#pragma unroll
        for (int c = 0; c < 8; ++c) { const bf16x8 vf = tr_frag(lds + 65536, lane, c, ks); accf[c] = MFMA16(kf, vf, accf[c]); accb[c] = MFMA16(kb, vf, accb[c]); }
    }
    bf16* Sf = (bf16*)(a->ws + WS_KVS) + ((size_t)(bh * 2 + 0) * 34 + s) * 16384;
    bf16* Sb = (bf16*)(a->ws + WS_KVS) + ((size_t)(bh * 2 + 1) * 34 + s) * 16384;
    const int d0 = 16 * wave + 4 * (lane >> 4);
#pragma unroll
    for (int c = 0; c < 8; ++c) { const int e = 16 * c + (lane & 15);
        *(v2u*)(Sf + e * 128 + d0) = (v2u){cvtpk(accf[c][0], accf[c][1]), cvtpk(accf[c][2], accf[c][3])};
        *(v2u*)(Sb + e * 128 + d0) = (v2u){cvtpk(accb[c][0], accb[c][1]), cvtpk(accb[c][2], accb[c][3])}; }
    __syncthreads();
}

__device__ __forceinline__ void r2_items(KArgs a, int G) {
    const int gtid = blockIdx.x * NTHREADS + opaque_tid(), GT = G * NTHREADS;
    for (int idx = gtid; idx < 32 * 4096; idx += GT) {
        const int bhd = idx >> 12, o4 = idx & 4095, dir = bhd & 1, h = (bhd >> 1) & 3;
        const float decay = expf(log_sigmoid(a->in[I_DECAY][dir * 4 + h]) * 128.0f);
        bf16* base = (bf16*)(a->ws + WS_KVS) + (size_t)bhd * 34 * 16384 + o4 * 4;
        const long step = dir == 0 ? 16384 : -16384;
        bf16* p0 = base + (dir == 0 ? 0 : 16384); bf16* p2 = base + (dir == 0 ? 2 * 16384 : 33 * 16384);
        v2u v[34];
        { bf16* p = p0;
#pragma unroll
          for (int i = 0; i < 34; ++i) { if (i == 2) p = p2; v[i] = *(const v2u*)p; p += step; asm volatile("" : "+v"(p)); } }
        float st0 = 0.f, st1 = 0.f, st2 = 0.f, st3 = 0.f;
        { bf16* p = p0;
#pragma unroll
          for (int i = 0; i < 34; ++i) { if (i == 2) p = p2;
            *(v2u*)p = (v2u){cvtpk(st0, st1), cvtpk(st2, st3)}; p += step; asm volatile("" : "+v"(p));
            st0 = fmaf(decay, st0, blo(v[i].x)); st1 = fmaf(decay, st1, bhi(v[i].x)); st2 = fmaf(decay, st2, blo(v[i].y)); st3 = fmaf(decay, st3, bhi(v[i].y)); } }
    }
}

__device__ __forceinline__ void r3_unit(KArgs a, LAS unsigned char* lds, int unit) {
    const int tid = opaque_tid(), lane = tid & 63, wave = __builtin_amdgcn_readfirstlane(tid >> 6);
    const int s = unit % 34, bh = unit / 34, h = bh & 3, b = bh >> 2, row0 = ret_row0(b, s);
    const bf16* QKVG = (const bf16*)(a->ws + WS_QKVG);
    const float l2f = log_sigmoid(a->in[I_DECAY][h]) * 1.4426950408889634f, l2b = log_sigmoid(a->in[I_DECAY][4 + h]) * 1.4426950408889634f;
    const bf16* Sf = (const bf16*)(a->ws + WS_KVS) + ((size_t)(bh * 2 + 0) * 34 + s) * 16384;
    const bf16* Sb = (const bf16*)(a->ws + WS_KVS) + ((size_t)(bh * 2 + 1) * 34 + s) * 16384;
    {
        v4u t[8];
#pragma unroll
        for (int it = 0; it < 4; ++it) { const int n = tid + NTHREADS * it, row = n >> 4, ch = n & 15; const bf16* gp = QKVG + (size_t)(row0 + row) * 2048 + 512 + 128 * h + 8 * ch;
            t[it] = *(const v4u*)(gp + 512); t[4 + it] = *(const v4u*)gp; }
#pragma unroll
        for (int it = 0; it < 4; ++it) { const int n = tid + NTHREADS * it, row = n >> 4, ch = n & 15; const unsigned o = off_b(row, ch);
            *(LAS v4u*)(lds + o) = t[it]; *(LAS v4u*)(lds + 32768 + o) = t[4 + it]; }
#pragma unroll
        for (int it = 0; it < 4; ++it) { const int n = tid + NTHREADS * it; t[it] = *(const v4u*)(Sf + (size_t)n * 8); t[4 + it] = *(const v4u*)(Sb + (size_t)n * 8); }
#pragma unroll
        for (int it = 0; it < 4; ++it) { const int n = tid + NTHREADS * it, row = n >> 4, ch = n & 15; const unsigned o = off_b(row, ch);
            *(LAS v4u*)(lds + 65536 + o) = t[it]; *(LAS v4u*)(lds + 98304 + o) = t[4 + it]; }
    }
    const int fr = lane & 15, g = lane >> 4;
    bf16x8 qf[4];
#pragma unroll
    for (int ks = 0; ks < 4; ++ks) qf[ks] = *(const bf16x8*)(QKVG + (size_t)(row0 + 16 * wave + fr) * 2048 + 128 * h + 32 * ks + 8 * g);
    __syncthreads();
    f32x4 acco[8];
#pragma unroll
    for (int c = 0; c < 8; ++c) acco[c] = (f32x4){0.f, 0.f, 0.f, 0.f};
    const int iq = 16 * wave + fr;
#pragma unroll
    for (int jt = 0; jt < 4; ++jt) {
        f32x4 sa = (f32x4){0.f, 0.f, 0.f, 0.f}, sb = sa;
        const int ja = 32 * jt + 8 * (fr >> 2) + (fr & 3);
#pragma unroll
        for (int ks = 0; ks < 4; ++ks) {
            const bf16x8 ka = *(const LAS bf16x8*)(lds + 32768 + off_b(ja, 4 * ks + g)), kb = *(const LAS bf16x8*)(lds + 32768 + off_b(ja + 4, 4 * ks + g));
            sa = MFMA16(ka, qf[ks], sa); sb = MFMA16(kb, qf[ks], sb);
        }
        f32x4 pa, pb;
#pragma unroll
        for (int r = 0; r < 4; ++r) {
            const int j0 = 32 * jt + 8 * g + r, d0 = iq - j0, d1 = d0 - 4;
            const float w0 = (d0 >= 0 ? __builtin_amdgcn_exp2f(l2f * (float)d0) : 0.f) + (d0 <= 0 ? __builtin_amdgcn_exp2f(-l2b * (float)d0) : 0.f);
            const float w1 = (d1 >= 0 ? __builtin_amdgcn_exp2f(l2f * (float)d1) : 0.f) + (d1 <= 0 ? __builtin_amdgcn_exp2f(-l2b * (float)d1) : 0.f);
            pa[r] = sa[r] * w0; pb[r] = sb[r] * w1;
        }
        const bf16x8 pf = pack8(pa, pb);
#pragma unroll
        for (int c = 0; c < 8; ++c) { const bf16x8 vf = tr_frag(lds, lane, c, jt); acco[c] = MFMA16(pf, vf, acco[c]); }
    }
    float ff[4], fb[4];
#pragma unroll
    for (int r = 0; r < 4; ++r) { const int i = 16 * wave + 4 * g + r; ff[r] = __builtin_amdgcn_exp2f(l2f * (float)(i + 1)); fb[r] = __builtin_amdgcn_exp2f(l2b * (float)(128 - i)); }
    float ss[4] = {0.f, 0.f, 0.f, 0.f};
#pragma unroll
    for (int c = 0; c < 8; ++c) {
        f32x4 t1 = (f32x4){0.f, 0.f, 0.f, 0.f}, t2 = t1;
#pragma unroll
        for (int ks = 0; ks < 4; ++ks) {
            const unsigned o = off_b(16 * c + fr, 4 * ks + g);
            t1 = MFMA16(qf[ks], *(const LAS bf16x8*)(lds + 65536 + o), t1); t2 = MFMA16(qf[ks], *(const LAS bf16x8*)(lds + 98304 + o), t2);
        }
#pragma unroll
        for (int r = 0; r < 4; ++r) { const float o = acco[c][r] + ff[r] * t1[r] + fb[r] * t2[r]; acco[c][r] = o; ss[r] = fmaf(o, o, ss[r]); }
    }
#pragma unroll
    for (int r = 0; r < 4; ++r) { float v = ss[r]; v += __shfl_xor(v, 1); v += __shfl_xor(v, 2); v += __shfl_xor(v, 4); v += __shfl_xor(v, 8); ss[r] = rsqrtf(v * (1.0f / 128.0f) + EPS); }
    __syncthreads();
    LAS unsigned short* ost = (LAS unsigned short*)(lds + 32768 + wave * 4096);
#pragma unroll
    for (int r = 0; r < 4; ++r)
#pragma unroll
        for (int c = 0; c < 8; ++c) ost[(4 * g + r) * 128 + 16 * c + fr] = (unsigned short)f2bf(acco[c][r] * ss[r]);
    asm volatile("s_waitcnt lgkmcnt(0)" ::: "memory");
    bf16* YM = (bf16*)(a->ws + WS_XN);
#pragma unroll
    for (int it = 0; it < 4; ++it) {
        const int n = lane + 64 * it, rr = n >> 4, ch = n & 15; const size_t row = (size_t)(row0 + 16 * wave + rr);
        const v4u ov = *(const LAS v4u*)(ost + rr * 128 + 8 * ch), gv = *(const v4u*)(QKVG + row * 2048 + 1536 + 128 * h + 8 * ch);
        v4u y;
        y.x = cvtpk(blo(ov.x) * pg8::fsilu(blo(gv.x)), bhi(ov.x) * pg8::fsilu(bhi(gv.x))); y.y = cvtpk(blo(ov.y) * pg8::fsilu(blo(gv.y)), bhi(ov.y) * pg8::fsilu(bhi(gv.y)));
        y.z = cvtpk(blo(ov.z) * pg8::fsilu(blo(gv.z)), bhi(ov.z) * pg8::fsilu(bhi(gv.z))); y.w = cvtpk(blo(ov.w) * pg8::fsilu(blo(gv.w)), bhi(ov.w) * pg8::fsilu(bhi(gv.w)));
        *(v4u*)(YM + row * DM + 128 * h + 8 * ch) = y;
    }
    __syncthreads();
}

__device__ __forceinline__ int s5_row0(int b, int c) { return c < 4 ? ML + b * CTXL + 64 * c : b * SEQ + 64 * (c - 4); }
constexpr int S5_WLDS = 12288;

__device__ __forceinline__ void s5_bu_block(const bf16x8 (&bbm)[8], const bf16* urow  , LAS unsigned char* bu, int fr, int gq) {
    bf16x8 uf = (bf16x8){0, 0, 0, 0, 0, 0, 0, 0};
    if (gq < 2) uf = *(const bf16x8*)urow;
#pragma unroll
    for (int j = 0; j < 8; ++j) {
        const f32x4 d = MFMA16(bbm[j], uf, ((f32x4){0.f, 0.f, 0.f, 0.f}));
        *(LAS v2u*)(bu + fr * 256 + (((2 * j + (gq >> 1)) ^ fr) * 16) + (gq & 1) * 8) = (v2u){cvtpk(d[0], d[1]), cvtpk(d[2], d[3])};
    }
    asm volatile("s_waitcnt lgkmcnt(0)" ::: "memory");
}
#define S5_BUREAD(tl_) ({ const unsigned w_ = *(const LAS unsigned*)(bu + (tl_) * 256 + (((p >> 2) ^ (tl_)) * 16) + (p & 3) * 4); (f32x2){blo(w_), bhi(w_)}; })
#define S5_UPD(bu_)  { const f32x2 xs_ = (f32x2){xv.y, xv.x}; xv = lrr * xv + (lmi * xs_ + (bu_)); }

__device__ __forceinline__ void s1_unit(KArgs a, LAS unsigned char* wl, int wu, int lane) {
    const int c = wu % 68, bgd = wu / 68, dir = bgd & 1, g = (bgd >> 1) & 31, b = bgd >> 6, dg = dir * 32 + g, p = lane, fr = lane & 15, gq = lane >> 4;
    LAS unsigned char* bu = wl;
    const f32x2 lb = ((const f32x2*)(a->ws + WS_LB))[dg * 64 + p]; const f32x2 lrr = (f32x2){lb.x, lb.x}, lmi = (f32x2){-lb.y, lb.y};
    bf16x8 bbm[8];
#pragma unroll
    for (int j = 0; j < 8; ++j) { bbm[j] = (bf16x8){0, 0, 0, 0, 0, 0, 0, 0}; if (gq < 2) bbm[j] = *(const bf16x8*)((const bf16*)(a->ws + WS_BBM) + ((size_t)dg * 128 + 16 * j + fr) * 16 + 8 * gq); }
    const bf16* ub = (const bf16*)(a->ws + WS_U) + (size_t)(s5_row0(b, c) + fr) * 512 + 16 * g + 8 * (gq & 1);
    f32x2 xv = (f32x2){0.f, 0.f};
    for (int blk = 0; blk < 4; ++blk) {
        const int tb = dir ? 3 - blk : blk;
        s5_bu_block(bbm, ub + (size_t)(16 * tb) * 512, bu, fr, gq);
        if (dir == 0) {
#pragma unroll
            for (int tl = 0; tl < 16; ++tl) { const f32x2 bv = S5_BUREAD(tl); S5_UPD(bv) }
        } else {
#pragma unroll
            for (int tl = 15; tl >= 0; --tl) { const f32x2 bv = S5_BUREAD(tl); S5_UPD(bv) }
        }
        asm volatile("s_waitcnt lgkmcnt(0)" ::: "memory");
    }
    ((f32x2*)(a->ws + WS_SF))[(size_t)wu * 64 + p] = xv;
}
__device__ __forceinline__ void s2_items(KArgs a, int G) {
    const int gtid = blockIdx.x * NTHREADS + opaque_tid(), GT = G * NTHREADS;
    for (int idx = gtid; idx < 4 * 32 * 2 * 64; idx += GT) {
        const int p = idx & 63, bgd = idx >> 6, dir = bgd & 1, g = (bgd >> 1) & 31, dg = dir * 32 + g;
        const f32x2 lt = ((const f32x2*)(a->ws + WS_LBT))[dg * 64 + p];
        f32x2* base = (f32x2*)(a->ws + WS_SF) + (size_t)bgd * 68 * 64 + p;
        const long step = dir == 0 ? 64 : -64;
        f32x2* q0 = base + (dir == 0 ? 0 : 3 * 64); f32x2* q4 = base + (dir == 0 ? 4 * 64 : 67 * 64);
        float cr = 0.f, ci = 0.f;
        f32x2* pl = q0; f32x2* ps = q0;
#pragma unroll
        for (int hb = 0; hb < 2; ++hb) {
            f32x2 v[34];
#pragma unroll
            for (int j = 0; j < 34; ++j) { if (34 * hb + j == 4) pl = q4; v[j] = *pl; pl += step; asm volatile("" : "+v"(pl)); }
#pragma unroll
            for (int j = 0; j < 34; ++j) { if (34 * hb + j == 4) ps = q4; *ps = (f32x2){cr, ci}; ps += step; asm volatile("" : "+v"(ps));
                const float nr = fmaf(lt.x, cr, fmaf(-lt.y, ci, v[j].x)), ni = fmaf(lt.x, ci, fmaf(lt.y, cr, v[j].y)); cr = nr; ci = ni; }
        }
    }
}
__device__ __forceinline__ void s3_unit(KArgs a, LAS unsigned char* wl, int wu, int lane) {
    const int c = wu % 68, bg = wu / 68, g = bg & 31, b = bg >> 5, p = lane, fr = lane & 15, gq = lane >> 4;
    LAS unsigned char* bu = wl; LAS unsigned char* xs = wl + 4096;
    const int rowbase = s5_row0(b, c);
    const bf16* ub = (const bf16*)(a->ws + WS_U) + (size_t)(rowbase + fr) * 512 + 16 * g + 8 * (gq & 1);
    f32x4 acc[4];
#pragma unroll
    for (int i = 0; i < 4; ++i) acc[i] = (f32x4){0.f, 0.f, 0.f, 0.f};
#pragma unroll
    for (int dir = 0; dir < 2; ++dir) {
        const int dg = dir * 32 + g;
        const f32x2 lb = ((const f32x2*)(a->ws + WS_LB))[dg * 64 + p]; const f32x2 lrr = (f32x2){lb.x, lb.x}, lmi = (f32x2){-lb.y, lb.y};
        bf16x8 bbm[8];
#pragma unroll
        for (int j = 0; j < 8; ++j) { bbm[j] = (bf16x8){0, 0, 0, 0, 0, 0, 0, 0}; if (gq < 2) bbm[j] = *(const bf16x8*)((const bf16*)(a->ws + WS_BBM) + ((size_t)dg * 128 + 16 * j + fr) * 16 + 8 * gq); }
        bf16x8 cm[4];
#pragma unroll
        for (int ks = 0; ks < 4; ++ks) cm[ks] = *(const bf16x8*)((const bf16*)(a->ws + WS_CM) + (size_t)(dg * 16 + fr) * 128 + 32 * ks + 8 * gq);
        f32x2 xv = ((const f32x2*)(a->ws + WS_SF))[((size_t)((b * 32 + g) * 2 + dir) * 68 + c) * 64 + p];
#pragma unroll
        for (int half = 0; half < 2; ++half) {
            const int hs = dir ? 1 - half : half;
#pragma unroll
            for (int q = 0; q < 2; ++q) {
                const int tq = dir ? 1 - q : q;
                s5_bu_block(bbm, ub + (size_t)(32 * hs + 16 * tq) * 512, bu, fr, gq);
#define S5_XST(tl_) *(LAS unsigned*)(xs + (16 * tq + (tl_)) * 256 + (((p >> 2) ^ (tl_)) * 16) + (p & 3) * 4) = cvtpk(xv.x, xv.y);
                if (dir == 0) {
#pragma unroll
                    for (int tl = 0; tl < 16; ++tl) { const f32x2 bv = S5_BUREAD(tl); S5_UPD(bv) S5_XST(tl) }
                } else {
#pragma unroll
                    for (int tl = 15; tl >= 0; --tl) { const f32x2 bv = S5_BUREAD(tl); S5_UPD(bv) S5_XST(tl) }
                }
#undef S5_XST
                asm volatile("s_waitcnt lgkmcnt(0)" ::: "memory");
            }
#pragma unroll
            for (int th = 0; th < 2; ++th) {
                const int row = 16 * th + fr;
                f32x4 d = acc[2 * hs + th];
#pragma unroll
                for (int ks = 0; ks < 4; ++ks) { const bf16x8 xf = *(const LAS bf16x8*)(xs + row * 256 + (((4 * ks + gq) ^ (row & 15)) * 16)); d = MFMA16(cm[ks], xf, d); }
                acc[2 * hs + th] = d;
            }
            asm volatile("s_waitcnt lgkmcnt(0)" ::: "memory");
        }
    }
    const f32x4 dsk = *(const f32x4*)(a->in[I_S5D] + 16 * g + 4 * gq);
    bf16* YS = (bf16*)(a->ws + WS_YS);
#pragma unroll
    for (int T4 = 0; T4 < 4; ++T4) {
        const int t = 16 * T4 + fr; const v2u uw = *(const v2u*)((const bf16*)(a->ws + WS_U) + (size_t)(rowbase + t) * 512 + 16 * g + 4 * gq);
        const f32x4 y = acc[T4] + dsk * (f32x4){blo(uw.x), bhi(uw.x), blo(uw.y), bhi(uw.y)};
        *(v2u*)(YS + (size_t)(rowbase + t) * 512 + 16 * g + 4 * gq) = (v2u){cvtpk(gelu_tanh(y[0]), gelu_tanh(y[1])), cvtpk(gelu_tanh(y[2]), gelu_tanh(y[3]))};
    }
}

constexpr int NA_KSTR = 144, NA_VSTR = 976, NA_VCSTR = 528;
constexpr int NA_VOFF = 480 * NA_KSTR;
constexpr int NA_VCOFF = 256 * NA_KSTR;
constexpr int NA_RPBOFF = NA_VOFF + 64 * NA_VSTR;
__device__ __forceinline__ void na_unit(KArgs a, LAS unsigned char* lds, int unit) {
    const int tid = opaque_tid(), lane = tid & 63, wave = __builtin_amdgcn_readfirstlane(tid >> 6);
    const int rb = unit & 7, cb = (unit >> 3) & 3, h = (unit >> 5) & 15, b = unit >> 9, fr = lane & 15, g = lane >> 4;
    const bf16* QK = (const bf16*)(a->ws + WS_QK); const bf16* VT = (const bf16*)(a->ws + WS_VT); bf16* AO = (bf16*)(a->ws + WS_XN);
    const int kcol0 = min(max(16 * cb - 8, 0), 32);
    const int Rlo = min(max(8 * rb - 4, 0), 56), nrows = min(max(8 * rb + 3, 0), 56) + 8 - Rlo;
    const int r = 8 * rb + wave, r0 = min(max(r - 4, 0), 56);
    {
        const bf16* kg = QK + (size_t)(b * SEQ + Rlo * 64 + kcol0) * 2048 + 1024 + 64 * h;
        { v4u t[8]; const int lim = nrows * 256;
#pragma unroll
          for (int it = 0; it < 8; ++it) { const int n = tid + NTHREADS * it, key = n >> 3, ch = n & 7, kr = key >> 5, co = key & 31; if (n < lim) t[it] = *(const v4u*)(kg + (size_t)(kr * 64 + co) * 2048 + 8 * ch); }
#pragma unroll
          for (int it = 0; it < 8; ++it) { const int n = tid + NTHREADS * it, key = n >> 3, ch = n & 7; if (n < lim) *(LAS v4u*)(lds + key * NA_KSTR + ch * 16) = t[it]; } }
        const bf16* vg = VT + (size_t)(64 * h) * MT + b * SEQ + Rlo * 64 + kcol0;
        { v4u t[8];
#pragma unroll
          for (int it = 0; it < 8; ++it) { const int n = tid + NTHREADS * it, d = n / 60, rem = n - d * 60, kr = rem >> 2, c4 = rem & 3; if (n < 64 * 60 && kr < nrows) t[it] = *(const v4u*)(vg + (size_t)d * MT + kr * 64 + 8 * c4); }
#pragma unroll
          for (int it = 0; it < 8; ++it) { const int n = tid + NTHREADS * it, d = n / 60, rem = n - d * 60, kr = rem >> 2, c4 = rem & 3; if (n < 64 * 60 && kr < nrows) *(LAS v4u*)(lds + NA_VOFF + d * NA_VSTR + (kr * 32 + 8 * c4) * 2) = t[it]; } }
    }
    const int tq0 = b * SEQ + r * 64 + 16 * cb;
    const bf16* qb = QK + (size_t)tq0 * 2048 + 64 * h;
    const unsigned qoff = (unsigned)(fr * 2048 + 8 * g);
    bf16x8 qf[2]; qf[0] = *(const bf16x8*)(qb + qoff); qf[1] = *(const bf16x8*)(qb + qoff + 32);
    const int koffl = (8 * (fr >> 2) + (fr & 3)) * NA_KSTR + 16 * g;
    const int cq = 16 * cb + fr, ws = min(max(cq - 8, 0), 48);
    const int vbase = kcol0 + 8 * g - ws, ibase = kcol0 + 8 * g - cq + 15;
    LAS float* rpbl = (LAS float*)(lds + NA_RPBOFF);
    if (tid < 15 * 31) rpbl[tid] = a->in[I_RPB][(size_t)h * 15 * 31 + tid];
    f32x4 o[4];
#pragma unroll
    for (int dt = 0; dt < 4; ++dt) o[dt] = (f32x4){0.f, 0.f, 0.f, 0.f};
    float mrun = -1e30f, lsum = 0.f;
    __syncthreads();
#pragma unroll 1
    for (int half = 0; half < 2; ++half) {
        if (half == 1) {
            __syncthreads();
            const bf16* kg = QK + (size_t)(ML + b * CTXL) * 2048 + 1024 + 64 * h;
            v4u t[8];
#pragma unroll
            for (int it = 0; it < 4; ++it) { const int n = tid + NTHREADS * it, key = n >> 3, ch = n & 7; t[it] = *(const v4u*)(kg + (size_t)key * 2048 + 8 * ch); }
            const bf16* vg = VT + (size_t)(64 * h) * MT + ML + b * CTXL;
#pragma unroll
            for (int it = 0; it < 4; ++it) { const int n = tid + NTHREADS * it, d = n >> 5, c = n & 31; t[4 + it] = *(const v4u*)(vg + (size_t)d * MT + 8 * c); }
#pragma unroll
            for (int it = 0; it < 4; ++it) { const int n = tid + NTHREADS * it, key = n >> 3, ch = n & 7; *(LAS v4u*)(lds + key * NA_KSTR + ch * 16) = t[it]; }
#pragma unroll
            for (int it = 0; it < 4; ++it) { const int n = tid + NTHREADS * it, d = n >> 5, c = n & 31; *(LAS v4u*)(lds + NA_VCOFF + d * NA_VCSTR + c * 16) = t[4 + it]; }
            __syncthreads();
        }
        const int kbase = half == 0 ? (r0 - Rlo) * 32 : 0;
        const LAS unsigned char* kl = lds + kbase * NA_KSTR + koffl;
        const LAS unsigned char* vl = half == 0 ? lds + NA_VOFF + fr * NA_VSTR + (kbase + 8 * g) * 2 : lds + NA_VCOFF + fr * NA_VCSTR + (8 * g) * 2;
        const int vstr16 = 16 * (half == 0 ? NA_VSTR : NA_VCSTR);
#pragma unroll 1
        for (int qt = 0; qt < 2; ++qt) {
            f32x4 sc[4][2];
#pragma unroll
            for (int ii = 0; ii < 4; ++ii) {
                const int i = 4 * qt + ii;
                const LAS unsigned char* kp = kl + i * 32 * NA_KSTR;
                f32x4 sa = (f32x4){0.f, 0.f, 0.f, 0.f}, sb = sa;
                sa = MFMA16(*(const LAS bf16x8*)kp, qf[0], sa); sa = MFMA16(*(const LAS bf16x8*)(kp + 64), qf[1], sa);
                sb = MFMA16(*(const LAS bf16x8*)(kp + 4 * NA_KSTR), qf[0], sb); sb = MFMA16(*(const LAS bf16x8*)(kp + 4 * NA_KSTR + 64), qf[1], sb);
                if (half == 0) {
                    const LAS float* bp = rpbl + (r0 + i - r + 7) * 31;
#pragma unroll
                    for (int rr = 0; rr < 4; ++rr) { const float b0 = bp[min(max(ibase + rr, 0), 30)], b1 = bp[min(max(ibase + 4 + rr, 0), 30)];
                        sa[rr] = (unsigned)(vbase + rr) < 16u ? sa[rr] + b0 : -1e30f; sb[rr] = (unsigned)(vbase + 4 + rr) < 16u ? sb[rr] + b1 : -1e30f; }
                }
                sc[ii][0] = sa; sc[ii][1] = sb;
            }
            float mx = -1e30f;
#pragma unroll
            for (int ii = 0; ii < 4; ++ii)
#pragma unroll
                for (int t = 0; t < 2; ++t) mx = fmaxf(mx, fmaxf(fmaxf(sc[ii][t][0], sc[ii][t][1]), fmaxf(sc[ii][t][2], sc[ii][t][3])));
            mx = fmaxf(mx, __shfl_xor(mx, 16)); mx = fmaxf(mx, __shfl_xor(mx, 32));
            const float mnew = fmaxf(mrun, mx);
            const float resc = __builtin_amdgcn_exp2f((mrun - mnew) * 1.4426950408889634f);
            mrun = mnew; lsum *= resc;
#pragma unroll
            for (int dt = 0; dt < 4; ++dt) o[dt] = o[dt] * resc;
            const float mneg = -mnew * 1.4426950408889634f;
            float ls = 0.f;
#pragma unroll
            for (int ii = 0; ii < 4; ++ii)
#pragma unroll
                for (int t = 0; t < 2; ++t)
#pragma unroll
                    for (int rr = 0; rr < 4; ++rr) { const float pv = __builtin_amdgcn_exp2f(fmaf(sc[ii][t][rr], 1.4426950408889634f, mneg)); sc[ii][t][rr] = pv; ls += pv; }
            lsum += ls;
#pragma unroll
            for (int ii = 0; ii < 4; ++ii) {
                const bf16x8 pf = pack8(sc[ii][0], sc[ii][1]);
#pragma unroll
                for (int dt = 0; dt < 4; ++dt) o[dt] = MFMA16(*(const LAS bf16x8*)(vl + dt * vstr16 + (4 * qt + ii) * 64), pf, o[dt]);
            }
        }
    }
    lsum += __shfl_xor(lsum, 16); lsum += __shfl_xor(lsum, 32);
    const float rl = 1.0f / lsum;
    bf16* ob = AO + (size_t)tq0 * DM + 64 * h;
#pragma unroll
    for (int dt = 0; dt < 4; ++dt)
        *(v2u*)(ob + (unsigned)(fr * DM + 16 * dt + 4 * g)) = (v2u){cvtpk(o[dt][0] * rl, o[dt][1] * rl), cvtpk(o[dt][2] * rl, o[dt][3] * rl)};
    __syncthreads();
}

#ifndef STAGE
#define STAGE 6
#endif
#define GSYNC() xcd_barrier(bar)
#ifndef REP_A
#define REP_A 1
#endif
#ifndef REP_B
#define REP_B 1
#endif
#ifndef REP_MODE
#define REP_MODE 0
#endif
#ifndef REP_G1
#define REP_G1 1
#endif
#ifndef REP_G2
#define REP_G2 1
#endif
#ifndef REP_P0
#define REP_P0 1
#endif
#ifndef REP_NORM
#define REP_NORM 1
#endif
#ifndef REP_N
#define REP_N 1
#endif

__device__ __forceinline__ int s_deal(int c, int j, int G, int nS, int n_lo) {
    if (G != 256) { const int v = c + j * G; return v < nS ? v : -1; }
    if (c < 32) return j < n_lo ? c * n_lo + j : -1;
    const int v = 32 * n_lo + (c - 32) + 224 * j; return v < nS ? v : -1;
}
template <class Epi>
__device__ __forceinline__ void run_gemm(LAS unsigned char* lds, const bf16* A, const bf16* Bt, int M, int N, int K, int G, const Epi& E) {
    pg8::Gemm g{A, Bt, M, N, K, A, Bt}; pg8::StaticOrder S; S.init(M, N, G, (int)blockIdx.x, K);
    pg8::gemm_phase<Epi, pg8::StaticOrder, true, true>(lds, g, S, E);
}
template <class Epi>
__device__ __forceinline__ void run_gemm_splitctx(LAS unsigned char* lds, const bf16* A, const bf16* Bt, int N, int K, int nsplit, int G, const Epi& E) {
    pg8::Gemm g{A, Bt, MT, N, K, A, Bt}; pg8::SplitCtxOrder S; S.init(ML, MC, N, K, G, (int)blockIdx.x, nsplit);
    pg8::gemm_phase<Epi, pg8::SplitCtxOrder, true, true>(lds, g, S, E);
}

__device__ __forceinline__ void ffn_block(KArgs a, LAS unsigned char* lds, const XcdBarrier& bar, int G, int layer, int f, const float* rin_lat, const float* rin_ctx, int nrows, const float* part_in, int npart_in) {
    const float* MODL = (const float*)(a->ws + WS_MOD) + (size_t)layer * 5 * MODW;
    float* hl = a->out; float* hc = (float*)(a->ws + WS_HCTX);
    bf16* XN = (bf16*)(a->ws + WS_XN); bf16* HID = (bf16*)(a->ws + WS_HID);
    const bf16* W1b = (const bf16*)(a->ws + WS_W1) + (size_t)(layer * 2 + f) * 2 * FF * DM;
    const bf16* W2b = (const bf16*)(a->ws + WS_W2) + (size_t)(layer * 2 + f) * DM * FF;
    for (int rep = 1; rep < REP_NORM; ++rep) { norm_phase(rin_lat, rin_ctx, XN, a->in[I_NORMG] + (size_t)(layer * 3 + (f ? 2 : 0)) * DM, MODL, f ? 6 : 0, nrows, G, nullptr, 0, hc); GSYNC(); }
    norm_phase(rin_lat, rin_ctx, XN, a->in[I_NORMG] + (size_t)(layer * 3 + (f ? 2 : 0)) * DM, MODL, f ? 6 : 0, nrows, G, part_in, npart_in, hc);
    GSYNC();
    for (int rep = 0; rep < REP_G1; ++rep) {
    { pg8::EpiSwiglu E{HID, FF}; run_gemm(lds, XN, W1b, nrows, 2 * FF, DM, G, E); }
    GSYNC(); }
    for (int rep = 0; rep < REP_G2; ++rep) {
    { pg8::EpiResid E{rin_lat, rin_ctx, hl, hc, MODL + (f ? 8 : 2) * DM, (float*)(a->ws + WS_PARTF), rep == REP_G2 - 1 ? 0.5f : 0.0f};
      if (nrows == MT) run_gemm_splitctx(lds, HID, W2b, DM, FF, 11, G, E); else run_gemm(lds, HID, W2b, nrows, DM, FF, G, E); }
    GSYNC(); }
}

__global__ void __launch_bounds__(NTHREADS, 2) fwd_megakernel(Args a_unused) {
#define a kargs()
    extern __shared__ __attribute__((aligned(16))) unsigned char lds_raw[];
    LAS unsigned char* lds = (LAS unsigned char*)lds_raw;
    const int G = gridDim.x;
#define LANEWAVE() const int tid = opaque_tid(), lane = tid & 63, wave = __builtin_amdgcn_readfirstlane(tid >> 6)
#define hl (a->out)
#define hc ((float*)(a->ws + WS_HCTX))
#define XN ((bf16*)(a->ws + WS_XN))
#define MOD0 ((const float*)(a->ws + WS_MOD))
#define MOD1 (MOD0 + 5 * MODW)

    if (threadIdx.x < 8) ((LAS unsigned*)(lds + BARLDS_OFF))[threadIdx.x] = 0u;
    __syncthreads();
    const XcdBarrier bar = xcd_barrier_post((unsigned*)(a->ws + WS_BAR), (volatile LAS unsigned*)(lds + BARLDS_OFF));

#ifndef REP_P0_PARTS
#define REP_P0_PARTS 7
#endif
    for (int rep = 1; rep < REP_P0; ++rep) { p0_prologue(a, lds, G, REP_P0_PARTS); __syncthreads(); }
    p0_prologue(a, lds, G);
    xcd_barrier_census(bar);
    GSYNC();

    if (STAGE == 0) {
        const int gtid = blockIdx.x * NTHREADS + opaque_tid(), GT = G * NTHREADS;
        for (int i = gtid; i < ML * DM / 4; i += GT) ((f32x4*)hl)[i] = ((const f32x4*)a->in[I_X])[i];
        GSYNC();
    }
    if (STAGE >= 1) ffn_block(a, lds, bar, G, 0, 0, a->in[I_X], hc, MT, nullptr, 0);
    if (STAGE >= 2) {
        norm_phase(hl, hc, XN, a->in[I_NORMG] + 1 * DM, MOD0, 3, MT, G, (const float*)(a->ws + WS_PARTF), 11, hc);
        GSYNC();
        { pg8::EpiWin E{(bf16*)(a->ws + WS_QKVG), (bf16*)(a->ws + WS_U), (const float*)(a->ws + WS_ROPE)}; run_gemm(lds, XN, (const bf16*)(a->ws + WS_WIN), MT, 2560, DM, G, E); }
        GSYNC();
        for (int rep = 0; rep < REP_A; ++rep) {
        { LANEWAVE(); if (!(rep > 0 && REP_MODE == 2)) for (int u = blockIdx.x; u < 544; u += G) r1_unit(a, lds, u);
          if (!(rep > 0 && REP_MODE == 1)) for (int j = 0; ; ++j) { const int v = s_deal((int)blockIdx.x, j, G, 2176, 5); if (v < 0) break; s1_unit(a, lds + wave * S5_WLDS, v * 8 + wave, lane); } }
        GSYNC(); }
        r2_items(a, G); s2_items(a, G);
        GSYNC();
        for (int rep = 0; rep < REP_B; ++rep) {
        { LANEWAVE(); if (!(rep > 0 && REP_MODE == 2)) for (int u = blockIdx.x; u < 544; u += G) r3_unit(a, lds, u);
          if (!(rep > 0 && REP_MODE == 1)) for (int j = 0; ; ++j) { const int v = s_deal((int)blockIdx.x, j, G, 1088, 3); if (v < 0) break; s3_unit(a, lds + wave * S5_WLDS, v * 8 + wave, lane); } }
        GSYNC(); }
        { pg8::EpiGlu E{(const bf16*)(a->ws + WS_YS), XN, a->in[I_GLUB]}; run_gemm(lds, (const bf16*)(a->ws + WS_YS), (const bf16*)(a->ws + WS_GLU), MT, 512, 512, G, E); }
        GSYNC();
        { pg8::EpiResid E{hl, hc, hl, hc, MOD0 + 5 * DM, (float*)(a->ws + WS_PARTM), 1.0f}; run_gemm_splitctx(lds, XN, (const bf16*)(a->ws + WS_WOUT), DM, DM, 8, G, E); }
        GSYNC();
    }
    if (STAGE >= 3) ffn_block(a, lds, bar, G, 0, 1, hl, hc, MT, (const float*)(a->ws + WS_PARTM), 8);
    if (STAGE >= 4) ffn_block(a, lds, bar, G, 1, 0, hl, hc, MT, (const float*)(a->ws + WS_PARTF), 11);
    if (STAGE >= 5) {
        norm_phase(hl, hc, XN, a->in[I_NORMG] + 4 * DM, MOD1, 3, MT, G, (const float*)(a->ws + WS_PARTF), 11, hc);
        GSYNC();
        { pg8::EpiQkVt E{(bf16*)(a->ws + WS_QK), (bf16*)(a->ws + WS_VT)};
          pg8::Gemm g{XN, (const bf16*)(a->ws + WS_WQKV), MT, 2048, DM, (const bf16*)(a->ws + WS_WQKV) + (size_t)2048 * DM, XN};
          pg8::QkVtOrder S; S.init(DM, G, (int)blockIdx.x);
          pg8::gemm_phase<pg8::EpiQkVt, pg8::QkVtOrder, true, true>(lds, g, S, E); }
        GSYNC();
        for (int rep = 0; rep < REP_N; ++rep) {
        for (int u = blockIdx.x; u < 2048; u += G) na_unit(a, lds, u);
        GSYNC(); }
        { pg8::EpiResid E{hl, hc, hl, hc, MOD1 + 5 * DM, nullptr, 1.0f}; run_gemm(lds, XN, (const bf16*)(a->ws + WS_WO), ML, DM, DM, G, E); }
        GSYNC();
    }
    if (STAGE >= 6) ffn_block(a, lds, bar, G, 1, 1, hl, hc, ML, nullptr, 0);
    final_norm_phase(a->out, a->in[I_FINALG], G);
#undef a
#undef hl
#undef hc
#undef XN
#undef MOD0
#undef MOD1
}

extern "C" void kernel_launch(void* const* d_in, const int* in_sizes, int n_in, void* d_out, int out_size, void* d_ws, size_t ws_size, hipStream_t stream) {
    static int grid = 0;
    if (grid == 0) {
        if (n_in != 26 || out_size != ML * DM || ws_size < WS_END) { fprintf(stderr, "kernel_launch: unexpected problem (n_in %d, out %d, ws %zu)\n", n_in, out_size, ws_size); grid = -1; return; }
        int dev = 0, cus = 0, per_cu = 0;
        if (hipGetDevice(&dev) != hipSuccess || hipDeviceGetAttribute(&cus, hipDeviceAttributeMultiprocessorCount, dev) != hipSuccess) { grid = -1; return; }
        if (hipFuncSetAttribute((const void*)fwd_megakernel, hipFuncAttributeMaxDynamicSharedMemorySize, LDS_BYTES) != hipSuccess) { fprintf(stderr, "kernel_launch: hipFuncSetAttribute failed\n"); grid = -1; return; }
        if (hipOccupancyMaxActiveBlocksPerMultiprocessor(&per_cu, (const void*)fwd_megakernel, NTHREADS, LDS_BYTES) != hipSuccess || per_cu < 1) { fprintf(stderr, "kernel_launch: occupancy query failed (%d)\n", per_cu); (void)hipGetLastError(); grid = -1; return; }
        grid = cus * per_cu;
    }
    if (grid < 0) return;
    if (hipMemsetAsync((char*)d_ws + WS_BAR, 0, 16384, stream) != hipSuccess) { fprintf(stderr, "kernel_launch: memset failed\n"); return; }
    Args a{};
    for (int i = 0; i < 26; ++i) a.in[i] = (const float*)d_in[i];
    a.out = (float*)d_out; a.ws = (unsigned char*)d_ws; a.probe = 0; a.pad = 0;
    void* args[] = {&a};
    hipError_t e = hipLaunchCooperativeKernel((const void*)fwd_megakernel, dim3(grid), dim3(NTHREADS), args, LDS_BYTES, stream);
    if (e != hipSuccess) fprintf(stderr, "kernel_launch: cooperative launch failed: %s (grid %d)\n", hipGetErrorString(e), grid);
}
```

```cpp
#include <hip/hip_runtime.h>
#include <hip/hip_cooperative_groups.h>
#include <cstdio>
#include <cstdint>
namespace cg = cooperative_groups;

constexpr int DM = 1024, NB = 4, SEQ = 4096, CTXL = 256, FF = 2816, NMOD = 9;
constexpr int ML = NB * SEQ, MC = NB * CTXL, MT = ML + MC;
constexpr int MODW = NMOD * DM;
constexpr float EPS = 1e-6f;

namespace pg8 {
#define PG8_LAS __attribute__((address_space(3)))
typedef unsigned short bf16_t;
typedef short bf16x8 __attribute__((ext_vector_type(8)));
typedef float f32x4 __attribute__((ext_vector_type(4)));
typedef unsigned u32x4 __attribute__((ext_vector_type(4)));
constexpr int BM = 256, BK = 64, HALF = 128, HTB = HALF * BK * 2  , STAGE_BYTES = 8 * HTB, NXCD = 8, WGM = 8;

__host__ __device__ __forceinline__ int lds_byte(int r, int c) { const int st = (r >> 4) * 2 + (c >> 5), rr = r & 15, cc = c & 31, ob = rr * 64 + cc * 2; return st * 1024 + (ob ^ (((ob >> 9) & 1) << 5)); }
__host__ __device__ __forceinline__ void stage_rc(int b, int& R, int& C) { const int st = b / 1024, sb = b % 1024, swz = sb ^ (((sb >> 9) & 1) << 5); R = (st >> 1) * 16 + swz / 64; C = (st & 1) * 32 + (swz % 64) / 2; }
__host__ __device__ __forceinline__ int perm32(int rho) { const int n = rho >> 4, i = rho & 15; return 8 * (i >> 2) + 4 * n + (i & 3); }

struct Unit { int pm, pn, k0, nt, split, which; };
struct Gemm { const bf16_t* A; const bf16_t* Bt; int M, N, K; const bf16_t* A2; const bf16_t* Bt2; };

struct StaticOrder {
    int nM, nN, nwg, G, c, ntk;
    __host__ __device__ void init(int M, int N, int G_, int c_, int K_ = 0) { nM = M / BM; nN = N / BM; nwg = nM * nN; G = G_; c = c_; ntk = K_ / BK; }
    __host__ __device__ bool next(int i, Unit& u) const {
        const long L = (long)i * G + c; if (L >= nwg) return false;
        int wgid = (int)L; { const int q = nwg / NXCD, r = nwg % NXCD, xcd = wgid % NXCD, off = wgid / NXCD; wgid = (xcd < r ? xcd * (q + 1) : r * (q + 1) + (xcd - r) * q) + off; }
        const int nig = WGM * nN, gid = wgid / nig, fm = gid * WGM, gsz = (nM - fm) < WGM ? (nM - fm) : WGM;
        u.pm = fm + ((wgid % nig) % gsz); u.pn = (wgid % nig) / gsz; u.k0 = 0; u.nt = ntk; u.split = 0; u.which = 0; return true;
    }
    __device__ __forceinline__ void a_ready(const Unit&) const {}
    __device__ __forceinline__ void done(const Unit&) const {}
};

struct SplitCtxOrder {
    StaticOrder lat; int nN, nsplit, ntp, npieces, G, c;
    __host__ __device__ void init(int MLAT, int MCTX, int N, int K, int G_, int c_, int nsplit_) { lat.init(MLAT, N, G_, c_, K); nN = N / BM; nsplit = nsplit_; ntp = (K / BK) / nsplit_; npieces = (MCTX / BM) * nN * nsplit_; G = G_; c = c_; }
    __host__ __device__ bool next(int i, Unit& u) const {
        int ii = i; if (lat.nwg == G && c < 128 && c < npieces && i < 2) ii = 1 - i;
        const long L = (long)ii * G + c;
        if (L < lat.nwg) { StaticOrder t = lat; return t.next(ii, u); }
        const int q = (int)(L - lat.nwg); if (q >= npieces) return false;
        const int ks = q % nsplit, t = q / nsplit; u.pn = t % nN; u.pm = lat.nM + t / nN; u.k0 = ks * ntp; u.nt = ntp; u.split = 1; u.which = 0; return true;
    }
    __device__ __forceinline__ void a_ready(const Unit&) const {}
    __device__ __forceinline__ void done(const Unit&) const {}
};

struct QkVtOrder {
    int G, c, ntk; static constexpr int NLATQK = (ML / BM) * 8, NCTXK = (MC / BM) * 4, NVT = 4 * (MT / BM);
    __host__ __device__ void init(int K, int G_, int c_) { G = G_; c = c_; ntk = K / BK; }
    __host__ __device__ bool next(int i, Unit& u) const {
        long L = (long)i * G + c; if (L >= NLATQK + NCTXK + NVT) return false;
        u.k0 = 0; u.nt = ntk; u.split = 0;
        if (L < NLATQK) { u.which = 0; u.pm = (int)(L >> 3); u.pn = (int)(L & 7); return true; } L -= NLATQK;
        if (L < NVT) { u.which = 1; u.pm = (int)(L & 3); u.pn = (int)(L >> 2); return true; } L -= NVT;
        u.which = 0; u.pm = ML / BM + (int)(L >> 2); u.pn = 4 + (int)(L & 3); return true;
    }
    __device__ __forceinline__ void a_ready(const Unit&) const {}
    __device__ __forceinline__ void done(const Unit&) const {}
};

__device__ __forceinline__ unsigned cvt_pk_bf16(float lo, float hi) { unsigned r; asm volatile("v_cvt_pk_bf16_f32 %0, %1, %2" : "=v"(r) : "v"(lo), "v"(hi)); return r; }
__device__ __forceinline__ float bf_lo(unsigned w) { return __uint_as_float(w << 16); }
__device__ __forceinline__ float bf_hi(unsigned w) { return __uint_as_float(w & 0xffff0000u); }
__device__ __forceinline__ float fsilu(float a) { return a * __builtin_amdgcn_rcpf(1.0f + __expf(-a)); }
__device__ __forceinline__ float fsigmoid(float a) { return __builtin_amdgcn_rcpf(1.0f + __expf(-a)); }

__device__ __forceinline__ void wt_store16(const void* base, unsigned off, u32x4 v) {
    const __amdgpu_buffer_rsrc_t rs = __builtin_amdgcn_make_buffer_rsrc((void*)base, 0, 0x7fffffff, 0x00020000);
    __builtin_amdgcn_raw_buffer_store_b128(v, rs, off, 0, 16);
}
struct EpiSwiglu {
    static constexpr bool PERM = true, AFTER_DRAIN = false;
    bf16_t* O; int ldo;
    __device__ __forceinline__ void operator()(const f32x4 (&acc)[2][2][4][2], const Unit& u, int wr, int wc, int fr, int fq) const {
        const int row0 = u.pm * BM + wr * 64 + fr, col0 = u.pn * HALF + wc * 32 + 8 * fq;
#pragma unroll
        for (int ai = 0; ai < 2; ++ai)
#pragma unroll
            for (int m = 0; m < 4; ++m) {
                bf16_t* rowp = O + (size_t)(row0 + ai * HALF + m * 16) * ldo + col0;
                float h[8];
#pragma unroll
                for (int n = 0; n < 2; ++n)
#pragma unroll
                    for (int i = 0; i < 4; ++i) { const float a = acc[ai][0][m][n][i], b = acc[ai][1][m][n][i]; h[4 * n + i] = fsilu(a) * b; }
                u32x4 w; w.x = cvt_pk_bf16(h[0], h[1]); w.y = cvt_pk_bf16(h[2], h[3]); w.z = cvt_pk_bf16(h[4], h[5]); w.w = cvt_pk_bf16(h[6], h[7]);
                *(u32x4*)rowp = w;
            }
    }
};

struct EpiResid {
    static constexpr bool PERM = false, AFTER_DRAIN = false;
    const float* rin_lat; const float* rin_ctx; float* rout_lat; float* rout_ctx; const float* gate; float* part; float gs;
    __device__ __forceinline__ void operator()(const f32x4 (&acc)[2][2][4][2], const Unit& u, int wr, int wc, int fr, int fq) const {
        const bool lat = u.pm < (ML / BM);
        const int bidx = lat ? (u.pm >> 4) : 4;
        const float* gp = gate + (size_t)bidx * MODW;
        const float* ri = lat ? rin_lat + (size_t)u.pm * BM * DM : rin_ctx + (size_t)(u.pm - ML / BM) * BM * DM;
        float* ro = lat ? rout_lat + (size_t)u.pm * BM * DM : rout_ctx + (size_t)(u.pm - ML / BM) * BM * DM;
        const int col0 = u.pn * BM + wc * 32 + 4 * fq;
        f32x4 gv[2][2];
#pragma unroll
        for (int bj = 0; bj < 2; ++bj)
#pragma unroll
            for (int n = 0; n < 2; ++n) gv[bj][n] = *(const f32x4*)(gp + col0 + bj * HALF + n * 16) * gs;
#pragma unroll
        for (int ai = 0; ai < 2; ++ai)
#pragma unroll
            for (int m = 0; m < 4; ++m) {
                const size_t off = (size_t)(ai * HALF + wr * 64 + m * 16 + fr) * DM + col0;
#pragma unroll
                for (int bj = 0; bj < 2; ++bj)
#pragma unroll
                    for (int n = 0; n < 2; ++n) {
                        if (u.split) { float* o = part + ((size_t)(u.k0 / u.nt) * MC + (size_t)(u.pm - ML / BM) * BM) * DM + off + bj * HALF + n * 16; *(f32x4*)o = gv[bj][n] * acc[ai][bj][m][n]; }
                        else { const f32x4 r = *(const f32x4*)(ri + off + bj * HALF + n * 16); *(f32x4*)(ro + off + bj * HALF + n * 16) = r + gv[bj][n] * acc[ai][bj][m][n]; } }
            }
    }
};

struct EpiWin {
    static constexpr bool PERM = true, AFTER_DRAIN = false;
    bf16_t* QKVG; bf16_t* U; const float* rope;
    __device__ __forceinline__ void operator()(const f32x4 (&acc)[2][2][4][2], const Unit& u, int wr, int wc, int fr, int fq) const {
        const int row0 = u.pm * BM + wr * 64 + fr;
        if (u.pn >= 4) {
            bf16_t* base = u.pn < 8 ? QKVG + u.pn * BM : U + (u.pn - 8) * BM; const int ld = u.pn < 8 ? 2048 : 512;
            const int col0 = wc * 32 + 8 * fq;
#pragma unroll
            for (int ai = 0; ai < 2; ++ai)
#pragma unroll
                for (int m = 0; m < 4; ++m) { bf16_t* rowp = base + (size_t)(row0 + ai * HALF + m * 16) * ld + col0;
#pragma unroll
                    for (int bj = 0; bj < 2; ++bj) { const f32x4 v0 = acc[ai][bj][m][0], v1 = acc[ai][bj][m][1];
                        u32x4 w; w.x = cvt_pk_bf16(v0[0], v0[1]); w.y = cvt_pk_bf16(v0[2], v0[3]); w.z = cvt_pk_bf16(v1[0], v1[1]); w.w = cvt_pk_bf16(v1[2], v1[3]);
                        *(u32x4*)(rowp + bj * HALF) = w; } }
        } else {
            const bool lat = u.pm < (ML / BM);
            const float sc = u.pn >= 2 ? 0.08838834764831845f : 1.0f;
            const int hh = wc >> 1, rot = wc & 1, f0 = 8 * fq;
            const int dcol = u.pn * BM + 128 * hh + 64 * rot + f0;
#pragma unroll
            for (int ai = 0; ai < 2; ++ai)
#pragma unroll
                for (int m = 0; m < 4; ++m) {
                    const int row = row0 + ai * HALF + m * 16;
                    float y1[8], y2[8];
                    const int t = row & (SEQ - 1), pos = rot ? (t & 63) : (t >> 6);
                    const float* rp = rope + (size_t)(pos * 32 + f0) * 2;
#pragma unroll
                    for (int n = 0; n < 2; ++n) {
                        f32x4 cs0 = (f32x4){1.f, 0.f, 1.f, 0.f}, cs1 = cs0;
                        if (lat) { cs0 = *(const f32x4*)(rp + 8 * n); cs1 = *(const f32x4*)(rp + 8 * n + 4); }
                        const f32x4 x1 = acc[ai][0][m][n], x2 = acc[ai][1][m][n];
                        y1[4 * n + 0] = (x1[0] * cs0[0] - x2[0] * cs0[1]) * sc; y2[4 * n + 0] = (x2[0] * cs0[0] + x1[0] * cs0[1]) * sc;
                        y1[4 * n + 1] = (x1[1] * cs0[2] - x2[1] * cs0[3]) * sc; y2[4 * n + 1] = (x2[1] * cs0[2] + x1[1] * cs0[3]) * sc;
                        y1[4 * n + 2] = (x1[2] * cs1[0] - x2[2] * cs1[1]) * sc; y2[4 * n + 2] = (x2[2] * cs1[0] + x1[2] * cs1[1]) * sc;
                        y1[4 * n + 3] = (x1[3] * cs1[2] - x2[3] * cs1[3]) * sc; y2[4 * n + 3] = (x2[3] * cs1[2] + x1[3] * cs1[3]) * sc;
                    }
                    bf16_t* rowp = QKVG + (size_t)row * 2048 + dcol;
                    u32x4 w; w.x = cvt_pk_bf16(y1[0], y1[1]); w.y = cvt_pk_bf16(y1[2], y1[3]); w.z = cvt_pk_bf16(y1[4], y1[5]); w.w = cvt_pk_bf16(y1[6], y1[7]);
                    *(u32x4*)rowp = w;
                    w.x = cvt_pk_bf16(y2[0], y2[1]); w.y = cvt_pk_bf16(y2[2], y2[3]); w.z = cvt_pk_bf16(y2[4], y2[5]); w.w = cvt_pk_bf16(y2[6], y2[7]);
                    *(u32x4*)(rowp + 32) = w;
                }
        }
    }
};

struct EpiGlu {
    static constexpr bool PERM = true, AFTER_DRAIN = false;
    const bf16_t* YS; bf16_t* YM; const float* bias;
    __device__ __forceinline__ void operator()(const f32x4 (&acc)[2][2][4][2], const Unit& u, int wr, int wc, int fr, int fq) const {
        const int row0 = u.pm * BM + wr * 64 + fr, col0 = u.pn * BM + wc * 32 + 8 * fq;
        f32x4 bv[2][2];
#pragma unroll
        for (int bj = 0; bj < 2; ++bj)
#pragma unroll
            for (int n = 0; n < 2; ++n) bv[bj][n] = *(const f32x4*)(bias + col0 + bj * HALF + 4 * n);
#pragma unroll
        for (int ai = 0; ai < 2; ++ai)
#pragma unroll
            for (int m = 0; m < 4; ++m) { const int row = row0 + ai * HALF + m * 16;
#pragma unroll
                for (int bj = 0; bj < 2; ++bj) {
                    const u32x4 yv = *(const u32x4*)(YS + (size_t)row * 512 + col0 + bj * HALF);
                    const f32x4 z0 = acc[ai][bj][m][0] + bv[bj][0], z1 = acc[ai][bj][m][1] + bv[bj][1];
                    u32x4 w;
                    w.x = cvt_pk_bf16(bf_lo(yv.x) * fsigmoid(z0[0]), bf_hi(yv.x) * fsigmoid(z0[1]));
                    w.y = cvt_pk_bf16(bf_lo(yv.y) * fsigmoid(z0[2]), bf_hi(yv.y) * fsigmoid(z0[3]));
                    w.z = cvt_pk_bf16(bf_lo(yv.z) * fsigmoid(z1[0]), bf_hi(yv.z) * fsigmoid(z1[1]));
                    w.w = cvt_pk_bf16(bf_lo(yv.w) * fsigmoid(z1[2]), bf_hi(yv.w) * fsigmoid(z1[3]));
                    *(u32x4*)(YM + (size_t)row * DM + 512 + col0 + bj * HALF) = w; } }
    }
};

struct EpiBf16S {
    static constexpr bool PERM = true, AFTER_DRAIN = false;
    bf16_t* O; int ldo; int nscale; float scale0;
    __device__ __forceinline__ void operator()(const f32x4 (&acc)[2][2][4][2], const Unit& u, int wr, int wc, int fr, int fq) const {
        const int row0 = u.pm * BM + wr * 64 + fr, col0 = u.pn * BM + wc * 32 + 8 * fq;
        const float sc = u.pn < nscale ? scale0 : 1.0f;
#pragma unroll
        for (int ai = 0; ai < 2; ++ai)
#pragma unroll
            for (int m = 0; m < 4; ++m) { bf16_t* rowp = O + (size_t)(row0 + ai * HALF + m * 16) * ldo + col0;
#pragma unroll
                for (int bj = 0; bj < 2; ++bj) { const f32x4 v0 = acc[ai][bj][m][0] * sc, v1 = acc[ai][bj][m][1] * sc;
                    u32x4 w; w.x = cvt_pk_bf16(v0[0], v0[1]); w.y = cvt_pk_bf16(v0[2], v0[3]); w.z = cvt_pk_bf16(v1[0], v1[1]); w.w = cvt_pk_bf16(v1[2], v1[3]);
                    *(u32x4*)(rowp + bj * HALF) = w; } }
    }
};

struct EpiQkVt {
    static constexpr bool PERM = true, AFTER_DRAIN = false;
    bf16_t* QK; bf16_t* VT;
    __device__ __forceinline__ void operator()(const f32x4 (&acc)[2][2][4][2], const Unit& u, int wr, int wc, int fr, int fq) const {
        const int row0 = u.pm * BM + wr * 64 + fr, col0 = u.pn * BM + wc * 32 + 8 * fq;
        bf16_t* O = u.which ? VT : QK; const int ldo = u.which ? MT : 2048;
        const float sc = (!u.which && u.pn < 4) ? 0.125f : 1.0f;
#pragma unroll
        for (int ai = 0; ai < 2; ++ai)
#pragma unroll
            for (int m = 0; m < 4; ++m) { bf16_t* rowp = O + (size_t)(row0 + ai * HALF + m * 16) * ldo + col0;
#pragma unroll
                for (int bj = 0; bj < 2; ++bj) { const f32x4 v0 = acc[ai][bj][m][0] * sc, v1 = acc[ai][bj][m][1] * sc;
                    u32x4 w; w.x = cvt_pk_bf16(v0[0], v0[1]); w.y = cvt_pk_bf16(v0[2], v0[3]); w.z = cvt_pk_bf16(v1[0], v1[1]); w.w = cvt_pk_bf16(v1[2], v1[3]);
                    *(u32x4*)(rowp + bj * HALF) = w; } }
    }
};
template <class Epi, class Sched, bool ALIGN_EPI = false, bool SP2 = false>
__device__ __forceinline__ void gemm_phase(PG8_LAS unsigned char* lds, const Gemm g, const Sched& S, const Epi& E) {
    int tid_ = threadIdx.x; asm volatile("" : "+v"(tid_));
    const int tid = tid_, wid = __builtin_amdgcn_readfirstlane(tid >> 6), lane = tid & 63, wr = wid >> 2, wc = wid & 3, fr = lane & 15, fq = lane >> 4;
    const int K = g.K;
    unsigned voffA[2], voffB[2];
#pragma unroll
    for (int i = 0; i < 2; ++i) { int R, C; stage_rc(tid * 16 + i * 8192, R, C); const int Rb = Epi::PERM ? ((R & ~31) + perm32(R & 31)) : R;
        voffA[i] = (unsigned)(R * K + C) * 2u; voffB[i] = (unsigned)(Rb * K + C) * 2u; }
    const size_t kstep = (size_t)(BK * 2);
    const size_t hstep = (size_t)HALF * K * 2;
    const size_t tstep = 2 * hstep;
    const unsigned ldsw = (unsigned)wid * 1024u;
    const int aoff = lds_byte(wr * 64 + fr, fq * 8), boff = lds_byte(wc * 32 + fr, fq * 8);
#define PG8_SA(b, h) (((b) * 2 + (h)) * HTB)
#define PG8_SB(b, h) ((4 + (b) * 2 + (h)) * HTB)
#define PG8_STAGE(bufoff, gbase, voff) do { _Pragma("unroll") for (int _i = 0; _i < 2; ++_i) \
        __builtin_amdgcn_global_load_lds((const unsigned*)((const char*)(gbase) + (voff)[_i]), (PG8_LAS unsigned*)(lds + (bufoff) + ldsw + _i * 8192), 16, 0, 0); } while (0)
#define PG8_LDA(dst, b, h) do { _Pragma("unroll") for (int m = 0; m < 4; ++m) _Pragma("unroll") for (int k = 0; k < 2; ++k) dst[m][k] = *(const PG8_LAS bf16x8*)(lds + PG8_SA(b, h) + aoff + m * 2048 + k * 1024); } while (0)
#define PG8_LDB(dst, b, h) do { _Pragma("unroll") for (int n = 0; n < 2; ++n) _Pragma("unroll") for (int k = 0; k < 2; ++k) dst[n][k] = *(const PG8_LAS bf16x8*)(lds + PG8_SB(b, h) + boff + n * 2048 + k * 1024); } while (0)
#define PG8_MMA(ai, bj, At, Bt) do { __builtin_amdgcn_s_setprio(1); _Pragma("unroll") for (int m = 0; m < 4; ++m) _Pragma("unroll") for (int n = 0; n < 2; ++n) _Pragma("unroll") for (int k = 0; k < 2; ++k) \
        acc[ai][bj][m][n] = __builtin_amdgcn_mfma_f32_16x16x32_bf16(Bt[n][k], At[m][k], acc[ai][bj][m][n], 0, 0, 0); __builtin_amdgcn_s_setprio(0); } while (0)
#define PG8_WAIT_V(n) asm volatile("s_waitcnt vmcnt(" #n ")" ::: "memory")
#define PG8_WAIT_L(n) asm volatile("s_waitcnt lgkmcnt(" #n ")" ::: "memory")
#define PG8_BAR __builtin_amdgcn_s_barrier()
#define PG8_SCHED __builtin_amdgcn_sched_barrier(0)
    Unit cur, nxt; int ui = 0;
    if (!S.next(0, cur)) return;
    f32x4 acc[2][2][4][2];
#pragma unroll
    for (int a = 0; a < 2; ++a)
#pragma unroll
        for (int b = 0; b < 2; ++b)
#pragma unroll
            for (int m = 0; m < 4; ++m)
#pragma unroll
                for (int n = 0; n < 2; ++n) acc[a][b][m][n] = (f32x4){0.f, 0.f, 0.f, 0.f};
    bf16x8 At[4][2], B0[2][2], B1[2][2];
    const char* cA = (const char*)(cur.which ? g.A2 : g.A) + (size_t)cur.pm * tstep + (size_t)cur.k0 * kstep; const char* cB = (const char*)(cur.which ? g.Bt2 : g.Bt) + (size_t)cur.pn * tstep + (size_t)cur.k0 * kstep;
    S.a_ready(cur);
    if constexpr (SP2) {
        PG8_STAGE(PG8_SB(0, 0), cB, voffB); PG8_STAGE(PG8_SB(0, 1), cB + hstep, voffB); PG8_STAGE(PG8_SA(0, 0), cA, voffA); PG8_STAGE(PG8_SA(0, 1), cA + hstep, voffA);
        if (wr == 1) PG8_BAR;
        PG8_WAIT_V(2); PG8_BAR;
        PG8_STAGE(PG8_SB(1, 0), cB + kstep, voffB); PG8_STAGE(PG8_SA(1, 0), cA + kstep, voffA); PG8_STAGE(PG8_SB(1, 1), cB + hstep + kstep, voffB);
        PG8_WAIT_V(6); PG8_BAR;
    } else {
        PG8_STAGE(PG8_SB(0, 0), cB, voffB); PG8_STAGE(PG8_SA(0, 0), cA, voffA); PG8_STAGE(PG8_SB(0, 1), cB + hstep, voffB); PG8_STAGE(PG8_SA(0, 1), cA + hstep, voffA);
        if (wr == 1) PG8_BAR;
        PG8_WAIT_V(4); PG8_BAR;
        PG8_STAGE(PG8_SB(1, 0), cB + kstep, voffB); PG8_STAGE(PG8_SA(1, 0), cA + kstep, voffA); PG8_STAGE(PG8_SB(1, 1), cB + hstep + kstep, voffB);
        PG8_WAIT_V(6); PG8_BAR;
    }
    for (;;) {
        const bool has_next = S.next(ui + 1, nxt);
        const char* nA = has_next ? (const char*)(nxt.which ? g.A2 : g.A) + (size_t)nxt.pm * tstep + (size_t)nxt.k0 * kstep : cA; const char* nB = has_next ? (const char*)(nxt.which ? g.Bt2 : g.Bt) + (size_t)nxt.pn * tstep + (size_t)nxt.k0 * kstep : cB;
        const int nt = cur.nt;
        for (int t = 0; t < nt; t += 2) {
            const bool last = (t == nt - 2);
            const char* a1 = cA + (size_t)(t + 1) * kstep;
            const char* a2 = last ? nA : cA + (size_t)(t + 2) * kstep; const char* b2 = last ? nB : cB + (size_t)(t + 2) * kstep;
            const char* a3 = a2 + kstep; const char* b3 = b2 + kstep;
            if (last && has_next) S.a_ready(nxt);
            if constexpr (SP2) {
            PG8_LDB(B0, 0, 0); PG8_LDB(B1, 0, 1); PG8_SCHED; PG8_LDA(At, 0, 0); PG8_STAGE(PG8_SA(1, 1), a1 + hstep, voffA);
            PG8_WAIT_V(8); PG8_WAIT_L(0); PG8_BAR; PG8_MMA(0, 0, At, B0); PG8_MMA(0, 1, At, B1); PG8_BAR; PG8_SCHED;
            PG8_LDA(At, 0, 1); PG8_STAGE(PG8_SB(0, 0), b2, voffB); PG8_STAGE(PG8_SB(0, 1), b2 + hstep, voffB); PG8_STAGE(PG8_SA(0, 0), a2, voffA);
            PG8_WAIT_V(8); PG8_WAIT_L(0); PG8_BAR; PG8_MMA(1, 0, At, B0); PG8_MMA(1, 1, At, B1); PG8_BAR; PG8_SCHED;
            PG8_LDB(B0, 1, 0); PG8_LDB(B1, 1, 1); PG8_SCHED; PG8_LDA(At, 1, 0); PG8_STAGE(PG8_SA(0, 1), a2 + hstep, voffA);
            PG8_WAIT_V(8); PG8_WAIT_L(0); PG8_BAR; PG8_MMA(0, 0, At, B0); PG8_MMA(0, 1, At, B1); PG8_BAR; PG8_SCHED;
            PG8_LDA(At, 1, 1); PG8_STAGE(PG8_SB(1, 0), b3, voffB); PG8_STAGE(PG8_SB(1, 1), b3 + hstep, voffB); PG8_STAGE(PG8_SA(1, 0), a3, voffA);
            PG8_WAIT_V(8); PG8_WAIT_L(0); PG8_BAR; PG8_MMA(1, 0, At, B0); PG8_MMA(1, 1, At, B1); PG8_BAR; PG8_SCHED;
            } else {
            PG8_LDB(B0, 0, 0); PG8_SCHED; PG8_LDA(At, 0, 0); PG8_STAGE(PG8_SA(1, 1), a1 + hstep, voffA);
            PG8_WAIT_L(8); PG8_BAR; PG8_WAIT_L(0); PG8_MMA(0, 0, At, B0); PG8_BAR; PG8_SCHED;
            PG8_LDB(B1, 0, 1); PG8_STAGE(PG8_SB(0, 0), b2, voffB);
            PG8_BAR; PG8_WAIT_L(0); PG8_MMA(0, 1, At, B1); PG8_BAR;
            PG8_LDA(At, 0, 1); PG8_STAGE(PG8_SA(0, 0), a2, voffA);
            PG8_BAR; PG8_WAIT_L(0); PG8_MMA(1, 0, At, B0); PG8_BAR; PG8_SCHED;
            PG8_STAGE(PG8_SB(0, 1), b2 + hstep, voffB);
            PG8_WAIT_V(6); PG8_BAR; PG8_MMA(1, 1, At, B1); PG8_BAR;
            PG8_LDB(B0, 1, 0); PG8_SCHED; PG8_LDA(At, 1, 0); PG8_STAGE(PG8_SA(0, 1), a2 + hstep, voffA);
            PG8_WAIT_L(8); PG8_BAR; PG8_WAIT_L(0); PG8_MMA(0, 0, At, B0); PG8_BAR; PG8_SCHED;
            PG8_LDB(B1, 1, 1); PG8_STAGE(PG8_SB(1, 0), b3, voffB);
            PG8_BAR; PG8_WAIT_L(0); PG8_MMA(0, 1, At, B1); PG8_BAR;
            PG8_LDA(At, 1, 1); PG8_STAGE(PG8_SA(1, 0), a3, voffA);
            PG8_BAR; PG8_WAIT_L(0); PG8_MMA(1, 0, At, B0); PG8_BAR; PG8_SCHED;
            PG8_STAGE(PG8_SB(1, 1), b3 + hstep, voffB);
            PG8_WAIT_V(6); PG8_BAR; PG8_MMA(1, 1, At, B1); PG8_BAR;
            }
        }
        if constexpr (ALIGN_EPI) { if (wr == 0) PG8_BAR; }
        if constexpr (!Epi::AFTER_DRAIN) { E(acc, cur, wr, wc, fr, fq); S.done(cur); }
        if (!has_next) break;
#pragma unroll
        for (int a = 0; a < 2; ++a)
#pragma unroll
            for (int b = 0; b < 2; ++b)
#pragma unroll
                for (int m = 0; m < 4; ++m)
#pragma unroll
                    for (int n = 0; n < 2; ++n) acc[a][b][m][n] = (f32x4){0.f, 0.f, 0.f, 0.f};
        cur = nxt; cA = nA; cB = nB; ++ui;
        if constexpr (ALIGN_EPI) { if (wr == 1) PG8_BAR; }
    }
    PG8_WAIT_V(0);
    if constexpr (!ALIGN_EPI) { if (wr == 0) PG8_BAR; }
    PG8_BAR;
    if constexpr (Epi::AFTER_DRAIN) { E.fused(acc, cur, wr, wc, fr, fq, lds, wid, lane); S.done(cur); }
#undef PG8_SA
#undef PG8_SB
#undef PG8_STAGE
#undef PG8_LDA
#undef PG8_LDB
#undef PG8_MMA
#undef PG8_WAIT_V
#undef PG8_WAIT_L
#undef PG8_BAR
#undef PG8_SCHED
}
}

#define LAS __attribute__((address_space(3)))
typedef unsigned short bf16;
typedef unsigned v4u __attribute__((ext_vector_type(4)));
typedef unsigned v2u __attribute__((ext_vector_type(2)));
typedef float f32x4 __attribute__((ext_vector_type(4)));
typedef float f32x2 __attribute__((ext_vector_type(2)));
typedef short bf16x8 __attribute__((ext_vector_type(8)));
typedef short s16x4 __attribute__((ext_vector_type(4)));

constexpr size_t MiB = 1u << 20;
constexpr size_t WS_MOD   = 1 * MiB;
constexpr size_t WS_ROPE  = WS_MOD + 512 * 1024;
constexpr size_t WS_LB    = WS_ROPE + 64 * 1024;
constexpr size_t WS_LBT   = WS_LB + 64 * 1024;
constexpr size_t WS_BBR   = WS_LBT + 64 * 1024;
constexpr size_t WS_BBI   = WS_BBR + 256 * 1024;
constexpr size_t WS_CM    = WS_BBI + 256 * 1024;
constexpr size_t WS_BBM   = WS_CM + 256 * 1024;
static_assert(WS_BBM + 256 * 1024 <= 4 * MiB, "param block");
constexpr size_t WS_W1    = 4 * MiB;
constexpr size_t WS_W2    = 48 * MiB;
constexpr size_t WS_WIN   = 70 * MiB;
constexpr size_t WS_WOUT  = 75 * MiB;
constexpr size_t WS_GLU   = 77 * MiB;
constexpr size_t WS_WQKV  = 78 * MiB;
constexpr size_t WS_WO    = 84 * MiB;
constexpr size_t WS_HCTX  = 86 * MiB;
constexpr size_t WS_XN    = 90 * MiB;
constexpr size_t WS_R     = 124 * MiB;
constexpr size_t WS_HID   = WS_R;
constexpr size_t WS_QKVG  = WS_R;
constexpr size_t WS_U     = WS_R + 68 * MiB;
constexpr size_t WS_KVS   = WS_R + 85 * MiB;
constexpr size_t WS_SF    = WS_R + 119 * MiB;
constexpr size_t WS_YS    = WS_R + 128 * MiB;
constexpr size_t WS_QK    = WS_R;
constexpr size_t WS_VT    = WS_R + 68 * MiB;
constexpr size_t WS_PARTF = WS_R + 96 * MiB;
constexpr size_t WS_PARTM = WS_R;
constexpr size_t WS_END   = WS_R + 145 * MiB;

constexpr size_t WS_BAR = 0;
constexpr int BARLDS_OFF = 147456 - 64;
constexpr int NWAVES = 8, NTHREADS = 512;
constexpr int LDS_BYTES = 147456;

struct Args {
    const float* in[26]; float* out; unsigned char* ws; int probe; int pad;
};
typedef const __attribute__((address_space(4))) Args* KArgs;
__device__ __forceinline__ KArgs kargs() { KArgs p = (KArgs)__builtin_amdgcn_kernarg_segment_ptr(); asm volatile("" : "+s"(p)); return p; }
enum { I_X = 0, I_C, I_CTX, I_CCTX, I_WMOD, I_BMOD, I_NORMG, I_W1, I_W2, I_WIN, I_WOUT, I_DECAY, I_LAMRE, I_LAMIM, I_LOGDT, I_BRE, I_BIM, I_CRE, I_CIM,
       I_S5D, I_GLUW, I_GLUB, I_WQKV, I_WO, I_RPB, I_FINALG };

__device__ __forceinline__ unsigned f2bf(float f) { unsigned u = __builtin_bit_cast(unsigned, f); return (u + 0x7fffu + ((u >> 16) & 1u)) >> 16; }
__device__ __forceinline__ unsigned pk2(float lo, float hi) { return f2bf(lo) | (f2bf(hi) << 16); }
typedef __bf16 bf16x2_t __attribute__((ext_vector_type(2)));
__device__ __forceinline__ unsigned cvtpk(float lo, float hi) { const f32x2 v = {lo, hi}; const bf16x2_t b = __builtin_convertvector(v, bf16x2_t); return __builtin_bit_cast(unsigned, b); }
__device__ __forceinline__ float bf2f(unsigned short h) { return __uint_as_float((unsigned)h << 16); }
__device__ __forceinline__ float blo(unsigned w) { return __uint_as_float(w << 16); }
__device__ __forceinline__ float bhi(unsigned w) { return __uint_as_float(w & 0xffff0000u); }
__device__ __forceinline__ int opaque_tid() { int t = threadIdx.x; asm volatile("" : "+v"(t)); return t; }
__device__ __forceinline__ float wave_sum(float v) {
#pragma unroll
    for (int o = 1; o < 64; o <<= 1) v += __shfl_xor(v, o);
    return v;
}
__device__ __forceinline__ void sincos_acc(float x, float& s, float& c) {
    const float k = rintf(x * 0.6366197723675814f);
    float r = fmaf(k, -1.5703125f, x); r = fmaf(k, -4.837512969970703125e-4f, r); r = fmaf(k, -7.54978995489188216e-8f, r);
    const float r2 = r * r;
    float sp = 2.7557319e-6f; sp = fmaf(sp, r2, -1.9841270e-4f); sp = fmaf(sp, r2, 8.3333333e-3f); sp = fmaf(sp, r2, -1.6666667e-1f); sp = fmaf(sp * r2, r, r);
    float cp = -2.7557319e-7f; cp = fmaf(cp, r2, 2.4801587e-5f); cp = fmaf(cp, r2, -1.3888889e-3f); cp = fmaf(cp, r2, 4.1666667e-2f); cp = fmaf(cp, r2, -0.5f); cp = fmaf(cp, r2, 1.0f);
    const int q = ((int)k) & 3;
    s = (q == 0) ? sp : (q == 1) ? cp : (q == 2) ? -sp : -cp;
    c = (q == 0) ? cp : (q == 1) ? -sp : (q == 2) ? -cp : sp;
}
__device__ __forceinline__ float gelu_tanh(float v) {
    const float t = 0.7978845608028654f * (v + 0.044715f * v * v * v);
    const float e = __expf(2.0f * t);
    const float th = 1.0f - 2.0f * __builtin_amdgcn_rcpf(e + 1.0f);
    return 0.5f * v * (1.0f + th);
}

__device__ __forceinline__ int map_row(int kind, int n) {
    if (kind == 1) { const int j = n < FF ? n : n - FF; return 256 * (j >> 7) + (n < FF ? 0 : 128) + (j & 127); }
    if (kind == 2 && n < 1024) { const int tile = n >> 8, hh = (n >> 7) & 1, d = n & 127; return 256 * tile + 128 * ((d >> 5) & 1) + 64 * hh + 32 * (d >> 6) + (d & 31); }
    return n;
}
__device__ __forceinline__ void p0_transpose_item(const float* W, int K, int N, int kind, bf16* WT, LAS float* scr, int item, int lane) {
    const int nblk = N / 32, kb = item / nblk, nb = item % nblk, k0 = 64 * kb, n0 = 32 * nb;
    const int drow = map_row(kind, n0);
    float wv[32];
#pragma unroll
    for (int i = 0; i < 32; ++i) { const int kk = 2 * i + (lane >> 5); wv[i] = W[(size_t)(k0 + kk) * N + n0 + (lane & 31)]; }
#pragma unroll
    for (int i = 0; i < 32; ++i) { const int kk = 2 * i + (lane >> 5); scr[kk * 33 + (lane & 31)] = wv[i]; }
    asm volatile("s_waitcnt lgkmcnt(0)" ::: "memory");
    const int c = lane & 7;
#pragma unroll
    for (int j = 0; j < 4; ++j) { const int n = (lane >> 3) + 8 * j; const LAS float* s = scr + (8 * c) * 33 + n;
        v4u o; o.x = cvtpk(s[0 * 33], s[1 * 33]); o.y = cvtpk(s[2 * 33], s[3 * 33]); o.z = cvtpk(s[4 * 33], s[5 * 33]); o.w = cvtpk(s[6 * 33], s[7 * 33]);
        *(v4u*)(WT + (size_t)(drow + n) * K + k0 + 8 * c) = o; }
    asm volatile("s_waitcnt lgkmcnt(0)" ::: "memory");
}

struct WDesc { const float* W; bf16* dst; int K, N, kind, items; };
__device__ __forceinline__ WDesc wdesc(KArgs a, int mi) {
    WDesc d;
    if (mi < 4)       { d.W = a->in[I_W1] + (size_t)mi * DM * 2 * FF; d.dst = (bf16*)(a->ws + WS_W1) + (size_t)mi * 2 * FF * DM; d.K = DM; d.N = 2 * FF; d.kind = 1; }
    else if (mi < 8)  { d.W = a->in[I_W2] + (size_t)(mi - 4) * FF * DM; d.dst = (bf16*)(a->ws + WS_W2) + (size_t)(mi - 4) * DM * FF; d.K = FF; d.N = DM; d.kind = 0; }
    else if (mi == 8) { d.W = a->in[I_WIN]; d.dst = (bf16*)(a->ws + WS_WIN); d.K = DM; d.N = 2560; d.kind = 2; }
    else if (mi == 9) { d.W = a->in[I_WOUT]; d.dst = (bf16*)(a->ws + WS_WOUT); d.K = DM; d.N = DM; d.kind = 0; }
    else if (mi == 10){ d.W = a->in[I_GLUW]; d.dst = (bf16*)(a->ws + WS_GLU); d.K = 512; d.N = 512; d.kind = 0; }
    else if (mi == 11){ d.W = a->in[I_WQKV]; d.dst = (bf16*)(a->ws + WS_WQKV); d.K = DM; d.N = 3072; d.kind = 0; }
    else              { d.W = a->in[I_WO]; d.dst = (bf16*)(a->ws + WS_WO); d.K = DM; d.N = DM; d.kind = 0; }
    d.items = (d.K / 64) * (d.N / 32);
    return d;
}
constexpr int NWMAT = 13;

__device__ __forceinline__ void p0_prologue(KArgs a, LAS unsigned char* lds, int G, int parts = 7) {
    const int tid = opaque_tid(), lane = tid & 63, wave = __builtin_amdgcn_readfirstlane(tid >> 6);
    if (parts & 1)
    {
        LAS float* sv = (LAS float*)lds;
        LAS float* red = (LAS float*)(lds + 32768);
        bool have = false;
        for (int it = blockIdx.x; it < 2 * (MODW / 64); it += G) {
            if (!have) {
                for (int i = tid; i < 5 * DM; i += NTHREADS) { const int b = i >> 10, k = i & 1023; const float v = b < 4 ? a->in[I_C][b * DM + k] : a->in[I_CCTX][k]; sv[k * 8 + b] = v / (1.0f + expf(-v)); }
                __syncthreads(); have = true;
            }
            const int layer = it / (MODW / 64), n = (it % (MODW / 64)) * 64 + lane;
            const float* wp = a->in[I_WMOD] + (size_t)layer * DM * MODW + n;
            float acc[5] = {0.f, 0.f, 0.f, 0.f, 0.f};
#pragma unroll 16
            for (int kk = 0; kk < 128; ++kk) { const int k = wave * 128 + kk; const float w = wp[(size_t)k * MODW];
                const f32x4 s0 = *(const LAS f32x4*)(sv + k * 8); const float s4 = sv[k * 8 + 4];
                acc[0] = fmaf(s0[0], w, acc[0]); acc[1] = fmaf(s0[1], w, acc[1]); acc[2] = fmaf(s0[2], w, acc[2]); acc[3] = fmaf(s0[3], w, acc[3]); acc[4] = fmaf(s4, w, acc[4]); }
#pragma unroll
            for (int b = 0; b < 5; ++b) red[(wave * 5 + b) * 64 + lane] = acc[b];
            __syncthreads();
            if (tid < 320) { const int b = tid >> 6, l = tid & 63, nn = (it % (MODW / 64)) * 64 + l; float s = a->in[I_BMOD][layer * MODW + nn];
#pragma unroll
                for (int w = 0; w < 8; ++w) s += red[(w * 5 + b) * 64 + l];
                ((float*)(a->ws + WS_MOD))[((size_t)layer * 5 + b) * MODW + nn] = s; }
            __syncthreads();
        }
        __syncthreads();
    }
    const int gtid = blockIdx.x * NTHREADS + tid, GT = G * NTHREADS;
    for (int i = gtid; i < MC * DM / 4; i += GT) ((f32x4*)(a->ws + WS_HCTX))[i] = ((const f32x4*)a->in[I_CTX])[i];
    for (int i = gtid; i < 64 * 32; i += GT) { const int pos = i >> 5, f = i & 31; const float inv = exp2f(-(float)f * (13.287712379549449f / 32.0f));
        float s, c; sincos_acc((float)pos * inv, s, c); ((f32x2*)(a->ws + WS_ROPE))[i] = (f32x2){c, s}; }
    for (int i = gtid; i < 2 * 32 * 64; i += GT) {
        const int p = i & 63, dg = i >> 6;
        const float lr = fminf(a->in[I_LAMRE][i], -1e-4f), li = a->in[I_LAMIM][i], dt = expf(a->in[I_LOGDT][dg]);
        float s, c; sincos_acc(li * dt, s, c); const float mg = expf(lr * dt); const float br = mg * c, bi = mg * s;
        ((f32x2*)(a->ws + WS_LB))[i] = (f32x2){br, bi};
        float s64, c64; sincos_acc(li * dt * 64.0f, s64, c64); const float m64 = expf(lr * dt * 64.0f);
        ((f32x2*)(a->ws + WS_LBT))[i] = (f32x2){m64 * c64, m64 * s64};
        const float nr = br - 1.0f, ni = bi, den = 1.0f / (lr * lr + li * li);
        const float cr = (nr * lr + ni * li) * den, ci = (ni * lr - nr * li) * den;
        for (int k = 0; k < 16; ++k) {
            const float bre = a->in[I_BRE][(size_t)i * 16 + k], bim = a->in[I_BIM][(size_t)i * 16 + k];
            ((bf16*)(a->ws + WS_BBM))[((size_t)dg * 128 + 2 * p) * 16 + k] = (bf16)f2bf(cr * bre - ci * bim);
            ((bf16*)(a->ws + WS_BBM))[((size_t)dg * 128 + 2 * p + 1) * 16 + k] = (bf16)f2bf(cr * bim + ci * bre);
            const float cre = a->in[I_CRE][((size_t)dg * 16 + k) * 64 + p], cim = a->in[I_CIM][((size_t)dg * 16 + k) * 64 + p];
            ((unsigned*)(a->ws + WS_CM))[((size_t)dg * 16 + k) * 64 + p] = cvtpk(cre, -cim);
        }
    }
    if (parts & 4) {
        LAS float* scr = (LAS float*)(lds + wave * 16384);
        const int gw = blockIdx.x * NWAVES + wave, NGW = G * NWAVES;
        int total = 0;
        for (int mi = 0; mi < NWMAT; ++mi) total += wdesc(a, mi).items;
        const int nshort = G == 256 ? 32 : 0, per_s = 8, per_l = G == 256 ? 11 : (total + NGW - 1) / NGW;
        const int it0 = (int)blockIdx.x < nshort ? gw * per_s : nshort * NWAVES * per_s + (gw - nshort * NWAVES) * per_l;
        const int it1 = min(total, it0 + ((int)blockIdx.x < nshort ? per_s : per_l));
        for (int it = it0; it < it1; ++it) {
            int r = it;
            for (int mi = 0; mi < NWMAT; ++mi) { const WDesc d = wdesc(a, mi); if (r < d.items) { p0_transpose_item(d.W, d.K, d.N, d.kind, d.dst, scr, r, lane); break; } r -= d.items; }
        }
    }
}

__device__ __forceinline__ void norm_phase(const float* src_lat, const float* src_ctx, bf16* XN, const float* g, const float* mod  , int ishift, int nrows, int G, const float* part = nullptr, int npart = 0, float* hctx_rw = nullptr) {
    const int tid = opaque_tid(), lane = tid & 63, wave = __builtin_amdgcn_readfirstlane(tid >> 6);
    const int gw = blockIdx.x * NWAVES + wave, NGW = G * NWAVES;
    f32x4 gv[4];
#pragma unroll
    for (int j = 0; j < 4; ++j) gv[j] = *((const f32x4*)g + lane + 64 * j);
    for (int row = gw; row < nrows; row += NGW) {
        const float* xr = row < ML ? src_lat + (size_t)row * DM : src_ctx + (size_t)(row - ML) * DM;
        const int bidx = row < ML ? (row >> 12) : 4;
        const float* sh = mod + (size_t)bidx * MODW + ishift * DM; const float* sc = sh + DM;
        f32x4 v[4]; float s = 0.f;
#pragma unroll
        for (int j = 0; j < 4; ++j) v[j] = *((const f32x4*)xr + lane + 64 * j);
        if (npart > 0 && row >= ML) {
            for (int pp = 0; pp < npart; ++pp) { const float* pr = part + ((size_t)pp * MC + (row - ML)) * DM;
#pragma unroll
                for (int j = 0; j < 4; ++j) v[j] += *((const f32x4*)pr + lane + 64 * j); }
#pragma unroll
            for (int j = 0; j < 4; ++j) *((f32x4*)(hctx_rw + (size_t)(row - ML) * DM) + lane + 64 * j) = v[j];
        }
#pragma unroll
        for (int j = 0; j < 4; ++j) s += (v[j][0] * v[j][0] + v[j][1] * v[j][1]) + (v[j][2] * v[j][2] + v[j][3] * v[j][3]);
        const float rstd = rsqrtf(wave_sum(s) * (1.0f / DM) + EPS);
#pragma unroll
        for (int j = 0; j < 4; ++j) {
            const f32x4 shv = *((const f32x4*)sh + lane + 64 * j), scv = *((const f32x4*)sc + lane + 64 * j);
            const f32x4 y = v[j] * rstd * gv[j] * (scv + 1.0f) + shv;
            *((v2u*)(XN + (size_t)row * DM) + lane + 64 * j) = (v2u){cvtpk(y[0], y[1]), cvtpk(y[2], y[3])};
        }
    }
}
__device__ __forceinline__ void final_norm_phase(float* io, const float* g, int G) {
    const int tid = opaque_tid(), lane = tid & 63, wave = __builtin_amdgcn_readfirstlane(tid >> 6);
    const int gw = blockIdx.x * NWAVES + wave, NGW = G * NWAVES;
    f32x4 gv[4];
#pragma unroll
    for (int j = 0; j < 4; ++j) gv[j] = *((const f32x4*)g + lane + 64 * j);
    for (int row = gw; row < ML; row += NGW) {
        float* xr = io + (size_t)row * DM;
        f32x4 v[4]; float s = 0.f;
#pragma unroll
        for (int j = 0; j < 4; ++j) { v[j] = *((const f32x4*)xr + lane + 64 * j); s += (v[j][0] * v[j][0] + v[j][1] * v[j][1]) + (v[j][2] * v[j][2] + v[j][3] * v[j][3]); }
        const float rstd = rsqrtf(wave_sum(s) * (1.0f / DM) + EPS);
#pragma unroll
        for (int j = 0; j < 4; ++j) *((f32x4*)xr + lane + 64 * j) = v[j] * rstd * gv[j];
    }
}

#define XB_TMO      128
#define XB_XCNT(j)  (256  + 64 * (j))
#define XB_XSUB(j)  (1280 + 64 * (j))
#define XB_XGEN(j)  (2304 + 64 * (j))
#define XB_TOP      3328
#define XB_TOPGEN   3392
#define XCD_BAR_WORDS 3456
#define XB_SPIN_CAP (1u << 18)

__device__ __forceinline__ unsigned xb_ld(unsigned* p)              { return __hip_atomic_load(p, __ATOMIC_RELAXED, __HIP_MEMORY_SCOPE_AGENT); }
__device__ __forceinline__ unsigned xb_add(unsigned* p, unsigned v) { return __hip_atomic_fetch_add(p, v, __ATOMIC_RELAXED, __HIP_MEMORY_SCOPE_AGENT); }
__device__ __forceinline__ unsigned xb_xcc_id() { return (unsigned)__builtin_amdgcn_s_getreg((3 << 11) | 20) & 0xFu; }
#define XB_SPIN(cond, bar) do { unsigned _sp = 0; while (cond) { __builtin_amdgcn_s_sleep(1); \
    if ((++_sp & 255u) == 0u) { if (xb_ld(&(bar)[XB_TMO])) break; if (_sp > XB_SPIN_CAP) { atomicAdd(&(bar)[XB_TMO], 1u); break; } } } } while (0)

struct XcdBarrier {
    unsigned* bar; unsigned x;
    volatile LAS unsigned* st;
};

__device__ __forceinline__ XcdBarrier xcd_barrier_post(unsigned* bar, volatile LAS unsigned* st) {
    XcdBarrier b; b.bar = bar; b.x = xb_xcc_id(); b.st = st;
    if (threadIdx.x == 0) (void)xb_add(&bar[XB_XCNT(b.x)], 1u);
    return b;
}
__device__ __forceinline__ void xcd_barrier_complete(unsigned* bar, unsigned x, unsigned& nloc, unsigned& nx) {
    const unsigned G = gridDim.x * gridDim.y * gridDim.z;
    unsigned sum, cnt, mine, sp = 0u;
    for (;;) {
        sum = 0u; cnt = 0u; mine = 0u;
#pragma unroll
        for (unsigned j = 0; j < 16; ++j) { const unsigned c = xb_ld(&bar[XB_XCNT(j)]); sum += c; cnt += (c > 0u) ? 1u : 0u; mine = (j == x) ? c : mine; }
        if (sum == G) break;
        __builtin_amdgcn_s_sleep(1);
        if ((++sp & 255u) == 0u) { if (xb_ld(&bar[XB_TMO])) break; if (sp > XB_SPIN_CAP) { atomicAdd(&bar[XB_TMO], 1u); break; } }
    }
    nloc = mine > 0u ? mine : 1u; nx = cnt > 0u ? cnt : 1u;
}

__device__ __forceinline__ void xcd_barrier(const XcdBarrier& b) {
    asm volatile("s_waitcnt vmcnt(0)" ::: "memory");
    __syncthreads();
    if (threadIdx.x == 0) {
        unsigned* bar = b.bar; unsigned bx = b.x; asm volatile("" : "+s"(bar), "+s"(bx));
        __builtin_amdgcn_s_waitcnt(0);
        unsigned nloc = b.st[0], nx = b.st[1];
        const unsigned old = xb_add(&bar[XB_XSUB(bx)], 1u);
        const unsigned gen = old / nloc;
        if (old + 1u == (gen + 1u) * nloc) {
            __builtin_amdgcn_fence(__ATOMIC_RELEASE, "agent");
            asm volatile("s_waitcnt vmcnt(0)" ::: "memory");
            const unsigned og = xb_add(&bar[XB_TOP], 1u);
            const unsigned tg = og / nx;
            if (og + 1u == (tg + 1u) * nx) xb_add(&bar[XB_TOPGEN], 1u);
            else XB_SPIN(xb_ld(&bar[XB_TOPGEN]) == tg, bar);
            __builtin_amdgcn_fence(__ATOMIC_ACQUIRE, "agent");
            xb_add(&bar[XB_XGEN(bx)], 1u);
            asm volatile("s_waitcnt vmcnt(0)" ::: "memory");
        } else {
            XB_SPIN(xb_ld(&bar[XB_XGEN(bx)]) == gen, bar);
            __builtin_amdgcn_fence(__ATOMIC_ACQUIRE, "agent");
            asm volatile("s_waitcnt vmcnt(0)" ::: "memory");
        }
    }
    __syncthreads();
}


__device__ __forceinline__ void xcd_barrier_census(const XcdBarrier& b) {
    if (threadIdx.x == 0) { unsigned nloc, nx; xcd_barrier_complete(b.bar, b.x, nloc, nx); b.st[0] = nloc; b.st[1] = nx; }
    __syncthreads();
}

typedef float f32x4m __attribute__((ext_vector_type(4)));
#define MFMA16(a, b, c) __builtin_amdgcn_mfma_f32_16x16x32_bf16((a), (b), (c), 0, 0, 0)
__device__ __forceinline__ unsigned off_b(unsigned row, unsigned ch) { return 256u * row + 16u * (ch ^ (((row & 3u) << 2) | ((row >> 2) & 3u))); }
__device__ __forceinline__ bf16x8 tr_frag(LAS unsigned char* tile, int lane, int c, int ks) {
    const unsigned g = lane >> 4, q = (lane & 15) >> 2, p = lane & 3;
    const s16x4 lo = __builtin_amdgcn_ds_read_tr16_b64_v4i16((LAS s16x4*)(tile + off_b(32 * ks + 8 * g + q, 2 * c + (p >> 1)) + 8 * (p & 1)));
    const s16x4 hi = __builtin_amdgcn_ds_read_tr16_b64_v4i16((LAS s16x4*)(tile + off_b(32 * ks + 8 * g + 4 + q, 2 * c + (p >> 1)) + 8 * (p & 1)));
    return (bf16x8){lo[0], lo[1], lo[2], lo[3], hi[0], hi[1], hi[2], hi[3]};
}
__device__ __forceinline__ bf16x8 pack8(const f32x4 a, const f32x4 b) {
    v4u w; w.x = cvtpk(a[0], a[1]); w.y = cvtpk(a[2], a[3]); w.z = cvtpk(b[0], b[1]); w.w = cvtpk(b[2], b[3]);
    return __builtin_bit_cast(bf16x8, w);
}
__device__ __forceinline__ float log_sigmoid(float x) { return -log1pf(expf(-x)); }

__device__ __forceinline__ int ret_row0(int b, int s) { return s < 2 ? ML + b * CTXL + s * 128 : b * SEQ + (s - 2) * 128; }

__device__ __forceinline__ void r1_unit(KArgs a, LAS unsigned char* lds, int unit) {
    const int tid = opaque_tid(), lane = tid & 63, wave = __builtin_amdgcn_readfirstlane(tid >> 6);
    const int s = unit % 34, bh = unit / 34, h = bh & 3, b = bh >> 2, row0 = ret_row0(b, s);
    const bf16* QKVG = (const bf16*)(a->ws + WS_QKVG);
    const float lgf = log_sigmoid(a->in[I_DECAY][h]), lgb = log_sigmoid(a->in[I_DECAY][4 + h]);
#pragma unroll
    for (int it = 0; it < 4; ++it) {
        const int n = tid + NTHREADS * it, row = n >> 4, ch = n & 15;
        const bf16* kp = QKVG + (size_t)(row0 + row) * 2048 + 512 + 128 * h + 8 * ch;
        const v4u kv = *(const v4u*)kp, vv = *(const v4u*)(kp + 512);
        const float wf = expf(lgf * (float)(127 - row)), wb = expf(lgb * (float)row);
        v4u kf, kb;
        kf.x = cvtpk(blo(kv.x) * wf, bhi(kv.x) * wf); kf.y = cvtpk(blo(kv.y) * wf, bhi(kv.y) * wf); kf.z = cvtpk(blo(kv.z) * wf, bhi(kv.z) * wf); kf.w = cvtpk(blo(kv.w) * wf, bhi(kv.w) * wf);
        kb.x = cvtpk(blo(kv.x) * wb, bhi(kv.x) * wb); kb.y = cvtpk(blo(kv.y) * wb, bhi(kv.y) * wb); kb.z = cvtpk(blo(kv.z) * wb, bhi(kv.z) * wb); kb.w = cvtpk(blo(kv.w) * wb, bhi(kv.w) * wb);
        const unsigned o = off_b(row, ch);
        *(LAS v4u*)(lds + o) = kf; *(LAS v4u*)(lds + 32768 + o) = kb; *(LAS v4u*)(lds + 65536 + o) = vv;
    }
    __syncthreads();
    f32x4 accf[8], accb[8];
#pragma unroll
    for (int c = 0; c < 8; ++c) { accf[c] = (f32x4){0.f, 0.f, 0.f, 0.f}; accb[c] = (f32x4){0.f, 0.f, 0.f, 0.f}; }
#pragma unroll
    for (int ks = 0; ks < 4; ++ks) {
        const bf16x8 kf = tr_frag(lds, lane, wave, ks), kb = tr_frag(lds + 32768, lane, wave, ks);
#pragma unroll
        for (int c = 0; c < 8; ++c) { const bf16x8 vf = tr_frag(lds + 65536, lane, c, ks); accf[c] = MFMA16(kf, vf, accf[c]); accb[c] = MFMA16(kb, vf, accb[c]); }
    }
    bf16* Sf = (bf16*)(a->ws + WS_KVS) + ((size_t)(bh * 2 + 0) * 34 + s) * 16384;
    bf16* Sb = (bf16*)(a->ws + WS_KVS) + ((size_t)(bh * 2 + 1) * 34 + s) * 16384;
    const int d0 = 16 * wave + 4 * (lane >> 4);
#pragma unroll
    for (int c = 0; c < 8; ++c) { const int e = 16 * c + (lane & 15);
        *(v2u*)(Sf + e * 128 + d0) = (v2u){cvtpk(accf[c][0], accf[c][1]), cvtpk(accf[c][2], accf[c][3])};
        *(v2u*)(Sb + e * 128 + d0) = (v2u){cvtpk(accb[c][0], accb[c][1]), cvtpk(accb[c][2], accb[c][3])}; }
    __syncthreads();
}

__device__ __forceinline__ void r2_items(KArgs a, int G) {
    const int gtid = blockIdx.x * NTHREADS + opaque_tid(), GT = G * NTHREADS;
    for (int idx = gtid; idx < 32 * 4096; idx += GT) {
        const int bhd = idx >> 12, o4 = idx & 4095, dir = bhd & 1, h = (bhd >> 1) & 3;
        const float decay = expf(log_sigmoid(a->in[I_DECAY][dir * 4 + h]) * 128.0f);
        bf16* base = (bf16*)(a->ws + WS_KVS) + (size_t)bhd * 34 * 16384 + o4 * 4;
        const long step = dir == 0 ? 16384 : -16384;
        bf16* p0 = base + (dir == 0 ? 0 : 16384); bf16* p2 = base + (dir == 0 ? 2 * 16384 : 33 * 16384);
        v2u v[34];
        { bf16* p = p0;
#pragma unroll
          for (int i = 0; i < 34; ++i) { if (i == 2) p = p2; v[i] = *(const v2u*)p; p += step; asm volatile("" : "+v"(p)); } }
        float st0 = 0.f, st1 = 0.f, st2 = 0.f, st3 = 0.f;
        { bf16* p = p0;
#pragma unroll
          for (int i = 0; i < 34; ++i) { if (i == 2) p = p2;
            *(v2u*)p = (v2u){cvtpk(st0, st1), cvtpk(st2, st3)}; p += step; asm volatile("" : "+v"(p));
            st0 = fmaf(decay, st0, blo(v[i].x)); st1 = fmaf(decay, st1, bhi(v[i].x)); st2 = fmaf(decay, st2, blo(v[i].y)); st3 = fmaf(decay, st3, bhi(v[i].y)); } }
    }
}

__device__ __forceinline__ void r3_unit(KArgs a, LAS unsigned char* lds, int unit) {
    const int tid = opaque_tid(), lane = tid & 63, wave = __builtin_amdgcn_readfirstlane(tid >> 6);
    const int s = unit % 34, bh = unit / 34, h = bh & 3, b = bh >> 2, row0 = ret_row0(b, s);
    const bf16* QKVG = (const bf16*)(a->ws + WS_QKVG);
    const float l2f = log_sigmoid(a->in[I_DECAY][h]) * 1.4426950408889634f, l2b = log_sigmoid(a->in[I_DECAY][4 + h]) * 1.4426950408889634f;
    const bf16* Sf = (const bf16*)(a->ws + WS_KVS) + ((size_t)(bh * 2 + 0) * 34 + s) * 16384;
    const bf16* Sb = (const bf16*)(a->ws + WS_KVS) + ((size_t)(bh * 2 + 1) * 34 + s) * 16384;
    {
        v4u t[8];
#pragma unroll
        for (int it = 0; it < 4; ++it) { const int n = tid + NTHREADS * it, row = n >> 4, ch = n & 15; const bf16* gp = QKVG + (size_t)(row0 + row) * 2048 + 512 + 128 * h + 8 * ch;
            t[it] = *(const v4u*)(gp + 512); t[4 + it] = *(const v4u*)gp; }
#pragma unroll
        for (int it = 0; it < 4; ++it) { const int n = tid + NTHREADS * it, row = n >> 4, ch = n & 15; const unsigned o = off_b(row, ch);
            *(LAS v4u*)(lds + o) = t[it]; *(LAS v4u*)(lds + 32768 + o) = t[4 + it]; }
#pragma unroll
        for (int it = 0; it < 4; ++it) { const int n = tid + NTHREADS * it; t[it] = *(const v4u*)(Sf + (size_t)n * 8); t[4 + it] = *(const v4u*)(Sb + (size_t)n * 8); }
#pragma unroll
        for (int it = 0; it < 4; ++it) { const int n = tid + NTHREADS * it, row = n >> 4, ch = n & 15; const unsigned o = off_b(row, ch);
            *(LAS v4u*)(lds + 65536 + o) = t[it]; *(LAS v4u*)(lds + 98304 + o) = t[4 + it]; }
    }
    const int fr = lane & 15, g = lane >> 4;
    bf16x8 qf[4];
#pragma unroll
    for (int ks = 0; ks < 4; ++ks) qf[ks] = *(const bf16x8*)(QKVG + (size_t)(row0 + 16 * wave + fr) * 2048 + 128 * h + 32 * ks + 8 * g);
    __syncthreads();
    f32x4 acco[8];
#pragma unroll
    for (int c = 0; c < 8; ++c) acco[c] = (f32x4){0.f, 0.f, 0.f, 0.f};
    const int iq = 16 * wave + fr;
#pragma unroll
    for (int jt = 0; jt < 4; ++jt) {
        f32x4 sa = (f32x4){0.f, 0.f, 0.f, 0.f}, sb = sa;
        const int ja = 32 * jt + 8 * (fr >> 2) + (fr & 3);
#pragma unroll
        for (int ks = 0; ks < 4; ++ks) {
            const bf16x8 ka = *(const LAS bf16x8*)(lds + 32768 + off_b(ja, 4 * ks + g)), kb = *(const LAS bf16x8*)(lds + 32768 + off_b(ja + 4, 4 * ks + g));
            sa = MFMA16(ka, qf[ks], sa); sb = MFMA16(kb, qf[ks], sb);
        }
        f32x4 pa, pb;
#pragma unroll
        for (int r = 0; r < 4; ++r) {
            const int j0 = 32 * jt + 8 * g + r, d0 = iq - j0, d1 = d0 - 4;
            const float w0 = (d0 >= 0 ? __builtin_amdgcn_exp2f(l2f * (float)d0) : 0.f) + (d0 <= 0 ? __builtin_amdgcn_exp2f(-l2b * (float)d0) : 0.f);
            const float w1 = (d1 >= 0 ? __builtin_amdgcn_exp2f(l2f * (float)d1) : 0.f) + (d1 <= 0 ? __builtin_amdgcn_exp2f(-l2b * (float)d1) : 0.f);
            pa[r] = sa[r] * w0; pb[r] = sb[r] * w1;
        }
        const bf16x8 pf = pack8(pa, pb);
#pragma unroll
        for (int c = 0; c < 8; ++c) { const bf16x8 vf = tr_frag(lds, lane, c, jt); acco[c] = MFMA16(pf, vf, acco[c]); }
    }
    float ff[4], fb[4];
#pragma unroll
    for (int r = 0; r < 4; ++r) { const int i = 16 * wave + 4 * g + r; ff[r] = __builtin_amdgcn_exp2f(l2f * (float)(i + 1)); fb[r] = __builtin_amdgcn_exp2f(l2b * (float)(128 - i)); }
    float ss[4] = {0.f, 0.f, 0.f, 0.f};
#pragma unroll
    for (int c = 0; c < 8; ++c) {
        f32x4 t1 = (f32x4){0.f, 0.f, 0.f, 0.f}, t2 = t1;
#pragma unroll
        for (int ks = 0; ks < 4; ++ks) {
            const unsigned o = off_b(16 * c + fr, 4 * ks + g);
            t1 = MFMA16(qf[ks], *(const LAS bf16x8*)(lds + 65536 + o), t1); t2 = MFMA16(qf[ks], *(const LAS bf16x8*)(lds + 98304 + o), t2);
        }
#pragma unroll
        for (int r = 0; r < 4; ++r) { const float o = acco[c][r] + ff[r] * t1[r] + fb[r] * t2[r]; acco[c][r] = o; ss[r] = fmaf(o, o, ss[r]); }
    }
#pragma unroll
    for (int r = 0; r < 4; ++r) { float v = ss[r]; v += __shfl_xor(v, 1); v += __shfl_xor(v, 2); v += __shfl_xor(v, 4); v += __shfl_xor(v, 8); ss[r] = rsqrtf(v * (1.0f / 128.0f) + EPS); }
    __syncthreads();
    LAS unsigned short* ost = (LAS unsigned short*)(lds + 32768 + wave * 4096);
#pragma unroll
    for (int r = 0; r < 4; ++r)
#pragma unroll
        for (int c = 0; c < 8; ++c) ost[(4 * g + r) * 128 + 16 * c + fr] = (unsigned short)f2bf(acco[c][r] * ss[r]);
    asm volatile("s_waitcnt lgkmcnt(0)" ::: "memory");
    bf16* YM = (bf16*)(a->ws + WS_XN);
#pragma unroll
    for (int it = 0; it < 4; ++it) {
        const int n = lane + 64 * it, rr = n >> 4, ch = n & 15; const size_t row = (size_t)(row0 + 16 * wave + rr);
        const v4u ov = *(const LAS v4u*)(ost + rr * 128 + 8 * ch), gv = *(const v4u*)(QKVG + row * 2048 + 1536 + 128 * h + 8 * ch);
        v4u y;
        y.x = cvtpk(blo(ov.x) * pg8::fsilu(blo(gv.x)), bhi(ov.x) * pg8::fsilu(bhi(gv.x))); y.y = cvtpk(blo(ov.y) * pg8::fsilu(blo(gv.y)), bhi(ov.y) * pg8::fsilu(bhi(gv.y)));
        y.z = cvtpk(blo(ov.z) * pg8::fsilu(blo(gv.z)), bhi(ov.z) * pg8::fsilu(bhi(gv.z))); y.w = cvtpk(blo(ov.w) * pg8::fsilu(blo(gv.w)), bhi(ov.w) * pg8::fsilu(bhi(gv.w)));
        *(v4u*)(YM + row * DM + 128 * h + 8 * ch) = y;
    }
    __syncthreads();
}

__device__ __forceinline__ int s5_row0(int b, int c) { return c < 4 ? ML + b * CTXL + 64 * c : b * SEQ + 64 * (c - 4); }
constexpr int S5_WLDS = 16384;

__device__ __forceinline__ void s5_bu_block(const bf16x8 (&bbm)[8], const bf16x8 uf  , LAS unsigned char* bu, int fr, int gq) {
#pragma unroll
    for (int j = 0; j < 8; ++j) {
        const f32x4 d = MFMA16(bbm[j], uf, ((f32x4){0.f, 0.f, 0.f, 0.f}));
        *(LAS v2u*)(bu + fr * 256 + (((2 * j + (gq >> 1)) ^ fr) * 16) + (gq & 1) * 8) = (v2u){cvtpk(d[0], d[1]), cvtpk(d[2], d[3])};
    }
    asm volatile("s_waitcnt lgkmcnt(0)" ::: "memory");
}
#define S5_BUREAD(tl_) ({ const unsigned w_ = *(const LAS unsigned*)(bu + (tl_) * 256 + (((p >> 2) ^ (tl_)) * 16) + (p & 3) * 4); (f32x2){blo(w_), bhi(w_)}; })
#define S5_UPD(bu_)  { const f32x2 xs_ = (f32x2){xv.y, xv.x}; xv = lrr * xv + (lmi * xs_ + (bu_)); }

__device__ __forceinline__ void s1_unit(KArgs a, LAS unsigned char* wl, int wu, int lane) {
    const int c = wu % 68, bg = wu / 68, g = bg & 31, b = bg >> 5, p = lane, fr = lane & 15, gq = lane >> 4;
    LAS unsigned char* bu0 = wl; LAS unsigned char* bu1 = wl + 4096;
    const f32x2 lb0 = ((const f32x2*)(a->ws + WS_LB))[g * 64 + p], lb1 = ((const f32x2*)(a->ws + WS_LB))[(32 + g) * 64 + p];
    const f32x2 lrr0 = (f32x2){lb0.x, lb0.x}, lmi0 = (f32x2){-lb0.y, lb0.y}, lrr1 = (f32x2){lb1.x, lb1.x}, lmi1 = (f32x2){-lb1.y, lb1.y};
    bf16x8 bbm0[8], bbm1[8];
#pragma unroll
    for (int j = 0; j < 8; ++j) { bbm0[j] = (bf16x8){0, 0, 0, 0, 0, 0, 0, 0}; bbm1[j] = bbm0[j];
        if (gq < 2) { bbm0[j] = *(const bf16x8*)((const bf16*)(a->ws + WS_BBM) + ((size_t)g * 128 + 16 * j + fr) * 16 + 8 * gq);
                      bbm1[j] = *(const bf16x8*)((const bf16*)(a->ws + WS_BBM) + ((size_t)(32 + g) * 128 + 16 * j + fr) * 16 + 8 * gq); } }
    const bf16* ub = (const bf16*)(a->ws + WS_U) + (size_t)(s5_row0(b, c) + fr) * 512 + 16 * g + 8 * (gq & 1);
    bf16x8 uf[4];
#pragma unroll
    for (int t4 = 0; t4 < 4; ++t4) { uf[t4] = (bf16x8){0, 0, 0, 0, 0, 0, 0, 0}; if (gq < 2) uf[t4] = *(const bf16x8*)(ub + (size_t)(16 * t4) * 512); }
    f32x2 xv0 = (f32x2){0.f, 0.f}, xv1 = xv0;
#pragma unroll
    for (int blk = 0; blk < 4; ++blk) {
        s5_bu_block(bbm0, uf[blk], bu0, fr, gq);
        s5_bu_block(bbm1, uf[3 - blk], bu1, fr, gq);
#pragma unroll
        for (int i = 0; i < 16; ++i) {
            const unsigned w0 = *(const LAS unsigned*)(bu0 + i * 256 + (((p >> 2) ^ i) * 16) + (p & 3) * 4), w1 = *(const LAS unsigned*)(bu1 + (15 - i) * 256 + (((p >> 2) ^ (15 - i)) * 16) + (p & 3) * 4);
            { const f32x2 xs_ = (f32x2){xv0.y, xv0.x}; xv0 = lrr0 * xv0 + (lmi0 * xs_ + (f32x2){blo(w0), bhi(w0)}); }
            { const f32x2 xs_ = (f32x2){xv1.y, xv1.x}; xv1 = lrr1 * xv1 + (lmi1 * xs_ + (f32x2){blo(w1), bhi(w1)}); }
        }
        asm volatile("s_waitcnt lgkmcnt(0)" ::: "memory");
    }
    ((f32x2*)(a->ws + WS_SF))[((size_t)((b * 32 + g) * 2 + 0) * 68 + c) * 64 + p] = xv0;
    ((f32x2*)(a->ws + WS_SF))[((size_t)((b * 32 + g) * 2 + 1) * 68 + c) * 64 + p] = xv1;
}
__device__ __forceinline__ void s2_items(KArgs a, int G) {
    const int gtid = blockIdx.x * NTHREADS + opaque_tid(), GT = G * NTHREADS;
    for (int idx = gtid; idx < 4 * 32 * 2 * 64; idx += GT) {
        const int p = idx & 63, bgd = idx >> 6, dir = bgd & 1, g = (bgd >> 1) & 31, dg = dir * 32 + g;
        const f32x2 lt = ((const f32x2*)(a->ws + WS_LBT))[dg * 64 + p];
        f32x2* base = (f32x2*)(a->ws + WS_SF) + (size_t)bgd * 68 * 64 + p;
        const long step = dir == 0 ? 64 : -64;
        f32x2* q0 = base + (dir == 0 ? 0 : 3 * 64); f32x2* q4 = base + (dir == 0 ? 4 * 64 : 67 * 64);
        float cr = 0.f, ci = 0.f;
        f32x2* pl = q0; f32x2* ps = q0;
#pragma unroll
        for (int hb = 0; hb < 2; ++hb) {
            f32x2 v[34];
#pragma unroll
            for (int j = 0; j < 34; ++j) { if (34 * hb + j == 4) pl = q4; v[j] = *pl; pl += step; asm volatile("" : "+v"(pl)); }
#pragma unroll
            for (int j = 0; j < 34; ++j) { if (34 * hb + j == 4) ps = q4; *ps = (f32x2){cr, ci}; ps += step; asm volatile("" : "+v"(ps));
                const float nr = fmaf(lt.x, cr, fmaf(-lt.y, ci, v[j].x)), ni = fmaf(lt.x, ci, fmaf(lt.y, cr, v[j].y)); cr = nr; ci = ni; }
        }
    }
}
__device__ __forceinline__ void s3_unit(KArgs a, LAS unsigned char* wl, int wu, int lane) {
    const int c = wu % 68, bg = wu / 68, g = bg & 31, b = bg >> 5, p = lane, fr = lane & 15, gq = lane >> 4;
    LAS unsigned char* bu0 = wl; LAS unsigned char* bu1 = wl + 4096; LAS unsigned char* xs0 = wl + 8192; LAS unsigned char* xs1 = wl + 12288;
    const int rowbase = s5_row0(b, c);
    const f32x2 lb0 = ((const f32x2*)(a->ws + WS_LB))[g * 64 + p], lb1 = ((const f32x2*)(a->ws + WS_LB))[(32 + g) * 64 + p];
    const f32x2 lrr0 = (f32x2){lb0.x, lb0.x}, lmi0 = (f32x2){-lb0.y, lb0.y}, lrr1 = (f32x2){lb1.x, lb1.x}, lmi1 = (f32x2){-lb1.y, lb1.y};
    bf16x8 bbm0[8], bbm1[8], cm0[4], cm1[4];
#pragma unroll
    for (int j = 0; j < 8; ++j) { bbm0[j] = (bf16x8){0, 0, 0, 0, 0, 0, 0, 0}; bbm1[j] = bbm0[j];
        if (gq < 2) { bbm0[j] = *(const bf16x8*)((const bf16*)(a->ws + WS_BBM) + ((size_t)g * 128 + 16 * j + fr) * 16 + 8 * gq);
                      bbm1[j] = *(const bf16x8*)((const bf16*)(a->ws + WS_BBM) + ((size_t)(32 + g) * 128 + 16 * j + fr) * 16 + 8 * gq); } }
#pragma unroll
    for (int ks = 0; ks < 4; ++ks) { cm0[ks] = *(const bf16x8*)((const bf16*)(a->ws + WS_CM) + (size_t)(g * 16 + fr) * 128 + 32 * ks + 8 * gq);
                                     cm1[ks] = *(const bf16x8*)((const bf16*)(a->ws + WS_CM) + (size_t)((32 + g) * 16 + fr) * 128 + 32 * ks + 8 * gq); }
    const bf16* ub = (const bf16*)(a->ws + WS_U) + (size_t)(rowbase + fr) * 512 + 16 * g + 8 * (gq & 1);
    bf16x8 uf[4];
#pragma unroll
    for (int t4 = 0; t4 < 4; ++t4) { uf[t4] = (bf16x8){0, 0, 0, 0, 0, 0, 0, 0}; if (gq < 2) uf[t4] = *(const bf16x8*)(ub + (size_t)(16 * t4) * 512); }
    f32x2 xv0 = ((const f32x2*)(a->ws + WS_SF))[((size_t)((b * 32 + g) * 2 + 0) * 68 + c) * 64 + p];
    f32x2 xv1 = ((const f32x2*)(a->ws + WS_SF))[((size_t)((b * 32 + g) * 2 + 1) * 68 + c) * 64 + p];
    f32x4 acc[4];
#pragma unroll
    for (int i = 0; i < 4; ++i) acc[i] = (f32x4){0.f, 0.f, 0.f, 0.f};
#pragma unroll
    for (int blk = 0; blk < 4; ++blk) {
        s5_bu_block(bbm0, uf[blk], bu0, fr, gq);
        s5_bu_block(bbm1, uf[3 - blk], bu1, fr, gq);
#pragma unroll
        for (int i = 0; i < 16; ++i) {
            const int i1 = 15 - i;
            const unsigned o0 = i * 256 + (((p >> 2) ^ i) * 16) + (p & 3) * 4, o1 = i1 * 256 + (((p >> 2) ^ i1) * 16) + (p & 3) * 4;
            const unsigned w0 = *(const LAS unsigned*)(bu0 + o0), w1 = *(const LAS unsigned*)(bu1 + o1);
            { const f32x2 xs_ = (f32x2){xv0.y, xv0.x}; xv0 = lrr0 * xv0 + (lmi0 * xs_ + (f32x2){blo(w0), bhi(w0)}); }
            { const f32x2 xs_ = (f32x2){xv1.y, xv1.x}; xv1 = lrr1 * xv1 + (lmi1 * xs_ + (f32x2){blo(w1), bhi(w1)}); }
            *(LAS unsigned*)(xs0 + o0) = cvtpk(xv0.x, xv0.y); *(LAS unsigned*)(xs1 + o1) = cvtpk(xv1.x, xv1.y);
        }
        asm volatile("s_waitcnt lgkmcnt(0)" ::: "memory");
        f32x4 d0 = acc[blk], d1 = acc[3 - blk];
        if (blk == 3 - blk) { }
#pragma unroll
        for (int ks = 0; ks < 4; ++ks) { const unsigned xo = fr * 256 + (((4 * ks + gq) ^ fr) * 16);
            d0 = MFMA16(cm0[ks], *(const LAS bf16x8*)(xs0 + xo), d0); d1 = MFMA16(cm1[ks], *(const LAS bf16x8*)(xs1 + xo), d1); }
        acc[blk] = d0; acc[3 - blk] = d1;
        asm volatile("s_waitcnt lgkmcnt(0)" ::: "memory");
    }
    const f32x4 dsk = *(const f32x4*)(a->in[I_S5D] + 16 * g + 4 * gq);
    bf16* YS = (bf16*)(a->ws + WS_YS);
#pragma unroll
    for (int T4 = 0; T4 < 4; ++T4) {
        const int t = 16 * T4 + fr; const v2u uw = *(const v2u*)((const bf16*)(a->ws + WS_U) + (size_t)(rowbase + t) * 512 + 16 * g + 4 * gq);
        const f32x4 y = acc[T4] + dsk * (f32x4){blo(uw.x), bhi(uw.x), blo(uw.y), bhi(uw.y)};
        *(v2u*)(YS + (size_t)(rowbase + t) * 512 + 16 * g + 4 * gq) = (v2u){cvtpk(gelu_tanh(y[0]), gelu_tanh(y[1])), cvtpk(gelu_tanh(y[2]), gelu_tanh(y[3]))};
    }
}

constexpr int NA_KSTR = 144, NA_VSTR = 976, NA_VCSTR = 528;
constexpr int NA_VOFF = 480 * NA_KSTR;
constexpr int NA_VCOFF = 256 * NA_KSTR;
constexpr int NA_RPBOFF = NA_VOFF + 64 * NA_VSTR;
__device__ __forceinline__ void na_unit(KArgs a, LAS unsigned char* lds, int unit) {
    const int tid = opaque_tid(), lane = tid & 63, wave = __builtin_amdgcn_readfirstlane(tid >> 6);
    const int rb = unit & 7, cb = (unit >> 3) & 3, h = (unit >> 5) & 15, b = unit >> 9, fr = lane & 15, g = lane >> 4;
    const bf16* QK = (const bf16*)(a->ws + WS_QK); const bf16* VT = (const bf16*)(a->ws + WS_VT); bf16* AO = (bf16*)(a->ws + WS_XN);
    const int kcol0 = min(max(16 * cb - 8, 0), 32);
    const int Rlo = min(max(8 * rb - 4, 0), 56), nrows = min(max(8 * rb + 3, 0), 56) + 8 - Rlo;
    const int r = 8 * rb + wave, r0 = min(max(r - 4, 0), 56);
    {
        const bf16* kg = QK + (size_t)(b * SEQ + Rlo * 64 + kcol0) * 2048 + 1024 + 64 * h;
        { v4u t[8]; const int lim = nrows * 256;
#pragma unroll
          for (int it = 0; it < 8; ++it) { const int n = tid + NTHREADS * it, key = n >> 3, ch = n & 7, kr = key >> 5, co = key & 31; if (n < lim) t[it] = *(const v4u*)(kg + (size_t)(kr * 64 + co) * 2048 + 8 * ch); }
#pragma unroll
          for (int it = 0; it < 8; ++it) { const int n = tid + NTHREADS * it, key = n >> 3, ch = n & 7; if (n < lim) *(LAS v4u*)(lds + key * NA_KSTR + ch * 16) = t[it]; } }
        const bf16* vg = VT + (size_t)(64 * h) * MT + b * SEQ + Rlo * 64 + kcol0;
        { v4u t[8];
#pragma unroll
          for (int it = 0; it < 8; ++it) { const int n = tid + NTHREADS * it, d = n / 60, rem = n - d * 60, kr = rem >> 2, c4 = rem & 3; if (n < 64 * 60 && kr < nrows) t[it] = *(const v4u*)(vg + (size_t)d * MT + kr * 64 + 8 * c4); }
#pragma unroll
          for (int it = 0; it < 8; ++it) { const int n = tid + NTHREADS * it, d = n / 60, rem = n - d * 60, kr = rem >> 2, c4 = rem & 3; if (n < 64 * 60 && kr < nrows) *(LAS v4u*)(lds + NA_VOFF + d * NA_VSTR + (kr * 32 + 8 * c4) * 2) = t[it]; } }
    }
    const int tq0 = b * SEQ + r * 64 + 16 * cb;
    const bf16* qb = QK + (size_t)tq0 * 2048 + 64 * h;
    const unsigned qoff = (unsigned)(fr * 2048 + 8 * g);
    bf16x8 qf[2]; qf[0] = *(const bf16x8*)(qb + qoff); qf[1] = *(const bf16x8*)(qb + qoff + 32);
    const int koffl = (8 * (fr >> 2) + (fr & 3)) * NA_KSTR + 16 * g;
    const int cq = 16 * cb + fr, ws = min(max(cq - 8, 0), 48);
    const int vbase = kcol0 + 8 * g - ws, ibase = kcol0 + 8 * g - cq + 15;
    LAS float* rpbl = (LAS float*)(lds + NA_RPBOFF);
    if (tid < 15 * 31) rpbl[tid] = a->in[I_RPB][(size_t)h * 15 * 31 + tid];
    f32x4 o[4];
#pragma unroll
    for (int dt = 0; dt < 4; ++dt) o[dt] = (f32x4){0.f, 0.f, 0.f, 0.f};
    float mrun = -1e30f, lsum = 0.f;
    __syncthreads();
#pragma unroll 1
    for (int half = 0; half < 2; ++half) {
        if (half == 1) {
            __syncthreads();
            const bf16* kg = QK + (size_t)(ML + b * CTXL) * 2048 + 1024 + 64 * h;
            v4u t[8];
#pragma unroll
            for (int it = 0; it < 4; ++it) { const int n = tid + NTHREADS * it, key = n >> 3, ch = n & 7; t[it] = *(const v4u*)(kg + (size_t)key * 2048 + 8 * ch); }
            const bf16* vg = VT + (size_t)(64 * h) * MT + ML + b * CTXL;
#pragma unroll
            for (int it = 0; it < 4; ++it) { const int n = tid + NTHREADS * it, d = n >> 5, c = n & 31; t[4 + it] = *(const v4u*)(vg + (size_t)d * MT + 8 * c); }
#pragma unroll
            for (int it = 0; it < 4; ++it) { const int n = tid + NTHREADS * it, key = n >> 3, ch = n & 7; *(LAS v4u*)(lds + key * NA_KSTR + ch * 16) = t[it]; }
#pragma unroll
            for (int it = 0; it < 4; ++it) { const int n = tid + NTHREADS * it, d = n >> 5, c = n & 31; *(LAS v4u*)(lds + NA_VCOFF + d * NA_VCSTR + c * 16) = t[4 + it]; }
            __syncthreads();
        }
        const int kbase = half == 0 ? (r0 - Rlo) * 32 : 0;
        const LAS unsigned char* kl = lds + kbase * NA_KSTR + koffl;
        const LAS unsigned char* vl = half == 0 ? lds + NA_VOFF + fr * NA_VSTR + (kbase + 8 * g) * 2 : lds + NA_VCOFF + fr * NA_VCSTR + (8 * g) * 2;
        const int vstr16 = 16 * (half == 0 ? NA_VSTR : NA_VCSTR);
#pragma unroll 1
        for (int qt = 0; qt < 2; ++qt) {
            f32x4 sc[4][2];
#pragma unroll
            for (int ii = 0; ii < 4; ++ii) {
                const int i = 4 * qt + ii;
                const LAS unsigned char* kp = kl + i * 32 * NA_KSTR;
                f32x4 sa = (f32x4){0.f, 0.f, 0.f, 0.f}, sb = sa;
                sa = MFMA16(*(const LAS bf16x8*)kp, qf[0], sa); sa = MFMA16(*(const LAS bf16x8*)(kp + 64), qf[1], sa);
                sb = MFMA16(*(const LAS bf16x8*)(kp + 4 * NA_KSTR), qf[0], sb); sb = MFMA16(*(const LAS bf16x8*)(kp + 4 * NA_KSTR + 64), qf[1], sb);
                if (half == 0) {
                    const LAS float* bp = rpbl + (r0 + i - r + 7) * 31;
#pragma unroll
                    for (int rr = 0; rr < 4; ++rr) { const float b0 = bp[min(max(ibase + rr, 0), 30)], b1 = bp[min(max(ibase + 4 + rr, 0), 30)];
                        sa[rr] = (unsigned)(vbase + rr) < 16u ? sa[rr] + b0 : -1e30f; sb[rr] = (unsigned)(vbase + 4 + rr) < 16u ? sb[rr] + b1 : -1e30f; }
                }
                sc[ii][0] = sa; sc[ii][1] = sb;
            }
            float mx = -1e30f;
#pragma unroll
            for (int ii = 0; ii < 4; ++ii)
#pragma unroll
                for (int t = 0; t < 2; ++t) mx = fmaxf(mx, fmaxf(fmaxf(sc[ii][t][0], sc[ii][t][1]), fmaxf(sc[ii][t][2], sc[ii][t][3])));
            mx = fmaxf(mx, __shfl_xor(mx, 16)); mx = fmaxf(mx, __shfl_xor(mx, 32));
            const float mnew = fmaxf(mrun, mx);
            const float resc = __builtin_amdgcn_exp2f((mrun - mnew) * 1.4426950408889634f);
            mrun = mnew; lsum *= resc;
#pragma unroll
            for (int dt = 0; dt < 4; ++dt) o[dt] = o[dt] * resc;
            const float mneg = -mnew * 1.4426950408889634f;
            float ls = 0.f;
#pragma unroll
            for (int ii = 0; ii < 4; ++ii)
#pragma unroll
                for (int t = 0; t < 2; ++t)
#pragma unroll
                    for (int rr = 0; rr < 4; ++rr) { const float pv = __builtin_amdgcn_exp2f(fmaf(sc[ii][t][rr], 1.4426950408889634f, mneg)); sc[ii][t][rr] = pv; ls += pv; }
            lsum += ls;
#pragma unroll
            for (int ii = 0; ii < 4; ++ii) {
                const bf16x8 pf = pack8(sc[ii][0], sc[ii][1]);
#pragma unroll
                for (int dt = 0; dt < 4; ++dt) o[dt] = MFMA16(*(const LAS bf16x8*)(vl + dt * vstr16 + (4 * qt + ii) * 64), pf, o[dt]);
            }
        }
    }
    lsum += __shfl_xor(lsum, 16); lsum += __shfl_xor(lsum, 32);
    const float rl = 1.0f / lsum;
    bf16* ob = AO + (size_t)tq0 * DM + 64 * h;
#pragma unroll
    for (int dt = 0; dt < 4; ++dt)
        *(v2u*)(ob + (unsigned)(fr * DM + 16 * dt + 4 * g)) = (v2u){cvtpk(o[dt][0] * rl, o[dt][1] * rl), cvtpk(o[dt][2] * rl, o[dt][3] * rl)};
    __syncthreads();
}

#ifndef STAGE
#define STAGE 6
#endif
#define GSYNC() xcd_barrier(bar)
#ifndef REP_A
#define REP_A 1
#endif
#ifndef REP_B
#define REP_B 1
#endif
#ifndef REP_MODE
#define REP_MODE 0
#endif
#ifndef REP_G1
#define REP_G1 1
#endif
#ifndef REP_G2
#define REP_G2 1
#endif
#ifndef REP_P0
#define REP_P0 1
#endif
#ifndef REP_NORM
#define REP_NORM 1
#endif
#ifndef REP_WIN
#define REP_WIN 1
#endif
#ifndef REP_GLU
#define REP_GLU 1
#endif
#ifndef REP_QKVT
#define REP_QKVT 1
#endif
#ifndef REP_WOUT
#define REP_WOUT 1
#endif
#ifndef REP_WO
#define REP_WO 1
#endif
#ifndef REP_N
#define REP_N 1
#endif

__device__ __forceinline__ int s_deal(int c, int j, int G, int nS, int n_lo) {
    if (G != 256) { const int v = c + j * G; return v < nS ? v : -1; }
    if (c < 32) return j < n_lo ? c * n_lo + j : -1;
    const int v = 32 * n_lo + (c - 32) + 224 * j; return v < nS ? v : -1;
}
template <class Epi>
__device__ __forceinline__ void run_gemm(LAS unsigned char* lds, const bf16* A, const bf16* Bt, int M, int N, int K, int G, const Epi& E) {
    pg8::Gemm g{A, Bt, M, N, K, A, Bt}; pg8::StaticOrder S; S.init(M, N, G, (int)blockIdx.x, K);
    pg8::gemm_phase<Epi, pg8::StaticOrder, true, true>(lds, g, S, E);
}
template <class Epi>
__device__ __forceinline__ void run_gemm_splitctx(LAS unsigned char* lds, const bf16* A, const bf16* Bt, int N, int K, int nsplit, int G, const Epi& E) {
    pg8::Gemm g{A, Bt, MT, N, K, A, Bt}; pg8::SplitCtxOrder S; S.init(ML, MC, N, K, G, (int)blockIdx.x, nsplit);
    pg8::gemm_phase<Epi, pg8::SplitCtxOrder, true, true>(lds, g, S, E);
}

__device__ __forceinline__ void ffn_block(KArgs a, LAS unsigned char* lds, const XcdBarrier& bar, int G, int layer, int f, const float* rin_lat, const float* rin_ctx, int nrows, const float* part_in, int npart_in) {
    const float* MODL = (const float*)(a->ws + WS_MOD) + (size_t)layer * 5 * MODW;
    float* hl = a->out; float* hc = (float*)(a->ws + WS_HCTX);
    bf16* XN = (bf16*)(a->ws + WS_XN); bf16* HID = (bf16*)(a->ws + WS_HID);
    const bf16* W1b = (const bf16*)(a->ws + WS_W1) + (size_t)(layer * 2 + f) * 2 * FF * DM;
    const bf16* W2b = (const bf16*)(a->ws + WS_W2) + (size_t)(layer * 2 + f) * DM * FF;
    for (int rep = 1; rep < REP_NORM; ++rep) { norm_phase(rin_lat, rin_ctx, XN, a->in[I_NORMG] + (size_t)(layer * 3 + (f ? 2 : 0)) * DM, MODL, f ? 6 : 0, nrows, G, nullptr, 0, hc); GSYNC(); }
    norm_phase(rin_lat, rin_ctx, XN, a->in[I_NORMG] + (size_t)(layer * 3 + (f ? 2 : 0)) * DM, MODL, f ? 6 : 0, nrows, G, part_in, npart_in, hc);
    GSYNC();
    for (int rep = 0; rep < REP_G1; ++rep) {
    { pg8::EpiSwiglu E{HID, FF}; run_gemm(lds, XN, W1b, nrows, 2 * FF, DM, G, E); }
    GSYNC(); }
    for (int rep = 0; rep < REP_G2; ++rep) {
    { pg8::EpiResid E{rin_lat, rin_ctx, hl, hc, MODL + (f ? 8 : 2) * DM, (float*)(a->ws + WS_PARTF), rep == REP_G2 - 1 ? 0.5f : 0.0f};
      if (nrows == MT) run_gemm_splitctx(lds, HID, W2b, DM, FF, 11, G, E); else run_gemm(lds, HID, W2b, nrows, DM, FF, G, E); }
    GSYNC(); }
}

__global__ void __launch_bounds__(NTHREADS, 2) fwd_megakernel(Args a_unused) {
#define a kargs()
    extern __shared__ __attribute__((aligned(16))) unsigned char lds_raw[];
    LAS unsigned char* lds = (LAS unsigned char*)lds_raw;
    const int G = gridDim.x;
#define LANEWAVE() const int tid = opaque_tid(), lane = tid & 63, wave = __builtin_amdgcn_readfirstlane(tid >> 6)
#define hl (a->out)
#define hc ((float*)(a->ws + WS_HCTX))
#define XN ((bf16*)(a->ws + WS_XN))
#define MOD0 ((const float*)(a->ws + WS_MOD))
#define MOD1 (MOD0 + 5 * MODW)

    if (threadIdx.x < 8) ((LAS unsigned*)(lds + BARLDS_OFF))[threadIdx.x] = 0u;
    __syncthreads();
    const XcdBarrier bar = xcd_barrier_post((unsigned*)(a->ws + WS_BAR), (volatile LAS unsigned*)(lds + BARLDS_OFF));

#ifndef REP_P0_PARTS
#define REP_P0_PARTS 7
#endif
    for (int rep = 1; rep < REP_P0; ++rep) { p0_prologue(a, lds, G, REP_P0_PARTS); __syncthreads(); }
    p0_prologue(a, lds, G);
    xcd_barrier_census(bar);
    GSYNC();

    if (STAGE == 0) {
        const int gtid = blockIdx.x * NTHREADS + opaque_tid(), GT = G * NTHREADS;
        for (int i = gtid; i < ML * DM / 4; i += GT) ((f32x4*)hl)[i] = ((const f32x4*)a->in[I_X])[i];
        GSYNC();
    }
    if (STAGE >= 1) ffn_block(a, lds, bar, G, 0, 0, a->in[I_X], hc, MT, nullptr, 0);
    if (STAGE >= 2) {
        norm_phase(hl, hc, XN, a->in[I_NORMG] + 1 * DM, MOD0, 3, MT, G, (const float*)(a->ws + WS_PARTF), 11, hc);
        GSYNC();
        for (int rep = 0; rep < REP_WIN; ++rep) {
        { pg8::EpiWin E{(bf16*)(a->ws + WS_QKVG), (bf16*)(a->ws + WS_U), (const float*)(a->ws + WS_ROPE)}; run_gemm(lds, XN, (const bf16*)(a->ws + WS_WIN), MT, 2560, DM, G, E); }
        GSYNC(); }
        for (int rep = 0; rep < REP_A; ++rep) {
        { LANEWAVE(); if (!(rep > 0 && REP_MODE == 2)) for (int u = blockIdx.x; u < 544; u += G) r1_unit(a, lds, u);
          if (!(rep > 0 && REP_MODE == 1)) for (int j = 0; ; ++j) { const int v = s_deal((int)blockIdx.x, j, G, 1088, 3); if (v < 0) break; s1_unit(a, lds + wave * S5_WLDS, v * 8 + wave, lane); } }
        GSYNC(); }
        r2_items(a, G); s2_items(a, G);
        GSYNC();
        for (int rep = 0; rep < REP_B; ++rep) {
        { LANEWAVE(); if (!(rep > 0 && REP_MODE == 2)) for (int u = blockIdx.x; u < 544; u += G) r3_unit(a, lds, u);
          if (!(rep > 0 && REP_MODE == 1)) for (int j = 0; ; ++j) { const int v = s_deal((int)blockIdx.x, j, G, 1088, 3); if (v < 0) break; s3_unit(a, lds + wave * S5_WLDS, v * 8 + wave, lane); } }
        GSYNC(); }
        for (int rep = 0; rep < REP_GLU; ++rep) {
        { pg8::EpiGlu E{(const bf16*)(a->ws + WS_YS), XN, a->in[I_GLUB]}; run_gemm(lds, (const bf16*)(a->ws + WS_YS), (const bf16*)(a->ws + WS_GLU), MT, 512, 512, G, E); }
        GSYNC(); }
        for (int rep = 0; rep < REP_WOUT; ++rep) {
        { pg8::EpiResid E{hl, hc, hl, hc, MOD0 + 5 * DM, (float*)(a->ws + WS_PARTM), rep == REP_WOUT - 1 ? 1.0f : 0.0f}; run_gemm_splitctx(lds, XN, (const bf16*)(a->ws + WS_WOUT), DM, DM, 8, G, E); }
        GSYNC(); }
    }
    if (STAGE >= 3) ffn_block(a, lds, bar, G, 0, 1, hl, hc, MT, (const float*)(a->ws + WS_PARTM), 8);
    if (STAGE >= 4) ffn_block(a, lds, bar, G, 1, 0, hl, hc, MT, (const float*)(a->ws + WS_PARTF), 11);
    if (STAGE >= 5) {
        norm_phase(hl, hc, XN, a->in[I_NORMG] + 4 * DM, MOD1, 3, MT, G, (const float*)(a->ws + WS_PARTF), 11, hc);
        GSYNC();
        for (int rep = 0; rep < REP_QKVT; ++rep) {
        { pg8::EpiQkVt E{(bf16*)(a->ws + WS_QK), (bf16*)(a->ws + WS_VT)};
          pg8::Gemm g{XN, (const bf16*)(a->ws + WS_WQKV), MT, 2048, DM, (const bf16*)(a->ws + WS_WQKV) + (size_t)2048 * DM, XN};
          pg8::QkVtOrder S; S.init(DM, G, (int)blockIdx.x);
          pg8::gemm_phase<pg8::EpiQkVt, pg8::QkVtOrder, true, true>(lds, g, S, E); }
        GSYNC(); }
        for (int rep = 0; rep < REP_N; ++rep) {
        for (int u = blockIdx.x; u < 2048; u += G) na_unit(a, lds, u);
        GSYNC(); }
        for (int rep = 0; rep < REP_WO; ++rep) {
        { pg8::EpiResid E{hl, hc, hl, hc, MOD1 + 5 * DM, nullptr, rep == REP_WO - 1 ? 1.0f : 0.0f}; run_gemm(lds, XN, (const bf16*)(a->ws + WS_WO), ML, DM, DM, G, E); }
        GSYNC(); }
    }
    if (STAGE >= 6) ffn_block(a, lds, bar, G, 1, 1, hl, hc, ML, nullptr, 0);
    final_norm_phase(a->out, a->in[I_FINALG], G);
#undef a
#undef hl
#undef hc
#undef XN
#undef MOD0
#undef MOD1
}

extern "C" void kernel_launch(void* const* d_in, const int* in_sizes, int n_in, void* d_out, int out_size, void* d_ws, size_t ws_size, hipStream_t stream) {
    static int grid = 0;
    if (grid == 0) {
        if (n_in != 26 || out_size != ML * DM || ws_size < WS_END) { fprintf(stderr, "kernel_launch: unexpected problem (n_in %d, out %d, ws %zu)\n", n_in, out_size, ws_size); grid = -1; return; }
        int dev = 0, cus = 0, per_cu = 0;
        if (hipGetDevice(&dev) != hipSuccess || hipDeviceGetAttribute(&cus, hipDeviceAttributeMultiprocessorCount, dev) != hipSuccess) { grid = -1; return; }
        if (hipFuncSetAttribute((const void*)fwd_megakernel, hipFuncAttributeMaxDynamicSharedMemorySize, LDS_BYTES) != hipSuccess) { fprintf(stderr, "kernel_launch: hipFuncSetAttribute failed\n"); grid = -1; return; }
        if (hipOccupancyMaxActiveBlocksPerMultiprocessor(&per_cu, (const void*)fwd_megakernel, NTHREADS, LDS_BYTES) != hipSuccess || per_cu < 1) { fprintf(stderr, "kernel_launch: occupancy query failed (%d)\n", per_cu); (void)hipGetLastError(); grid = -1; return; }
        grid = cus * per_cu;
    }
    if (grid < 0) return;
    if (hipMemsetAsync((char*)d_ws + WS_BAR, 0, 16384, stream) != hipSuccess) { fprintf(stderr, "kernel_launch: memset failed\n"); return; }
    Args a{};
    for (int i = 0; i < 26; ++i) a.in[i] = (const float*)d_in[i];
    a.out = (float*)d_out; a.ws = (unsigned char*)d_ws; a.probe = 0; a.pad = 0;
    void* args[] = {&a};
    hipError_t e = hipLaunchCooperativeKernel((const void*)fwd_megakernel, dim3(grid), dim3(NTHREADS), args, LDS_BYTES, stream);
    if (e != hipSuccess) fprintf(stderr, "kernel_launch: cooperative launch failed: %s (grid %d)\n", hipGetErrorString(e), grid);
}
```
